# Optimizing an MI355X kernel written in HIP

```python
import math
import jax, jax.numpy as jnp
from jax import lax
import numpy as np

D_MODEL = 2048
BATCH = 4
SEQ = 2048
DEPTH = 1
DEC_BATCH = 8
DEC_SEQ = 8
PAST_LEN = 16384
PAGE_SIZE = 128

D_MIX = D_MODEL
D_A = D_MIX // 2
D_B = D_MIX - D_A
HEAD_DIM_A = 128
N_HEADS_A = D_A // HEAD_DIM_A
HEAD_DIM_B = 128
N_HEADS_B = D_B // HEAD_DIM_B
D_IN = 4 * D_A + 3 * D_B
SPLITS = [D_A, 2 * D_A, 3 * D_A, 4 * D_A, 4 * D_A + D_B, 4 * D_A + 2 * D_B]
D_FF = 5632
GLA_CHUNK = 32
Q_BLOCK = 128
N_MOD = 9
SB_BIAS_INIT = -9.0
EPS = 1e-6

kernel_name = "hymba_hgrn2_stickbreak_macaron_adaln_step"


def rmsnorm(x, g):
    xf = x.astype(jnp.float32)
    y = xf * lax.rsqrt(jnp.mean(xf * xf, axis=-1, keepdims=True) + EPS)
    return (y * g.astype(jnp.float32)).astype(x.dtype)


def head_rmsnorm(o, g):
    of = o.astype(jnp.float32)
    y = of * lax.rsqrt(jnp.mean(of * of, axis=-1, keepdims=True) + EPS)
    return y.reshape(o.shape[0], o.shape[1], -1) * g.astype(jnp.float32)


def modulate(h, shift, scale):
    return h * (1.0 + scale[:, None, :]) + shift[:, None, :]


def swiglu(h, w_gate, w_up, w_down):
    return (jax.nn.silu(h @ w_gate) * (h @ w_up)) @ w_down


def forget_lower_bounds(lb_logits):
    logits = jnp.concatenate([lb_logits.astype(jnp.float32), jnp.zeros((1, lb_logits.shape[1]), jnp.float32)], axis=0)
    return jnp.cumsum(jax.nn.softmax(logits, axis=0), axis=0)[:lb_logits.shape[0]]


def gated_linear_recurrence(q, k, v, logf, s0, chunk):
    B, T, H, DK = q.shape
    DV = v.shape[-1]
    n = T // chunk

    def to_chunks(a):
        return a.reshape(B, n, chunk, H, a.shape[-1]).transpose(1, 0, 2, 3, 4)

    causal = jnp.tril(jnp.ones((chunk, chunk), dtype=bool))

    def step(s, xs):
        qi, ki, vi, fi = xs
        b = jnp.cumsum(fi, axis=1)
        b_last = b[:, -1:]
        q_dec = qi * jnp.exp(b)
        k_inv = ki * jnp.exp(-b)
        k_end = ki * jnp.exp(b_last - b)
        a = jnp.einsum('bthk,bshk->bhts', q_dec, k_inv)
        a = jnp.where(causal, a, 0.0)
        o = jnp.einsum('bhts,bshv->bthv', a, vi) + jnp.einsum('bthk,bhkv->bthv', q_dec, s)
        s = jnp.exp(b_last[:, 0])[..., None] * s + jnp.einsum('bshk,bshv->bhkv', k_end, vi)
        return s, o

    s_fin, o = lax.scan(step, s0, (to_chunks(q), to_chunks(k), to_chunks(v), to_chunks(logf)))
    return o.transpose(1, 0, 2, 3, 4).reshape(B, T, H, DV), s_fin


def stick_breaking_block(q, k_segs, v_segs, q_pos, k_pos, bias):
    qf = q.astype(jnp.float32) * (HEAD_DIM_B ** -0.5)
    z = jnp.concatenate([jnp.einsum('bqhd,bkhd->bhqk', qf, kk.astype(jnp.float32)) for kk in k_segs], axis=-1)
    z = z + bias.astype(jnp.float32)[None, :, None, None]
    visible = k_pos[None, :] < q_pos[:, None]
    log1mb = jnp.where(visible, jax.nn.log_sigmoid(-z), 0.0)
    rev = lax.cumsum(log1mb, axis=3, reverse=True)
    a = jnp.exp(jnp.where(visible, z + rev, -jnp.inf))
    out = 0.0
    off = 0
    for vv in v_segs:
        L = vv.shape[1]
        out = out + jnp.einsum('bhqk,bkhd->bqhd', a[..., off:off + L], vv.astype(jnp.float32))
        off += L
    return out


def stick_breaking(q, k, v, k_past, v_past, bias):
    Tq = q.shape[1]
    past = 0 if k_past is None else k_past.shape[1]
    pos = jnp.arange(past + Tq, dtype=jnp.int32)
    outs = []
    for start in range(0, Tq, Q_BLOCK):
        end = min(start + Q_BLOCK, Tq)
        k_segs = ([] if k_past is None else [k_past]) + [k[:, :end]]
        v_segs = ([] if v_past is None else [v_past]) + [v[:, :end]]
        outs.append(stick_breaking_block(q[:, start:end], k_segs, v_segs,
                                         pos[past + start:past + end], pos[:past + end], bias))
    return jnp.concatenate(outs, axis=1)


def token_mixer(h, lb, s0, k_past, v_past, chunk, w_in, g_out_a, g_out_b, b_sb, w_out):
    B, T, _ = h.shape
    proj = h @ w_in
    q_a, f_a, i_a, g_a, q_b, k_b, v_b = jnp.split(proj, SPLITS, axis=-1)

    def heads_a(t):
        return t.reshape(B, T, N_HEADS_A, HEAD_DIM_A)

    def heads_b(t):
        return t.reshape(B, T, N_HEADS_B, HEAD_DIM_B)

    f = lb + (1.0 - lb) * jax.nn.sigmoid(f_a.astype(jnp.float32))
    o_a, s_fin = gated_linear_recurrence(
        heads_a(q_a.astype(jnp.float32)) * (HEAD_DIM_A ** -0.5),
        heads_a(1.0 - f), heads_a(i_a.astype(jnp.float32)), heads_a(jnp.log(f)),
        s0.astype(jnp.float32), chunk)
    o_a = head_rmsnorm(o_a, g_out_a).astype(h.dtype) * jax.nn.silu(g_a)

    kh, vh = heads_b(k_b), heads_b(v_b)
    o_b = head_rmsnorm(stick_breaking(heads_b(q_b), kh, vh, k_past, v_past, b_sb), g_out_b).astype(h.dtype)

    out = jnp.concatenate([o_a, o_b], axis=-1) @ w_out
    return out, s_fin.astype(s0.dtype), kh, vh


def decoder_layer(x, c, lb, s0, k_past, v_past, chunk,
                  norm_ffn1, norm_mix, norm_ffn2, w_mod, b_mod,
                  w_ffn1_gate, w_ffn1_up, w_ffn1_down,
                  w_in, g_out_a, g_out_b, b_sb, w_out,
                  w_ffn2_gate, w_ffn2_up, w_ffn2_down):
    mod = jax.nn.silu(c) @ w_mod + b_mod
    sh1, sc1, ga1, sh2, sc2, ga2, sh3, sc3, ga3 = jnp.split(mod, N_MOD, axis=-1)
    h = modulate(rmsnorm(x, norm_ffn1), sh1, sc1)
    x = x + 0.5 * ga1[:, None, :] * swiglu(h, w_ffn1_gate, w_ffn1_up, w_ffn1_down)
    h = modulate(rmsnorm(x, norm_mix), sh2, sc2)
    m, s_fin, k_new, v_new = token_mixer(h, lb, s0, k_past, v_past, chunk, w_in, g_out_a, g_out_b, b_sb, w_out)
    x = x + ga2[:, None, :] * m
    h = modulate(rmsnorm(x, norm_ffn2), sh3, sc3)
    x = x + 0.5 * ga3[:, None, :] * swiglu(h, w_ffn2_gate, w_ffn2_up, w_ffn2_down)
    return x, s_fin, k_new, v_new


def final_norm(x, c, norm_final, w_final_mod, b_final_mod):
    shift, scale = jnp.split(jax.nn.silu(c) @ w_final_mod + b_final_mod, 2, axis=-1)
    return modulate(rmsnorm(x, norm_final), shift, scale)


def setup_inputs(seed: int = 0) -> dict:
    key = jax.random.key(seed)
    it = iter(jax.random.split(key, 40))

    def nrm(shape, std):
        return std * jax.random.normal(next(it), shape, dtype=jnp.float32)

    n_pages = PAST_LEN // PAGE_SIZE
    n_used = DEC_BATCH * n_pages
    n_phys = n_used + max(1, n_used // 4)
    page_table = jax.random.permutation(next(it), n_phys)[:n_used].reshape(DEC_BATCH, n_pages).astype(jnp.int32)
    sd = D_MODEL ** -0.5
    return {
        "x_prompt": nrm((BATCH, SEQ, D_MODEL), 1.0),
        "x_sample": nrm((DEC_BATCH, DEC_SEQ, D_MODEL), 1.0),
        "cache_k": nrm((DEPTH, n_phys, PAGE_SIZE, N_HEADS_B, HEAD_DIM_B), 1.0),
        "cache_v": nrm((DEPTH, n_phys, PAGE_SIZE, N_HEADS_B, HEAD_DIM_B), 1.0),
        "state_hgrn": nrm((DEPTH, DEC_BATCH, N_HEADS_A, HEAD_DIM_A, HEAD_DIM_A), 0.4),
        "page_table": page_table,
        "c_prompt": nrm((BATCH, D_MODEL), 1.0),
        "c_sample": nrm((DEC_BATCH, D_MODEL), 1.0),
        "lb_logits": nrm((DEPTH, D_A), 0.1),
        "norm_ffn1": 1.0 + nrm((DEPTH, D_MODEL), 0.02),
        "norm_mix": 1.0 + nrm((DEPTH, D_MODEL), 0.02),
        "norm_ffn2": 1.0 + nrm((DEPTH, D_MODEL), 0.02),
        "w_mod": nrm((DEPTH, D_MODEL, N_MOD * D_MODEL), 0.5 * sd),
        "b_mod": nrm((DEPTH, N_MOD * D_MODEL), 0.02),
        "w_ffn1_gate": nrm((DEPTH, D_MODEL, D_FF), sd),
        "w_ffn1_up": nrm((DEPTH, D_MODEL, D_FF), sd),
        "w_ffn1_down": nrm((DEPTH, D_FF, D_MODEL), D_FF ** -0.5),
        "w_in": nrm((DEPTH, D_MODEL, D_IN), sd),
        "g_out_a": 1.0 + nrm((DEPTH, D_A), 0.02),
        "g_out_b": 1.0 + nrm((DEPTH, D_B), 0.02),
        "b_sb": SB_BIAS_INIT + nrm((DEPTH, N_HEADS_B), 0.1),
        "w_out": nrm((DEPTH, D_MIX, D_MODEL), D_MIX ** -0.5),
        "w_ffn2_gate": nrm((DEPTH, D_MODEL, D_FF), sd),
        "w_ffn2_up": nrm((DEPTH, D_MODEL, D_FF), sd),
        "w_ffn2_down": nrm((DEPTH, D_FF, D_MODEL), D_FF ** -0.5),
        "norm_final": 1.0 + nrm((D_MODEL,), 0.02),
        "w_final_mod": nrm((D_MODEL, 2 * D_MODEL), 0.5 * sd),
        "b_final_mod": nrm((2 * D_MODEL,), 0.02),
    }


def reference(x_prompt, x_sample, cache_k, cache_v, state_hgrn, page_table, c_prompt, c_sample,
              lb_logits, norm_ffn1, norm_mix, norm_ffn2, w_mod, b_mod,
              w_ffn1_gate, w_ffn1_up, w_ffn1_down, w_in, g_out_a, g_out_b, b_sb, w_out,
              w_ffn2_gate, w_ffn2_up, w_ffn2_down, norm_final, w_final_mod, b_final_mod):
    lbs = forget_lower_bounds(lb_logits)
    xp, xs = x_prompt, x_sample
    n_dec = x_sample.shape[0]
    s0_prompt = jnp.zeros((x_prompt.shape[0], N_HEADS_A, HEAD_DIM_A, HEAD_DIM_A), x_prompt.dtype)
    chunk_prompt = min(GLA_CHUNK, x_prompt.shape[1])
    chunk_sample = x_sample.shape[1]
    kp_l, vp_l, sp_l, ks_l, vs_l, ss_l = [], [], [], [], [], []
    for l in range(DEPTH):
        lw = (norm_ffn1[l], norm_mix[l], norm_ffn2[l], w_mod[l], b_mod[l],
              w_ffn1_gate[l], w_ffn1_up[l], w_ffn1_down[l],
              w_in[l], g_out_a[l], g_out_b[l], b_sb[l], w_out[l],
              w_ffn2_gate[l], w_ffn2_up[l], w_ffn2_down[l])
        xp, sp, kp, vp = decoder_layer(xp, c_prompt, lbs[l], s0_prompt, None, None, chunk_prompt, *lw)
        k_past = jnp.take(cache_k[l], page_table, axis=0).reshape(n_dec, -1, N_HEADS_B, HEAD_DIM_B)
        v_past = jnp.take(cache_v[l], page_table, axis=0).reshape(n_dec, -1, N_HEADS_B, HEAD_DIM_B)
        xs, ss, ks, vs = decoder_layer(xs, c_sample, lbs[l], state_hgrn[l], k_past, v_past, chunk_sample, *lw)
        kp_l.append(kp); vp_l.append(vp); sp_l.append(sp)
        ks_l.append(ks); vs_l.append(vs); ss_l.append(ss)
    y_prompt = final_norm(xp, c_prompt, norm_final, w_final_mod, b_final_mod)
    y_sample = final_norm(xs, c_sample, norm_final, w_final_mod, b_final_mod)
    k_prompt = jnp.stack(kp_l)
    v_prompt = jnp.stack(vp_l)
    k_sample = jnp.stack(ks_l)
    v_sample = jnp.stack(vs_l)
    s_prompt = jnp.stack(sp_l)
    s_sample = jnp.stack(ss_l)
    return (y_prompt, y_sample, k_prompt, v_prompt, k_sample, v_sample, s_prompt, s_sample)
```

```cpp
#include <hip/hip_runtime.h>
#include <cstdio>
#include <cstdint>

constexpr int DM = 2048, SEQ = 2048, NB = 4, MP = NB * SEQ  , DECB = 8, DECT = 8, MS = DECB * DECT  ;
constexpr int MREAL = MP + MS  , MPAD = 8448  ;
constexpr int DFF = 5632, DIN = 7168, NMODC = 9 * DM  , NFMODC = 2 * DM;
constexpr int DA = 1024, NHEAD = 8, HD = 128, PAST = 16384, PAGE = 128, NPAGES = PAST / PAGE  ;
constexpr float EPS = 1e-6f, QSCALE = 0.08838834764831845f  ;
constexpr size_t OFF_YP = 0, OFF_YS = OFF_YP + (size_t)MP * DM, OFF_KP = OFF_YS + (size_t)MS * DM, OFF_VP = OFF_KP + (size_t)MP * DA,
                 OFF_KS = OFF_VP + (size_t)MP * DA, OFF_VS = OFF_KS + (size_t)MS * DA, OFF_SP = OFF_VS + (size_t)MS * DA,
                 OFF_SS = OFF_SP + (size_t)NB * NHEAD * HD * HD, OUT_TOTAL = OFF_SS + (size_t)DECB * NHEAD * HD * HD;
enum { I_XP = 0, I_XS, I_CK, I_CV, I_ST, I_PT, I_CP, I_CS, I_LB, I_N1, I_NM, I_N2, I_WMOD, I_BMOD, I_WG1, I_WU1, I_WD1, I_WIN, I_GOA, I_GOB, I_BSB, I_WOUT,
       I_WG2, I_WU2, I_WD2, I_NF, I_WFM, I_BFM, N_IN };
constexpr size_t MiB = 1u << 20;
constexpr size_t WS_CTL = 0, CTL_BYTES = 1 * MiB;
constexpr size_t WS_MOD = 1 * MiB;
constexpr size_t WS_FMOD = 2 * MiB;
constexpr size_t WS_LBV = 3 * MiB;
constexpr size_t WS_WGU1 = 4 * MiB, WS_WD1 = 48 * MiB, WS_WIN = 70 * MiB, WS_WOUT = 98 * MiB, WS_WGU2 = 106 * MiB, WS_WD2 = 150 * MiB;
constexpr size_t WS_XN = 172 * MiB;
constexpr size_t WS_H = 206 * MiB;
constexpr size_t WS_X = 298 * MiB;
constexpr size_t WS_QA = 364 * MiB, WS_IA = 381 * MiB, WS_GA = 398 * MiB, WS_QB = 415 * MiB, WS_KB = 432 * MiB, WS_VB = 449 * MiB;
constexpr size_t WS_LF = 466 * MiB;
constexpr size_t WS_OM = 500 * MiB;
constexpr size_t WS_PART = 534 * MiB;
constexpr size_t WS_END = 560 * MiB;

#define GAS __attribute__((address_space(1)))
#define LAS __attribute__((address_space(3)))
typedef unsigned short bf16;
typedef unsigned v4u __attribute__((ext_vector_type(4)));
typedef unsigned v2u __attribute__((ext_vector_type(2)));
typedef float f32x4 __attribute__((ext_vector_type(4)));
typedef float f32x2 __attribute__((ext_vector_type(2)));
typedef short bf16x8 __attribute__((ext_vector_type(8)));

struct Args { const void* in[N_IN]; float* out; unsigned char* ws; };

__device__ __forceinline__ unsigned f2bf(float f) { unsigned u = __builtin_bit_cast(unsigned, f); return (u + 0x7fffu + ((u >> 16) & 1u)) >> 16; }
__device__ __forceinline__ unsigned pk2(float lo, float hi) { return f2bf(lo) | (f2bf(hi) << 16); }
__device__ __forceinline__ float bf2f(unsigned short b) { return __builtin_bit_cast(float, (unsigned)b << 16); }
__device__ __forceinline__ float bflo(unsigned w) { return __builtin_bit_cast(float, w << 16); }
__device__ __forceinline__ float bfhi(unsigned w) { return __builtin_bit_cast(float, w & 0xffff0000u); }
__device__ __forceinline__ float sigmoid_f(float x) { return __builtin_amdgcn_rcpf(1.f + __expf(-x)); }
__device__ __forceinline__ float silu_f(float x) { return x * sigmoid_f(x); }
__device__ __forceinline__ int mod_row(int r) { const int s = 4 + ((r - MP) >> 3); return r < MP ? (r >> 11) : (s > 11 ? 11 : s); }
__device__ __forceinline__ float wave_sum(float v) {
#pragma unroll
    for (int o = 1; o < 64; o <<= 1) v += __shfl_xor(v, o);
    return v;
}
#define LDS_WAIT() asm volatile("s_waitcnt lgkmcnt(0)" ::: "memory")
#define VM_WAIT() asm volatile("s_waitcnt vmcnt(0)" ::: "memory")

namespace pg8 {
#define PG8_LAS __attribute__((address_space(3)))
typedef unsigned short bf16_t;
typedef short bf16x8 __attribute__((ext_vector_type(8)));
typedef float f32x4 __attribute__((ext_vector_type(4)));
typedef unsigned u32x4 __attribute__((ext_vector_type(4)));
constexpr int BM = 256, BK = 64, HALF = 128, HTB = HALF * BK * 2  , STAGE_BYTES = 8 * HTB, NXCD = 8, WGM = 8;

__host__ __device__ __forceinline__ int lds_byte(int r, int c) { const int st = (r >> 4) * 2 + (c >> 5), rr = r & 15, cc = c & 31, ob = rr * 64 + cc * 2; return st * 1024 + (ob ^ (((ob >> 9) & 1) << 5)); }
__host__ __device__ __forceinline__ void stage_rc(int b, int& R, int& C) { const int st = b / 1024, sb = b % 1024, swz = sb ^ (((sb >> 9) & 1) << 5); R = (st >> 1) * 16 + swz / 64; C = (st & 1) * 32 + (swz % 64) / 2; }
__host__ __device__ __forceinline__ int perm32(int rho) { const int n = rho >> 4, i = rho & 15; return 8 * (i >> 2) + 4 * n + (i & 3); }

struct Unit { int pm, pn; };
struct Gemm { const bf16_t* A; const bf16_t* Bt; int M, N, K; };

struct StaticOrder {
    int nM, nN, nwg, G, c;
    __host__ __device__ void init(int M, int N, int G_, int c_) { nM = M / BM; nN = N / BM; nwg = nM * nN; G = G_; c = c_; }
    __host__ __device__ bool next(int i, Unit& u) const {
        const long L = (long)i * G + c; if (L >= nwg) return false;
        int wgid = (int)L; { const int q = nwg / NXCD, r = nwg % NXCD, xcd = wgid % NXCD, off = wgid / NXCD; wgid = (xcd < r ? xcd * (q + 1) : r * (q + 1) + (xcd - r) * q) + off; }
        const int nig = WGM * nN, gid = wgid / nig, fm = gid * WGM, gsz = (nM - fm) < WGM ? (nM - fm) : WGM;
        u.pm = fm + ((wgid % nig) % gsz); u.pn = (wgid % nig) / gsz; return true;
    }
    __device__ __forceinline__ void a_ready(const Unit&) const {}
    __device__ __forceinline__ void done(const Unit&) const {}
};


__device__ __forceinline__ unsigned cvt_pk_bf16(float lo, float hi) { unsigned r; asm volatile("v_cvt_pk_bf16_f32 %0, %1, %2" : "=v"(r) : "v"(lo), "v"(hi)); return r; }

struct EpiSwiGLU {
    static constexpr bool PERM = true, AFTER_DRAIN = false;
    bf16_t* H; int ldh;
    __device__ __forceinline__ void operator()(const f32x4 (&acc)[2][2][4][2], const Unit& u, int wr, int wc, int fr, int fq) const {
        const int row0 = u.pm * BM + wr * 64 + fr, col0 = u.pn * HALF + wc * 32 + 8 * fq;
#pragma unroll
        for (int ai = 0; ai < 2; ++ai)
#pragma unroll
            for (int m = 0; m < 4; ++m) {
                const f32x4 g0 = acc[ai][0][m][0], g1 = acc[ai][0][m][1], u0 = acc[ai][1][m][0], u1 = acc[ai][1][m][1];
                float v[8];
#pragma unroll
                for (int j = 0; j < 4; ++j) { v[j] = silu_f(g0[j]) * u0[j]; v[4 + j] = silu_f(g1[j]) * u1[j]; }
                u32x4 w; w.x = cvt_pk_bf16(v[0], v[1]); w.y = cvt_pk_bf16(v[2], v[3]); w.z = cvt_pk_bf16(v[4], v[5]); w.w = cvt_pk_bf16(v[6], v[7]);
                *(u32x4*)(H + (size_t)(row0 + ai * HALF + m * 16) * ldh + col0) = w;
            }
    }
};
struct EpiResid {
    static constexpr bool PERM = false, AFTER_DRAIN = false;
    const float* xp; const float* xs; float* X; const float* gate; float scale;
    __device__ __forceinline__ void operator()(const f32x4 (&acc)[2][2][4][2], const Unit& u, int wr, int wc, int fr, int fq) const {
        const int col0 = u.pn * BM + wc * 32 + 4 * fq;
#pragma unroll
        for (int ai = 0; ai < 2; ++ai)
#pragma unroll
            for (int m = 0; m < 4; ++m) {
                const int row = u.pm * BM + ai * HALF + wr * 64 + m * 16 + fr;
                if (row < MREAL) {
                    const float* base = xp ? (row < MP ? xp + (size_t)row * DM : xs + (size_t)(row - MP) * DM) : X + (size_t)row * DM;
                    const float* gr = gate + (size_t)mod_row(row) * NMODC;
#pragma unroll
                    for (int bj = 0; bj < 2; ++bj)
#pragma unroll
                        for (int n = 0; n < 2; ++n) { const int c = col0 + bj * HALF + n * 16;
                            const f32x4 gv = *(const f32x4*)(gr + c), bv = *(const f32x4*)(base + c);
                            *(f32x4*)(X + (size_t)row * DM + c) = bv + (gv * scale) * acc[ai][bj][m][n]; }
                }
            }
    }
};
struct EpiProj {
    static constexpr bool PERM = true, AFTER_DRAIN = false;
    unsigned char* ws; float* LF; float* out; const float* lbv;
    template <int MODE> __device__ __forceinline__ void run(const f32x4 (&acc)[2][2][4][2], const Unit& u, int wr, int wc, int fr, int fq, bf16_t* B, float s, size_t offp, size_t offs) const {
        const int cb = (u.pn & 3) * BM + wc * 32 + 8 * fq;
#pragma unroll
        for (int ai = 0; ai < 2; ++ai)
#pragma unroll
            for (int m = 0; m < 4; ++m) {
                const int row = u.pm * BM + ai * HALF + wr * 64 + m * 16 + fr;
#pragma unroll
                for (int bj = 0; bj < 2; ++bj) {
                    const int c = cb + bj * HALF; const size_t o = (size_t)row * DA + c;
                    f32x4 v0 = acc[ai][bj][m][0], v1 = acc[ai][bj][m][1];
                    if constexpr (MODE == 1) {
                        const f32x4 l0 = *(const f32x4*)(lbv + c), l1 = *(const f32x4*)(lbv + c + 4);
#pragma unroll
                        for (int j = 0; j < 4; ++j) { v0[j] = __logf(l0[j] + (1.f - l0[j]) * sigmoid_f(v0[j])); v1[j] = __logf(l1[j] + (1.f - l1[j]) * sigmoid_f(v1[j])); }
                        *(f32x4*)(LF + o) = v0; *(f32x4*)(LF + o + 4) = v1;
                    } else {
                        if constexpr (MODE == 3) {
                            if (row < MREAL) { float* dst = row < MP ? out + offp + o : out + offs + (o - (size_t)MP * DA); *(f32x4*)dst = v0; *(f32x4*)(dst + 4) = v1; }
                        }
                        if constexpr (MODE == 0) { v0 = v0 * s; v1 = v1 * s; }
                        if constexpr (MODE == 2) {
#pragma unroll
                            for (int j = 0; j < 4; ++j) { v0[j] = silu_f(v0[j]); v1[j] = silu_f(v1[j]); }
                        }
                        u32x4 w; w.x = cvt_pk_bf16(v0[0], v0[1]); w.y = cvt_pk_bf16(v0[2], v0[3]); w.z = cvt_pk_bf16(v1[0], v1[1]); w.w = cvt_pk_bf16(v1[2], v1[3]);
                        *(u32x4*)(B + o) = w;
                    }
                }
            }
    }
    __device__ __forceinline__ void operator()(const f32x4 (&acc)[2][2][4][2], const Unit& u, int wr, int wc, int fr, int fq) const {
        const int rng = u.pn >> 2;
        bf16_t* B = (bf16_t*)(ws + WS_QA + (size_t)(rng == 0 ? 0 : rng - 1) * (WS_IA - WS_QA));
        if (rng == 1) run<1>(acc, u, wr, wc, fr, fq, nullptr, 1.f, 0, 0);
        else if (rng == 3) run<2>(acc, u, wr, wc, fr, fq, B, 1.f, 0, 0);
        else if (rng >= 5) run<3>(acc, u, wr, wc, fr, fq, B, 1.f, rng == 5 ? OFF_KP : OFF_VP, rng == 5 ? OFF_KS : OFF_VS);
        else run<0>(acc, u, wr, wc, fr, fq, B, rng == 2 ? 1.f : QSCALE, 0, 0);
    }
};
template <class Epi, class Sched, bool ALIGN_EPI = false, bool SP2 = false>
__device__ __forceinline__ void gemm_phase(PG8_LAS unsigned char* lds, const Gemm g, const Sched& S, const Epi& E) {
    const int tid = threadIdx.x, wid = __builtin_amdgcn_readfirstlane(tid >> 6), lane = tid & 63, wr = wid >> 2, wc = wid & 3, fr = lane & 15, fq = lane >> 4;
    const int K = g.K, nt = K / BK;
    unsigned voffA[2], voffB[2];
#pragma unroll
    for (int i = 0; i < 2; ++i) { int R, C; stage_rc(tid * 16 + i * 8192, R, C); const int Rb = Epi::PERM ? ((R & ~31) + perm32(R & 31)) : R;
        voffA[i] = (unsigned)(R * K + C) * 2u; voffB[i] = (unsigned)(Rb * K + C) * 2u; }
    const size_t kstep = (size_t)(BK * 2);
    const size_t hstep = (size_t)HALF * K * 2;
    const size_t tstep = 2 * hstep;
    const unsigned ldsw = (unsigned)wid * 1024u;
    const int aoff = lds_byte(wr * 64 + fr, fq * 8), boff = lds_byte(wc * 32 + fr, fq * 8);
#define PG8_SA(b, h) (((b) * 2 + (h)) * HTB)
#define PG8_SB(b, h) ((4 + (b) * 2 + (h)) * HTB)
#define PG8_STAGE(bufoff, gbase, voff) do { _Pragma("unroll") for (int _i = 0; _i < 2; ++_i) \
        __builtin_amdgcn_global_load_lds((const unsigned*)((const char*)(gbase) + (voff)[_i]), (PG8_LAS unsigned*)(lds + (bufoff) + ldsw + _i * 8192), 16, 0, 0); } while (0)
#define PG8_LDA(dst, b, h) do { _Pragma("unroll") for (int m = 0; m < 4; ++m) _Pragma("unroll") for (int k = 0; k < 2; ++k) dst[m][k] = *(const PG8_LAS bf16x8*)(lds + PG8_SA(b, h) + aoff + m * 2048 + k * 1024); } while (0)
#define PG8_LDB(dst, b, h) do { _Pragma("unroll") for (int n = 0; n < 2; ++n) _Pragma("unroll") for (int k = 0; k < 2; ++k) dst[n][k] = *(const PG8_LAS bf16x8*)(lds + PG8_SB(b, h) + boff + n * 2048 + k * 1024); } while (0)
#define PG8_MMA(ai, bj, At, Bt) do { __builtin_amdgcn_s_setprio(1); _Pragma("unroll") for (int m = 0; m < 4; ++m) _Pragma("unroll") for (int n = 0; n < 2; ++n) _Pragma("unroll") for (int k = 0; k < 2; ++k) \
        acc[ai][bj][m][n] = __builtin_amdgcn_mfma_f32_16x16x32_bf16(Bt[n][k], At[m][k], acc[ai][bj][m][n], 0, 0, 0); __builtin_amdgcn_s_setprio(0); } while (0)
#define PG8_WAIT_V(n) asm volatile("s_waitcnt vmcnt(" #n ")" ::: "memory")
#define PG8_WAIT_L(n) asm volatile("s_waitcnt lgkmcnt(" #n ")" ::: "memory")
#define PG8_BAR __builtin_amdgcn_s_barrier()
#define PG8_SCHED __builtin_amdgcn_sched_barrier(0)
    Unit cur, nxt; int ui = 0;
    if (!S.next(0, cur)) return;
    f32x4 acc[2][2][4][2];
#pragma unroll
    for (int a = 0; a < 2; ++a)
#pragma unroll
        for (int b = 0; b < 2; ++b)
#pragma unroll
            for (int m = 0; m < 4; ++m)
#pragma unroll
                for (int n = 0; n < 2; ++n) acc[a][b][m][n] = (f32x4){0.f, 0.f, 0.f, 0.f};
    bf16x8 At[4][2], B0[2][2], B1[2][2];
    const char* cA = (const char*)g.A + (size_t)cur.pm * tstep; const char* cB = (const char*)g.Bt + (size_t)cur.pn * tstep;
    S.a_ready(cur);
    if constexpr (SP2) {
        PG8_STAGE(PG8_SB(0, 0), cB, voffB); PG8_STAGE(PG8_SB(0, 1), cB + hstep, voffB); PG8_STAGE(PG8_SA(0, 0), cA, voffA); PG8_STAGE(PG8_SA(0, 1), cA + hstep, voffA);
        if (wr == 1) PG8_BAR;
        PG8_WAIT_V(2); PG8_BAR;
        PG8_STAGE(PG8_SB(1, 0), cB + kstep, voffB); PG8_STAGE(PG8_SA(1, 0), cA + kstep, voffA); PG8_STAGE(PG8_SB(1, 1), cB + hstep + kstep, voffB);
        PG8_WAIT_V(6); PG8_BAR;
    } else {
        PG8_STAGE(PG8_SB(0, 0), cB, voffB); PG8_STAGE(PG8_SA(0, 0), cA, voffA); PG8_STAGE(PG8_SB(0, 1), cB + hstep, voffB); PG8_STAGE(PG8_SA(0, 1), cA + hstep, voffA);
        if (wr == 1) PG8_BAR;
        PG8_WAIT_V(4); PG8_BAR;
        PG8_STAGE(PG8_SB(1, 0), cB + kstep, voffB); PG8_STAGE(PG8_SA(1, 0), cA + kstep, voffA); PG8_STAGE(PG8_SB(1, 1), cB + hstep + kstep, voffB);
        PG8_WAIT_V(6); PG8_BAR;
    }
    for (;;) {
        const bool has_next = S.next(ui + 1, nxt);
        const char* nA = has_next ? (const char*)g.A + (size_t)nxt.pm * tstep : cA; const char* nB = has_next ? (const char*)g.Bt + (size_t)nxt.pn * tstep : cB;
        for (int t = 0; t < nt; t += 2) {
            const bool last = (t == nt - 2);
            const char* a1 = cA + (size_t)(t + 1) * kstep;
            const char* a2 = last ? nA : cA + (size_t)(t + 2) * kstep; const char* b2 = last ? nB : cB + (size_t)(t + 2) * kstep;
            const char* a3 = a2 + kstep; const char* b3 = b2 + kstep;
            if (last && has_next) S.a_ready(nxt);
            if constexpr (SP2) {
            PG8_LDB(B0, 0, 0); PG8_LDB(B1, 0, 1); PG8_SCHED; PG8_LDA(At, 0, 0); PG8_STAGE(PG8_SA(1, 1), a1 + hstep, voffA);
            PG8_WAIT_V(8); PG8_WAIT_L(0); PG8_BAR; PG8_MMA(0, 0, At, B0); PG8_MMA(0, 1, At, B1); PG8_BAR; PG8_SCHED;
            PG8_LDA(At, 0, 1); PG8_STAGE(PG8_SB(0, 0), b2, voffB); PG8_STAGE(PG8_SB(0, 1), b2 + hstep, voffB); PG8_STAGE(PG8_SA(0, 0), a2, voffA);
            PG8_WAIT_V(8); PG8_WAIT_L(0); PG8_BAR; PG8_MMA(1, 0, At, B0); PG8_MMA(1, 1, At, B1); PG8_BAR; PG8_SCHED;
            PG8_LDB(B0, 1, 0); PG8_LDB(B1, 1, 1); PG8_SCHED; PG8_LDA(At, 1, 0); PG8_STAGE(PG8_SA(0, 1), a2 + hstep, voffA);
            PG8_WAIT_V(8); PG8_WAIT_L(0); PG8_BAR; PG8_MMA(0, 0, At, B0); PG8_MMA(0, 1, At, B1); PG8_BAR; PG8_SCHED;
            PG8_LDA(At, 1, 1); PG8_STAGE(PG8_SB(1, 0), b3, voffB); PG8_STAGE(PG8_SB(1, 1), b3 + hstep, voffB); PG8_STAGE(PG8_SA(1, 0), a3, voffA);
            PG8_WAIT_V(8); PG8_WAIT_L(0); PG8_BAR; PG8_MMA(1, 0, At, B0); PG8_MMA(1, 1, At, B1); PG8_BAR; PG8_SCHED;
            } else {
            PG8_LDB(B0, 0, 0); PG8_SCHED; PG8_LDA(At, 0, 0); PG8_STAGE(PG8_SA(1, 1), a1 + hstep, voffA);
            PG8_WAIT_L(8); PG8_BAR; PG8_WAIT_L(0); PG8_MMA(0, 0, At, B0); PG8_BAR; PG8_SCHED;
            PG8_LDB(B1, 0, 1); PG8_STAGE(PG8_SB(0, 0), b2, voffB);
            PG8_BAR; PG8_WAIT_L(0); PG8_MMA(0, 1, At, B1); PG8_BAR;
            PG8_LDA(At, 0, 1); PG8_STAGE(PG8_SA(0, 0), a2, voffA);
            PG8_BAR; PG8_WAIT_L(0); PG8_MMA(1, 0, At, B0); PG8_BAR; PG8_SCHED;
            PG8_STAGE(PG8_SB(0, 1), b2 + hstep, voffB);
            PG8_WAIT_V(6); PG8_BAR; PG8_MMA(1, 1, At, B1); PG8_BAR;
            PG8_LDB(B0, 1, 0); PG8_SCHED; PG8_LDA(At, 1, 0); PG8_STAGE(PG8_SA(0, 1), a2 + hstep, voffA);
            PG8_WAIT_L(8); PG8_BAR; PG8_WAIT_L(0); PG8_MMA(0, 0, At, B0); PG8_BAR; PG8_SCHED;
            PG8_LDB(B1, 1, 1); PG8_STAGE(PG8_SB(1, 0), b3, voffB);
            PG8_BAR; PG8_WAIT_L(0); PG8_MMA(0, 1, At, B1); PG8_BAR;
            PG8_LDA(At, 1, 1); PG8_STAGE(PG8_SA(1, 0), a3, voffA);
            PG8_BAR; PG8_WAIT_L(0); PG8_MMA(1, 0, At, B0); PG8_BAR; PG8_SCHED;
            PG8_STAGE(PG8_SB(1, 1), b3 + hstep, voffB);
            PG8_WAIT_V(6); PG8_BAR; PG8_MMA(1, 1, At, B1); PG8_BAR;
            }
        }
        if constexpr (ALIGN_EPI) { if (wr == 0) PG8_BAR; }
        if constexpr (!Epi::AFTER_DRAIN) { E(acc, cur, wr, wc, fr, fq); S.done(cur); }
        if (!has_next) break;
#pragma unroll
        for (int a = 0; a < 2; ++a)
#pragma unroll
            for (int b = 0; b < 2; ++b)
#pragma unroll
                for (int m = 0; m < 4; ++m)
#pragma unroll
                    for (int n = 0; n < 2; ++n) acc[a][b][m][n] = (f32x4){0.f, 0.f, 0.f, 0.f};
        cur = nxt; cA = nA; cB = nB; ++ui;
        if constexpr (ALIGN_EPI) { if (wr == 1) PG8_BAR; }
    }
    PG8_WAIT_V(0);
    if constexpr (!ALIGN_EPI) { if (wr == 0) PG8_BAR; }
    PG8_BAR;
    if constexpr (Epi::AFTER_DRAIN) { E.fused(acc, cur, wr, wc, fr, fq, lds, wid, lane); S.done(cur); }
#undef PG8_SA
#undef PG8_SB
#undef PG8_STAGE
#undef PG8_LDA
#undef PG8_LDB
#undef PG8_MMA
#undef PG8_WAIT_V
#undef PG8_WAIT_L
#undef PG8_BAR
#undef PG8_SCHED
}
}

constexpr int NTHR = 512, NWAVES = 8;
constexpr int LDS_BYTES = 147456;

#define IN_F(i) ((const float*)a.in[i])
#define WS_F(off) ((float*)(a.ws + (off)))
#define WS_B(off) ((bf16*)(a.ws + (off)))

__device__ __forceinline__ void phase_mod(const Args& a, LAS unsigned char* lds, int bid, int nblk) {
    const int tid = threadIdx.x, lane = tid & 63, w = tid >> 6;
    LAS float* sc = (LAS float*)lds;
    LAS float* red = (LAS float*)(lds + 98304);
    for (int i = tid; i < 12 * DM; i += NTHR) { const int b = i >> 11, k = i & 2047; const float c = b < 4 ? IN_F(I_CP)[b * DM + k] : IN_F(I_CS)[(b - 4) * DM + k]; sc[i] = silu_f(c); }
    if (bid == 0) for (int i = tid; i < DA; i += NTHR) WS_F(WS_LBV)[i] = sigmoid_f(IN_F(I_LB)[i]);
    __syncthreads();
    for (int u = bid; u < 176; u += nblk) {
        const bool fm = u >= 144; const int n0 = (fm ? u - 144 : u) * 128, ld = fm ? NFMODC : NMODC;
        const float* W = fm ? IN_F(I_WFM) : IN_F(I_WMOD); const float* bias = fm ? IN_F(I_BFM) : IN_F(I_BMOD); float* outp = fm ? WS_F(WS_FMOD) : WS_F(WS_MOD);
        f32x2 acc[12];
#pragma unroll
        for (int b = 0; b < 12; ++b) acc[b] = (f32x2){0.f, 0.f};
        const float* wp = W + (size_t)(w * 256) * ld + n0 + 2 * lane;
        for (int k = 0; k < 256; k += 4) {
            const f32x2 w0 = *(const f32x2*)(wp + (size_t)(k + 0) * ld), w1 = *(const f32x2*)(wp + (size_t)(k + 1) * ld), w2 = *(const f32x2*)(wp + (size_t)(k + 2) * ld), w3 = *(const f32x2*)(wp + (size_t)(k + 3) * ld);
#pragma unroll
            for (int b = 0; b < 12; ++b) { const f32x4 s = *(const LAS f32x4*)(sc + b * DM + w * 256 + k); acc[b] += w0 * s.x + w1 * s.y + w2 * s.z + w3 * s.w; }
        }
#pragma unroll
        for (int b = 0; b < 12; ++b) *(LAS f32x2*)(red + (w * 12 + b) * 128 + 2 * lane) = acc[b];
        __syncthreads();
        for (int i = tid; i < 12 * 128; i += NTHR) { const int b = i >> 7, c = i & 127; float s = 0.f;
#pragma unroll
            for (int ww = 0; ww < 8; ++ww) s += red[(ww * 12 + b) * 128 + c];
            outp[(size_t)b * ld + n0 + c] = s + bias[n0 + c]; }
        __syncthreads();
    }
}

__device__ __forceinline__ void cvt_item(const float* W, int K, int N, bf16* WT, int k0, int n0, int drow0, LAS float* scr, int lane) {
#pragma unroll 8
    for (int i = 0; i < 32; ++i) { const int kk = 2 * i + (lane >> 5); scr[kk * 33 + (lane & 31)] = W[(size_t)(k0 + kk) * N + n0 + (lane & 31)]; }
    LDS_WAIT(); asm volatile("" ::: "memory");
    const int c = lane & 7;
#pragma unroll
    for (int j = 0; j < 4; ++j) { const int n = (lane >> 3) + 8 * j; const LAS float* s = scr + (8 * c) * 33 + n;
        v4u o; o.x = pk2(s[0 * 33], s[1 * 33]); o.y = pk2(s[2 * 33], s[3 * 33]); o.z = pk2(s[4 * 33], s[5 * 33]); o.w = pk2(s[6 * 33], s[7 * 33]);
        *(GAS v4u*)(WT + (size_t)(drow0 + n) * K + k0 + 8 * c) = o; }
    LDS_WAIT(); asm volatile("" ::: "memory");
}
__device__ __forceinline__ void cvt_matrix(const float* W, int K, int N, bf16* WT, int mode, LAS float* scr, int gw, int ngw, int lane) {
    const int nblk = N / 32, nitems = (K / 64) * nblk;
    for (int it = gw; it < nitems; it += ngw) { const int kb = it / nblk, nb = it % nblk, n0 = 32 * nb;
        const int drow0 = mode == 0 ? n0 : ((n0 >> 7) * 256 + (mode == 2 ? 128 : 0) + (n0 & 127));
        cvt_item(W, K, N, WT, 64 * kb, n0, drow0, scr, lane); }
}
__device__ __forceinline__ void phase_cvt(const Args& a, LAS unsigned char* lds, int bid, int nblk, int first, int last) {
    const int tid = threadIdx.x, lane = tid & 63, w = tid >> 6;
    LAS float* scr = (LAS float*)(lds + w * 16384);
    const int gw = bid * NWAVES + w, ngw = nblk * NWAVES;
    if (first <= 0 && 0 <= last) { cvt_matrix(IN_F(I_WG1), DM, DFF, WS_B(WS_WGU1), 1, scr, gw, ngw, lane); cvt_matrix(IN_F(I_WU1), DM, DFF, WS_B(WS_WGU1), 2, scr, gw, ngw, lane);
                                   cvt_matrix(IN_F(I_WD1), DFF, DM, WS_B(WS_WD1), 0, scr, gw, ngw, lane); }
    if (first <= 1 && 1 <= last) { cvt_matrix(IN_F(I_WIN), DM, DIN, WS_B(WS_WIN), 0, scr, gw, ngw, lane); cvt_matrix(IN_F(I_WOUT), DM, DM, WS_B(WS_WOUT), 0, scr, gw, ngw, lane); }
    if (first <= 2 && 2 <= last) { cvt_matrix(IN_F(I_WG2), DM, DFF, WS_B(WS_WGU2), 1, scr, gw, ngw, lane); cvt_matrix(IN_F(I_WU2), DM, DFF, WS_B(WS_WGU2), 2, scr, gw, ngw, lane);
                                   cvt_matrix(IN_F(I_WD2), DFF, DM, WS_B(WS_WD2), 0, scr, gw, ngw, lane); }
}

template <bool FINAL>
__device__ __forceinline__ void phase_norm(const Args& a, int bid, int nblk, bool from_inputs, const float* gvec, const float* modp, int ldmod, int sh_off, int sc_off) {
    const int tid = threadIdx.x, lane = tid & 63, w = tid >> 6;
    const int gw = bid * NWAVES + w, ngw = nblk * NWAVES;
    const int nrows = FINAL ? MREAL : MPAD;
    for (int r = gw; r < nrows; r += ngw) {
        if (r >= MREAL) {
            GAS v4u* o = (GAS v4u*)(WS_B(WS_XN) + (size_t)r * DM) + lane;
#pragma unroll
            for (int j = 0; j < 4; ++j) o[64 * j] = (v4u){0u, 0u, 0u, 0u};
            continue;
        }
        const float* xrow = from_inputs ? (r < MP ? IN_F(I_XP) + (size_t)r * DM : IN_F(I_XS) + (size_t)(r - MP) * DM) : WS_F(WS_X) + (size_t)r * DM;
        const GAS f32x4* xr = (const GAS f32x4*)xrow + lane;
        f32x4 v[8]; float s = 0.f;
#pragma unroll
        for (int j = 0; j < 8; ++j) { v[j] = xr[64 * j]; s += (v[j].x * v[j].x + v[j].y * v[j].y) + (v[j].z * v[j].z + v[j].w * v[j].w); }
        const float rstd = 1.0f / sqrtf(wave_sum(s) * (1.f / DM) + EPS);
        const float* mr = modp + (size_t)mod_row(r) * ldmod;
#pragma unroll
        for (int j = 0; j < 8; ++j) {
            const int c = 4 * (lane + 64 * j);
            const f32x4 g = *(const f32x4*)(gvec + c), sh = *(const f32x4*)(mr + sh_off + c), sc = *(const f32x4*)(mr + sc_off + c);
            const f32x4 y = (v[j] * rstd * g) * (1.f + sc) + sh;
            if (FINAL) { float* dst = r < MP ? a.out + OFF_YP + (size_t)r * DM : a.out + OFF_YS + (size_t)(r - MP) * DM; *(f32x4*)(dst + c) = y; }
            else { v2u o; o.x = pk2(y.x, y.y); o.y = pk2(y.z, y.w); *(GAS v2u*)(WS_B(WS_XN) + (size_t)r * DM + c) = o; }
        }
    }
}

template <int WHICH> __device__ __forceinline__ void phase_gemm(const Args& a, LAS unsigned char* lds, int bid, int nblk) {
    using namespace pg8;
    if constexpr (WHICH == 1 || WHICH == 5) {
        Gemm g{WS_B(WS_XN), WS_B(WHICH == 1 ? WS_WGU1 : WS_WGU2), MPAD, 2 * DFF, DM}; StaticOrder S; S.init(MPAD, 2 * DFF, nblk, bid);
        EpiSwiGLU E{WS_B(WS_H), DFF};
        gemm_phase<EpiSwiGLU, StaticOrder, true, true>(lds, g, S, E);
    } else if constexpr (WHICH == 2 || WHICH == 6) {
        Gemm g{WS_B(WS_H), WS_B(WHICH == 2 ? WS_WD1 : WS_WD2), MPAD, DM, DFF}; StaticOrder S; S.init(MPAD, DM, nblk, bid);
        EpiResid E{WHICH == 2 ? IN_F(I_XP) : nullptr, IN_F(I_XS), WS_F(WS_X), WS_F(WS_MOD) + (WHICH == 2 ? 2 : 8) * DM, 0.5f};
        gemm_phase<EpiResid, StaticOrder, true, true>(lds, g, S, E);
    } else if constexpr (WHICH == 3) {
        Gemm g{WS_B(WS_XN), WS_B(WS_WIN), MPAD, DIN, DM}; StaticOrder S; S.init(MPAD, DIN, nblk, bid);
        EpiProj E{a.ws, WS_F(WS_LF), a.out, WS_F(WS_LBV)};
        gemm_phase<EpiProj, StaticOrder, true, true>(lds, g, S, E);
    } else {
        Gemm g{WS_B(WS_OM), WS_B(WS_WOUT), MPAD, DM, DM}; StaticOrder S; S.init(MPAD, DM, nblk, bid);
        EpiResid E{nullptr, IN_F(I_XS), WS_F(WS_X), WS_F(WS_MOD) + 5 * DM, 1.0f};
        gemm_phase<EpiResid, StaticOrder, true, true>(lds, g, S, E);
    }
}

__device__ __forceinline__ void hgrn_unit(const Args& a, LAS unsigned char* lds, int unit) {
    const int tid = threadIdx.x, dv = tid & 127, g = tid >> 7;
    const bool smp = unit >= 32; const int u = smp ? unit - 32 : unit, b = u >> 3, h = u & 7;
    const int T = smp ? DECT : SEQ, row0 = smp ? MP + b * DECT : b * SEQ;
    float* sout = a.out + (smp ? OFF_SS : OFF_SP) + (size_t)u * HD * HD;
    LAS float* fL = (LAS float*)lds; LAS float* kL = fL + 2048; LAS float* qL = kL + 2048; LAS float* vL = qL + 2048; LAS float* red = vL + 2048;
    const bf16* QA = WS_B(WS_QA); const bf16* IA = WS_B(WS_IA); const bf16* GA = WS_B(WS_GA); const float* LF = WS_F(WS_LF);
    float S[32];
#pragma unroll
    for (int i = 0; i < 32; ++i) S[i] = smp ? IN_F(I_ST)[(size_t)u * HD * HD + (size_t)(32 * g + i) * HD + dv] : 0.f;
    for (int t0 = 0; t0 < T; t0 += 16) {
        const int nt = (T - t0) < 16 ? (T - t0) : 16;
        for (int i = tid; i < nt * 128; i += NTHR) { const int tt = i >> 7, ch = i & 127; const size_t o = (size_t)(row0 + t0 + tt) * DA + h * HD + ch;
            const float f = __expf(LF[o]); fL[i] = f; kL[i] = 1.f - f; qL[i] = bf2f(QA[o]); vL[i] = bf2f(IA[o]); }
        __syncthreads();
        for (int tt = 0; tt < nt; ++tt) {
            const float v = vL[tt * 128 + dv]; float op = 0.f;
#pragma unroll
            for (int i4 = 0; i4 < 8; ++i4) {
                const f32x4 f4 = *(const LAS f32x4*)(fL + tt * 128 + g * 32 + 4 * i4), k4 = *(const LAS f32x4*)(kL + tt * 128 + g * 32 + 4 * i4), q4 = *(const LAS f32x4*)(qL + tt * 128 + g * 32 + 4 * i4);
#pragma unroll
                for (int j = 0; j < 4; ++j) { S[4 * i4 + j] = f4[j] * S[4 * i4 + j] + k4[j] * v; op += S[4 * i4 + j] * q4[j]; }
            }
            red[(g * 16 + tt) * 128 + dv] = op;
        }
        __syncthreads();
        { const int tt = tid >> 5, l32 = tid & 31;
          if (tt < nt) {
            f32x4 o = (f32x4){0.f, 0.f, 0.f, 0.f};
#pragma unroll
            for (int gg = 0; gg < 4; ++gg) o += *(const LAS f32x4*)(red + (gg * 16 + tt) * 128 + 4 * l32);
            float ss = (o.x * o.x + o.y * o.y) + (o.z * o.z + o.w * o.w);
#pragma unroll
            for (int m = 1; m < 32; m <<= 1) ss += __shfl_xor(ss, m);
            const float rstd = 1.0f / sqrtf(ss * (1.f / HD) + EPS);
            const int row = row0 + t0 + tt, col = h * HD + 4 * l32;
            const f32x4 gw = *(const f32x4*)(IN_F(I_GOA) + col); const v2u gt = *(const v2u*)(GA + (size_t)row * DA + col);
            v2u w; w.x = pk2(o.x * rstd * gw.x * bflo(gt.x), o.y * rstd * gw.y * bfhi(gt.x)); w.y = pk2(o.z * rstd * gw.z * bflo(gt.y), o.w * rstd * gw.w * bfhi(gt.y));
            *(v2u*)(WS_B(WS_OM) + (size_t)row * DM + col) = w;
          } }
        __syncthreads();
    }
#pragma unroll
    for (int i = 0; i < 32; ++i) sout[(size_t)(32 * g + i) * HD + dv] = S[i];
}

__device__ __forceinline__ void sb_tile(const LAS float* Kt, const LAS float* Vt, const LAS float* q, float bias, int lane, int nvis  , float& R, float& o0, float& o1) {
    float z = bias;
#pragma unroll 8
    for (int d = 0; d < HD; d += 4) { const f32x4 qv = *(const LAS f32x4*)(q + d);
        z += qv.x * Kt[lane * 129 + d] + qv.y * Kt[lane * 129 + d + 1] + qv.z * Kt[lane * 129 + d + 2] + qv.w * Kt[lane * 129 + d + 3]; }
    const bool vis = lane < nvis;
    const float L = vis ? -(z > 20.f ? z : log1pf(__expf(z))) : 0.f;
    float c = L;
#pragma unroll
    for (int off = 1; off < 64; off <<= 1) { const float t = __shfl_down(c, off); if (lane + off < 64) c += t; }
    const float P = vis ? __expf(z + c + R) : 0.f;
    R += __shfl(c, 0);
#pragma unroll 8
    for (int s = 0; s < 64; ++s) { const float p = __builtin_bit_cast(float, __builtin_amdgcn_readlane(__builtin_bit_cast(int, P), s));
        o0 += p * Vt[s * 128 + lane]; o1 += p * Vt[s * 128 + 64 + lane]; }
}
__device__ __forceinline__ void sb_finish(const Args& a, int row, int h, int lane, float o0, float o1) {
    const float ss = wave_sum(o0 * o0 + o1 * o1);
    const float rstd = 1.0f / sqrtf(ss * (1.f / HD) + EPS);
    const float* gw = IN_F(I_GOB) + h * HD; bf16* dst = WS_B(WS_OM) + (size_t)row * DM + DA + h * HD;
    dst[lane] = (bf16)f2bf(o0 * rstd * gw[lane]); dst[64 + lane] = (bf16)f2bf(o1 * rstd * gw[64 + lane]);
}
__device__ __forceinline__ void sb_stage_bf16(const Args& a, LAS float* Kt, LAS float* Vt, int krow0, int nvalid, int h, int tid) {
    const bf16* KB = WS_B(WS_KB); const bf16* VB = WS_B(WS_VB);
#pragma unroll
    for (int i = 0; i < 2; ++i) { const int ch = tid + i * NTHR, r = ch >> 4, d0 = (ch & 15) * 8;
        v4u kv = (v4u){0u, 0u, 0u, 0u}, vv = (v4u){0u, 0u, 0u, 0u};
        if (r < nvalid) { const size_t o = (size_t)(krow0 + r) * DA + h * HD + d0; kv = *(const v4u*)(KB + o); vv = *(const v4u*)(VB + o); }
        LAS float* kd = Kt + r * 129 + d0; LAS float* vd = Vt + r * 128 + d0;
        kd[0] = bflo(kv.x); kd[1] = bfhi(kv.x); kd[2] = bflo(kv.y); kd[3] = bfhi(kv.y); kd[4] = bflo(kv.z); kd[5] = bfhi(kv.z); kd[6] = bflo(kv.w); kd[7] = bfhi(kv.w);
        vd[0] = bflo(vv.x); vd[1] = bfhi(vv.x); vd[2] = bflo(vv.y); vd[3] = bfhi(vv.y); vd[4] = bflo(vv.z); vd[5] = bfhi(vv.z); vd[6] = bflo(vv.w); vd[7] = bfhi(vv.w); }
}
__device__ __forceinline__ void sb_unit_prompt(const Args& a, LAS unsigned char* lds, int unit) {
    const int tid = threadIdx.x, lane = tid & 63, w = tid >> 6;
    const int bh = unit >> 8, qb = unit & 255, b = bh >> 3, h = bh & 7, t = qb * 8 + w, row = b * SEQ + t;
    LAS float* Kt = (LAS float*)lds; LAS float* Vt = Kt + 64 * 129; LAS float* qs = Vt + 64 * 128;
    if (lane < 32) { const v2u qv = *(const v2u*)(WS_B(WS_QB) + (size_t)row * DA + h * HD + 4 * lane); LAS float* q = qs + w * HD + 4 * lane; q[0] = bflo(qv.x); q[1] = bfhi(qv.x); q[2] = bflo(qv.y); q[3] = bfhi(qv.y); }
    const float bias = IN_F(I_BSB)[h];
    float R = 0.f, o0 = 0.f, o1 = 0.f;
    for (int j = (qb * 8 + 6) >> 6; j >= 0; --j) {
        __syncthreads();
        sb_stage_bf16(a, Kt, Vt, b * SEQ + 64 * j, 64, h, tid);
        __syncthreads();
        int nvis = t - 64 * j; nvis = nvis < 0 ? 0 : (nvis > 64 ? 64 : nvis);
        sb_tile(Kt, Vt, qs + w * HD, bias, lane, nvis, R, o0, o1);
    }
    sb_finish(a, row, h, lane, o0, o1);
    __syncthreads();
}
__device__ __forceinline__ void sb_unit_sample(const Args& a, LAS unsigned char* lds, int unit) {
    const int tid = threadIdx.x, lane = tid & 63, w = tid >> 6;
    const int b = unit >> 3, h = unit & 7, row = MP + b * DECT + w;
    LAS float* Kt = (LAS float*)lds; LAS float* Vt = Kt + 64 * 129; LAS float* qs = Vt + 64 * 128;
    if (lane < 32) { const v2u qv = *(const v2u*)(WS_B(WS_QB) + (size_t)row * DA + h * HD + 4 * lane); LAS float* q = qs + w * HD + 4 * lane; q[0] = bflo(qv.x); q[1] = bfhi(qv.x); q[2] = bflo(qv.y); q[3] = bfhi(qv.y); }
    const float bias = IN_F(I_BSB)[h];
    float R = 0.f, o0 = 0.f, o1 = 0.f;
    __syncthreads();
    sb_stage_bf16(a, Kt, Vt, MP + b * DECT, DECT, h, tid);
    __syncthreads();
    sb_tile(Kt, Vt, qs + w * HD, bias, lane, w, R, o0, o1);
    const int* pt = (const int*)a.in[I_PT] + b * NPAGES;
    for (int j = PAST / 64 - 1; j >= 0; --j) {
        __syncthreads();
        { const int page = pt[j >> 1]; const size_t base = ((size_t)page * PAGE + (j & 1) * 64) * (NHEAD * HD) + h * HD;
          const float* ck = IN_F(I_CK) + base; const float* cv = IN_F(I_CV) + base;
#pragma unroll
          for (int i = 0; i < 4; ++i) { const int ch = tid + i * NTHR, r = ch >> 5, d0 = (ch & 31) * 4;
              const f32x4 kv = *(const f32x4*)(ck + (size_t)r * (NHEAD * HD) + d0), vv = *(const f32x4*)(cv + (size_t)r * (NHEAD * HD) + d0);
              LAS float* kd = Kt + r * 129 + d0; kd[0] = kv.x; kd[1] = kv.y; kd[2] = kv.z; kd[3] = kv.w;
              *(LAS f32x4*)(Vt + r * 128 + d0) = vv; } }
        __syncthreads();
        sb_tile(Kt, Vt, qs + w * HD, bias, lane, 64, R, o0, o1);
    }
    sb_finish(a, row, h, lane, o0, o1);
    __syncthreads();
}
__device__ __forceinline__ void phase_mixer(const Args& a, LAS unsigned char* lds, int bid, int nblk) {
    { const int tid = threadIdx.x; GAS v4u* o = (GAS v4u*)(WS_B(WS_OM) + (size_t)MREAL * DM);
      for (int i = bid * NTHR + tid; i < (MPAD - MREAL) * DM / 8; i += nblk * NTHR) o[i] = (v4u){0u, 0u, 0u, 0u}; }
    for (int u = bid; u < 96 + 64 + 8192; u += nblk) {
        if (u < 96) hgrn_unit(a, lds, u);
        else if (u < 160) sb_unit_sample(a, lds, u - 96);
        else sb_unit_prompt(a, lds, u - 160);
    }
}


enum { PH_MOD = 0, PH_CVT, PH_NORM1, PH_G1, PH_G2, PH_NORM2, PH_G3, PH_MIX, PH_G4, PH_NORM3, PH_G5, PH_G6, PH_FINAL, N_PHASES };

template <int PH> __device__ __forceinline__ void run_phase(const Args& a, LAS unsigned char* lds, int bid, int nblk) {
    if constexpr (PH == PH_MOD) phase_mod(a, lds, bid, nblk);
    else if constexpr (PH == PH_CVT) phase_cvt(a, lds, bid, nblk, 0, 2);
    else if constexpr (PH == PH_NORM1) phase_norm<false>(a, bid, nblk, true, IN_F(I_N1), WS_F(WS_MOD), NMODC, 0 * DM, 1 * DM);
    else if constexpr (PH == PH_G1) phase_gemm<1>(a, lds, bid, nblk);
    else if constexpr (PH == PH_G2) phase_gemm<2>(a, lds, bid, nblk);
    else if constexpr (PH == PH_NORM2) phase_norm<false>(a, bid, nblk, false, IN_F(I_NM), WS_F(WS_MOD), NMODC, 3 * DM, 4 * DM);
    else if constexpr (PH == PH_G3) phase_gemm<3>(a, lds, bid, nblk);
    else if constexpr (PH == PH_MIX) phase_mixer(a, lds, bid, nblk);
    else if constexpr (PH == PH_G4) phase_gemm<4>(a, lds, bid, nblk);
    else if constexpr (PH == PH_NORM3) phase_norm<false>(a, bid, nblk, false, IN_F(I_N2), WS_F(WS_MOD), NMODC, 6 * DM, 7 * DM);
    else if constexpr (PH == PH_G5) phase_gemm<5>(a, lds, bid, nblk);
    else if constexpr (PH == PH_G6) phase_gemm<6>(a, lds, bid, nblk);
    else phase_norm<true>(a, bid, nblk, false, IN_F(I_NF), WS_F(WS_FMOD), NFMODC, 0, DM);
}

template <int PH> __global__ void __launch_bounds__(NTHR, 2) k_phase(Args a) {
    extern __shared__ __attribute__((aligned(16))) unsigned char lds_raw[];
    run_phase<PH>(a, (LAS unsigned char*)lds_raw, (int)blockIdx.x, (int)gridDim.x);
}

template <int PH> static void launch_phase(const Args& a, int grid, hipStream_t stream) {
    static bool attr_done = false;
    if (!attr_done) { (void)hipFuncSetAttribute((const void*)k_phase<PH>, hipFuncAttributeMaxDynamicSharedMemorySize, LDS_BYTES); attr_done = true; }
    hipLaunchKernelGGL(k_phase<PH>, dim3(grid), dim3(NTHR), LDS_BYTES, stream, a);
}
template <int PH> static void launch_all(const Args& a, int grid, hipStream_t stream) {
    launch_phase<PH>(a, grid, stream);
    if constexpr (PH + 1 < N_PHASES) launch_all<PH + 1>(a, grid, stream);
}

extern "C" void kernel_launch(void* const* d_in, const int* in_sizes, int n_in, void* d_out, int out_size, void* d_ws, size_t ws_size, hipStream_t stream) {
    if (n_in != N_IN || (size_t)out_size != OUT_TOTAL || ws_size < WS_END) { fprintf(stderr, "kernel_launch: unexpected shapes (n_in %d, out %d, ws %zu)\n", n_in, out_size, ws_size); return; }
    Args a{};
    for (int i = 0; i < N_IN; ++i) a.in[i] = d_in[i];
    a.out = (float*)d_out; a.ws = (unsigned char*)d_ws;
    launch_all<0>(a, 256, stream);
}
```

```cpp
#include <hip/hip_runtime.h>
#include <cstdio>
#include <cstdint>

constexpr int DM = 2048, SEQ = 2048, NB = 4, MP = NB * SEQ  , DECB = 8, DECT = 8, MS = DECB * DECT  ;
constexpr int MREAL = MP + MS  , MPAD = 8448  ;
constexpr int DFF = 5632, DIN = 7168, NMODC = 9 * DM  , NFMODC = 2 * DM;
constexpr int DA = 1024, NHEAD = 8, HD = 128, PAST = 16384, PAGE = 128, NPAGES = PAST / PAGE  ;
constexpr float EPS = 1e-6f, QSCALE = 0.08838834764831845f  ;
constexpr size_t OFF_YP = 0, OFF_YS = OFF_YP + (size_t)MP * DM, OFF_KP = OFF_YS + (size_t)MS * DM, OFF_VP = OFF_KP + (size_t)MP * DA,
                 OFF_KS = OFF_VP + (size_t)MP * DA, OFF_VS = OFF_KS + (size_t)MS * DA, OFF_SP = OFF_VS + (size_t)MS * DA,
                 OFF_SS = OFF_SP + (size_t)NB * NHEAD * HD * HD, OUT_TOTAL = OFF_SS + (size_t)DECB * NHEAD * HD * HD;
enum { I_XP = 0, I_XS, I_CK, I_CV, I_ST, I_PT, I_CP, I_CS, I_LB, I_N1, I_NM, I_N2, I_WMOD, I_BMOD, I_WG1, I_WU1, I_WD1, I_WIN, I_GOA, I_GOB, I_BSB, I_WOUT,
       I_WG2, I_WU2, I_WD2, I_NF, I_WFM, I_BFM, N_IN };
constexpr size_t MiB = 1u << 20;
constexpr size_t WS_CTL = 0, CTL_BYTES = 1 * MiB;
constexpr size_t WS_MOD = 1 * MiB;
constexpr size_t WS_FMOD = 2 * MiB;
constexpr size_t WS_LBV = 3 * MiB;
constexpr size_t WS_WGU1 = 4 * MiB, WS_WD1 = 48 * MiB, WS_WIN = 70 * MiB, WS_WOUT = 98 * MiB, WS_WGU2 = 106 * MiB, WS_WD2 = 150 * MiB;
constexpr size_t WS_XN = 172 * MiB;
constexpr size_t WS_H = 206 * MiB;
constexpr size_t WS_X = 298 * MiB;
constexpr size_t WS_QA = 364 * MiB, WS_IA = 381 * MiB, WS_GA = 398 * MiB, WS_QB = 415 * MiB, WS_KB = 432 * MiB, WS_VB = 449 * MiB;
constexpr size_t WS_LF = 466 * MiB;
constexpr size_t WS_OM = 500 * MiB;
constexpr size_t WS_PART = 534 * MiB;
constexpr size_t WS_END = 560 * MiB;

#define GAS __attribute__((address_space(1)))
#define LAS __attribute__((address_space(3)))
typedef unsigned short bf16;
typedef unsigned v4u __attribute__((ext_vector_type(4)));
typedef unsigned v2u __attribute__((ext_vector_type(2)));
typedef float f32x4 __attribute__((ext_vector_type(4)));
typedef float f32x2 __attribute__((ext_vector_type(2)));
typedef short bf16x8 __attribute__((ext_vector_type(8)));

struct Args { const void* in[N_IN]; float* out; unsigned char* ws; };

__device__ __forceinline__ unsigned f2bf(float f) { unsigned u = __builtin_bit_cast(unsigned, f); return (u + 0x7fffu + ((u >> 16) & 1u)) >> 16; }
__device__ __forceinline__ unsigned pk2(float lo, float hi) { return f2bf(lo) | (f2bf(hi) << 16); }
__device__ __forceinline__ float bf2f(unsigned short b) { return __builtin_bit_cast(float, (unsigned)b << 16); }
__device__ __forceinline__ float bflo(unsigned w) { return __builtin_bit_cast(float, w << 16); }
__device__ __forceinline__ float bfhi(unsigned w) { return __builtin_bit_cast(float, w & 0xffff0000u); }
__device__ __forceinline__ float sigmoid_f(float x) { return __builtin_amdgcn_rcpf(1.f + __expf(-x)); }
__device__ __forceinline__ float silu_f(float x) { return x * sigmoid_f(x); }
__device__ __forceinline__ int mod_row(int r) { const int s = 4 + ((r - MP) >> 3); return r < MP ? (r >> 11) : (s > 11 ? 11 : s); }
__device__ __forceinline__ float wave_sum(float v) {
#pragma unroll
    for (int o = 1; o < 64; o <<= 1) v += __shfl_xor(v, o);
    return v;
}
#define LDS_WAIT() asm volatile("s_waitcnt lgkmcnt(0)" ::: "memory")
#define VM_WAIT() asm volatile("s_waitcnt vmcnt(0)" ::: "memory")

namespace pg8 {
#define PG8_LAS __attribute__((address_space(3)))
typedef unsigned short bf16_t;
typedef short bf16x8 __attribute__((ext_vector_type(8)));
typedef float f32x4 __attribute__((ext_vector_type(4)));
typedef unsigned u32x4 __attribute__((ext_vector_type(4)));
constexpr int BM = 256, BK = 64, HALF = 128, HTB = HALF * BK * 2  , STAGE_BYTES = 8 * HTB, NXCD = 8, WGM = 8;

__host__ __device__ __forceinline__ int lds_byte(int r, int c) { const int st = (r >> 4) * 2 + (c >> 5), rr = r & 15, cc = c & 31, ob = rr * 64 + cc * 2; return st * 1024 + (ob ^ (((ob >> 9) & 1) << 5)); }
__host__ __device__ __forceinline__ void stage_rc(int b, int& R, int& C) { const int st = b / 1024, sb = b % 1024, swz = sb ^ (((sb >> 9) & 1) << 5); R = (st >> 1) * 16 + swz / 64; C = (st & 1) * 32 + (swz % 64) / 2; }
__host__ __device__ __forceinline__ int perm32(int rho) { const int n = rho >> 4, i = rho & 15; return 8 * (i >> 2) + 4 * n + (i & 3); }

struct Unit { int pm, pn; };
struct Gemm { const bf16_t* A; const bf16_t* Bt; int M, N, K; };

struct StaticOrder {
    int nM, nN, nwg, G, c;
    __host__ __device__ void init(int M, int N, int G_, int c_) { nM = M / BM; nN = N / BM; nwg = nM * nN; G = G_; c = c_; }
    __host__ __device__ bool next(int i, Unit& u) const {
        const long L = (long)i * G + c; if (L >= nwg) return false;
        int wgid = (int)L; { const int q = nwg / NXCD, r = nwg % NXCD, xcd = wgid % NXCD, off = wgid / NXCD; wgid = (xcd < r ? xcd * (q + 1) : r * (q + 1) + (xcd - r) * q) + off; }
        const int nig = WGM * nN, gid = wgid / nig, fm = gid * WGM, gsz = (nM - fm) < WGM ? (nM - fm) : WGM;
        u.pm = fm + ((wgid % nig) % gsz); u.pn = (wgid % nig) / gsz; return true;
    }
    __device__ __forceinline__ void a_ready(const Unit&) const {}
    __device__ __forceinline__ void done(const Unit&) const {}
};


__device__ __forceinline__ unsigned cvt_pk_bf16(float lo, float hi) { unsigned r; asm volatile("v_cvt_pk_bf16_f32 %0, %1, %2" : "=v"(r) : "v"(lo), "v"(hi)); return r; }

struct EpiSwiGLU {
    static constexpr bool PERM = true, AFTER_DRAIN = false;
    bf16_t* H; int ldh;
    __device__ __forceinline__ void operator()(const f32x4 (&acc)[2][2][4][2], const Unit& u, int wr, int wc, int fr, int fq) const {
        const int row0 = u.pm * BM + wr * 64 + fr, col0 = u.pn * HALF + wc * 32 + 8 * fq;
#pragma unroll
        for (int ai = 0; ai < 2; ++ai)
#pragma unroll
            for (int m = 0; m < 4; ++m) {
                const f32x4 g0 = acc[ai][0][m][0], g1 = acc[ai][0][m][1], u0 = acc[ai][1][m][0], u1 = acc[ai][1][m][1];
                float v[8];
#pragma unroll
                for (int j = 0; j < 4; ++j) { v[j] = silu_f(g0[j]) * u0[j]; v[4 + j] = silu_f(g1[j]) * u1[j]; }
                u32x4 w; w.x = cvt_pk_bf16(v[0], v[1]); w.y = cvt_pk_bf16(v[2], v[3]); w.z = cvt_pk_bf16(v[4], v[5]); w.w = cvt_pk_bf16(v[6], v[7]);
                *(u32x4*)(H + (size_t)(row0 + ai * HALF + m * 16) * ldh + col0) = w;
            }
    }
};
struct EpiResid {
    static constexpr bool PERM = false, AFTER_DRAIN = false;
    const float* xp; const float* xs; float* X; const float* gate; float scale;
    __device__ __forceinline__ void operator()(const f32x4 (&acc)[2][2][4][2], const Unit& u, int wr, int wc, int fr, int fq) const {
        const int col0 = u.pn * BM + wc * 32 + 4 * fq;
#pragma unroll
        for (int ai = 0; ai < 2; ++ai)
#pragma unroll
            for (int m = 0; m < 4; ++m) {
                const int row = u.pm * BM + ai * HALF + wr * 64 + m * 16 + fr;
                if (row < MREAL) {
                    const float* base = xp ? (row < MP ? xp + (size_t)row * DM : xs + (size_t)(row - MP) * DM) : X + (size_t)row * DM;
                    const float* gr = gate + (size_t)mod_row(row) * NMODC;
#pragma unroll
                    for (int bj = 0; bj < 2; ++bj)
#pragma unroll
                        for (int n = 0; n < 2; ++n) { const int c = col0 + bj * HALF + n * 16;
                            const f32x4 gv = *(const f32x4*)(gr + c), bv = *(const f32x4*)(base + c);
                            *(f32x4*)(X + (size_t)row * DM + c) = bv + (gv * scale) * acc[ai][bj][m][n]; }
                }
            }
    }
};
struct EpiProj {
    static constexpr bool PERM = true, AFTER_DRAIN = false;
    unsigned char* ws; float* LF; float* out; const float* lbv;
    template <int MODE> __device__ __forceinline__ void run(const f32x4 (&acc)[2][2][4][2], const Unit& u, int wr, int wc, int fr, int fq, bf16_t* B, float s, size_t offp, size_t offs) const {
        const int cb = (u.pn & 3) * BM + wc * 32 + 8 * fq;
#pragma unroll
        for (int ai = 0; ai < 2; ++ai)
#pragma unroll
            for (int m = 0; m < 4; ++m) {
                const int row = u.pm * BM + ai * HALF + wr * 64 + m * 16 + fr;
#pragma unroll
                for (int bj = 0; bj < 2; ++bj) {
                    const int c = cb + bj * HALF; const size_t o = (size_t)row * DA + c;
                    f32x4 v0 = acc[ai][bj][m][0], v1 = acc[ai][bj][m][1];
                    if constexpr (MODE == 1) {
                        const f32x4 l0 = *(const f32x4*)(lbv + c), l1 = *(const f32x4*)(lbv + c + 4);
#pragma unroll
                        for (int j = 0; j < 4; ++j) { v0[j] = __logf(l0[j] + (1.f - l0[j]) * sigmoid_f(v0[j])); v1[j] = __logf(l1[j] + (1.f - l1[j]) * sigmoid_f(v1[j])); }
                        *(f32x4*)(LF + o) = v0; *(f32x4*)(LF + o + 4) = v1;
                    } else {
                        if constexpr (MODE == 3) {
                            if (row < MREAL) { float* dst = row < MP ? out + offp + o : out + offs + (o - (size_t)MP * DA); *(f32x4*)dst = v0; *(f32x4*)(dst + 4) = v1; }
                        }
                        if constexpr (MODE == 0) { v0 = v0 * s; v1 = v1 * s; }
                        if constexpr (MODE == 2) {
#pragma unroll
                            for (int j = 0; j < 4; ++j) { v0[j] = silu_f(v0[j]); v1[j] = silu_f(v1[j]); }
                        }
                        u32x4 w; w.x = cvt_pk_bf16(v0[0], v0[1]); w.y = cvt_pk_bf16(v0[2], v0[3]); w.z = cvt_pk_bf16(v1[0], v1[1]); w.w = cvt_pk_bf16(v1[2], v1[3]);
                        *(u32x4*)(B + o) = w;
                    }
                }
            }
    }
    __device__ __forceinline__ void operator()(const f32x4 (&acc)[2][2][4][2], const Unit& u, int wr, int wc, int fr, int fq) const {
        const int rng = u.pn >> 2;
        bf16_t* B = (bf16_t*)(ws + WS_QA + (size_t)(rng == 0 ? 0 : rng - 1) * (WS_IA - WS_QA));
        if (rng == 1) run<1>(acc, u, wr, wc, fr, fq, nullptr, 1.f, 0, 0);
        else if (rng == 3) run<2>(acc, u, wr, wc, fr, fq, B, 1.f, 0, 0);
        else if (rng >= 5) run<3>(acc, u, wr, wc, fr, fq, B, 1.f, rng == 5 ? OFF_KP : OFF_VP, rng == 5 ? OFF_KS : OFF_VS);
        else run<0>(acc, u, wr, wc, fr, fq, B, rng == 2 ? 1.f : QSCALE, 0, 0);
    }
};
template <class Epi, class Sched, bool ALIGN_EPI = false, bool SP2 = false>
__device__ __forceinline__ void gemm_phase(PG8_LAS unsigned char* lds, const Gemm g, const Sched& S, const Epi& E) {
    const int tid = threadIdx.x, wid = __builtin_amdgcn_readfirstlane(tid >> 6), lane = tid & 63, wr = wid >> 2, wc = wid & 3, fr = lane & 15, fq = lane >> 4;
    const int K = g.K, nt = K / BK;
    unsigned voffA[2], voffB[2];
#pragma unroll
    for (int i = 0; i < 2; ++i) { int R, C; stage_rc(tid * 16 + i * 8192, R, C); const int Rb = Epi::PERM ? ((R & ~31) + perm32(R & 31)) : R;
        voffA[i] = (unsigned)(R * K + C) * 2u; voffB[i] = (unsigned)(Rb * K + C) * 2u; }
    const size_t kstep = (size_t)(BK * 2);
    const size_t hstep = (size_t)HALF * K * 2;
    const size_t tstep = 2 * hstep;
    const unsigned ldsw = (unsigned)wid * 1024u;
    const int aoff = lds_byte(wr * 64 + fr, fq * 8), boff = lds_byte(wc * 32 + fr, fq * 8);
#define PG8_SA(b, h) (((b) * 2 + (h)) * HTB)
#define PG8_SB(b, h) ((4 + (b) * 2 + (h)) * HTB)
#define PG8_STAGE(bufoff, gbase, voff) do { _Pragma("unroll") for (int _i = 0; _i < 2; ++_i) \
        __builtin_amdgcn_global_load_lds((const unsigned*)((const char*)(gbase) + (voff)[_i]), (PG8_LAS unsigned*)(lds + (bufoff) + ldsw + _i * 8192), 16, 0, 0); } while (0)
#define PG8_LDA(dst, b, h) do { _Pragma("unroll") for (int m = 0; m < 4; ++m) _Pragma("unroll") for (int k = 0; k < 2; ++k) dst[m][k] = *(const PG8_LAS bf16x8*)(lds + PG8_SA(b, h) + aoff + m * 2048 + k * 1024); } while (0)
#define PG8_LDB(dst, b, h) do { _Pragma("unroll") for (int n = 0; n < 2; ++n) _Pragma("unroll") for (int k = 0; k < 2; ++k) dst[n][k] = *(const PG8_LAS bf16x8*)(lds + PG8_SB(b, h) + boff + n * 2048 + k * 1024); } while (0)
#define PG8_MMA(ai, bj, At, Bt) do { __builtin_amdgcn_s_setprio(1); _Pragma("unroll") for (int m = 0; m < 4; ++m) _Pragma("unroll") for (int n = 0; n < 2; ++n) _Pragma("unroll") for (int k = 0; k < 2; ++k) \
        acc[ai][bj][m][n] = __builtin_amdgcn_mfma_f32_16x16x32_bf16(Bt[n][k], At[m][k], acc[ai][bj][m][n], 0, 0, 0); __builtin_amdgcn_s_setprio(0); } while (0)
#define PG8_WAIT_V(n) asm volatile("s_waitcnt vmcnt(" #n ")" ::: "memory")
#define PG8_WAIT_L(n) asm volatile("s_waitcnt lgkmcnt(" #n ")" ::: "memory")
#define PG8_BAR __builtin_amdgcn_s_barrier()
#define PG8_SCHED __builtin_amdgcn_sched_barrier(0)
    Unit cur, nxt; int ui = 0;
    if (!S.next(0, cur)) return;
    f32x4 acc[2][2][4][2];
#pragma unroll
    for (int a = 0; a < 2; ++a)
#pragma unroll
        for (int b = 0; b < 2; ++b)
#pragma unroll
            for (int m = 0; m < 4; ++m)
#pragma unroll
                for (int n = 0; n < 2; ++n) acc[a][b][m][n] = (f32x4){0.f, 0.f, 0.f, 0.f};
    bf16x8 At[4][2], B0[2][2], B1[2][2];
    const char* cA = (const char*)g.A + (size_t)cur.pm * tstep; const char* cB = (const char*)g.Bt + (size_t)cur.pn * tstep;
    S.a_ready(cur);
    if constexpr (SP2) {
        PG8_STAGE(PG8_SB(0, 0), cB, voffB); PG8_STAGE(PG8_SB(0, 1), cB + hstep, voffB); PG8_STAGE(PG8_SA(0, 0), cA, voffA); PG8_STAGE(PG8_SA(0, 1), cA + hstep, voffA);
        if (wr == 1) PG8_BAR;
        PG8_WAIT_V(2); PG8_BAR;
        PG8_STAGE(PG8_SB(1, 0), cB + kstep, voffB); PG8_STAGE(PG8_SA(1, 0), cA + kstep, voffA); PG8_STAGE(PG8_SB(1, 1), cB + hstep + kstep, voffB);
        PG8_WAIT_V(6); PG8_BAR;
    } else {
        PG8_STAGE(PG8_SB(0, 0), cB, voffB); PG8_STAGE(PG8_SA(0, 0), cA, voffA); PG8_STAGE(PG8_SB(0, 1), cB + hstep, voffB); PG8_STAGE(PG8_SA(0, 1), cA + hstep, voffA);
        if (wr == 1) PG8_BAR;
        PG8_WAIT_V(4); PG8_BAR;
        PG8_STAGE(PG8_SB(1, 0), cB + kstep, voffB); PG8_STAGE(PG8_SA(1, 0), cA + kstep, voffA); PG8_STAGE(PG8_SB(1, 1), cB + hstep + kstep, voffB);
        PG8_WAIT_V(6); PG8_BAR;
    }
    for (;;) {
        const bool has_next = S.next(ui + 1, nxt);
        const char* nA = has_next ? (const char*)g.A + (size_t)nxt.pm * tstep : cA; const char* nB = has_next ? (const char*)g.Bt + (size_t)nxt.pn * tstep : cB;
        for (int t = 0; t < nt; t += 2) {
            const bool last = (t == nt - 2);
            const char* a1 = cA + (size_t)(t + 1) * kstep;
            const char* a2 = last ? nA : cA + (size_t)(t + 2) * kstep; const char* b2 = last ? nB : cB + (size_t)(t + 2) * kstep;
            const char* a3 = a2 + kstep; const char* b3 = b2 + kstep;
            if (last && has_next) S.a_ready(nxt);
            if constexpr (SP2) {
            PG8_LDB(B0, 0, 0); PG8_LDB(B1, 0, 1); PG8_SCHED; PG8_LDA(At, 0, 0); PG8_STAGE(PG8_SA(1, 1), a1 + hstep, voffA);
            PG8_WAIT_V(8); PG8_WAIT_L(0); PG8_BAR; PG8_MMA(0, 0, At, B0); PG8_MMA(0, 1, At, B1); PG8_BAR; PG8_SCHED;
            PG8_LDA(At, 0, 1); PG8_STAGE(PG8_SB(0, 0), b2, voffB); PG8_STAGE(PG8_SB(0, 1), b2 + hstep, voffB); PG8_STAGE(PG8_SA(0, 0), a2, voffA);
            PG8_WAIT_V(8); PG8_WAIT_L(0); PG8_BAR; PG8_MMA(1, 0, At, B0); PG8_MMA(1, 1, At, B1); PG8_BAR; PG8_SCHED;
            PG8_LDB(B0, 1, 0); PG8_LDB(B1, 1, 1); PG8_SCHED; PG8_LDA(At, 1, 0); PG8_STAGE(PG8_SA(0, 1), a2 + hstep, voffA);
            PG8_WAIT_V(8); PG8_WAIT_L(0); PG8_BAR; PG8_MMA(0, 0, At, B0); PG8_MMA(0, 1, At, B1); PG8_BAR; PG8_SCHED;
            PG8_LDA(At, 1, 1); PG8_STAGE(PG8_SB(1, 0), b3, voffB); PG8_STAGE(PG8_SB(1, 1), b3 + hstep, voffB); PG8_STAGE(PG8_SA(1, 0), a3, voffA);
            PG8_WAIT_V(8); PG8_WAIT_L(0); PG8_BAR; PG8_MMA(1, 0, At, B0); PG8_MMA(1, 1, At, B1); PG8_BAR; PG8_SCHED;
            } else {
            PG8_LDB(B0, 0, 0); PG8_SCHED; PG8_LDA(At, 0, 0); PG8_STAGE(PG8_SA(1, 1), a1 + hstep, voffA);
            PG8_WAIT_L(8); PG8_BAR; PG8_WAIT_L(0); PG8_MMA(0, 0, At, B0); PG8_BAR; PG8_SCHED;
            PG8_LDB(B1, 0, 1); PG8_STAGE(PG8_SB(0, 0), b2, voffB);
            PG8_BAR; PG8_WAIT_L(0); PG8_MMA(0, 1, At, B1); PG8_BAR;
            PG8_LDA(At, 0, 1); PG8_STAGE(PG8_SA(0, 0), a2, voffA);
            PG8_BAR; PG8_WAIT_L(0); PG8_MMA(1, 0, At, B0); PG8_BAR; PG8_SCHED;
            PG8_STAGE(PG8_SB(0, 1), b2 + hstep, voffB);
            PG8_WAIT_V(6); PG8_BAR; PG8_MMA(1, 1, At, B1); PG8_BAR;
            PG8_LDB(B0, 1, 0); PG8_SCHED; PG8_LDA(At, 1, 0); PG8_STAGE(PG8_SA(0, 1), a2 + hstep, voffA);
            PG8_WAIT_L(8); PG8_BAR; PG8_WAIT_L(0); PG8_MMA(0, 0, At, B0); PG8_BAR; PG8_SCHED;
            PG8_LDB(B1, 1, 1); PG8_STAGE(PG8_SB(1, 0), b3, voffB);
            PG8_BAR; PG8_WAIT_L(0); PG8_MMA(0, 1, At, B1); PG8_BAR;
            PG8_LDA(At, 1, 1); PG8_STAGE(PG8_SA(1, 0), a3, voffA);
            PG8_BAR; PG8_WAIT_L(0); PG8_MMA(1, 0, At, B0); PG8_BAR; PG8_SCHED;
            PG8_STAGE(PG8_SB(1, 1), b3 + hstep, voffB);
            PG8_WAIT_V(6); PG8_BAR; PG8_MMA(1, 1, At, B1); PG8_BAR;
            }
        }
        if constexpr (ALIGN_EPI) { if (wr == 0) PG8_BAR; }
        if constexpr (!Epi::AFTER_DRAIN) { E(acc, cur, wr, wc, fr, fq); S.done(cur); }
        if (!has_next) break;
#pragma unroll
        for (int a = 0; a < 2; ++a)
#pragma unroll
            for (int b = 0; b < 2; ++b)
#pragma unroll
                for (int m = 0; m < 4; ++m)
#pragma unroll
                    for (int n = 0; n < 2; ++n) acc[a][b][m][n] = (f32x4){0.f, 0.f, 0.f, 0.f};
        cur = nxt; cA = nA; cB = nB; ++ui;
        if constexpr (ALIGN_EPI) { if (wr == 1) PG8_BAR; }
    }
    PG8_WAIT_V(0);
    if constexpr (!ALIGN_EPI) { if (wr == 0) PG8_BAR; }
    PG8_BAR;
    if constexpr (Epi::AFTER_DRAIN) { E.fused(acc, cur, wr, wc, fr, fq, lds, wid, lane); S.done(cur); }
#undef PG8_SA
#undef PG8_SB
#undef PG8_STAGE
#undef PG8_LDA
#undef PG8_LDB
#undef PG8_MMA
#undef PG8_WAIT_V
#undef PG8_WAIT_L
#undef PG8_BAR
#undef PG8_SCHED
}
}

constexpr int NTHR = 512, NWAVES = 8;
constexpr int LDS_BYTES = 147456;

#define IN_F(i) ((const float*)a.in[i])
#define WS_F(off) ((float*)(a.ws + (off)))
#define WS_B(off) ((bf16*)(a.ws + (off)))

__device__ __forceinline__ void phase_mod(const Args& a, LAS unsigned char* lds, int bid, int nblk) {
    const int tid = threadIdx.x, lane = tid & 63, w = tid >> 6;
    LAS float* sc = (LAS float*)lds;
    LAS float* red = (LAS float*)(lds + 98304);
    for (int i = tid; i < 12 * DM; i += NTHR) { const int b = i >> 11, k = i & 2047; const float c = b < 4 ? IN_F(I_CP)[b * DM + k] : IN_F(I_CS)[(b - 4) * DM + k]; sc[i] = silu_f(c); }
    if (bid == 0) for (int i = tid; i < DA; i += NTHR) WS_F(WS_LBV)[i] = sigmoid_f(IN_F(I_LB)[i]);
    __syncthreads();
    for (int u = bid; u < 176; u += nblk) {
        const bool fm = u >= 144; const int n0 = (fm ? u - 144 : u) * 128, ld = fm ? NFMODC : NMODC;
        const float* W = fm ? IN_F(I_WFM) : IN_F(I_WMOD); const float* bias = fm ? IN_F(I_BFM) : IN_F(I_BMOD); float* outp = fm ? WS_F(WS_FMOD) : WS_F(WS_MOD);
        f32x2 acc[12];
#pragma unroll
        for (int b = 0; b < 12; ++b) acc[b] = (f32x2){0.f, 0.f};
        const float* wp = W + (size_t)(w * 256) * ld + n0 + 2 * lane;
        for (int k = 0; k < 256; k += 4) {
            const f32x2 w0 = *(const f32x2*)(wp + (size_t)(k + 0) * ld), w1 = *(const f32x2*)(wp + (size_t)(k + 1) * ld), w2 = *(const f32x2*)(wp + (size_t)(k + 2) * ld), w3 = *(const f32x2*)(wp + (size_t)(k + 3) * ld);
#pragma unroll
            for (int b = 0; b < 12; ++b) { const f32x4 s = *(const LAS f32x4*)(sc + b * DM + w * 256 + k); acc[b] += w0 * s.x + w1 * s.y + w2 * s.z + w3 * s.w; }
        }
#pragma unroll
        for (int b = 0; b < 12; ++b) *(LAS f32x2*)(red + (w * 12 + b) * 128 + 2 * lane) = acc[b];
        __syncthreads();
        for (int i = tid; i < 12 * 128; i += NTHR) { const int b = i >> 7, c = i & 127; float s = 0.f;
#pragma unroll
            for (int ww = 0; ww < 8; ++ww) s += red[(ww * 12 + b) * 128 + c];
            outp[(size_t)b * ld + n0 + c] = s + bias[n0 + c]; }
        __syncthreads();
    }
}

__device__ __forceinline__ void cvt_item(const float* W, int K, int N, bf16* WT, int k0, int n0, int drow0, LAS float* scr, int lane) {
#pragma unroll 8
    for (int i = 0; i < 32; ++i) { const int kk = 2 * i + (lane >> 5); scr[kk * 33 + (lane & 31)] = W[(size_t)(k0 + kk) * N + n0 + (lane & 31)]; }
    LDS_WAIT(); asm volatile("" ::: "memory");
    const int c = lane & 7;
#pragma unroll
    for (int j = 0; j < 4; ++j) { const int n = (lane >> 3) + 8 * j; const LAS float* s = scr + (8 * c) * 33 + n;
        v4u o; o.x = pk2(s[0 * 33], s[1 * 33]); o.y = pk2(s[2 * 33], s[3 * 33]); o.z = pk2(s[4 * 33], s[5 * 33]); o.w = pk2(s[6 * 33], s[7 * 33]);
        *(GAS v4u*)(WT + (size_t)(drow0 + n) * K + k0 + 8 * c) = o; }
    LDS_WAIT(); asm volatile("" ::: "memory");
}
__device__ __forceinline__ void cvt_matrix(const float* W, int K, int N, bf16* WT, int mode, LAS float* scr, int gw, int ngw, int lane) {
    const int nblk = N / 32, nitems = (K / 64) * nblk;
    for (int it = gw; it < nitems; it += ngw) { const int kb = it / nblk, nb = it % nblk, n0 = 32 * nb;
        const int drow0 = mode == 0 ? n0 : ((n0 >> 7) * 256 + (mode == 2 ? 128 : 0) + (n0 & 127));
        cvt_item(W, K, N, WT, 64 * kb, n0, drow0, scr, lane); }
}
__device__ __forceinline__ void phase_cvt(const Args& a, LAS unsigned char* lds, int bid, int nblk, int first, int last) {
    const int tid = threadIdx.x, lane = tid & 63, w = tid >> 6;
    LAS float* scr = (LAS float*)(lds + w * 16384);
    const int gw = bid * NWAVES + w, ngw = nblk * NWAVES;
    if (first <= 0 && 0 <= last) { cvt_matrix(IN_F(I_WG1), DM, DFF, WS_B(WS_WGU1), 1, scr, gw, ngw, lane); cvt_matrix(IN_F(I_WU1), DM, DFF, WS_B(WS_WGU1), 2, scr, gw, ngw, lane);
                                   cvt_matrix(IN_F(I_WD1), DFF, DM, WS_B(WS_WD1), 0, scr, gw, ngw, lane); }
    if (first <= 1 && 1 <= last) { cvt_matrix(IN_F(I_WIN), DM, DIN, WS_B(WS_WIN), 0, scr, gw, ngw, lane); cvt_matrix(IN_F(I_WOUT), DM, DM, WS_B(WS_WOUT), 0, scr, gw, ngw, lane); }
    if (first <= 2 && 2 <= last) { cvt_matrix(IN_F(I_WG2), DM, DFF, WS_B(WS_WGU2), 1, scr, gw, ngw, lane); cvt_matrix(IN_F(I_WU2), DM, DFF, WS_B(WS_WGU2), 2, scr, gw, ngw, lane);
                                   cvt_matrix(IN_F(I_WD2), DFF, DM, WS_B(WS_WD2), 0, scr, gw, ngw, lane); }
}

template <bool FINAL>
__device__ __forceinline__ void phase_norm(const Args& a, int bid, int nblk, bool from_inputs, const float* gvec, const float* modp, int ldmod, int sh_off, int sc_off) {
    const int tid = threadIdx.x, lane = tid & 63, w = tid >> 6;
    const int gw = bid * NWAVES + w, ngw = nblk * NWAVES;
    const int nrows = FINAL ? MREAL : MPAD;
    for (int r = gw; r < nrows; r += ngw) {
        if (r >= MREAL) {
            GAS v4u* o = (GAS v4u*)(WS_B(WS_XN) + (size_t)r * DM) + lane;
#pragma unroll
            for (int j = 0; j < 4; ++j) o[64 * j] = (v4u){0u, 0u, 0u, 0u};
            continue;
        }
        const float* xrow = from_inputs ? (r < MP ? IN_F(I_XP) + (size_t)r * DM : IN_F(I_XS) + (size_t)(r - MP) * DM) : WS_F(WS_X) + (size_t)r * DM;
        const GAS f32x4* xr = (const GAS f32x4*)xrow + lane;
        f32x4 v[8]; float s = 0.f;
#pragma unroll
        for (int j = 0; j < 8; ++j) { v[j] = xr[64 * j]; s += (v[j].x * v[j].x + v[j].y * v[j].y) + (v[j].z * v[j].z + v[j].w * v[j].w); }
        const float rstd = 1.0f / sqrtf(wave_sum(s) * (1.f / DM) + EPS);
        const float* mr = modp + (size_t)mod_row(r) * ldmod;
#pragma unroll
        for (int j = 0; j < 8; ++j) {
            const int c = 4 * (lane + 64 * j);
            const f32x4 g = *(const f32x4*)(gvec + c), sh = *(const f32x4*)(mr + sh_off + c), sc = *(const f32x4*)(mr + sc_off + c);
            const f32x4 y = (v[j] * rstd * g) * (1.f + sc) + sh;
            if (FINAL) { float* dst = r < MP ? a.out + OFF_YP + (size_t)r * DM : a.out + OFF_YS + (size_t)(r - MP) * DM; *(f32x4*)(dst + c) = y; }
            else { v2u o; o.x = pk2(y.x, y.y); o.y = pk2(y.z, y.w); *(GAS v2u*)(WS_B(WS_XN) + (size_t)r * DM + c) = o; }
        }
    }
}

template <int WHICH> __device__ __forceinline__ void phase_gemm(const Args& a, LAS unsigned char* lds, int bid, int nblk) {
    using namespace pg8;
    if constexpr (WHICH == 1 || WHICH == 5) {
        Gemm g{WS_B(WS_XN), WS_B(WHICH == 1 ? WS_WGU1 : WS_WGU2), MPAD, 2 * DFF, DM}; StaticOrder S; S.init(MPAD, 2 * DFF, nblk, bid);
        EpiSwiGLU E{WS_B(WS_H), DFF};
        gemm_phase<EpiSwiGLU, StaticOrder, true, true>(lds, g, S, E);
    } else if constexpr (WHICH == 2 || WHICH == 6) {
        Gemm g{WS_B(WS_H), WS_B(WHICH == 2 ? WS_WD1 : WS_WD2), MPAD, DM, DFF}; StaticOrder S; S.init(MPAD, DM, nblk, bid);
        EpiResid E{WHICH == 2 ? IN_F(I_XP) : nullptr, IN_F(I_XS), WS_F(WS_X), WS_F(WS_MOD) + (WHICH == 2 ? 2 : 8) * DM, 0.5f};
        gemm_phase<EpiResid, StaticOrder, true, true>(lds, g, S, E);
    } else if constexpr (WHICH == 3) {
        Gemm g{WS_B(WS_XN), WS_B(WS_WIN), MPAD, DIN, DM}; StaticOrder S; S.init(MPAD, DIN, nblk, bid);
        EpiProj E{a.ws, WS_F(WS_LF), a.out, WS_F(WS_LBV)};
        gemm_phase<EpiProj, StaticOrder, true, true>(lds, g, S, E);
    } else {
        Gemm g{WS_B(WS_OM), WS_B(WS_WOUT), MPAD, DM, DM}; StaticOrder S; S.init(MPAD, DM, nblk, bid);
        EpiResid E{nullptr, IN_F(I_XS), WS_F(WS_X), WS_F(WS_MOD) + 5 * DM, 1.0f};
        gemm_phase<EpiResid, StaticOrder, true, true>(lds, g, S, E);
    }
}

__device__ __forceinline__ void hgrn_unit(const Args& a, LAS unsigned char* lds, int unit) {
    const int tid = threadIdx.x, dv = tid & 127, g = tid >> 7;
    const bool smp = unit >= 32; const int u = smp ? unit - 32 : unit, b = u >> 3, h = u & 7;
    const int T = smp ? DECT : SEQ, row0 = smp ? MP + b * DECT : b * SEQ;
    float* sout = a.out + (smp ? OFF_SS : OFF_SP) + (size_t)u * HD * HD;
    LAS float* fL = (LAS float*)lds; LAS float* kL = fL + 2048; LAS float* qL = kL + 2048; LAS float* vL = qL + 2048; LAS float* red = vL + 2048;
    const bf16* QA = WS_B(WS_QA); const bf16* IA = WS_B(WS_IA); const bf16* GA = WS_B(WS_GA); const float* LF = WS_F(WS_LF);
    float S[32];
#pragma unroll
    for (int i = 0; i < 32; ++i) S[i] = smp ? IN_F(I_ST)[(size_t)u * HD * HD + (size_t)(32 * g + i) * HD + dv] : 0.f;
    for (int t0 = 0; t0 < T; t0 += 16) {
        const int nt = (T - t0) < 16 ? (T - t0) : 16;
        for (int i = tid; i < nt * 128; i += NTHR) { const int tt = i >> 7, ch = i & 127; const size_t o = (size_t)(row0 + t0 + tt) * DA + h * HD + ch;
            const float f = __expf(LF[o]); fL[i] = f; kL[i] = 1.f - f; qL[i] = bf2f(QA[o]); vL[i] = bf2f(IA[o]); }
        __syncthreads();
        for (int tt = 0; tt < nt; ++tt) {
            const float v = vL[tt * 128 + dv]; float op = 0.f;
#pragma unroll
            for (int i4 = 0; i4 < 8; ++i4) {
                const f32x4 f4 = *(const LAS f32x4*)(fL + tt * 128 + g * 32 + 4 * i4), k4 = *(const LAS f32x4*)(kL + tt * 128 + g * 32 + 4 * i4), q4 = *(const LAS f32x4*)(qL + tt * 128 + g * 32 + 4 * i4);
#pragma unroll
                for (int j = 0; j < 4; ++j) { S[4 * i4 + j] = f4[j] * S[4 * i4 + j] + k4[j] * v; op += S[4 * i4 + j] * q4[j]; }
            }
            red[(g * 16 + tt) * 128 + dv] = op;
        }
        __syncthreads();
        { const int tt = tid >> 5, l32 = tid & 31;
          if (tt < nt) {
            f32x4 o = (f32x4){0.f, 0.f, 0.f, 0.f};
#pragma unroll
            for (int gg = 0; gg < 4; ++gg) o += *(const LAS f32x4*)(red + (gg * 16 + tt) * 128 + 4 * l32);
            float ss = (o.x * o.x + o.y * o.y) + (o.z * o.z + o.w * o.w);
#pragma unroll
            for (int m = 1; m < 32; m <<= 1) ss += __shfl_xor(ss, m);
            const float rstd = 1.0f / sqrtf(ss * (1.f / HD) + EPS);
            const int row = row0 + t0 + tt, col = h * HD + 4 * l32;
            const f32x4 gw = *(const f32x4*)(IN_F(I_GOA) + col); const v2u gt = *(const v2u*)(GA + (size_t)row * DA + col);
            v2u w; w.x = pk2(o.x * rstd * gw.x * bflo(gt.x), o.y * rstd * gw.y * bfhi(gt.x)); w.y = pk2(o.z * rstd * gw.z * bflo(gt.y), o.w * rstd * gw.w * bfhi(gt.y));
            *(v2u*)(WS_B(WS_OM) + (size_t)row * DM + col) = w;
          } }
        __syncthreads();
    }
#pragma unroll
    for (int i = 0; i < 32; ++i) sout[(size_t)(32 * g + i) * HD + dv] = S[i];
}

__device__ __forceinline__ void sb_tile(const LAS float* Kt, const LAS float* Vt, const LAS float* q, float bias, int lane, int nvis  , float& R, float& o0, float& o1) {
    float z = bias;
#pragma unroll 8
    for (int d = 0; d < HD; d += 4) { const f32x4 qv = *(const LAS f32x4*)(q + d);
        z += qv.x * Kt[lane * 129 + d] + qv.y * Kt[lane * 129 + d + 1] + qv.z * Kt[lane * 129 + d + 2] + qv.w * Kt[lane * 129 + d + 3]; }
    const bool vis = lane < nvis;
    const float L = vis ? -(z > 20.f ? z : log1pf(__expf(z))) : 0.f;
    float c = L;
#pragma unroll
    for (int off = 1; off < 64; off <<= 1) { const float t = __shfl_down(c, off); if (lane + off < 64) c += t; }
    const float P = vis ? __expf(z + c + R) : 0.f;
    R += __shfl(c, 0);
#pragma unroll 8
    for (int s = 0; s < 64; ++s) { const float p = __builtin_bit_cast(float, __builtin_amdgcn_readlane(__builtin_bit_cast(int, P), s));
        o0 += p * Vt[s * 128 + lane]; o1 += p * Vt[s * 128 + 64 + lane]; }
}
__device__ __forceinline__ void sb_finish(const Args& a, int row, int h, int lane, float o0, float o1) {
    const float ss = wave_sum(o0 * o0 + o1 * o1);
    const float rstd = 1.0f / sqrtf(ss * (1.f / HD) + EPS);
    const float* gw = IN_F(I_GOB) + h * HD; bf16* dst = WS_B(WS_OM) + (size_t)row * DM + DA + h * HD;
    dst[lane] = (bf16)f2bf(o0 * rstd * gw[lane]); dst[64 + lane] = (bf16)f2bf(o1 * rstd * gw[64 + lane]);
}
__device__ __forceinline__ void sb_stage_bf16(const Args& a, LAS float* Kt, LAS float* Vt, int krow0, int nvalid, int h, int tid) {
    const bf16* KB = WS_B(WS_KB); const bf16* VB = WS_B(WS_VB);
#pragma unroll
    for (int i = 0; i < 2; ++i) { const int ch = tid + i * NTHR, r = ch >> 4, d0 = (ch & 15) * 8;
        v4u kv = (v4u){0u, 0u, 0u, 0u}, vv = (v4u){0u, 0u, 0u, 0u};
        if (r < nvalid) { const size_t o = (size_t)(krow0 + r) * DA + h * HD + d0; kv = *(const v4u*)(KB + o); vv = *(const v4u*)(VB + o); }
        LAS float* kd = Kt + r * 129 + d0; LAS float* vd = Vt + r * 128 + d0;
        kd[0] = bflo(kv.x); kd[1] = bfhi(kv.x); kd[2] = bflo(kv.y); kd[3] = bfhi(kv.y); kd[4] = bflo(kv.z); kd[5] = bfhi(kv.z); kd[6] = bflo(kv.w); kd[7] = bfhi(kv.w);
        vd[0] = bflo(vv.x); vd[1] = bfhi(vv.x); vd[2] = bflo(vv.y); vd[3] = bfhi(vv.y); vd[4] = bflo(vv.z); vd[5] = bfhi(vv.z); vd[6] = bflo(vv.w); vd[7] = bfhi(vv.w); }
}
__device__ __forceinline__ void sb_unit_prompt(const Args& a, LAS unsigned char* lds, int unit) {
    const int tid = threadIdx.x, lane = tid & 63, w = tid >> 6;
    const int bh = unit >> 8, qb = unit & 255, b = bh >> 3, h = bh & 7, t = qb * 8 + w, row = b * SEQ + t;
    LAS float* Kt = (LAS float*)lds; LAS float* Vt = Kt + 64 * 129; LAS float* qs = Vt + 64 * 128;
    if (lane < 32) { const v2u qv = *(const v2u*)(WS_B(WS_QB) + (size_t)row * DA + h * HD + 4 * lane); LAS float* q = qs + w * HD + 4 * lane; q[0] = bflo(qv.x); q[1] = bfhi(qv.x); q[2] = bflo(qv.y); q[3] = bfhi(qv.y); }
    const float bias = IN_F(I_BSB)[h];
    float R = 0.f, o0 = 0.f, o1 = 0.f;
    for (int j = (qb * 8 + 6) >> 6; j >= 0; --j) {
        __syncthreads();
        sb_stage_bf16(a, Kt, Vt, b * SEQ + 64 * j, 64, h, tid);
        __syncthreads();
        int nvis = t - 64 * j; nvis = nvis < 0 ? 0 : (nvis > 64 ? 64 : nvis);
        sb_tile(Kt, Vt, qs + w * HD, bias, lane, nvis, R, o0, o1);
    }
    sb_finish(a, row, h, lane, o0, o1);
    __syncthreads();
}
__device__ __forceinline__ void sb_unit_sample(const Args& a, LAS unsigned char* lds, int unit) {
    const int tid = threadIdx.x, lane = tid & 63, w = tid >> 6;
    const int b = unit >> 3, h = unit & 7, row = MP + b * DECT + w;
    LAS float* Kt = (LAS float*)lds; LAS float* Vt = Kt + 64 * 129; LAS float* qs = Vt + 64 * 128;
    if (lane < 32) { const v2u qv = *(const v2u*)(WS_B(WS_QB) + (size_t)row * DA + h * HD + 4 * lane); LAS float* q = qs + w * HD + 4 * lane; q[0] = bflo(qv.x); q[1] = bfhi(qv.x); q[2] = bflo(qv.y); q[3] = bfhi(qv.y); }
    const float bias = IN_F(I_BSB)[h];
    float R = 0.f, o0 = 0.f, o1 = 0.f;
    __syncthreads();
    sb_stage_bf16(a, Kt, Vt, MP + b * DECT, DECT, h, tid);
    __syncthreads();
    sb_tile(Kt, Vt, qs + w * HD, bias, lane, w, R, o0, o1);
    const int* pt = (const int*)a.in[I_PT] + b * NPAGES;
    for (int j = PAST / 64 - 1; j >= 0; --j) {
        __syncthreads();
        { const int page = pt[j >> 1]; const size_t base = ((size_t)page * PAGE + (j & 1) * 64) * (NHEAD * HD) + h * HD;
          const float* ck = IN_F(I_CK) + base; const float* cv = IN_F(I_CV) + base;
#pragma unroll
          for (int i = 0; i < 4; ++i) { const int ch = tid + i * NTHR, r = ch >> 5, d0 = (ch & 31) * 4;
              const f32x4 kv = *(const f32x4*)(ck + (size_t)r * (NHEAD * HD) + d0), vv = *(const f32x4*)(cv + (size_t)r * (NHEAD * HD) + d0);
              LAS float* kd = Kt + r * 129 + d0; kd[0] = kv.x; kd[1] = kv.y; kd[2] = kv.z; kd[3] = kv.w;
              *(LAS f32x4*)(Vt + r * 128 + d0) = vv; } }
        __syncthreads();
        sb_tile(Kt, Vt, qs + w * HD, bias, lane, 64, R, o0, o1);
    }
    sb_finish(a, row, h, lane, o0, o1);
    __syncthreads();
}
__device__ __forceinline__ void phase_mixer(const Args& a, LAS unsigned char* lds, int bid, int nblk) {
    { const int tid = threadIdx.x; GAS v4u* o = (GAS v4u*)(WS_B(WS_OM) + (size_t)MREAL * DM);
      for (int i = bid * NTHR + tid; i < (MPAD - MREAL) * DM / 8; i += nblk * NTHR) o[i] = (v4u){0u, 0u, 0u, 0u}; }
    for (int u = bid; u < 96 + 64 + 8192; u += nblk) {
        if (u < 96) hgrn_unit(a, lds, u);
        else if (u < 160) sb_unit_sample(a, lds, u - 96);
        else sb_unit_prompt(a, lds, u - 160);
    }
}


enum { PH_MOD = 0, PH_CVT, PH_NORM1, PH_G1, PH_G2, PH_NORM2, PH_G3, PH_MIX, PH_G4, PH_NORM3, PH_G5, PH_G6, PH_FINAL, N_PHASES };

template <int PH> __device__ __forceinline__ void run_phase(const Args& a, LAS unsigned char* lds, int bid, int nblk) {
    if constexpr (PH == PH_MOD) phase_mod(a, lds, bid, nblk);
    else if constexpr (PH == PH_CVT) phase_cvt(a, lds, bid, nblk, 0, 2);
    else if constexpr (PH == PH_NORM1) phase_norm<false>(a, bid, nblk, true, IN_F(I_N1), WS_F(WS_MOD), NMODC, 0 * DM, 1 * DM);
    else if constexpr (PH == PH_G1) phase_gemm<1>(a, lds, bid, nblk);
    else if constexpr (PH == PH_G2) phase_gemm<2>(a, lds, bid, nblk);
    else if constexpr (PH == PH_NORM2) phase_norm<false>(a, bid, nblk, false, IN_F(I_NM), WS_F(WS_MOD), NMODC, 3 * DM, 4 * DM);
    else if constexpr (PH == PH_G3) phase_gemm<3>(a, lds, bid, nblk);
    else if constexpr (PH == PH_MIX) phase_mixer(a, lds, bid, nblk);
    else if constexpr (PH == PH_G4) phase_gemm<4>(a, lds, bid, nblk);
    else if constexpr (PH == PH_NORM3) phase_norm<false>(a, bid, nblk, false, IN_F(I_N2), WS_F(WS_MOD), NMODC, 6 * DM, 7 * DM);
    else if constexpr (PH == PH_G5) phase_gemm<5>(a, lds, bid, nblk);
    else if constexpr (PH == PH_G6) phase_gemm<6>(a, lds, bid, nblk);
    else phase_norm<true>(a, bid, nblk, false, IN_F(I_NF), WS_F(WS_FMOD), NFMODC, 0, DM);
}

#define XB_TMO      128
#define XB_XCNT(j)  (256  + 64 * (j))
#define XB_XSUB(j)  (1280 + 64 * (j))
#define XB_XGEN(j)  (2304 + 64 * (j))
#define XB_TOP      3328
#define XB_TOPGEN   3392
#define XCD_BAR_WORDS 3456
#define XB_SPIN_CAP (1u << 18)

__device__ __forceinline__ unsigned xb_ld(unsigned* p)              { return __hip_atomic_load(p, __ATOMIC_RELAXED, __HIP_MEMORY_SCOPE_AGENT); }
__device__ __forceinline__ unsigned xb_add(unsigned* p, unsigned v) { return __hip_atomic_fetch_add(p, v, __ATOMIC_RELAXED, __HIP_MEMORY_SCOPE_AGENT); }
__device__ __forceinline__ unsigned xb_xcc_id() { return (unsigned)__builtin_amdgcn_s_getreg((3 << 11) | 20) & 0xFu; }
#define XB_SPIN(cond, bar) do { unsigned _sp = 0; while (cond) { __builtin_amdgcn_s_sleep(1); \
    if ((++_sp & 255u) == 0u) { if (xb_ld(&(bar)[XB_TMO])) break; if (_sp > XB_SPIN_CAP) { atomicAdd(&(bar)[XB_TMO], 1u); break; } } } } while (0)

struct XcdBarrier {
    unsigned* bar; unsigned x;
    volatile LAS unsigned* st;
};

__device__ __forceinline__ XcdBarrier xcd_barrier_post(unsigned* bar, volatile LAS unsigned* st) {
    XcdBarrier b; b.bar = bar; b.x = xb_xcc_id(); b.st = st;
    if (threadIdx.x == 0) (void)xb_add(&bar[XB_XCNT(b.x)], 1u);
    return b;
}
__device__ __forceinline__ void xcd_barrier_complete(unsigned* bar, unsigned x, unsigned& nloc, unsigned& nx) {
    const unsigned G = gridDim.x * gridDim.y * gridDim.z;
    unsigned sum, cnt, mine, sp = 0u;
    for (;;) {
        sum = 0u; cnt = 0u; mine = 0u;
#pragma unroll
        for (unsigned j = 0; j < 16; ++j) { const unsigned c = xb_ld(&bar[XB_XCNT(j)]); sum += c; cnt += (c > 0u) ? 1u : 0u; mine = (j == x) ? c : mine; }
        if (sum == G) break;
        __builtin_amdgcn_s_sleep(1);
        if ((++sp & 255u) == 0u) { if (xb_ld(&bar[XB_TMO])) break; if (sp > XB_SPIN_CAP) { atomicAdd(&bar[XB_TMO], 1u); break; } }
    }
    nloc = mine > 0u ? mine : 1u; nx = cnt > 0u ? cnt : 1u;
}

__device__ __forceinline__ void xcd_barrier(const XcdBarrier& b) {
    asm volatile("s_waitcnt vmcnt(0)" ::: "memory");
    __syncthreads();
    if (threadIdx.x == 0) {
        unsigned* bar = b.bar;
        __builtin_amdgcn_s_waitcnt(0);
        unsigned nloc = b.st[0], nx = b.st[1];
        if (nloc == 0u) { xcd_barrier_complete(bar, b.x, nloc, nx); b.st[0] = nloc; b.st[1] = nx; }
        const unsigned old = xb_add(&bar[XB_XSUB(b.x)], 1u);
        const unsigned gen = old / nloc;
        if (old + 1u == (gen + 1u) * nloc) {
            __builtin_amdgcn_fence(__ATOMIC_RELEASE, "agent");
            asm volatile("s_waitcnt vmcnt(0)" ::: "memory");
            const unsigned og = xb_add(&bar[XB_TOP], 1u);
            const unsigned tg = og / nx;
            if (og + 1u == (tg + 1u) * nx) xb_add(&bar[XB_TOPGEN], 1u);
            else XB_SPIN(xb_ld(&bar[XB_TOPGEN]) == tg, bar);
            __builtin_amdgcn_fence(__ATOMIC_ACQUIRE, "agent");
            xb_add(&bar[XB_XGEN(b.x)], 1u);
            asm volatile("s_waitcnt vmcnt(0)" ::: "memory");
        } else {
            XB_SPIN(xb_ld(&bar[XB_XGEN(b.x)]) == gen, bar);
            __builtin_amdgcn_fence(__ATOMIC_ACQUIRE, "agent");
            asm volatile("s_waitcnt vmcnt(0)" ::: "memory");
        }
    }
    __syncthreads();
}


constexpr int LDS_BAR_OFF = LDS_BYTES;
constexpr int LDS_TOTAL = LDS_BYTES + 64;

__global__ void __launch_bounds__(NTHR, 2) mega_fwd(Args a) {
    extern __shared__ __attribute__((aligned(16))) unsigned char lds_raw[];
    LAS unsigned char* lds = (LAS unsigned char*)lds_raw;
    const int bid = (int)blockIdx.x, nblk = (int)gridDim.x;
    if (threadIdx.x < 16) ((LAS unsigned*)(lds + LDS_BAR_OFF))[threadIdx.x] = 0u;
    __syncthreads();
    XcdBarrier bar = xcd_barrier_post((unsigned*)(a.ws + WS_CTL), (volatile LAS unsigned*)(lds + LDS_BAR_OFF));
    run_phase<PH_MOD>(a, lds, bid, nblk);
    __syncthreads();
    run_phase<PH_CVT>(a, lds, bid, nblk);
    xcd_barrier(bar);
    run_phase<PH_NORM1>(a, lds, bid, nblk);
    xcd_barrier(bar);
    run_phase<PH_G1>(a, lds, bid, nblk);
    xcd_barrier(bar);
    run_phase<PH_G2>(a, lds, bid, nblk);
    xcd_barrier(bar);
    run_phase<PH_NORM2>(a, lds, bid, nblk);
    xcd_barrier(bar);
    run_phase<PH_G3>(a, lds, bid, nblk);
    xcd_barrier(bar);
    run_phase<PH_MIX>(a, lds, bid, nblk);
    xcd_barrier(bar);
    run_phase<PH_G4>(a, lds, bid, nblk);
    xcd_barrier(bar);
    run_phase<PH_NORM3>(a, lds, bid, nblk);
    xcd_barrier(bar);
    run_phase<PH_G5>(a, lds, bid, nblk);
    xcd_barrier(bar);
    run_phase<PH_G6>(a, lds, bid, nblk);
    xcd_barrier(bar);
    run_phase<PH_FINAL>(a, lds, bid, nblk);
}

extern "C" void kernel_launch(void* const* d_in, const int* in_sizes, int n_in, void* d_out, int out_size, void* d_ws, size_t ws_size, hipStream_t stream) {
    static int grid = 0;
    if (grid == 0) {
        if (n_in != N_IN || (size_t)out_size != OUT_TOTAL || ws_size < WS_END) { fprintf(stderr, "kernel_launch: unexpected shapes (n_in %d, out %d, ws %zu)\n", n_in, out_size, ws_size); grid = -1; return; }
        int dev = 0, cus = 0, per_cu = 0;
        if (hipGetDevice(&dev) != hipSuccess || hipDeviceGetAttribute(&cus, hipDeviceAttributeMultiprocessorCount, dev) != hipSuccess) { grid = -1; return; }
        if (hipFuncSetAttribute((const void*)mega_fwd, hipFuncAttributeMaxDynamicSharedMemorySize, LDS_TOTAL) != hipSuccess) { fprintf(stderr, "kernel_launch: hipFuncSetAttribute failed\n"); grid = -1; return; }
        if (hipOccupancyMaxActiveBlocksPerMultiprocessor(&per_cu, (const void*)mega_fwd, NTHR, LDS_TOTAL) != hipSuccess || per_cu < 1) { fprintf(stderr, "kernel_launch: occupancy query says %d blocks per CU\n", per_cu); grid = -1; (void)hipGetLastError(); return; }
        grid = cus;
    }
    if (grid < 0) return;
    (void)hipMemsetAsync((char*)d_ws + WS_CTL, 0, 65536, stream);
    Args a{};
    for (int i = 0; i < N_IN; ++i) a.in[i] = d_in[i];
    a.out = (float*)d_out; a.ws = (unsigned char*)d_ws;
    hipLaunchKernelGGL(mega_fwd, dim3(grid), dim3(NTHR), LDS_TOTAL, stream, a);
}
```

```cpp
#include <hip/hip_runtime.h>
#include <cstdio>
#include <cstdint>

constexpr int DM = 2048, SEQ = 2048, NB = 4, MP = NB * SEQ  , DECB = 8, DECT = 8, MS = DECB * DECT  ;
constexpr int MREAL = MP + MS  , MPAD = 8448  ;
constexpr int DFF = 5632, DIN = 7168, NMODC = 9 * DM  , NFMODC = 2 * DM;
constexpr int DA = 1024, NHEAD = 8, HD = 128, PAST = 16384, PAGE = 128, NPAGES = PAST / PAGE  ;
constexpr float EPS = 1e-6f, QSCALE = 0.08838834764831845f  ;
constexpr float LOG2E = 1.4426950408889634f, LN2 = 0.6931471805599453f;
constexpr size_t OFF_YP = 0, OFF_YS = OFF_YP + (size_t)MP * DM, OFF_KP = OFF_YS + (size_t)MS * DM, OFF_VP = OFF_KP + (size_t)MP * DA,
                 OFF_KS = OFF_VP + (size_t)MP * DA, OFF_VS = OFF_KS + (size_t)MS * DA, OFF_SP = OFF_VS + (size_t)MS * DA,
                 OFF_SS = OFF_SP + (size_t)NB * NHEAD * HD * HD, OUT_TOTAL = OFF_SS + (size_t)DECB * NHEAD * HD * HD;
enum { I_XP = 0, I_XS, I_CK, I_CV, I_ST, I_PT, I_CP, I_CS, I_LB, I_N1, I_NM, I_N2, I_WMOD, I_BMOD, I_WG1, I_WU1, I_WD1, I_WIN, I_GOA, I_GOB, I_BSB, I_WOUT,
       I_WG2, I_WU2, I_WD2, I_NF, I_WFM, I_BFM, N_IN };
constexpr size_t MiB = 1u << 20;
constexpr size_t WS_CTL = 0, CTL_BYTES = 1 * MiB;
constexpr size_t WS_MOD = 1 * MiB;
constexpr size_t WS_FMOD = 2 * MiB;
constexpr size_t WS_LBV = 3 * MiB;
constexpr size_t WS_WGU1 = 4 * MiB, WS_WD1 = 48 * MiB, WS_WIN = 70 * MiB, WS_WOUT = 98 * MiB, WS_WGU2 = 106 * MiB, WS_WD2 = 150 * MiB;
constexpr size_t WS_XN = 172 * MiB;
constexpr size_t WS_H = 206 * MiB;
constexpr size_t WS_X = 298 * MiB;
constexpr size_t WS_QA = 364 * MiB, WS_IA = 381 * MiB, WS_GA = 398 * MiB, WS_QB = 415 * MiB, WS_KB = 432 * MiB, WS_VB = 449 * MiB;
constexpr size_t WS_LF = 466 * MiB;
constexpr size_t WS_OM = 500 * MiB;
constexpr size_t WS_PART = 534 * MiB;
constexpr size_t WS_END = 560 * MiB;

#define GAS __attribute__((address_space(1)))
#define LAS __attribute__((address_space(3)))
typedef unsigned short bf16;
typedef unsigned v4u __attribute__((ext_vector_type(4)));
typedef unsigned v2u __attribute__((ext_vector_type(2)));
typedef float f32x4 __attribute__((ext_vector_type(4)));
typedef float f32x2 __attribute__((ext_vector_type(2)));
typedef short bf16x8 __attribute__((ext_vector_type(8)));

struct Args { const void* in[N_IN]; float* out; unsigned char* ws; };

__device__ __forceinline__ unsigned f2bf(float f) { unsigned u = __builtin_bit_cast(unsigned, f); return (u + 0x7fffu + ((u >> 16) & 1u)) >> 16; }
__device__ __forceinline__ unsigned pk2(float lo, float hi) { return f2bf(lo) | (f2bf(hi) << 16); }
__device__ __forceinline__ float bf2f(unsigned short b) { return __builtin_bit_cast(float, (unsigned)b << 16); }
__device__ __forceinline__ float bflo(unsigned w) { return __builtin_bit_cast(float, w << 16); }
__device__ __forceinline__ float bfhi(unsigned w) { return __builtin_bit_cast(float, w & 0xffff0000u); }
__device__ __forceinline__ float sigmoid_f(float x) { return __builtin_amdgcn_rcpf(1.f + __expf(-x)); }
__device__ __forceinline__ float silu_f(float x) { return x * sigmoid_f(x); }
__device__ __forceinline__ int mod_row(int r) { const int s = 4 + ((r - MP) >> 3); return r < MP ? (r >> 11) : (s > 11 ? 11 : s); }
__device__ __forceinline__ float wave_sum(float v) {
#pragma unroll
    for (int o = 1; o < 64; o <<= 1) v += __shfl_xor(v, o);
    return v;
}
__device__ __forceinline__ int tid_opaque() { int t = (int)threadIdx.x; asm volatile("" : "+v"(t)); return t; }
#define LDS_WAIT() asm volatile("s_waitcnt lgkmcnt(0)" ::: "memory")
#define VM_WAIT() asm volatile("s_waitcnt vmcnt(0)" ::: "memory")

namespace pg8 {
#define PG8_LAS __attribute__((address_space(3)))
typedef unsigned short bf16_t;
typedef short bf16x8 __attribute__((ext_vector_type(8)));
typedef float f32x4 __attribute__((ext_vector_type(4)));
typedef unsigned u32x4 __attribute__((ext_vector_type(4)));
constexpr int BM = 256, BK = 64, HALF = 128, HTB = HALF * BK * 2  , STAGE_BYTES = 8 * HTB, NXCD = 8, WGM = 8;

__host__ __device__ __forceinline__ int lds_byte(int r, int c) { const int st = (r >> 4) * 2 + (c >> 5), rr = r & 15, cc = c & 31, ob = rr * 64 + cc * 2; return st * 1024 + (ob ^ (((ob >> 9) & 1) << 5)); }
__host__ __device__ __forceinline__ void stage_rc(int b, int& R, int& C) { const int st = b / 1024, sb = b % 1024, swz = sb ^ (((sb >> 9) & 1) << 5); R = (st >> 1) * 16 + swz / 64; C = (st & 1) * 32 + (swz % 64) / 2; }
__host__ __device__ __forceinline__ int perm32(int rho) { const int n = rho >> 4, i = rho & 15; return 8 * (i >> 2) + 4 * n + (i & 3); }

struct Unit { int pm, pn; };
struct Gemm { const bf16_t* A; const bf16_t* Bt; int M, N, K; };

struct StaticOrder {
    int nM, nN, nwg, G, c;
    __host__ __device__ void init(int M, int N, int G_, int c_) { nM = M / BM; nN = N / BM; nwg = nM * nN; G = G_; c = c_; }
    __host__ __device__ bool next(int i, Unit& u) const {
        const long L = (long)i * G + c; if (L >= nwg) return false;
        int wgid = (int)L; { const int q = nwg / NXCD, r = nwg % NXCD, xcd = wgid % NXCD, off = wgid / NXCD; wgid = (xcd < r ? xcd * (q + 1) : r * (q + 1) + (xcd - r) * q) + off; }
        const int nig = WGM * nN, gid = wgid / nig, fm = gid * WGM, gsz = (nM - fm) < WGM ? (nM - fm) : WGM;
        u.pm = fm + ((wgid % nig) % gsz); u.pn = (wgid % nig) / gsz; return true;
    }
    __device__ __forceinline__ void a_ready(const Unit&) const {}
    __device__ __forceinline__ void done(const Unit&) const {}
};


__device__ __forceinline__ unsigned cvt_pk_bf16(float lo, float hi) { unsigned r; asm volatile("v_cvt_pk_bf16_f32 %0, %1, %2" : "=v"(r) : "v"(lo), "v"(hi)); return r; }

struct EpiSwiGLU {
    static constexpr bool PERM = true, AFTER_DRAIN = false;
    bf16_t* H; int ldh;
    __device__ __forceinline__ void operator()(const f32x4 (&acc)[2][2][4][2], const Unit& u, int wr, int wc, int fr, int fq) const {
        const int row0 = u.pm * BM + wr * 64 + fr, col0 = u.pn * HALF + wc * 32 + 8 * fq;
#pragma unroll
        for (int ai = 0; ai < 2; ++ai)
#pragma unroll
            for (int m = 0; m < 4; ++m) {
                const f32x4 g0 = acc[ai][0][m][0], g1 = acc[ai][0][m][1], u0 = acc[ai][1][m][0], u1 = acc[ai][1][m][1];
                float v[8];
#pragma unroll
                for (int j = 0; j < 4; ++j) { v[j] = silu_f(g0[j]) * u0[j]; v[4 + j] = silu_f(g1[j]) * u1[j]; }
                u32x4 w; w.x = cvt_pk_bf16(v[0], v[1]); w.y = cvt_pk_bf16(v[2], v[3]); w.z = cvt_pk_bf16(v[4], v[5]); w.w = cvt_pk_bf16(v[6], v[7]);
                *(u32x4*)(H + (size_t)(row0 + ai * HALF + m * 16) * ldh + col0) = w;
            }
    }
};
struct EpiResid {
    static constexpr bool PERM = false, AFTER_DRAIN = false;
    const float* xp; const float* xs; float* X; const float* gate; float scale;
    __device__ __forceinline__ void operator()(const f32x4 (&acc)[2][2][4][2], const Unit& u, int wr, int wc, int fr, int fq) const {
        const int col0 = u.pn * BM + wc * 32 + 4 * fq;
#pragma unroll
        for (int ai = 0; ai < 2; ++ai)
#pragma unroll
            for (int m = 0; m < 4; ++m) {
                const int row = u.pm * BM + ai * HALF + wr * 64 + m * 16 + fr;
                if (row < MREAL) {
                    const float* base = xp ? (row < MP ? xp + (size_t)row * DM : xs + (size_t)(row - MP) * DM) : X + (size_t)row * DM;
                    const float* gr = gate + (size_t)mod_row(row) * NMODC;
#pragma unroll
                    for (int bj = 0; bj < 2; ++bj)
#pragma unroll
                        for (int n = 0; n < 2; ++n) { const int c = col0 + bj * HALF + n * 16;
                            const f32x4 gv = *(const f32x4*)(gr + c), bv = *(const f32x4*)(base + c);
                            *(f32x4*)(X + (size_t)row * DM + c) = bv + (gv * scale) * acc[ai][bj][m][n]; }
                }
            }
    }
};
struct EpiProj {
    static constexpr bool PERM = true, AFTER_DRAIN = false;
    unsigned char* ws; float* LF; float* out; const float* lbv;
    template <int MODE> __device__ __forceinline__ void run(const f32x4 (&acc)[2][2][4][2], const Unit& u, int wr, int wc, int fr, int fq, bf16_t* B, float s, size_t offp, size_t offs) const {
        const int cb = (u.pn & 3) * BM + wc * 32 + 8 * fq;
#pragma unroll
        for (int ai = 0; ai < 2; ++ai)
#pragma unroll
            for (int m = 0; m < 4; ++m) {
                const int row = u.pm * BM + ai * HALF + wr * 64 + m * 16 + fr;
#pragma unroll
                for (int bj = 0; bj < 2; ++bj) {
                    const int c = cb + bj * HALF; const size_t o = (size_t)row * DA + c;
                    f32x4 v0 = acc[ai][bj][m][0], v1 = acc[ai][bj][m][1];
                    if constexpr (MODE == 1) {
                        const f32x4 l0 = *(const f32x4*)(lbv + c), l1 = *(const f32x4*)(lbv + c + 4);
#pragma unroll
                        for (int j = 0; j < 4; ++j) { v0[j] = __logf(l0[j] + (1.f - l0[j]) * sigmoid_f(v0[j])); v1[j] = __logf(l1[j] + (1.f - l1[j]) * sigmoid_f(v1[j])); }
                        *(f32x4*)(LF + o) = v0; *(f32x4*)(LF + o + 4) = v1;
                    } else {
                        if constexpr (MODE == 3) {
                            if (row < MREAL) { float* dst = row < MP ? out + offp + o : out + offs + (o - (size_t)MP * DA); *(f32x4*)dst = v0; *(f32x4*)(dst + 4) = v1; }
                        }
                        if constexpr (MODE == 0) { v0 = v0 * s; v1 = v1 * s; }
                        if constexpr (MODE == 2) {
#pragma unroll
                            for (int j = 0; j < 4; ++j) { v0[j] = silu_f(v0[j]); v1[j] = silu_f(v1[j]); }
                        }
                        u32x4 w; w.x = cvt_pk_bf16(v0[0], v0[1]); w.y = cvt_pk_bf16(v0[2], v0[3]); w.z = cvt_pk_bf16(v1[0], v1[1]); w.w = cvt_pk_bf16(v1[2], v1[3]);
                        *(u32x4*)(B + o) = w;
                    }
                }
            }
    }
    __device__ __forceinline__ void operator()(const f32x4 (&acc)[2][2][4][2], const Unit& u, int wr, int wc, int fr, int fq) const {
        const int rng = u.pn >> 2;
        bf16_t* B = (bf16_t*)(ws + WS_QA + (size_t)(rng == 0 ? 0 : rng - 1) * (WS_IA - WS_QA));
        if (rng == 1) run<1>(acc, u, wr, wc, fr, fq, nullptr, 1.f, 0, 0);
        else if (rng == 3) run<2>(acc, u, wr, wc, fr, fq, B, 1.f, 0, 0);
        else if (rng >= 5) run<3>(acc, u, wr, wc, fr, fq, B, 1.f, rng == 5 ? OFF_KP : OFF_VP, rng == 5 ? OFF_KS : OFF_VS);
        else run<0>(acc, u, wr, wc, fr, fq, B, rng == 2 ? 1.f : (rng == 4 ? QSCALE * LOG2E : QSCALE), 0, 0);
    }
};
template <class Epi, class Sched, bool ALIGN_EPI = false, bool SP2 = false>
__device__ __forceinline__ void gemm_phase(PG8_LAS unsigned char* lds, const Gemm g, const Sched& S, const Epi& E) {
    const int tid = tid_opaque(), wid = __builtin_amdgcn_readfirstlane(tid >> 6), lane = tid & 63, wr = wid >> 2, wc = wid & 3, fr = lane & 15, fq = lane >> 4;
    const int K = g.K, nt = K / BK;
    unsigned voffA[2], voffB[2];
#pragma unroll
    for (int i = 0; i < 2; ++i) { int R, C; stage_rc(tid * 16 + i * 8192, R, C); const int Rb = Epi::PERM ? ((R & ~31) + perm32(R & 31)) : R;
        voffA[i] = (unsigned)(R * K + C) * 2u; voffB[i] = (unsigned)(Rb * K + C) * 2u; }
    const size_t kstep = (size_t)(BK * 2);
    const size_t hstep = (size_t)HALF * K * 2;
    const size_t tstep = 2 * hstep;
    const unsigned ldsw = (unsigned)wid * 1024u;
    const int aoff = lds_byte(wr * 64 + fr, fq * 8), boff = lds_byte(wc * 32 + fr, fq * 8);
#define PG8_SA(b, h) (((b) * 2 + (h)) * HTB)
#define PG8_SB(b, h) ((4 + (b) * 2 + (h)) * HTB)
#define PG8_STAGE(bufoff, gbase, voff) do { _Pragma("unroll") for (int _i = 0; _i < 2; ++_i) \
        __builtin_amdgcn_global_load_lds((const unsigned*)((const char*)(gbase) + (voff)[_i]), (PG8_LAS unsigned*)(lds + (bufoff) + ldsw + _i * 8192), 16, 0, 0); } while (0)
#define PG8_LDA(dst, b, h) do { _Pragma("unroll") for (int m = 0; m < 4; ++m) _Pragma("unroll") for (int k = 0; k < 2; ++k) dst[m][k] = *(const PG8_LAS bf16x8*)(lds + PG8_SA(b, h) + aoff + m * 2048 + k * 1024); } while (0)
#define PG8_LDB(dst, b, h) do { _Pragma("unroll") for (int n = 0; n < 2; ++n) _Pragma("unroll") for (int k = 0; k < 2; ++k) dst[n][k] = *(const PG8_LAS bf16x8*)(lds + PG8_SB(b, h) + boff + n * 2048 + k * 1024); } while (0)
#define PG8_MMA(ai, bj, At, Bt) do { __builtin_amdgcn_s_setprio(1); _Pragma("unroll") for (int m = 0; m < 4; ++m) _Pragma("unroll") for (int n = 0; n < 2; ++n) _Pragma("unroll") for (int k = 0; k < 2; ++k) \
        acc[ai][bj][m][n] = __builtin_amdgcn_mfma_f32_16x16x32_bf16(Bt[n][k], At[m][k], acc[ai][bj][m][n], 0, 0, 0); __builtin_amdgcn_s_setprio(0); } while (0)
#define PG8_WAIT_V(n) asm volatile("s_waitcnt vmcnt(" #n ")" ::: "memory")
#define PG8_WAIT_L(n) asm volatile("s_waitcnt lgkmcnt(" #n ")" ::: "memory")
#define PG8_BAR __builtin_amdgcn_s_barrier()
#define PG8_SCHED __builtin_amdgcn_sched_barrier(0)
    Unit cur, nxt; int ui = 0;
    if (!S.next(0, cur)) return;
    f32x4 acc[2][2][4][2];
#pragma unroll
    for (int a = 0; a < 2; ++a)
#pragma unroll
        for (int b = 0; b < 2; ++b)
#pragma unroll
            for (int m = 0; m < 4; ++m)
#pragma unroll
                for (int n = 0; n < 2; ++n) acc[a][b][m][n] = (f32x4){0.f, 0.f, 0.f, 0.f};
    bf16x8 At[4][2], B0[2][2], B1[2][2];
    const char* cA = (const char*)g.A + (size_t)cur.pm * tstep; const char* cB = (const char*)g.Bt + (size_t)cur.pn * tstep;
    S.a_ready(cur);
    if constexpr (SP2) {
        PG8_STAGE(PG8_SB(0, 0), cB, voffB); PG8_STAGE(PG8_SB(0, 1), cB + hstep, voffB); PG8_STAGE(PG8_SA(0, 0), cA, voffA); PG8_STAGE(PG8_SA(0, 1), cA + hstep, voffA);
        if (wr == 1) PG8_BAR;
        PG8_WAIT_V(2); PG8_BAR;
        PG8_STAGE(PG8_SB(1, 0), cB + kstep, voffB); PG8_STAGE(PG8_SA(1, 0), cA + kstep, voffA); PG8_STAGE(PG8_SB(1, 1), cB + hstep + kstep, voffB);
        PG8_WAIT_V(6); PG8_BAR;
    } else {
        PG8_STAGE(PG8_SB(0, 0), cB, voffB); PG8_STAGE(PG8_SA(0, 0), cA, voffA); PG8_STAGE(PG8_SB(0, 1), cB + hstep, voffB); PG8_STAGE(PG8_SA(0, 1), cA + hstep, voffA);
        if (wr == 1) PG8_BAR;
        PG8_WAIT_V(4); PG8_BAR;
        PG8_STAGE(PG8_SB(1, 0), cB + kstep, voffB); PG8_STAGE(PG8_SA(1, 0), cA + kstep, voffA); PG8_STAGE(PG8_SB(1, 1), cB + hstep + kstep, voffB);
        PG8_WAIT_V(6); PG8_BAR;
    }
    for (;;) {
        const bool has_next = S.next(ui + 1, nxt);
        const char* nA = has_next ? (const char*)g.A + (size_t)nxt.pm * tstep : cA; const char* nB = has_next ? (const char*)g.Bt + (size_t)nxt.pn * tstep : cB;
        for (int t = 0; t < nt; t += 2) {
            const bool last = (t == nt - 2);
            const char* a1 = cA + (size_t)(t + 1) * kstep;
            const char* a2 = last ? nA : cA + (size_t)(t + 2) * kstep; const char* b2 = last ? nB : cB + (size_t)(t + 2) * kstep;
            const char* a3 = a2 + kstep; const char* b3 = b2 + kstep;
            if (last && has_next) S.a_ready(nxt);
            if constexpr (SP2) {
            PG8_LDB(B0, 0, 0); PG8_LDB(B1, 0, 1); PG8_SCHED; PG8_LDA(At, 0, 0); PG8_STAGE(PG8_SA(1, 1), a1 + hstep, voffA);
            PG8_WAIT_V(8); PG8_WAIT_L(0); PG8_BAR; PG8_MMA(0, 0, At, B0); PG8_MMA(0, 1, At, B1); PG8_BAR; PG8_SCHED;
            PG8_LDA(At, 0, 1); PG8_STAGE(PG8_SB(0, 0), b2, voffB); PG8_STAGE(PG8_SB(0, 1), b2 + hstep, voffB); PG8_STAGE(PG8_SA(0, 0), a2, voffA);
            PG8_WAIT_V(8); PG8_WAIT_L(0); PG8_BAR; PG8_MMA(1, 0, At, B0); PG8_MMA(1, 1, At, B1); PG8_BAR; PG8_SCHED;
            PG8_LDB(B0, 1, 0); PG8_LDB(B1, 1, 1); PG8_SCHED; PG8_LDA(At, 1, 0); PG8_STAGE(PG8_SA(0, 1), a2 + hstep, voffA);
            PG8_WAIT_V(8); PG8_WAIT_L(0); PG8_BAR; PG8_MMA(0, 0, At, B0); PG8_MMA(0, 1, At, B1); PG8_BAR; PG8_SCHED;
            PG8_LDA(At, 1, 1); PG8_STAGE(PG8_SB(1, 0), b3, voffB); PG8_STAGE(PG8_SB(1, 1), b3 + hstep, voffB); PG8_STAGE(PG8_SA(1, 0), a3, voffA);
            PG8_WAIT_V(8); PG8_WAIT_L(0); PG8_BAR; PG8_MMA(1, 0, At, B0); PG8_MMA(1, 1, At, B1); PG8_BAR; PG8_SCHED;
            } else {
            PG8_LDB(B0, 0, 0); PG8_SCHED; PG8_LDA(At, 0, 0); PG8_STAGE(PG8_SA(1, 1), a1 + hstep, voffA);
            PG8_WAIT_L(8); PG8_BAR; PG8_WAIT_L(0); PG8_MMA(0, 0, At, B0); PG8_BAR; PG8_SCHED;
            PG8_LDB(B1, 0, 1); PG8_STAGE(PG8_SB(0, 0), b2, voffB);
            PG8_BAR; PG8_WAIT_L(0); PG8_MMA(0, 1, At, B1); PG8_BAR;
            PG8_LDA(At, 0, 1); PG8_STAGE(PG8_SA(0, 0), a2, voffA);
            PG8_BAR; PG8_WAIT_L(0); PG8_MMA(1, 0, At, B0); PG8_BAR; PG8_SCHED;
            PG8_STAGE(PG8_SB(0, 1), b2 + hstep, voffB);
            PG8_WAIT_V(6); PG8_BAR; PG8_MMA(1, 1, At, B1); PG8_BAR;
            PG8_LDB(B0, 1, 0); PG8_SCHED; PG8_LDA(At, 1, 0); PG8_STAGE(PG8_SA(0, 1), a2 + hstep, voffA);
            PG8_WAIT_L(8); PG8_BAR; PG8_WAIT_L(0); PG8_MMA(0, 0, At, B0); PG8_BAR; PG8_SCHED;
            PG8_LDB(B1, 1, 1); PG8_STAGE(PG8_SB(1, 0), b3, voffB);
            PG8_BAR; PG8_WAIT_L(0); PG8_MMA(0, 1, At, B1); PG8_BAR;
            PG8_LDA(At, 1, 1); PG8_STAGE(PG8_SA(1, 0), a3, voffA);
            PG8_BAR; PG8_WAIT_L(0); PG8_MMA(1, 0, At, B0); PG8_BAR; PG8_SCHED;
            PG8_STAGE(PG8_SB(1, 1), b3 + hstep, voffB);
            PG8_WAIT_V(6); PG8_BAR; PG8_MMA(1, 1, At, B1); PG8_BAR;
            }
        }
        if constexpr (ALIGN_EPI) { if (wr == 0) PG8_BAR; }
        if constexpr (!Epi::AFTER_DRAIN) { E(acc, cur, wr, wc, fr, fq); S.done(cur); }
        if (!has_next) break;
#pragma unroll
        for (int a = 0; a < 2; ++a)
#pragma unroll
            for (int b = 0; b < 2; ++b)
#pragma unroll
                for (int m = 0; m < 4; ++m)
#pragma unroll
                    for (int n = 0; n < 2; ++n) acc[a][b][m][n] = (f32x4){0.f, 0.f, 0.f, 0.f};
        cur = nxt; cA = nA; cB = nB; ++ui;
        if constexpr (ALIGN_EPI) { if (wr == 1) PG8_BAR; }
    }
    PG8_WAIT_V(0);
    if constexpr (!ALIGN_EPI) { if (wr == 0) PG8_BAR; }
    PG8_BAR;
    if constexpr (Epi::AFTER_DRAIN) { E.fused(acc, cur, wr, wc, fr, fq, lds, wid, lane); S.done(cur); }
#undef PG8_SA
#undef PG8_SB
#undef PG8_STAGE
#undef PG8_LDA
#undef PG8_LDB
#undef PG8_MMA
#undef PG8_WAIT_V
#undef PG8_WAIT_L
#undef PG8_BAR
#undef PG8_SCHED
}
}

constexpr int NTHR = 512, NWAVES = 8;
constexpr int LDS_BYTES = 147456;

#define IN_F(i) ((const float*)a.in[i])
#define WS_F(off) ((float*)(a.ws + (off)))
#define WS_B(off) ((bf16*)(a.ws + (off)))

__device__ __forceinline__ void phase_mod(const Args& a, LAS unsigned char* lds, int bid, int nblk) {
    const int tid = tid_opaque(), lane = tid & 63, w = tid >> 6;
    LAS float* sc = (LAS float*)lds;
    LAS float* red = (LAS float*)(lds + 98304);
    for (int i = tid; i < 12 * DM; i += NTHR) { const int b = i >> 11, k = i & 2047; const float c = b < 4 ? IN_F(I_CP)[b * DM + k] : IN_F(I_CS)[(b - 4) * DM + k]; sc[i] = silu_f(c); }
    if (bid == 0) for (int i = tid; i < DA; i += NTHR) WS_F(WS_LBV)[i] = sigmoid_f(IN_F(I_LB)[i]);
    __syncthreads();
    for (int u = bid; u < 176; u += nblk) {
        const bool fm = u >= 144; const int n0 = (fm ? u - 144 : u) * 128, ld = fm ? NFMODC : NMODC;
        const float* W = fm ? IN_F(I_WFM) : IN_F(I_WMOD); const float* bias = fm ? IN_F(I_BFM) : IN_F(I_BMOD); float* outp = fm ? WS_F(WS_FMOD) : WS_F(WS_MOD);
        f32x2 acc[12];
#pragma unroll
        for (int b = 0; b < 12; ++b) acc[b] = (f32x2){0.f, 0.f};
        const float* wp = W + (size_t)(w * 256) * ld + n0 + 2 * lane;
        for (int k = 0; k < 256; k += 4) {
            const f32x2 w0 = *(const f32x2*)(wp + (size_t)(k + 0) * ld), w1 = *(const f32x2*)(wp + (size_t)(k + 1) * ld), w2 = *(const f32x2*)(wp + (size_t)(k + 2) * ld), w3 = *(const f32x2*)(wp + (size_t)(k + 3) * ld);
#pragma unroll
            for (int b = 0; b < 12; ++b) { const f32x4 s = *(const LAS f32x4*)(sc + b * DM + w * 256 + k); acc[b] += w0 * s.x + w1 * s.y + w2 * s.z + w3 * s.w; }
        }
#pragma unroll
        for (int b = 0; b < 12; ++b) *(LAS f32x2*)(red + (w * 12 + b) * 128 + 2 * lane) = acc[b];
        __syncthreads();
        for (int i = tid; i < 12 * 128; i += NTHR) { const int b = i >> 7, c = i & 127; float s = 0.f;
#pragma unroll
            for (int ww = 0; ww < 8; ++ww) s += red[(ww * 12 + b) * 128 + c];
            outp[(size_t)b * ld + n0 + c] = s + bias[n0 + c]; }
        __syncthreads();
    }
}

__device__ __forceinline__ void cvt_item(const float* W, int K, int N, bf16* WT, int k0, int n0, int drow0, LAS float* scr, int lane) {
#pragma unroll 8
    for (int i = 0; i < 32; ++i) { const int kk = 2 * i + (lane >> 5); scr[kk * 33 + (lane & 31)] = W[(size_t)(k0 + kk) * N + n0 + (lane & 31)]; }
    LDS_WAIT(); asm volatile("" ::: "memory");
    const int c = lane & 7;
#pragma unroll
    for (int j = 0; j < 4; ++j) { const int n = (lane >> 3) + 8 * j; const LAS float* s = scr + (8 * c) * 33 + n;
        v4u o; o.x = pk2(s[0 * 33], s[1 * 33]); o.y = pk2(s[2 * 33], s[3 * 33]); o.z = pk2(s[4 * 33], s[5 * 33]); o.w = pk2(s[6 * 33], s[7 * 33]);
        *(GAS v4u*)(WT + (size_t)(drow0 + n) * K + k0 + 8 * c) = o; }
    LDS_WAIT(); asm volatile("" ::: "memory");
}
__device__ __forceinline__ void cvt_matrix(const float* W, int K, int N, bf16* WT, int mode, LAS float* scr, int gw, int ngw, int lane) {
    const int nblk = N / 32, nitems = (K / 64) * nblk;
    for (int it = gw; it < nitems; it += ngw) { const int kb = it / nblk, nb = it % nblk, n0 = 32 * nb;
        const int drow0 = mode == 0 ? n0 : ((n0 >> 7) * 256 + (mode == 2 ? 128 : 0) + (n0 & 127));
        cvt_item(W, K, N, WT, 64 * kb, n0, drow0, scr, lane); }
}
__device__ __forceinline__ void phase_cvt(const Args& a, LAS unsigned char* lds, int bid, int nblk, int first, int last) {
    const int tid = tid_opaque(), lane = tid & 63, w = tid >> 6;
    LAS float* scr = (LAS float*)(lds + w * 16384);
    const int gw = bid * NWAVES + w, ngw = nblk * NWAVES;
    if (first <= 0 && 0 <= last) { cvt_matrix(IN_F(I_WG1), DM, DFF, WS_B(WS_WGU1), 1, scr, gw, ngw, lane); cvt_matrix(IN_F(I_WU1), DM, DFF, WS_B(WS_WGU1), 2, scr, gw, ngw, lane);
                                   cvt_matrix(IN_F(I_WD1), DFF, DM, WS_B(WS_WD1), 0, scr, gw, ngw, lane); }
    if (first <= 1 && 1 <= last) { cvt_matrix(IN_F(I_WIN), DM, DIN, WS_B(WS_WIN), 0, scr, gw, ngw, lane); cvt_matrix(IN_F(I_WOUT), DM, DM, WS_B(WS_WOUT), 0, scr, gw, ngw, lane); }
    if (first <= 2 && 2 <= last) { cvt_matrix(IN_F(I_WG2), DM, DFF, WS_B(WS_WGU2), 1, scr, gw, ngw, lane); cvt_matrix(IN_F(I_WU2), DM, DFF, WS_B(WS_WGU2), 2, scr, gw, ngw, lane);
                                   cvt_matrix(IN_F(I_WD2), DFF, DM, WS_B(WS_WD2), 0, scr, gw, ngw, lane); }
}

template <bool FINAL>
__device__ __forceinline__ void phase_norm(const Args& a, int bid, int nblk, bool from_inputs, const float* gvec, const float* modp, int ldmod, int sh_off, int sc_off) {
    const int tid = tid_opaque(), lane = tid & 63, w = tid >> 6;
    const int gw = bid * NWAVES + w, ngw = nblk * NWAVES;
    const int nrows = FINAL ? MREAL : MPAD;
    for (int r = gw; r < nrows; r += ngw) {
        if (r >= MREAL) {
            GAS v4u* o = (GAS v4u*)(WS_B(WS_XN) + (size_t)r * DM) + lane;
#pragma unroll
            for (int j = 0; j < 4; ++j) o[64 * j] = (v4u){0u, 0u, 0u, 0u};
            continue;
        }
        const float* xrow = from_inputs ? (r < MP ? IN_F(I_XP) + (size_t)r * DM : IN_F(I_XS) + (size_t)(r - MP) * DM) : WS_F(WS_X) + (size_t)r * DM;
        const GAS f32x4* xr = (const GAS f32x4*)xrow + lane;
        f32x4 v[8]; float s = 0.f;
#pragma unroll
        for (int j = 0; j < 8; ++j) { v[j] = xr[64 * j]; s += (v[j].x * v[j].x + v[j].y * v[j].y) + (v[j].z * v[j].z + v[j].w * v[j].w); }
        const float rstd = 1.0f / sqrtf(wave_sum(s) * (1.f / DM) + EPS);
        const float* mr = modp + (size_t)mod_row(r) * ldmod;
#pragma unroll
        for (int j = 0; j < 8; ++j) {
            const int c = 4 * (lane + 64 * j);
            const f32x4 g = *(const f32x4*)(gvec + c), sh = *(const f32x4*)(mr + sh_off + c), sc = *(const f32x4*)(mr + sc_off + c);
            const f32x4 y = (v[j] * rstd * g) * (1.f + sc) + sh;
            if (FINAL) { float* dst = r < MP ? a.out + OFF_YP + (size_t)r * DM : a.out + OFF_YS + (size_t)(r - MP) * DM; *(f32x4*)(dst + c) = y; }
            else { v2u o; o.x = pk2(y.x, y.y); o.y = pk2(y.z, y.w); *(GAS v2u*)(WS_B(WS_XN) + (size_t)r * DM + c) = o; }
        }
    }
}

template <int WHICH> __device__ __forceinline__ void phase_gemm(const Args& a, LAS unsigned char* lds, int bid, int nblk) {
    using namespace pg8;
    if constexpr (WHICH == 1 || WHICH == 5) {
        Gemm g{WS_B(WS_XN), WS_B(WHICH == 1 ? WS_WGU1 : WS_WGU2), MPAD, 2 * DFF, DM}; StaticOrder S; S.init(MPAD, 2 * DFF, nblk, bid);
        EpiSwiGLU E{WS_B(WS_H), DFF};
        gemm_phase<EpiSwiGLU, StaticOrder, true, true>(lds, g, S, E);
    } else if constexpr (WHICH == 2 || WHICH == 6) {
        Gemm g{WS_B(WS_H), WS_B(WHICH == 2 ? WS_WD1 : WS_WD2), MPAD, DM, DFF}; StaticOrder S; S.init(MPAD, DM, nblk, bid);
        EpiResid E{WHICH == 2 ? IN_F(I_XP) : nullptr, IN_F(I_XS), WS_F(WS_X), WS_F(WS_MOD) + (WHICH == 2 ? 2 : 8) * DM, 0.5f};
        gemm_phase<EpiResid, StaticOrder, true, true>(lds, g, S, E);
    } else if constexpr (WHICH == 3) {
        Gemm g{WS_B(WS_XN), WS_B(WS_WIN), MPAD, DIN, DM}; StaticOrder S; S.init(MPAD, DIN, nblk, bid);
        EpiProj E{a.ws, WS_F(WS_LF), a.out, WS_F(WS_LBV)};
        gemm_phase<EpiProj, StaticOrder, true, true>(lds, g, S, E);
    } else {
        Gemm g{WS_B(WS_OM), WS_B(WS_WOUT), MPAD, DM, DM}; StaticOrder S; S.init(MPAD, DM, nblk, bid);
        EpiResid E{nullptr, IN_F(I_XS), WS_F(WS_X), WS_F(WS_MOD) + 5 * DM, 1.0f};
        gemm_phase<EpiResid, StaticOrder, true, true>(lds, g, S, E);
    }
}

__device__ __forceinline__ void hgrn_unit(const Args& a, LAS unsigned char* lds, int unit) {
    const int tid = tid_opaque(), dv = tid & 127, g = tid >> 7;
    const bool smp = unit >= 32; const int u = smp ? unit - 32 : unit, b = u >> 3, h = u & 7;
    const int T = smp ? DECT : SEQ, row0 = smp ? MP + b * DECT : b * SEQ;
    float* sout = a.out + (smp ? OFF_SS : OFF_SP) + (size_t)u * HD * HD;
    LAS float* fL = (LAS float*)lds; LAS float* kL = fL + 2048; LAS float* qL = kL + 2048; LAS float* vL = qL + 2048; LAS float* red = vL + 2048;
    const bf16* QA = WS_B(WS_QA); const bf16* IA = WS_B(WS_IA); const bf16* GA = WS_B(WS_GA); const float* LF = WS_F(WS_LF);
    float S[32];
#pragma unroll
    for (int i = 0; i < 32; ++i) S[i] = smp ? IN_F(I_ST)[(size_t)u * HD * HD + (size_t)(32 * g + i) * HD + dv] : 0.f;
    for (int t0 = 0; t0 < T; t0 += 16) {
        const int nt = (T - t0) < 16 ? (T - t0) : 16;
        for (int i = tid; i < nt * 128; i += NTHR) { const int tt = i >> 7, ch = i & 127; const size_t o = (size_t)(row0 + t0 + tt) * DA + h * HD + ch;
            const float f = __expf(LF[o]); fL[i] = f; kL[i] = 1.f - f; qL[i] = bf2f(QA[o]); vL[i] = bf2f(IA[o]); }
        __syncthreads();
        for (int tt = 0; tt < nt; ++tt) {
            const float v = vL[tt * 128 + dv]; float op = 0.f;
#pragma unroll
            for (int i4 = 0; i4 < 8; ++i4) {
                const f32x4 f4 = *(const LAS f32x4*)(fL + tt * 128 + g * 32 + 4 * i4), k4 = *(const LAS f32x4*)(kL + tt * 128 + g * 32 + 4 * i4), q4 = *(const LAS f32x4*)(qL + tt * 128 + g * 32 + 4 * i4);
#pragma unroll
                for (int j = 0; j < 4; ++j) { S[4 * i4 + j] = f4[j] * S[4 * i4 + j] + k4[j] * v; op += S[4 * i4 + j] * q4[j]; }
            }
            red[(g * 16 + tt) * 128 + dv] = op;
        }
        __syncthreads();
        { const int tt = tid >> 5, l32 = tid & 31;
          if (tt < nt) {
            f32x4 o = (f32x4){0.f, 0.f, 0.f, 0.f};
#pragma unroll
            for (int gg = 0; gg < 4; ++gg) o += *(const LAS f32x4*)(red + (gg * 16 + tt) * 128 + 4 * l32);
            float ss = (o.x * o.x + o.y * o.y) + (o.z * o.z + o.w * o.w);
#pragma unroll
            for (int m = 1; m < 32; m <<= 1) ss += __shfl_xor(ss, m);
            const float rstd = 1.0f / sqrtf(ss * (1.f / HD) + EPS);
            const int row = row0 + t0 + tt, col = h * HD + 4 * l32;
            const f32x4 gw = *(const f32x4*)(IN_F(I_GOA) + col); const v2u gt = *(const v2u*)(GA + (size_t)row * DA + col);
            v2u w; w.x = pk2(o.x * rstd * gw.x * bflo(gt.x), o.y * rstd * gw.y * bfhi(gt.x)); w.y = pk2(o.z * rstd * gw.z * bflo(gt.y), o.w * rstd * gw.w * bfhi(gt.y));
            *(v2u*)(WS_B(WS_OM) + (size_t)row * DM + col) = w;
          } }
        __syncthreads();
    }
#pragma unroll
    for (int i = 0; i < 32; ++i) sout[(size_t)(32 * g + i) * HD + dv] = S[i];
}

__device__ __forceinline__ void sb_tile(const LAS float* Kt, const LAS float* Vt, const LAS float* q, float bias, int lane, int nvis  , float& R, float& o0, float& o1) {
    float z = bias;
#pragma unroll 8
    for (int d = 0; d < HD; d += 4) { const f32x4 qv = *(const LAS f32x4*)(q + d);
        z += qv.x * Kt[lane * 129 + d] + qv.y * Kt[lane * 129 + d + 1] + qv.z * Kt[lane * 129 + d + 2] + qv.w * Kt[lane * 129 + d + 3]; }
    const bool vis = lane < nvis;
    const float L = vis ? -(z > 20.f ? z : log1pf(__expf(z))) : 0.f;
    float c = L;
#pragma unroll
    for (int off = 1; off < 64; off <<= 1) { const float t = __shfl_down(c, off); if (lane + off < 64) c += t; }
    const float P = vis ? __expf(z + c + R) : 0.f;
    R += __shfl(c, 0);
#pragma unroll 8
    for (int s = 0; s < 64; ++s) { const float p = __builtin_bit_cast(float, __builtin_amdgcn_readlane(__builtin_bit_cast(int, P), s));
        o0 += p * Vt[s * 128 + lane]; o1 += p * Vt[s * 128 + 64 + lane]; }
}
__device__ __forceinline__ void sb_finish(const Args& a, int row, int h, int lane, float o0, float o1) {
    const float ss = wave_sum(o0 * o0 + o1 * o1);
    const float rstd = 1.0f / sqrtf(ss * (1.f / HD) + EPS);
    const float* gw = IN_F(I_GOB) + h * HD; bf16* dst = WS_B(WS_OM) + (size_t)row * DM + DA + h * HD;
    dst[lane] = (bf16)f2bf(o0 * rstd * gw[lane]); dst[64 + lane] = (bf16)f2bf(o1 * rstd * gw[64 + lane]);
}
__device__ __forceinline__ void sb_stage_bf16(const Args& a, LAS float* Kt, LAS float* Vt, int krow0, int nvalid, int h, int tid) {
    const bf16* KB = WS_B(WS_KB); const bf16* VB = WS_B(WS_VB);
#pragma unroll
    for (int i = 0; i < 2; ++i) { const int ch = tid + i * NTHR, r = ch >> 4, d0 = (ch & 15) * 8;
        v4u kv = (v4u){0u, 0u, 0u, 0u}, vv = (v4u){0u, 0u, 0u, 0u};
        if (r < nvalid) { const size_t o = (size_t)(krow0 + r) * DA + h * HD + d0; kv = *(const v4u*)(KB + o); vv = *(const v4u*)(VB + o); }
        LAS float* kd = Kt + r * 129 + d0; LAS float* vd = Vt + r * 128 + d0;
        kd[0] = bflo(kv.x); kd[1] = bfhi(kv.x); kd[2] = bflo(kv.y); kd[3] = bfhi(kv.y); kd[4] = bflo(kv.z); kd[5] = bfhi(kv.z); kd[6] = bflo(kv.w); kd[7] = bfhi(kv.w);
        vd[0] = bflo(vv.x); vd[1] = bfhi(vv.x); vd[2] = bflo(vv.y); vd[3] = bfhi(vv.y); vd[4] = bflo(vv.z); vd[5] = bfhi(vv.z); vd[6] = bflo(vv.w); vd[7] = bfhi(vv.w); }
}
__device__ __forceinline__ void sb_unit_prompt(const Args& a, LAS unsigned char* lds, int unit) {
    const int tid = tid_opaque(), lane = tid & 63, w = tid >> 6;
    const int bh = unit >> 8, qb = unit & 255, b = bh >> 3, h = bh & 7, t = qb * 8 + w, row = b * SEQ + t;
    LAS float* Kt = (LAS float*)lds; LAS float* Vt = Kt + 64 * 129; LAS float* qs = Vt + 64 * 128;
    if (lane < 32) { const v2u qv = *(const v2u*)(WS_B(WS_QB) + (size_t)row * DA + h * HD + 4 * lane); LAS float* q = qs + w * HD + 4 * lane; q[0] = bflo(qv.x) * LN2; q[1] = bfhi(qv.x) * LN2; q[2] = bflo(qv.y) * LN2; q[3] = bfhi(qv.y) * LN2; }
    const float bias = IN_F(I_BSB)[h];
    float R = 0.f, o0 = 0.f, o1 = 0.f;
    for (int j = (qb * 8 + 6) >> 6; j >= 0; --j) {
        __syncthreads();
        sb_stage_bf16(a, Kt, Vt, b * SEQ + 64 * j, 64, h, tid);
        __syncthreads();
        int nvis = t - 64 * j; nvis = nvis < 0 ? 0 : (nvis > 64 ? 64 : nvis);
        sb_tile(Kt, Vt, qs + w * HD, bias, lane, nvis, R, o0, o1);
    }
    sb_finish(a, row, h, lane, o0, o1);
    __syncthreads();
}
__device__ __forceinline__ void sb_unit_sample(const Args& a, LAS unsigned char* lds, int unit) {
    const int tid = tid_opaque(), lane = tid & 63, w = tid >> 6;
    const int b = unit >> 3, h = unit & 7, row = MP + b * DECT + w;
    LAS float* Kt = (LAS float*)lds; LAS float* Vt = Kt + 64 * 129; LAS float* qs = Vt + 64 * 128;
    if (lane < 32) { const v2u qv = *(const v2u*)(WS_B(WS_QB) + (size_t)row * DA + h * HD + 4 * lane); LAS float* q = qs + w * HD + 4 * lane; q[0] = bflo(qv.x) * LN2; q[1] = bfhi(qv.x) * LN2; q[2] = bflo(qv.y) * LN2; q[3] = bfhi(qv.y) * LN2; }
    const float bias = IN_F(I_BSB)[h];
    float R = 0.f, o0 = 0.f, o1 = 0.f;
    __syncthreads();
    sb_stage_bf16(a, Kt, Vt, MP + b * DECT, DECT, h, tid);
    __syncthreads();
    sb_tile(Kt, Vt, qs + w * HD, bias, lane, w, R, o0, o1);
    const int* pt = (const int*)a.in[I_PT] + b * NPAGES;
    for (int j = PAST / 64 - 1; j >= 0; --j) {
        __syncthreads();
        { const int page = pt[j >> 1]; const size_t base = ((size_t)page * PAGE + (j & 1) * 64) * (NHEAD * HD) + h * HD;
          const float* ck = IN_F(I_CK) + base; const float* cv = IN_F(I_CV) + base;
#pragma unroll
          for (int i = 0; i < 4; ++i) { const int ch = tid + i * NTHR, r = ch >> 5, d0 = (ch & 31) * 4;
              const f32x4 kv = *(const f32x4*)(ck + (size_t)r * (NHEAD * HD) + d0), vv = *(const f32x4*)(cv + (size_t)r * (NHEAD * HD) + d0);
              LAS float* kd = Kt + r * 129 + d0; kd[0] = kv.x; kd[1] = kv.y; kd[2] = kv.z; kd[3] = kv.w;
              *(LAS f32x4*)(Vt + r * 128 + d0) = vv; } }
        __syncthreads();
        sb_tile(Kt, Vt, qs + w * HD, bias, lane, 64, R, o0, o1);
    }
    sb_finish(a, row, h, lane, o0, o1);
    __syncthreads();
}

typedef float f32x16 __attribute__((ext_vector_type(16)));
typedef short s16x4 __attribute__((ext_vector_type(4)));
typedef short v4i16_t __attribute__((ext_vector_type(4)));
typedef __bf16 bf16x2_t __attribute__((ext_vector_type(2)));
#define MFMA32(a, b, c) __builtin_amdgcn_mfma_f32_32x32x16_bf16((a), (b), (c), 0, 0, 0)

__device__ __forceinline__ unsigned cvtpk(float lo, float hi) { f32x2 v = {lo, hi}; bf16x2_t b = __builtin_convertvector(v, bf16x2_t); return __builtin_bit_cast(unsigned, b); }
template <int S> __device__ __forceinline__ bf16x8 pack8(const f32x16& x) {
    v4u p; p.x = cvtpk(x[8 * S + 0], x[8 * S + 1]); p.y = cvtpk(x[8 * S + 2], x[8 * S + 3]); p.z = cvtpk(x[8 * S + 4], x[8 * S + 5]); p.w = cvtpk(x[8 * S + 6], x[8 * S + 7]);
    return __builtin_bit_cast(bf16x8, p);
}
__device__ __forceinline__ unsigned off_a(unsigned row, unsigned ch) { return 2048u * (row >> 3) + 512u * (ch >> 2) + 64u * (row & 7) + 16u * ((ch & 3) ^ ((row >> 2) & 3)); }
__device__ __forceinline__ s16x4 vtr(const LAS unsigned char* p) { return __builtin_bit_cast(s16x4, __builtin_amdgcn_ds_read_tr16_b64_v4i16((LAS v4i16_t*)p)); }

struct SbLane {
    int kb0, kb1;
    int vb0, vb1;
    bf16x8 nu0, nu1;
};
__device__ __forceinline__ SbLane sb_lane_init(int lane) {
    SbLane L; const unsigned r = lane & 31, h = lane >> 5, q = (lane & 15) >> 2, p = lane & 3, blk = (lane >> 4) & 1;
    L.kb0 = (int)(2048u * (r >> 3) + 64u * (r & 7) + 16u * ((0u + h) ^ ((r >> 2) & 3)));
    L.kb1 = (int)(2048u * (r >> 3) + 64u * (r & 7) + 16u * ((2u + h) ^ ((r >> 2) & 3)));
    L.vb0 = (int)(64u * (4 * h + q) + 16u * ((2 * blk + (p >> 1)) ^ ((0u + h) & 3)) + 8u * (p & 1));
    L.vb1 = (int)(2048u + 64u * (4 * h + q) + 16u * ((2 * blk + (p >> 1)) ^ ((2u + h) & 3)) + 8u * (p & 1));
#pragma unroll
    for (int j = 0; j < 8; ++j) { const unsigned k0 = 8 * (j >> 2) + 4 * h + (j & 3), k1 = 16 + k0;
        L.nu0[j] = (k0 >= r) ? (short)0xBF80 : (short)0; L.nu1[j] = (k1 >= r) ? (short)0xBF80 : (short)0; }
    return L;
}
__device__ __forceinline__ void sbm_step(const LAS unsigned char* kt, const LAS unsigned char* vt, const LAS unsigned char* qfl  , float bias2, const SbLane& L, f32x16 (&o)[4], float& R, int lane, int tq) {
    f32x16 zt;
#pragma unroll
    for (int r = 0; r < 16; ++r) zt[r] = bias2;
#pragma unroll
    for (int s = 0; s < 8; ++s) { const bf16x8 kf = *(const LAS bf16x8*)(kt + ((s & 1) ? L.kb1 : L.kb0) + 512 * (s >> 1)); const bf16x8 qf = *(const LAS bf16x8*)(qfl + 1024 * s); zt = MFMA32(kf, qf, zt); }
    f32x16 sp, cin;
#pragma unroll
    for (int r = 0; r < 16; ++r) {
        const float e = __builtin_amdgcn_exp2f(zt[r]); float l = __builtin_amdgcn_logf(1.f + e); l = zt[r] > 30.f ? zt[r] : l;
        l = ((r & 3) + 8 * (r >> 2) < tq) ? l : 0.f;
        sp[r] = l; cin[r] = zt[r] + R;
    }
    f32x16 out = MFMA32(L.nu0, pack8<0>(sp), cin);
    out = MFMA32(L.nu1, pack8<1>(sp), out);
    const float rn = out[0] - zt[0];
    R = __shfl(rn, lane & 31);
    f32x16 p;
#pragma unroll
    for (int r = 0; r < 16; ++r) { float v = __builtin_amdgcn_exp2f(out[r]); v = ((r & 3) + 8 * (r >> 2) < tq) ? v : 0.f; p[r] = v; }
    const bf16x8 p0 = pack8<0>(p), p1 = pack8<1>(p);
#pragma unroll
    for (int c = 0; c < 4; ++c) {
        { const s16x4 lo = vtr(vt + L.vb0 + 512 * c), hi = vtr(vt + L.vb1 + 512 * c); const bf16x8 vf = __builtin_shufflevector(lo, hi, 0, 1, 2, 3, 4, 5, 6, 7); o[c] = MFMA32(vf, p0, o[c]); }
        { const s16x4 lo = vtr(vt + L.vb0 + 4096 + 512 * c), hi = vtr(vt + L.vb1 + 4096 + 512 * c); const bf16x8 vf = __builtin_shufflevector(lo, hi, 0, 1, 2, 3, 4, 5, 6, 7); o[c] = MFMA32(vf, p1, o[c]); }
    }
}
__device__ __forceinline__ void sbm_finish(const Args& a, const f32x16 (&o)[4], int row, int h, int lane) {
    float ss = 0.f;
#pragma unroll
    for (int c = 0; c < 4; ++c)
#pragma unroll
        for (int r = 0; r < 16; ++r) ss += o[c][r] * o[c][r];
    ss += __shfl_xor(ss, 32);
    const float rstd = 1.0f / sqrtf(ss * (1.f / HD) + EPS);
    const int hh = lane >> 5; const float* gw = IN_F(I_GOB) + h * HD; bf16* dst = WS_B(WS_OM) + (size_t)row * DM + DA + h * HD;
#pragma unroll
    for (int c = 0; c < 4; ++c)
#pragma unroll
        for (int g = 0; g < 4; ++g) { const int d = 32 * c + 8 * g + 4 * hh; const f32x4 gv = *(const f32x4*)(gw + d);
            v2u w; w.x = cvtpk(o[c][4 * g + 0] * rstd * gv.x, o[c][4 * g + 1] * rstd * gv.y); w.y = cvtpk(o[c][4 * g + 2] * rstd * gv.z, o[c][4 * g + 3] * rstd * gv.w);
            *(v2u*)(dst + d) = w; }
}
__device__ __forceinline__ void sbm_unit_prompt(const Args& a, LAS unsigned char* lds, int bh, int qb) {
    const int tid = tid_opaque(), lane = tid & 63, w = __builtin_amdgcn_readfirstlane(tid >> 6);
    const int b = bh >> 3, h = bh & 7, q0 = 256 * qb + 32 * w, idiag = 8 * qb + w;
    const SbLane L = sb_lane_init(lane);
    const bf16* QB = WS_B(WS_QB); const bf16* KB = WS_B(WS_KB); const bf16* VB = WS_B(WS_VB);
    LAS unsigned char* qfl = lds + 65536 + w * 8192 + lane * 16;
    { const bf16* qp = QB + (size_t)(b * SEQ + q0 + (lane & 31)) * DA + h * HD + 8 * (lane >> 5);
#pragma unroll
      for (int s = 0; s < 8; ++s) *(LAS bf16x8*)(qfl + 1024 * s) = *(const bf16x8*)(qp + 16 * s); }
    const float bias2 = IN_F(I_BSB)[h] * LOG2E;
    f32x16 o[4];
#pragma unroll
    for (int c = 0; c < 4; ++c)
#pragma unroll
        for (int r = 0; r < 16; ++r) o[c][r] = 0.f;
    float R = 0.f; const int tq = (lane & 31) - 4 * (lane >> 5);
    const int key0 = tid >> 4, ch = tid & 15;
    const size_t gsrc = (size_t)(b * SEQ + key0) * DA + h * HD + 8 * ch;
    const unsigned ldst = off_a(key0 & 31, ch);
    v4u kr[2], vr[2];
    int j = 4 * qb + 3;
#define SBM_LOAD(jj) do { const size_t o_ = gsrc + (size_t)(jj) * 64 * DA; kr[0] = *(const v4u*)(KB + o_); vr[0] = *(const v4u*)(VB + o_); kr[1] = *(const v4u*)(KB + o_ + 32 * DA); vr[1] = *(const v4u*)(VB + o_ + 32 * DA); } while (0)
#define SBM_WRITE(buf) do { LAS unsigned char* b_ = lds + (buf) * 32768; *(LAS v4u*)(b_ + ldst) = kr[0]; *(LAS v4u*)(b_ + 8192 + ldst) = kr[1]; *(LAS v4u*)(b_ + 16384 + ldst) = vr[0]; *(LAS v4u*)(b_ + 16384 + 8192 + ldst) = vr[1]; } while (0)
    SBM_LOAD(j); SBM_WRITE(0);
    __syncthreads();
    int cur = 0;
    for (; j >= 0; --j) {
        if (j > 0) SBM_LOAD(j - 1);
        const LAS unsigned char* kb_ = lds + cur * 32768; const LAS unsigned char* vb_ = kb_ + 16384;
#pragma unroll 1
        for (int tt = 1; tt >= 0; --tt) { const int ti = 2 * j + tt;
            if (ti <= idiag) sbm_step(kb_ + tt * 8192, vb_ + tt * 8192, qfl, bias2, L, o, R, lane, ti == idiag ? tq : 64); }
        if (j > 0) SBM_WRITE(cur ^ 1);
        __syncthreads();
        cur ^= 1;
    }
#undef SBM_LOAD
#undef SBM_WRITE
    sbm_finish(a, o, b * SEQ + q0 + (lane & 31), h, lane);
}

__device__ __forceinline__ void phase_mixer(const Args& a, LAS unsigned char* lds, int bid, int nblk) {
    { const int tid = tid_opaque(); GAS v4u* o = (GAS v4u*)(WS_B(WS_OM) + (size_t)MREAL * DM);
      for (int i = bid * NTHR + tid; i < (MPAD - MREAL) * DM / 8; i += nblk * NTHR) o[i] = (v4u){0u, 0u, 0u, 0u}; }
    for (int u = bid; u < 96 + 64 + 256; u += nblk) {
        if (u < 96) hgrn_unit(a, lds, u);
        else if (u < 160) sb_unit_sample(a, lds, u - 96);
        else { const int v = u - 160; sbm_unit_prompt(a, lds, v & 31, 7 - (v >> 5)); }
    }
}

enum { PH_MOD = 0, PH_CVT, PH_NORM1, PH_G1, PH_G2, PH_NORM2, PH_G3, PH_MIX, PH_G4, PH_NORM3, PH_G5, PH_G6, PH_FINAL, N_PHASES };

template <int PH> __device__ __forceinline__ void run_phase(const Args& a, LAS unsigned char* lds, int bid, int nblk) {
    if constexpr (PH == PH_MOD) phase_mod(a, lds, bid, nblk);
    else if constexpr (PH == PH_CVT) phase_cvt(a, lds, bid, nblk, 0, 2);
    else if constexpr (PH == PH_NORM1) phase_norm<false>(a, bid, nblk, true, IN_F(I_N1), WS_F(WS_MOD), NMODC, 0 * DM, 1 * DM);
    else if constexpr (PH == PH_G1) phase_gemm<1>(a, lds, bid, nblk);
    else if constexpr (PH == PH_G2) phase_gemm<2>(a, lds, bid, nblk);
    else if constexpr (PH == PH_NORM2) phase_norm<false>(a, bid, nblk, false, IN_F(I_NM), WS_F(WS_MOD), NMODC, 3 * DM, 4 * DM);
    else if constexpr (PH == PH_G3) phase_gemm<3>(a, lds, bid, nblk);
    else if constexpr (PH == PH_MIX) phase_mixer(a, lds, bid, nblk);
    else if constexpr (PH == PH_G4) phase_gemm<4>(a, lds, bid, nblk);
    else if constexpr (PH == PH_NORM3) phase_norm<false>(a, bid, nblk, false, IN_F(I_N2), WS_F(WS_MOD), NMODC, 6 * DM, 7 * DM);
    else if constexpr (PH == PH_G5) phase_gemm<5>(a, lds, bid, nblk);
    else if constexpr (PH == PH_G6) phase_gemm<6>(a, lds, bid, nblk);
    else phase_norm<true>(a, bid, nblk, false, IN_F(I_NF), WS_F(WS_FMOD), NFMODC, 0, DM);
}

#define XB_TMO      128
#define XB_XCNT(j)  (256  + 64 * (j))
#define XB_XSUB(j)  (1280 + 64 * (j))
#define XB_XGEN(j)  (2304 + 64 * (j))
#define XB_TOP      3328
#define XB_TOPGEN   3392
#define XCD_BAR_WORDS 3456
#define XB_SPIN_CAP (1u << 18)

__device__ __forceinline__ unsigned xb_ld(unsigned* p)              { return __hip_atomic_load(p, __ATOMIC_RELAXED, __HIP_MEMORY_SCOPE_AGENT); }
__device__ __forceinline__ unsigned xb_add(unsigned* p, unsigned v) { return __hip_atomic_fetch_add(p, v, __ATOMIC_RELAXED, __HIP_MEMORY_SCOPE_AGENT); }
__device__ __forceinline__ unsigned xb_xcc_id() { return (unsigned)__builtin_amdgcn_s_getreg((3 << 11) | 20) & 0xFu; }
#define XB_SPIN(cond, bar) do { unsigned _sp = 0; while (cond) { __builtin_amdgcn_s_sleep(1); \
    if ((++_sp & 255u) == 0u) { if (xb_ld(&(bar)[XB_TMO])) break; if (_sp > XB_SPIN_CAP) { atomicAdd(&(bar)[XB_TMO], 1u); break; } } } } while (0)

struct XcdBarrier {
    unsigned* bar; unsigned x;
    volatile LAS unsigned* st;
};

__device__ __forceinline__ XcdBarrier xcd_barrier_post(unsigned* bar, volatile LAS unsigned* st) {
    XcdBarrier b; b.bar = bar; b.x = xb_xcc_id(); b.st = st;
    if (threadIdx.x == 0) (void)xb_add(&bar[XB_XCNT(b.x)], 1u);
    return b;
}
__device__ __forceinline__ void xcd_barrier_complete(unsigned* bar, unsigned x, unsigned& nloc, unsigned& nx) {
    const unsigned G = gridDim.x * gridDim.y * gridDim.z;
    unsigned sum, cnt, mine, sp = 0u;
    for (;;) {
        sum = 0u; cnt = 0u; mine = 0u;
#pragma unroll
        for (unsigned j = 0; j < 16; ++j) { const unsigned c = xb_ld(&bar[XB_XCNT(j)]); sum += c; cnt += (c > 0u) ? 1u : 0u; mine = (j == x) ? c : mine; }
        if (sum == G) break;
        __builtin_amdgcn_s_sleep(1);
        if ((++sp & 255u) == 0u) { if (xb_ld(&bar[XB_TMO])) break; if (sp > XB_SPIN_CAP) { atomicAdd(&bar[XB_TMO], 1u); break; } }
    }
    nloc = mine > 0u ? mine : 1u; nx = cnt > 0u ? cnt : 1u;
}

__device__ __forceinline__ void xcd_barrier(const XcdBarrier& b) {
    asm volatile("s_waitcnt vmcnt(0)" ::: "memory");
    __syncthreads();
    if (threadIdx.x == 0) {
        unsigned* bar = b.bar;
        __builtin_amdgcn_s_waitcnt(0);
        unsigned nloc = b.st[0], nx = b.st[1];
        if (nloc == 0u) { xcd_barrier_complete(bar, b.x, nloc, nx); b.st[0] = nloc; b.st[1] = nx; }
        const unsigned old = xb_add(&bar[XB_XSUB(b.x)], 1u);
        const unsigned gen = old / nloc;
        if (old + 1u == (gen + 1u) * nloc) {
            __builtin_amdgcn_fence(__ATOMIC_RELEASE, "agent");
            asm volatile("s_waitcnt vmcnt(0)" ::: "memory");
            const unsigned og = xb_add(&bar[XB_TOP], 1u);
            const unsigned tg = og / nx;
            if (og + 1u == (tg + 1u) * nx) xb_add(&bar[XB_TOPGEN], 1u);
            else XB_SPIN(xb_ld(&bar[XB_TOPGEN]) == tg, bar);
            __builtin_amdgcn_fence(__ATOMIC_ACQUIRE, "agent");
            xb_add(&bar[XB_XGEN(b.x)], 1u);
            asm volatile("s_waitcnt vmcnt(0)" ::: "memory");
        } else {
            XB_SPIN(xb_ld(&bar[XB_XGEN(b.x)]) == gen, bar);
            __builtin_amdgcn_fence(__ATOMIC_ACQUIRE, "agent");
            asm volatile("s_waitcnt vmcnt(0)" ::: "memory");
        }
    }
    __syncthreads();
}


constexpr int LDS_BAR_OFF = LDS_BYTES;
constexpr int LDS_TOTAL = LDS_BYTES + 64;

__global__ void __launch_bounds__(NTHR, 2) mega_fwd(Args a) {
    extern __shared__ __attribute__((aligned(16))) unsigned char lds_raw[];
    LAS unsigned char* lds = (LAS unsigned char*)lds_raw;
    const int bid = (int)blockIdx.x, nblk = (int)gridDim.x;
    if (threadIdx.x < 16) ((LAS unsigned*)(lds + LDS_BAR_OFF))[threadIdx.x] = 0u;
    __syncthreads();
    XcdBarrier bar = xcd_barrier_post((unsigned*)(a.ws + WS_CTL), (volatile LAS unsigned*)(lds + LDS_BAR_OFF));
    run_phase<PH_MOD>(a, lds, bid, nblk);
    __syncthreads();
    run_phase<PH_CVT>(a, lds, bid, nblk);
    xcd_barrier(bar);
    run_phase<PH_NORM1>(a, lds, bid, nblk);
    xcd_barrier(bar);
    run_phase<PH_G1>(a, lds, bid, nblk);
    xcd_barrier(bar);
    run_phase<PH_G2>(a, lds, bid, nblk);
    xcd_barrier(bar);
    run_phase<PH_NORM2>(a, lds, bid, nblk);
    xcd_barrier(bar);
    run_phase<PH_G3>(a, lds, bid, nblk);
    xcd_barrier(bar);
    run_phase<PH_MIX>(a, lds, bid, nblk);
    xcd_barrier(bar);
    run_phase<PH_G4>(a, lds, bid, nblk);
    xcd_barrier(bar);
    run_phase<PH_NORM3>(a, lds, bid, nblk);
    xcd_barrier(bar);
    run_phase<PH_G5>(a, lds, bid, nblk);
    xcd_barrier(bar);
    run_phase<PH_G6>(a, lds, bid, nblk);
    xcd_barrier(bar);
    run_phase<PH_FINAL>(a, lds, bid, nblk);
}

extern "C" void kernel_launch(void* const* d_in, const int* in_sizes, int n_in, void* d_out, int out_size, void* d_ws, size_t ws_size, hipStream_t stream) {
    static int grid = 0;
    if (grid == 0) {
        if (n_in != N_IN || (size_t)out_size != OUT_TOTAL || ws_size < WS_END) { fprintf(stderr, "kernel_launch: unexpected shapes (n_in %d, out %d, ws %zu)\n", n_in, out_size, ws_size); grid = -1; return; }
        int dev = 0, cus = 0, per_cu = 0;
        if (hipGetDevice(&dev) != hipSuccess || hipDeviceGetAttribute(&cus, hipDeviceAttributeMultiprocessorCount, dev) != hipSuccess) { grid = -1; return; }
        if (hipFuncSetAttribute((const void*)mega_fwd, hipFuncAttributeMaxDynamicSharedMemorySize, LDS_TOTAL) != hipSuccess) { fprintf(stderr, "kernel_launch: hipFuncSetAttribute failed\n"); grid = -1; return; }
        if (hipOccupancyMaxActiveBlocksPerMultiprocessor(&per_cu, (const void*)mega_fwd, NTHR, LDS_TOTAL) != hipSuccess || per_cu < 1) { fprintf(stderr, "kernel_launch: occupancy query says %d blocks per CU\n", per_cu); grid = -1; (void)hipGetLastError(); return; }
        grid = cus;
    }
    if (grid < 0) return;
    (void)hipMemsetAsync((char*)d_ws + WS_CTL, 0, 65536, stream);
    Args a{};
    for (int i = 0; i < N_IN; ++i) a.in[i] = d_in[i];
    a.out = (float*)d_out; a.ws = (unsigned char*)d_ws;
    hipLaunchKernelGGL(mega_fwd, dim3(grid), dim3(NTHR), LDS_TOTAL, stream, a);
}
```

```cpp
#include <hip/hip_runtime.h>
#include <cstdio>
#include <cstdint>

constexpr int DM = 2048, SEQ = 2048, NB = 4, MP = NB * SEQ  , DECB = 8, DECT = 8, MS = DECB * DECT  ;
constexpr int MREAL = MP + MS  , MPAD = 8448  ;
constexpr int DFF = 5632, DIN = 7168, NMODC = 9 * DM  , NFMODC = 2 * DM;
constexpr int DA = 1024, NHEAD = 8, HD = 128, PAST = 16384, PAGE = 128, NPAGES = PAST / PAGE  ;
constexpr float EPS = 1e-6f, QSCALE = 0.08838834764831845f  ;
constexpr float LOG2E = 1.4426950408889634f, LN2 = 0.6931471805599453f;
constexpr size_t OFF_YP = 0, OFF_YS = OFF_YP + (size_t)MP * DM, OFF_KP = OFF_YS + (size_t)MS * DM, OFF_VP = OFF_KP + (size_t)MP * DA,
                 OFF_KS = OFF_VP + (size_t)MP * DA, OFF_VS = OFF_KS + (size_t)MS * DA, OFF_SP = OFF_VS + (size_t)MS * DA,
                 OFF_SS = OFF_SP + (size_t)NB * NHEAD * HD * HD, OUT_TOTAL = OFF_SS + (size_t)DECB * NHEAD * HD * HD;
enum { I_XP = 0, I_XS, I_CK, I_CV, I_ST, I_PT, I_CP, I_CS, I_LB, I_N1, I_NM, I_N2, I_WMOD, I_BMOD, I_WG1, I_WU1, I_WD1, I_WIN, I_GOA, I_GOB, I_BSB, I_WOUT,
       I_WG2, I_WU2, I_WD2, I_NF, I_WFM, I_BFM, N_IN };
constexpr size_t MiB = 1u << 20;
constexpr size_t WS_CTL = 0, CTL_BYTES = 1 * MiB;
constexpr size_t WS_MOD = 1 * MiB;
constexpr size_t WS_FMOD = 2 * MiB;
constexpr size_t WS_LBV = 3 * MiB;
constexpr size_t WS_WGU1 = 4 * MiB, WS_WD1 = 48 * MiB, WS_WIN = 70 * MiB, WS_WOUT = 98 * MiB, WS_WGU2 = 106 * MiB, WS_WD2 = 150 * MiB;
constexpr size_t WS_XN = 172 * MiB;
constexpr size_t WS_H = 206 * MiB;
constexpr size_t WS_X = 298 * MiB;
constexpr size_t WS_QA = 364 * MiB, WS_IA = 381 * MiB, WS_GA = 398 * MiB, WS_QB = 415 * MiB, WS_KB = 432 * MiB, WS_VB = 449 * MiB;
constexpr size_t WS_LF = 466 * MiB;
constexpr size_t WS_OM = 500 * MiB;
constexpr size_t WS_PART = 534 * MiB;
constexpr size_t WS_END = 560 * MiB;

#define GAS __attribute__((address_space(1)))
#define LAS __attribute__((address_space(3)))
typedef unsigned short bf16;
typedef unsigned v4u __attribute__((ext_vector_type(4)));
typedef unsigned v2u __attribute__((ext_vector_type(2)));
typedef float f32x4 __attribute__((ext_vector_type(4)));
typedef float f32x2 __attribute__((ext_vector_type(2)));
typedef short bf16x8 __attribute__((ext_vector_type(8)));

struct Args { const void* in[N_IN]; float* out; unsigned char* ws; };

__device__ __forceinline__ unsigned f2bf(float f) { unsigned u = __builtin_bit_cast(unsigned, f); return (u + 0x7fffu + ((u >> 16) & 1u)) >> 16; }
__device__ __forceinline__ unsigned pk2(float lo, float hi) { return f2bf(lo) | (f2bf(hi) << 16); }
__device__ __forceinline__ float bf2f(unsigned short b) { return __builtin_bit_cast(float, (unsigned)b << 16); }
__device__ __forceinline__ float bflo(unsigned w) { return __builtin_bit_cast(float, w << 16); }
__device__ __forceinline__ float bfhi(unsigned w) { return __builtin_bit_cast(float, w & 0xffff0000u); }
__device__ __forceinline__ float sigmoid_f(float x) { return __builtin_amdgcn_rcpf(1.f + __expf(-x)); }
__device__ __forceinline__ float silu_f(float x) { return x * sigmoid_f(x); }
__device__ __forceinline__ int mod_row(int r) { const int s = 4 + ((r - MP) >> 3); return r < MP ? (r >> 11) : (s > 11 ? 11 : s); }
__device__ __forceinline__ float wave_sum(float v) {
#pragma unroll
    for (int o = 1; o < 64; o <<= 1) v += __shfl_xor(v, o);
    return v;
}
__device__ __forceinline__ int tid_opaque() { int t = (int)threadIdx.x; asm volatile("" : "+v"(t)); return t; }
#define LDS_WAIT() asm volatile("s_waitcnt lgkmcnt(0)" ::: "memory")
#define VM_WAIT() asm volatile("s_waitcnt vmcnt(0)" ::: "memory")

namespace pg8 {
#define PG8_LAS __attribute__((address_space(3)))
typedef unsigned short bf16_t;
typedef short bf16x8 __attribute__((ext_vector_type(8)));
typedef float f32x4 __attribute__((ext_vector_type(4)));
typedef unsigned u32x4 __attribute__((ext_vector_type(4)));
constexpr int BM = 256, BK = 64, HALF = 128, HTB = HALF * BK * 2  , STAGE_BYTES = 8 * HTB, NXCD = 8, WGM = 8;

__host__ __device__ __forceinline__ int lds_byte(int r, int c) { const int st = (r >> 4) * 2 + (c >> 5), rr = r & 15, cc = c & 31, ob = rr * 64 + cc * 2; return st * 1024 + (ob ^ (((ob >> 9) & 1) << 5)); }
__host__ __device__ __forceinline__ void stage_rc(int b, int& R, int& C) { const int st = b / 1024, sb = b % 1024, swz = sb ^ (((sb >> 9) & 1) << 5); R = (st >> 1) * 16 + swz / 64; C = (st & 1) * 32 + (swz % 64) / 2; }
__host__ __device__ __forceinline__ int perm32(int rho) { const int n = rho >> 4, i = rho & 15; return 8 * (i >> 2) + 4 * n + (i & 3); }

struct Unit { int pm, pn; };
struct Gemm { const bf16_t* A; const bf16_t* Bt; int M, N, K; };

struct StaticOrder {
    int nM, nN, nwg, G, c;
    __host__ __device__ void init(int M, int N, int G_, int c_) { nM = M / BM; nN = N / BM; nwg = nM * nN; G = G_; c = c_; }
    __host__ __device__ bool next(int i, Unit& u) const {
        const long L = (long)i * G + c; if (L >= nwg) return false;
        int wgid = (int)L; { const int q = nwg / NXCD, r = nwg % NXCD, xcd = wgid % NXCD, off = wgid / NXCD; wgid = (xcd < r ? xcd * (q + 1) : r * (q + 1) + (xcd - r) * q) + off; }
        const int nig = WGM * nN, gid = wgid / nig, fm = gid * WGM, gsz = (nM - fm) < WGM ? (nM - fm) : WGM;
        u.pm = fm + ((wgid % nig) % gsz); u.pn = (wgid % nig) / gsz; return true;
    }
    __device__ __forceinline__ void a_ready(const Unit&) const {}
    __device__ __forceinline__ void done(const Unit&) const {}
};


__device__ __forceinline__ unsigned cvt_pk_bf16(float lo, float hi) { unsigned r; asm volatile("v_cvt_pk_bf16_f32 %0, %1, %2" : "=v"(r) : "v"(lo), "v"(hi)); return r; }

struct EpiSwiGLU {
    static constexpr bool PERM = true, AFTER_DRAIN = false;
    bf16_t* H; int ldh;
    __device__ __forceinline__ void operator()(const f32x4 (&acc)[2][2][4][2], const Unit& u, int wr, int wc, int fr, int fq) const {
        const int row0 = u.pm * BM + wr * 64 + fr, col0 = u.pn * HALF + wc * 32 + 8 * fq;
#pragma unroll
        for (int ai = 0; ai < 2; ++ai)
#pragma unroll
            for (int m = 0; m < 4; ++m) {
                const f32x4 g0 = acc[ai][0][m][0], g1 = acc[ai][0][m][1], u0 = acc[ai][1][m][0], u1 = acc[ai][1][m][1];
                float v[8];
#pragma unroll
                for (int j = 0; j < 4; ++j) { v[j] = silu_f(g0[j]) * u0[j]; v[4 + j] = silu_f(g1[j]) * u1[j]; }
                u32x4 w; w.x = cvt_pk_bf16(v[0], v[1]); w.y = cvt_pk_bf16(v[2], v[3]); w.z = cvt_pk_bf16(v[4], v[5]); w.w = cvt_pk_bf16(v[6], v[7]);
                *(u32x4*)(H + (size_t)(row0 + ai * HALF + m * 16) * ldh + col0) = w;
            }
    }
};
struct EpiResid {
    static constexpr bool PERM = false, AFTER_DRAIN = false;
    const float* xp; const float* xs; float* X; const float* gate; float scale;
    __device__ __forceinline__ void operator()(const f32x4 (&acc)[2][2][4][2], const Unit& u, int wr, int wc, int fr, int fq) const {
        const int col0 = u.pn * BM + wc * 32 + 4 * fq;
#pragma unroll
        for (int ai = 0; ai < 2; ++ai)
#pragma unroll
            for (int m = 0; m < 4; ++m) {
                const int row = u.pm * BM + ai * HALF + wr * 64 + m * 16 + fr;
                if (row < MREAL) {
                    const float* base = xp ? (row < MP ? xp + (size_t)row * DM : xs + (size_t)(row - MP) * DM) : X + (size_t)row * DM;
                    const float* gr = gate + (size_t)mod_row(row) * NMODC;
#pragma unroll
                    for (int bj = 0; bj < 2; ++bj)
#pragma unroll
                        for (int n = 0; n < 2; ++n) { const int c = col0 + bj * HALF + n * 16;
                            const f32x4 gv = *(const f32x4*)(gr + c), bv = *(const f32x4*)(base + c);
                            *(f32x4*)(X + (size_t)row * DM + c) = bv + (gv * scale) * acc[ai][bj][m][n]; }
                }
            }
    }
};
struct EpiProj {
    static constexpr bool PERM = true, AFTER_DRAIN = false;
    unsigned char* ws; float* LF; float* out; const float* lbv;
    template <int MODE> __device__ __forceinline__ void run(const f32x4 (&acc)[2][2][4][2], const Unit& u, int wr, int wc, int fr, int fq, bf16_t* B, float s, size_t offp, size_t offs) const {
        const int cb = (u.pn & 3) * BM + wc * 32 + 8 * fq;
#pragma unroll
        for (int ai = 0; ai < 2; ++ai)
#pragma unroll
            for (int m = 0; m < 4; ++m) {
                const int row = u.pm * BM + ai * HALF + wr * 64 + m * 16 + fr;
#pragma unroll
                for (int bj = 0; bj < 2; ++bj) {
                    const int c = cb + bj * HALF; const size_t o = (size_t)row * DA + c;
                    f32x4 v0 = acc[ai][bj][m][0], v1 = acc[ai][bj][m][1];
                    if constexpr (MODE == 1) {
                        const f32x4 l0 = *(const f32x4*)(lbv + c), l1 = *(const f32x4*)(lbv + c + 4);
#pragma unroll
                        for (int j = 0; j < 4; ++j) { v0[j] = __logf(l0[j] + (1.f - l0[j]) * sigmoid_f(v0[j])); v1[j] = __logf(l1[j] + (1.f - l1[j]) * sigmoid_f(v1[j])); }
                        *(f32x4*)(LF + o) = v0; *(f32x4*)(LF + o + 4) = v1;
                    } else {
                        if constexpr (MODE == 3) {
                            if (row < MREAL) { float* dst = row < MP ? out + offp + o : out + offs + (o - (size_t)MP * DA); *(f32x4*)dst = v0; *(f32x4*)(dst + 4) = v1; }
                        }
                        if constexpr (MODE == 0) { v0 = v0 * s; v1 = v1 * s; }
                        if constexpr (MODE == 2) {
#pragma unroll
                            for (int j = 0; j < 4; ++j) { v0[j] = silu_f(v0[j]); v1[j] = silu_f(v1[j]); }
                        }
                        u32x4 w; w.x = cvt_pk_bf16(v0[0], v0[1]); w.y = cvt_pk_bf16(v0[2], v0[3]); w.z = cvt_pk_bf16(v1[0], v1[1]); w.w = cvt_pk_bf16(v1[2], v1[3]);
                        *(u32x4*)(B + o) = w;
                    }
                }
            }
    }
    __device__ __forceinline__ void operator()(const f32x4 (&acc)[2][2][4][2], const Unit& u, int wr, int wc, int fr, int fq) const {
        const int rng = u.pn >> 2;
        bf16_t* B = (bf16_t*)(ws + WS_QA + (size_t)(rng == 0 ? 0 : rng - 1) * (WS_IA - WS_QA));
        if (rng == 1) run<1>(acc, u, wr, wc, fr, fq, nullptr, 1.f, 0, 0);
        else if (rng == 3) run<2>(acc, u, wr, wc, fr, fq, B, 1.f, 0, 0);
        else if (rng >= 5) run<3>(acc, u, wr, wc, fr, fq, B, 1.f, rng == 5 ? OFF_KP : OFF_VP, rng == 5 ? OFF_KS : OFF_VS);
        else run<0>(acc, u, wr, wc, fr, fq, B, rng == 2 ? 1.f : (rng == 4 ? QSCALE * LOG2E : QSCALE), 0, 0);
    }
};
template <class Epi, class Sched, bool ALIGN_EPI = false, bool SP2 = false>
__device__ __forceinline__ void gemm_phase(PG8_LAS unsigned char* lds, const Gemm g, const Sched& S, const Epi& E) {
    const int tid = tid_opaque(), wid = __builtin_amdgcn_readfirstlane(tid >> 6), lane = tid & 63, wr = wid >> 2, wc = wid & 3, fr = lane & 15, fq = lane >> 4;
    const int K = g.K, nt = K / BK;
    unsigned voffA[2], voffB[2];
#pragma unroll
    for (int i = 0; i < 2; ++i) { int R, C; stage_rc(tid * 16 + i * 8192, R, C); const int Rb = Epi::PERM ? ((R & ~31) + perm32(R & 31)) : R;
        voffA[i] = (unsigned)(R * K + C) * 2u; voffB[i] = (unsigned)(Rb * K + C) * 2u; }
    const size_t kstep = (size_t)(BK * 2);
    const size_t hstep = (size_t)HALF * K * 2;
    const size_t tstep = 2 * hstep;
    const unsigned ldsw = (unsigned)wid * 1024u;
    const int aoff = lds_byte(wr * 64 + fr, fq * 8), boff = lds_byte(wc * 32 + fr, fq * 8);
#define PG8_SA(b, h) (((b) * 2 + (h)) * HTB)
#define PG8_SB(b, h) ((4 + (b) * 2 + (h)) * HTB)
#define PG8_STAGE(bufoff, gbase, voff) do { _Pragma("unroll") for (int _i = 0; _i < 2; ++_i) \
        __builtin_amdgcn_global_load_lds((const unsigned*)((const char*)(gbase) + (voff)[_i]), (PG8_LAS unsigned*)(lds + (bufoff) + ldsw + _i * 8192), 16, 0, 0); } while (0)
#define PG8_LDA(dst, b, h) do { _Pragma("unroll") for (int m = 0; m < 4; ++m) _Pragma("unroll") for (int k = 0; k < 2; ++k) dst[m][k] = *(const PG8_LAS bf16x8*)(lds + PG8_SA(b, h) + aoff + m * 2048 + k * 1024); } while (0)
#define PG8_LDB(dst, b, h) do { _Pragma("unroll") for (int n = 0; n < 2; ++n) _Pragma("unroll") for (int k = 0; k < 2; ++k) dst[n][k] = *(const PG8_LAS bf16x8*)(lds + PG8_SB(b, h) + boff + n * 2048 + k * 1024); } while (0)
#define PG8_MMA(ai, bj, At, Bt) do { __builtin_amdgcn_s_setprio(1); _Pragma("unroll") for (int m = 0; m < 4; ++m) _Pragma("unroll") for (int n = 0; n < 2; ++n) _Pragma("unroll") for (int k = 0; k < 2; ++k) \
        acc[ai][bj][m][n] = __builtin_amdgcn_mfma_f32_16x16x32_bf16(Bt[n][k], At[m][k], acc[ai][bj][m][n], 0, 0, 0); __builtin_amdgcn_s_setprio(0); } while (0)
#define PG8_WAIT_V(n) asm volatile("s_waitcnt vmcnt(" #n ")" ::: "memory")
#define PG8_WAIT_L(n) asm volatile("s_waitcnt lgkmcnt(" #n ")" ::: "memory")
#define PG8_BAR __builtin_amdgcn_s_barrier()
#define PG8_SCHED __builtin_amdgcn_sched_barrier(0)
    Unit cur, nxt; int ui = 0;
    if (!S.next(0, cur)) return;
    f32x4 acc[2][2][4][2];
#pragma unroll
    for (int a = 0; a < 2; ++a)
#pragma unroll
        for (int b = 0; b < 2; ++b)
#pragma unroll
            for (int m = 0; m < 4; ++m)
#pragma unroll
                for (int n = 0; n < 2; ++n) acc[a][b][m][n] = (f32x4){0.f, 0.f, 0.f, 0.f};
    bf16x8 At[4][2], B0[2][2], B1[2][2];
    const char* cA = (const char*)g.A + (size_t)cur.pm * tstep; const char* cB = (const char*)g.Bt + (size_t)cur.pn * tstep;
    S.a_ready(cur);
    if constexpr (SP2) {
        PG8_STAGE(PG8_SB(0, 0), cB, voffB); PG8_STAGE(PG8_SB(0, 1), cB + hstep, voffB); PG8_STAGE(PG8_SA(0, 0), cA, voffA); PG8_STAGE(PG8_SA(0, 1), cA + hstep, voffA);
        if (wr == 1) PG8_BAR;
        PG8_WAIT_V(2); PG8_BAR;
        PG8_STAGE(PG8_SB(1, 0), cB + kstep, voffB); PG8_STAGE(PG8_SA(1, 0), cA + kstep, voffA); PG8_STAGE(PG8_SB(1, 1), cB + hstep + kstep, voffB);
        PG8_WAIT_V(6); PG8_BAR;
    } else {
        PG8_STAGE(PG8_SB(0, 0), cB, voffB); PG8_STAGE(PG8_SA(0, 0), cA, voffA); PG8_STAGE(PG8_SB(0, 1), cB + hstep, voffB); PG8_STAGE(PG8_SA(0, 1), cA + hstep, voffA);
        if (wr == 1) PG8_BAR;
        PG8_WAIT_V(4); PG8_BAR;
        PG8_STAGE(PG8_SB(1, 0), cB + kstep, voffB); PG8_STAGE(PG8_SA(1, 0), cA + kstep, voffA); PG8_STAGE(PG8_SB(1, 1), cB + hstep + kstep, voffB);
        PG8_WAIT_V(6); PG8_BAR;
    }
    for (;;) {
        const bool has_next = S.next(ui + 1, nxt);
        const char* nA = has_next ? (const char*)g.A + (size_t)nxt.pm * tstep : cA; const char* nB = has_next ? (const char*)g.Bt + (size_t)nxt.pn * tstep : cB;
        for (int t = 0; t < nt; t += 2) {
            const bool last = (t == nt - 2);
            const char* a1 = cA + (size_t)(t + 1) * kstep;
            const char* a2 = last ? nA : cA + (size_t)(t + 2) * kstep; const char* b2 = last ? nB : cB + (size_t)(t + 2) * kstep;
            const char* a3 = a2 + kstep; const char* b3 = b2 + kstep;
            if (last && has_next) S.a_ready(nxt);
            if constexpr (SP2) {
            PG8_LDB(B0, 0, 0); PG8_LDB(B1, 0, 1); PG8_SCHED; PG8_LDA(At, 0, 0); PG8_STAGE(PG8_SA(1, 1), a1 + hstep, voffA);
            PG8_WAIT_V(8); PG8_WAIT_L(0); PG8_BAR; PG8_MMA(0, 0, At, B0); PG8_MMA(0, 1, At, B1); PG8_BAR; PG8_SCHED;
            PG8_LDA(At, 0, 1); PG8_STAGE(PG8_SB(0, 0), b2, voffB); PG8_STAGE(PG8_SB(0, 1), b2 + hstep, voffB); PG8_STAGE(PG8_SA(0, 0), a2, voffA);
            PG8_WAIT_V(8); PG8_WAIT_L(0); PG8_BAR; PG8_MMA(1, 0, At, B0); PG8_MMA(1, 1, At, B1); PG8_BAR; PG8_SCHED;
            PG8_LDB(B0, 1, 0); PG8_LDB(B1, 1, 1); PG8_SCHED; PG8_LDA(At, 1, 0); PG8_STAGE(PG8_SA(0, 1), a2 + hstep, voffA);
            PG8_WAIT_V(8); PG8_WAIT_L(0); PG8_BAR; PG8_MMA(0, 0, At, B0); PG8_MMA(0, 1, At, B1); PG8_BAR; PG8_SCHED;
            PG8_LDA(At, 1, 1); PG8_STAGE(PG8_SB(1, 0), b3, voffB); PG8_STAGE(PG8_SB(1, 1), b3 + hstep, voffB); PG8_STAGE(PG8_SA(1, 0), a3, voffA);
            PG8_WAIT_V(8); PG8_WAIT_L(0); PG8_BAR; PG8_MMA(1, 0, At, B0); PG8_MMA(1, 1, At, B1); PG8_BAR; PG8_SCHED;
            } else {
            PG8_LDB(B0, 0, 0); PG8_SCHED; PG8_LDA(At, 0, 0); PG8_STAGE(PG8_SA(1, 1), a1 + hstep, voffA);
            PG8_WAIT_L(8); PG8_BAR; PG8_WAIT_L(0); PG8_MMA(0, 0, At, B0); PG8_BAR; PG8_SCHED;
            PG8_LDB(B1, 0, 1); PG8_STAGE(PG8_SB(0, 0), b2, voffB);
            PG8_BAR; PG8_WAIT_L(0); PG8_MMA(0, 1, At, B1); PG8_BAR;
            PG8_LDA(At, 0, 1); PG8_STAGE(PG8_SA(0, 0), a2, voffA);
            PG8_BAR; PG8_WAIT_L(0); PG8_MMA(1, 0, At, B0); PG8_BAR; PG8_SCHED;
            PG8_STAGE(PG8_SB(0, 1), b2 + hstep, voffB);
            PG8_WAIT_V(6); PG8_BAR; PG8_MMA(1, 1, At, B1); PG8_BAR;
            PG8_LDB(B0, 1, 0); PG8_SCHED; PG8_LDA(At, 1, 0); PG8_STAGE(PG8_SA(0, 1), a2 + hstep, voffA);
            PG8_WAIT_L(8); PG8_BAR; PG8_WAIT_L(0); PG8_MMA(0, 0, At, B0); PG8_BAR; PG8_SCHED;
            PG8_LDB(B1, 1, 1); PG8_STAGE(PG8_SB(1, 0), b3, voffB);
            PG8_BAR; PG8_WAIT_L(0); PG8_MMA(0, 1, At, B1); PG8_BAR;
            PG8_LDA(At, 1, 1); PG8_STAGE(PG8_SA(1, 0), a3, voffA);
            PG8_BAR; PG8_WAIT_L(0); PG8_MMA(1, 0, At, B0); PG8_BAR; PG8_SCHED;
            PG8_STAGE(PG8_SB(1, 1), b3 + hstep, voffB);
            PG8_WAIT_V(6); PG8_BAR; PG8_MMA(1, 1, At, B1); PG8_BAR;
            }
        }
        if constexpr (ALIGN_EPI) { if (wr == 0) PG8_BAR; }
        if constexpr (!Epi::AFTER_DRAIN) { E(acc, cur, wr, wc, fr, fq); S.done(cur); }
        if (!has_next) break;
#pragma unroll
        for (int a = 0; a < 2; ++a)
#pragma unroll
            for (int b = 0; b < 2; ++b)
#pragma unroll
                for (int m = 0; m < 4; ++m)
#pragma unroll
                    for (int n = 0; n < 2; ++n) acc[a][b][m][n] = (f32x4){0.f, 0.f, 0.f, 0.f};
        cur = nxt; cA = nA; cB = nB; ++ui;
        if constexpr (ALIGN_EPI) { if (wr == 1) PG8_BAR; }
    }
    PG8_WAIT_V(0);
    if constexpr (!ALIGN_EPI) { if (wr == 0) PG8_BAR; }
    PG8_BAR;
    if constexpr (Epi::AFTER_DRAIN) { E.fused(acc, cur, wr, wc, fr, fq, lds, wid, lane); S.done(cur); }
#undef PG8_SA
#undef PG8_SB
#undef PG8_STAGE
#undef PG8_LDA
#undef PG8_LDB
#undef PG8_MMA
#undef PG8_WAIT_V
#undef PG8_WAIT_L
#undef PG8_BAR
#undef PG8_SCHED
}
}

constexpr int NTHR = 512, NWAVES = 8;
constexpr int LDS_BYTES = 155648;

#define IN_F(i) ((const float*)a.in[i])
#define WS_F(off) ((float*)(a.ws + (off)))
#define WS_B(off) ((bf16*)(a.ws + (off)))

__device__ __forceinline__ void phase_mod(const Args& a, LAS unsigned char* lds, int bid, int nblk) {
    const int tid = tid_opaque(), lane = tid & 63, w = tid >> 6;
    LAS float* sc = (LAS float*)lds;
    LAS float* red = (LAS float*)(lds + 98304);
    for (int i = tid; i < 12 * DM; i += NTHR) { const int b = i >> 11, k = i & 2047; const float c = b < 4 ? IN_F(I_CP)[b * DM + k] : IN_F(I_CS)[(b - 4) * DM + k]; sc[i] = silu_f(c); }
    if (bid == 0) for (int i = tid; i < DA; i += NTHR) WS_F(WS_LBV)[i] = sigmoid_f(IN_F(I_LB)[i]);
    __syncthreads();
    for (int u = bid; u < 176; u += nblk) {
        const bool fm = u >= 144; const int n0 = (fm ? u - 144 : u) * 128, ld = fm ? NFMODC : NMODC;
        const float* W = fm ? IN_F(I_WFM) : IN_F(I_WMOD); const float* bias = fm ? IN_F(I_BFM) : IN_F(I_BMOD); float* outp = fm ? WS_F(WS_FMOD) : WS_F(WS_MOD);
        f32x2 acc[12];
#pragma unroll
        for (int b = 0; b < 12; ++b) acc[b] = (f32x2){0.f, 0.f};
        const float* wp = W + (size_t)(w * 256) * ld + n0 + 2 * lane;
        for (int k = 0; k < 256; k += 4) {
            const f32x2 w0 = *(const f32x2*)(wp + (size_t)(k + 0) * ld), w1 = *(const f32x2*)(wp + (size_t)(k + 1) * ld), w2 = *(const f32x2*)(wp + (size_t)(k + 2) * ld), w3 = *(const f32x2*)(wp + (size_t)(k + 3) * ld);
#pragma unroll
            for (int b = 0; b < 12; ++b) { const f32x4 s = *(const LAS f32x4*)(sc + b * DM + w * 256 + k); acc[b] += w0 * s.x + w1 * s.y + w2 * s.z + w3 * s.w; }
        }
#pragma unroll
        for (int b = 0; b < 12; ++b) *(LAS f32x2*)(red + (w * 12 + b) * 128 + 2 * lane) = acc[b];
        __syncthreads();
        for (int i = tid; i < 12 * 128; i += NTHR) { const int b = i >> 7, c = i & 127; float s = 0.f;
#pragma unroll
            for (int ww = 0; ww < 8; ++ww) s += red[(ww * 12 + b) * 128 + c];
            outp[(size_t)b * ld + n0 + c] = s + bias[n0 + c]; }
        __syncthreads();
    }
}

__device__ __forceinline__ void cvt_item(const float* W, int K, int N, bf16* WT, int k0, int n0, int drow0, LAS float* scr, int lane) {
#pragma unroll 8
    for (int i = 0; i < 32; ++i) { const int kk = 2 * i + (lane >> 5); scr[kk * 33 + (lane & 31)] = W[(size_t)(k0 + kk) * N + n0 + (lane & 31)]; }
    LDS_WAIT(); asm volatile("" ::: "memory");
    const int c = lane & 7;
#pragma unroll
    for (int j = 0; j < 4; ++j) { const int n = (lane >> 3) + 8 * j; const LAS float* s = scr + (8 * c) * 33 + n;
        v4u o; o.x = pk2(s[0 * 33], s[1 * 33]); o.y = pk2(s[2 * 33], s[3 * 33]); o.z = pk2(s[4 * 33], s[5 * 33]); o.w = pk2(s[6 * 33], s[7 * 33]);
        *(GAS v4u*)(WT + (size_t)(drow0 + n) * K + k0 + 8 * c) = o; }
    LDS_WAIT(); asm volatile("" ::: "memory");
}
__device__ __forceinline__ void cvt_matrix(const float* W, int K, int N, bf16* WT, int mode, LAS float* scr, int gw, int ngw, int lane) {
    const int nblk = N / 32, nitems = (K / 64) * nblk;
    for (int it = gw; it < nitems; it += ngw) { const int kb = it / nblk, nb = it % nblk, n0 = 32 * nb;
        const int drow0 = mode == 0 ? n0 : ((n0 >> 7) * 256 + (mode == 2 ? 128 : 0) + (n0 & 127));
        cvt_item(W, K, N, WT, 64 * kb, n0, drow0, scr, lane); }
}
__device__ __forceinline__ void phase_cvt(const Args& a, LAS unsigned char* lds, int bid, int nblk, int first, int last) {
    const int tid = tid_opaque(), lane = tid & 63, w = tid >> 6;
    LAS float* scr = (LAS float*)(lds + w * 16384);
    const int gw = bid * NWAVES + w, ngw = nblk * NWAVES;
    if (first <= 0 && 0 <= last) { cvt_matrix(IN_F(I_WG1), DM, DFF, WS_B(WS_WGU1), 1, scr, gw, ngw, lane); cvt_matrix(IN_F(I_WU1), DM, DFF, WS_B(WS_WGU1), 2, scr, gw, ngw, lane);
                                   cvt_matrix(IN_F(I_WD1), DFF, DM, WS_B(WS_WD1), 0, scr, gw, ngw, lane); }
    if (first <= 1 && 1 <= last) { cvt_matrix(IN_F(I_WIN), DM, DIN, WS_B(WS_WIN), 0, scr, gw, ngw, lane); cvt_matrix(IN_F(I_WOUT), DM, DM, WS_B(WS_WOUT), 0, scr, gw, ngw, lane); }
    if (first <= 2 && 2 <= last) { cvt_matrix(IN_F(I_WG2), DM, DFF, WS_B(WS_WGU2), 1, scr, gw, ngw, lane); cvt_matrix(IN_F(I_WU2), DM, DFF, WS_B(WS_WGU2), 2, scr, gw, ngw, lane);
                                   cvt_matrix(IN_F(I_WD2), DFF, DM, WS_B(WS_WD2), 0, scr, gw, ngw, lane); }
}

template <bool FINAL>
__device__ __forceinline__ void phase_norm(const Args& a, int bid, int nblk, bool from_inputs, const float* gvec, const float* modp, int ldmod, int sh_off, int sc_off) {
    const int tid = tid_opaque(), lane = tid & 63, w = tid >> 6;
    const int gw = bid * NWAVES + w, ngw = nblk * NWAVES;
    const int nrows = FINAL ? MREAL : MPAD;
    for (int r = gw; r < nrows; r += ngw) {
        if (r >= MREAL) {
            GAS v4u* o = (GAS v4u*)(WS_B(WS_XN) + (size_t)r * DM) + lane;
#pragma unroll
            for (int j = 0; j < 4; ++j) o[64 * j] = (v4u){0u, 0u, 0u, 0u};
            continue;
        }
        const float* xrow = from_inputs ? (r < MP ? IN_F(I_XP) + (size_t)r * DM : IN_F(I_XS) + (size_t)(r - MP) * DM) : WS_F(WS_X) + (size_t)r * DM;
        const GAS f32x4* xr = (const GAS f32x4*)xrow + lane;
        f32x4 v[8]; float s = 0.f;
#pragma unroll
        for (int j = 0; j < 8; ++j) { v[j] = xr[64 * j]; s += (v[j].x * v[j].x + v[j].y * v[j].y) + (v[j].z * v[j].z + v[j].w * v[j].w); }
        const float rstd = 1.0f / sqrtf(wave_sum(s) * (1.f / DM) + EPS);
        const float* mr = modp + (size_t)mod_row(r) * ldmod;
#pragma unroll
        for (int j = 0; j < 8; ++j) {
            const int c = 4 * (lane + 64 * j);
            const f32x4 g = *(const f32x4*)(gvec + c), sh = *(const f32x4*)(mr + sh_off + c), sc = *(const f32x4*)(mr + sc_off + c);
            const f32x4 y = (v[j] * rstd * g) * (1.f + sc) + sh;
            if (FINAL) { float* dst = r < MP ? a.out + OFF_YP + (size_t)r * DM : a.out + OFF_YS + (size_t)(r - MP) * DM; *(f32x4*)(dst + c) = y; }
            else { v2u o; o.x = pk2(y.x, y.y); o.y = pk2(y.z, y.w); *(GAS v2u*)(WS_B(WS_XN) + (size_t)r * DM + c) = o; }
        }
    }
}

template <int WHICH> __device__ __forceinline__ void phase_gemm(const Args& a, LAS unsigned char* lds, int bid, int nblk) {
    using namespace pg8;
    if constexpr (WHICH == 1 || WHICH == 5) {
        Gemm g{WS_B(WS_XN), WS_B(WHICH == 1 ? WS_WGU1 : WS_WGU2), MPAD, 2 * DFF, DM}; StaticOrder S; S.init(MPAD, 2 * DFF, nblk, bid);
        EpiSwiGLU E{WS_B(WS_H), DFF};
        gemm_phase<EpiSwiGLU, StaticOrder, true, true>(lds, g, S, E);
    } else if constexpr (WHICH == 2 || WHICH == 6) {
        Gemm g{WS_B(WS_H), WS_B(WHICH == 2 ? WS_WD1 : WS_WD2), MPAD, DM, DFF}; StaticOrder S; S.init(MPAD, DM, nblk, bid);
        EpiResid E{WHICH == 2 ? IN_F(I_XP) : nullptr, IN_F(I_XS), WS_F(WS_X), WS_F(WS_MOD) + (WHICH == 2 ? 2 : 8) * DM, 0.5f};
        gemm_phase<EpiResid, StaticOrder, true, true>(lds, g, S, E);
    } else if constexpr (WHICH == 3) {
        Gemm g{WS_B(WS_XN), WS_B(WS_WIN), MPAD, DIN, DM}; StaticOrder S; S.init(MPAD, DIN, nblk, bid);
        EpiProj E{a.ws, WS_F(WS_LF), a.out, WS_F(WS_LBV)};
        gemm_phase<EpiProj, StaticOrder, true, true>(lds, g, S, E);
    } else {
        Gemm g{WS_B(WS_OM), WS_B(WS_WOUT), MPAD, DM, DM}; StaticOrder S; S.init(MPAD, DM, nblk, bid);
        EpiResid E{nullptr, IN_F(I_XS), WS_F(WS_X), WS_F(WS_MOD) + 5 * DM, 1.0f};
        gemm_phase<EpiResid, StaticOrder, true, true>(lds, g, S, E);
    }
}

__device__ __forceinline__ void hgrn_unit(const Args& a, LAS unsigned char* lds, int unit) {
    const int tid = tid_opaque(), dv = tid & 127, g = tid >> 7;
    const bool smp = unit >= 32; const int u = smp ? unit - 32 : unit, b = u >> 3, h = u & 7;
    const int T = smp ? DECT : SEQ, row0 = smp ? MP + b * DECT : b * SEQ;
    float* sout = a.out + (smp ? OFF_SS : OFF_SP) + (size_t)u * HD * HD;
    LAS float* fL = (LAS float*)lds; LAS float* kL = fL + 2048; LAS float* qL = kL + 2048; LAS float* vL = qL + 2048; LAS float* red = vL + 2048;
    const bf16* QA = WS_B(WS_QA); const bf16* IA = WS_B(WS_IA); const bf16* GA = WS_B(WS_GA); const float* LF = WS_F(WS_LF);
    float S[32];
#pragma unroll
    for (int i = 0; i < 32; ++i) S[i] = smp ? IN_F(I_ST)[(size_t)u * HD * HD + (size_t)(32 * g + i) * HD + dv] : 0.f;
    for (int t0 = 0; t0 < T; t0 += 16) {
        const int nt = (T - t0) < 16 ? (T - t0) : 16;
        for (int i = tid; i < nt * 128; i += NTHR) { const int tt = i >> 7, ch = i & 127; const size_t o = (size_t)(row0 + t0 + tt) * DA + h * HD + ch;
            const float f = __expf(LF[o]); fL[i] = f; kL[i] = 1.f - f; qL[i] = bf2f(QA[o]); vL[i] = bf2f(IA[o]); }
        __syncthreads();
        for (int tt = 0; tt < nt; ++tt) {
            const float v = vL[tt * 128 + dv]; float op = 0.f;
#pragma unroll
            for (int i4 = 0; i4 < 8; ++i4) {
                const f32x4 f4 = *(const LAS f32x4*)(fL + tt * 128 + g * 32 + 4 * i4), k4 = *(const LAS f32x4*)(kL + tt * 128 + g * 32 + 4 * i4), q4 = *(const LAS f32x4*)(qL + tt * 128 + g * 32 + 4 * i4);
#pragma unroll
                for (int j = 0; j < 4; ++j) { S[4 * i4 + j] = f4[j] * S[4 * i4 + j] + k4[j] * v; op += S[4 * i4 + j] * q4[j]; }
            }
            red[(g * 16 + tt) * 128 + dv] = op;
        }
        __syncthreads();
        { const int tt = tid >> 5, l32 = tid & 31;
          if (tt < nt) {
            f32x4 o = (f32x4){0.f, 0.f, 0.f, 0.f};
#pragma unroll
            for (int gg = 0; gg < 4; ++gg) o += *(const LAS f32x4*)(red + (gg * 16 + tt) * 128 + 4 * l32);
            float ss = (o.x * o.x + o.y * o.y) + (o.z * o.z + o.w * o.w);
#pragma unroll
            for (int m = 1; m < 32; m <<= 1) ss += __shfl_xor(ss, m);
            const float rstd = 1.0f / sqrtf(ss * (1.f / HD) + EPS);
            const int row = row0 + t0 + tt, col = h * HD + 4 * l32;
            const f32x4 gw = *(const f32x4*)(IN_F(I_GOA) + col); const v2u gt = *(const v2u*)(GA + (size_t)row * DA + col);
            v2u w; w.x = pk2(o.x * rstd * gw.x * bflo(gt.x), o.y * rstd * gw.y * bfhi(gt.x)); w.y = pk2(o.z * rstd * gw.z * bflo(gt.y), o.w * rstd * gw.w * bfhi(gt.y));
            *(v2u*)(WS_B(WS_OM) + (size_t)row * DM + col) = w;
          } }
        __syncthreads();
    }
#pragma unroll
    for (int i = 0; i < 32; ++i) sout[(size_t)(32 * g + i) * HD + dv] = S[i];
}

__device__ __forceinline__ void sb_tile(const LAS float* Kt, const LAS float* Vt, const LAS float* q, float bias, int lane, int nvis  , float& R, float& o0, float& o1) {
    float z = bias;
#pragma unroll 8
    for (int d = 0; d < HD; d += 4) { const f32x4 qv = *(const LAS f32x4*)(q + d);
        z += qv.x * Kt[lane * 129 + d] + qv.y * Kt[lane * 129 + d + 1] + qv.z * Kt[lane * 129 + d + 2] + qv.w * Kt[lane * 129 + d + 3]; }
    const bool vis = lane < nvis;
    const float L = vis ? -(z > 20.f ? z : log1pf(__expf(z))) : 0.f;
    float c = L;
#pragma unroll
    for (int off = 1; off < 64; off <<= 1) { const float t = __shfl_down(c, off); if (lane + off < 64) c += t; }
    const float P = vis ? __expf(z + c + R) : 0.f;
    R += __shfl(c, 0);
#pragma unroll 8
    for (int s = 0; s < 64; ++s) { const float p = __builtin_bit_cast(float, __builtin_amdgcn_readlane(__builtin_bit_cast(int, P), s));
        o0 += p * Vt[s * 128 + lane]; o1 += p * Vt[s * 128 + 64 + lane]; }
}
__device__ __forceinline__ void sb_finish(const Args& a, int row, int h, int lane, float o0, float o1) {
    const float ss = wave_sum(o0 * o0 + o1 * o1);
    const float rstd = 1.0f / sqrtf(ss * (1.f / HD) + EPS);
    const float* gw = IN_F(I_GOB) + h * HD; bf16* dst = WS_B(WS_OM) + (size_t)row * DM + DA + h * HD;
    dst[lane] = (bf16)f2bf(o0 * rstd * gw[lane]); dst[64 + lane] = (bf16)f2bf(o1 * rstd * gw[64 + lane]);
}
__device__ __forceinline__ void sb_stage_bf16(const Args& a, LAS float* Kt, LAS float* Vt, int krow0, int nvalid, int h, int tid) {
    const bf16* KB = WS_B(WS_KB); const bf16* VB = WS_B(WS_VB);
#pragma unroll
    for (int i = 0; i < 2; ++i) { const int ch = tid + i * NTHR, r = ch >> 4, d0 = (ch & 15) * 8;
        v4u kv = (v4u){0u, 0u, 0u, 0u}, vv = (v4u){0u, 0u, 0u, 0u};
        if (r < nvalid) { const size_t o = (size_t)(krow0 + r) * DA + h * HD + d0; kv = *(const v4u*)(KB + o); vv = *(const v4u*)(VB + o); }
        LAS float* kd = Kt + r * 129 + d0; LAS float* vd = Vt + r * 128 + d0;
        kd[0] = bflo(kv.x); kd[1] = bfhi(kv.x); kd[2] = bflo(kv.y); kd[3] = bfhi(kv.y); kd[4] = bflo(kv.z); kd[5] = bfhi(kv.z); kd[6] = bflo(kv.w); kd[7] = bfhi(kv.w);
        vd[0] = bflo(vv.x); vd[1] = bfhi(vv.x); vd[2] = bflo(vv.y); vd[3] = bfhi(vv.y); vd[4] = bflo(vv.z); vd[5] = bfhi(vv.z); vd[6] = bflo(vv.w); vd[7] = bfhi(vv.w); }
}
__device__ __forceinline__ void sb_unit_prompt(const Args& a, LAS unsigned char* lds, int unit) {
    const int tid = tid_opaque(), lane = tid & 63, w = tid >> 6;
    const int bh = unit >> 8, qb = unit & 255, b = bh >> 3, h = bh & 7, t = qb * 8 + w, row = b * SEQ + t;
    LAS float* Kt = (LAS float*)lds; LAS float* Vt = Kt + 64 * 129; LAS float* qs = Vt + 64 * 128;
    if (lane < 32) { const v2u qv = *(const v2u*)(WS_B(WS_QB) + (size_t)row * DA + h * HD + 4 * lane); LAS float* q = qs + w * HD + 4 * lane; q[0] = bflo(qv.x) * LN2; q[1] = bfhi(qv.x) * LN2; q[2] = bflo(qv.y) * LN2; q[3] = bfhi(qv.y) * LN2; }
    const float bias = IN_F(I_BSB)[h];
    float R = 0.f, o0 = 0.f, o1 = 0.f;
    for (int j = (qb * 8 + 6) >> 6; j >= 0; --j) {
        __syncthreads();
        sb_stage_bf16(a, Kt, Vt, b * SEQ + 64 * j, 64, h, tid);
        __syncthreads();
        int nvis = t - 64 * j; nvis = nvis < 0 ? 0 : (nvis > 64 ? 64 : nvis);
        sb_tile(Kt, Vt, qs + w * HD, bias, lane, nvis, R, o0, o1);
    }
    sb_finish(a, row, h, lane, o0, o1);
    __syncthreads();
}
__device__ __forceinline__ void sb_unit_sample(const Args& a, LAS unsigned char* lds, int unit) {
    const int tid = tid_opaque(), lane = tid & 63, w = tid >> 6;
    const int b = unit >> 3, h = unit & 7, row = MP + b * DECT + w;
    LAS float* Kt = (LAS float*)lds; LAS float* Vt = Kt + 64 * 129; LAS float* qs = Vt + 64 * 128;
    if (lane < 32) { const v2u qv = *(const v2u*)(WS_B(WS_QB) + (size_t)row * DA + h * HD + 4 * lane); LAS float* q = qs + w * HD + 4 * lane; q[0] = bflo(qv.x) * LN2; q[1] = bfhi(qv.x) * LN2; q[2] = bflo(qv.y) * LN2; q[3] = bfhi(qv.y) * LN2; }
    const float bias = IN_F(I_BSB)[h];
    float R = 0.f, o0 = 0.f, o1 = 0.f;
    __syncthreads();
    sb_stage_bf16(a, Kt, Vt, MP + b * DECT, DECT, h, tid);
    __syncthreads();
    sb_tile(Kt, Vt, qs + w * HD, bias, lane, w, R, o0, o1);
    const int* pt = (const int*)a.in[I_PT] + b * NPAGES;
    for (int j = PAST / 64 - 1; j >= 0; --j) {
        __syncthreads();
        { const int page = pt[j >> 1]; const size_t base = ((size_t)page * PAGE + (j & 1) * 64) * (NHEAD * HD) + h * HD;
          const float* ck = IN_F(I_CK) + base; const float* cv = IN_F(I_CV) + base;
#pragma unroll
          for (int i = 0; i < 4; ++i) { const int ch = tid + i * NTHR, r = ch >> 5, d0 = (ch & 31) * 4;
              const f32x4 kv = *(const f32x4*)(ck + (size_t)r * (NHEAD * HD) + d0), vv = *(const f32x4*)(cv + (size_t)r * (NHEAD * HD) + d0);
              LAS float* kd = Kt + r * 129 + d0; kd[0] = kv.x; kd[1] = kv.y; kd[2] = kv.z; kd[3] = kv.w;
              *(LAS f32x4*)(Vt + r * 128 + d0) = vv; } }
        __syncthreads();
        sb_tile(Kt, Vt, qs + w * HD, bias, lane, 64, R, o0, o1);
    }
    sb_finish(a, row, h, lane, o0, o1);
    __syncthreads();
}

typedef float f32x16 __attribute__((ext_vector_type(16)));
typedef short s16x4 __attribute__((ext_vector_type(4)));
typedef short v4i16_t __attribute__((ext_vector_type(4)));
typedef __bf16 bf16x2_t __attribute__((ext_vector_type(2)));
#define MFMA32(a, b, c) __builtin_amdgcn_mfma_f32_32x32x16_bf16((a), (b), (c), 0, 0, 0)

__device__ __forceinline__ unsigned cvtpk(float lo, float hi) { f32x2 v = {lo, hi}; bf16x2_t b = __builtin_convertvector(v, bf16x2_t); return __builtin_bit_cast(unsigned, b); }
template <int S> __device__ __forceinline__ bf16x8 pack8(const f32x16& x) {
    v4u p; p.x = cvtpk(x[8 * S + 0], x[8 * S + 1]); p.y = cvtpk(x[8 * S + 2], x[8 * S + 3]); p.z = cvtpk(x[8 * S + 4], x[8 * S + 5]); p.w = cvtpk(x[8 * S + 6], x[8 * S + 7]);
    return __builtin_bit_cast(bf16x8, p);
}
__device__ __forceinline__ unsigned off_a(unsigned row, unsigned ch) { return 2048u * (row >> 3) + 512u * (ch >> 2) + 64u * (row & 7) + 16u * ((ch & 3) ^ ((row >> 2) & 3)); }
__device__ __forceinline__ s16x4 vtr(const LAS unsigned char* p) { return __builtin_bit_cast(s16x4, __builtin_amdgcn_ds_read_tr16_b64_v4i16((LAS v4i16_t*)p)); }

struct SbLane {
    int kb0, kb1;
    int vb0, vb1;
    bf16x8 nu0, nu1;
};
__device__ __forceinline__ SbLane sb_lane_init(int lane) {
    SbLane L; const unsigned r = lane & 31, h = lane >> 5, q = (lane & 15) >> 2, p = lane & 3, blk = (lane >> 4) & 1;
    L.kb0 = (int)(2048u * (r >> 3) + 64u * (r & 7) + 16u * ((0u + h) ^ ((r >> 2) & 3)));
    L.kb1 = (int)(2048u * (r >> 3) + 64u * (r & 7) + 16u * ((2u + h) ^ ((r >> 2) & 3)));
    L.vb0 = (int)(64u * (4 * h + q) + 16u * ((2 * blk + (p >> 1)) ^ ((0u + h) & 3)) + 8u * (p & 1));
    L.vb1 = (int)(2048u + 64u * (4 * h + q) + 16u * ((2 * blk + (p >> 1)) ^ ((2u + h) & 3)) + 8u * (p & 1));
#pragma unroll
    for (int j = 0; j < 8; ++j) { const unsigned k0 = 8 * (j >> 2) + 4 * h + (j & 3), k1 = 16 + k0;
        L.nu0[j] = (k0 >= r) ? (short)0xBF80 : (short)0; L.nu1[j] = (k1 >= r) ? (short)0xBF80 : (short)0; }
    return L;
}
__device__ __forceinline__ void sbm_step(const LAS unsigned char* kt, const LAS unsigned char* vt, const LAS unsigned char* qfl  , int qstride, float bias2, const SbLane& L, f32x16 (&o)[4], float& R, int lane, int tq) {
    f32x16 zt;
#pragma unroll
    for (int r = 0; r < 16; ++r) zt[r] = bias2;
#pragma unroll
    for (int s = 0; s < 8; ++s) { const bf16x8 kf = *(const LAS bf16x8*)(kt + ((s & 1) ? L.kb1 : L.kb0) + 512 * (s >> 1)); const bf16x8 qf = *(const LAS bf16x8*)(qfl + qstride * s); zt = MFMA32(kf, qf, zt); }
    f32x16 sp, cin;
#pragma unroll
    for (int r = 0; r < 16; ++r) {
        const float e = __builtin_amdgcn_exp2f(zt[r]); float l = __builtin_amdgcn_logf(1.f + e); l = zt[r] > 30.f ? zt[r] : l;
        l = ((r & 3) + 8 * (r >> 2) < tq) ? l : 0.f;
        sp[r] = l; cin[r] = zt[r] + R;
    }
    f32x16 out = MFMA32(L.nu0, pack8<0>(sp), cin);
    out = MFMA32(L.nu1, pack8<1>(sp), out);
    const float rn = out[0] - zt[0];
    R = __shfl(rn, lane & 31);
    f32x16 p;
#pragma unroll
    for (int r = 0; r < 16; ++r) { float v = __builtin_amdgcn_exp2f(out[r]); v = ((r & 3) + 8 * (r >> 2) < tq) ? v : 0.f; p[r] = v; }
    const bf16x8 p0 = pack8<0>(p), p1 = pack8<1>(p);
#pragma unroll
    for (int c = 0; c < 4; ++c) {
        { const s16x4 lo = vtr(vt + L.vb0 + 512 * c), hi = vtr(vt + L.vb1 + 512 * c); const bf16x8 vf = __builtin_shufflevector(lo, hi, 0, 1, 2, 3, 4, 5, 6, 7); o[c] = MFMA32(vf, p0, o[c]); }
        { const s16x4 lo = vtr(vt + L.vb0 + 4096 + 512 * c), hi = vtr(vt + L.vb1 + 4096 + 512 * c); const bf16x8 vf = __builtin_shufflevector(lo, hi, 0, 1, 2, 3, 4, 5, 6, 7); o[c] = MFMA32(vf, p1, o[c]); }
    }
}
__device__ __forceinline__ void sbm_finish(const Args& a, const f32x16 (&o)[4], int row, int h, int lane) {
    float ss = 0.f;
#pragma unroll
    for (int c = 0; c < 4; ++c)
#pragma unroll
        for (int r = 0; r < 16; ++r) ss += o[c][r] * o[c][r];
    ss += __shfl_xor(ss, 32);
    const float rstd = 1.0f / sqrtf(ss * (1.f / HD) + EPS);
    const int hh = lane >> 5; const float* gw = IN_F(I_GOB) + h * HD; bf16* dst = WS_B(WS_OM) + (size_t)row * DM + DA + h * HD;
#pragma unroll
    for (int c = 0; c < 4; ++c)
#pragma unroll
        for (int g = 0; g < 4; ++g) { const int d = 32 * c + 8 * g + 4 * hh; const f32x4 gv = *(const f32x4*)(gw + d);
            v2u w; w.x = cvtpk(o[c][4 * g + 0] * rstd * gv.x, o[c][4 * g + 1] * rstd * gv.y); w.y = cvtpk(o[c][4 * g + 2] * rstd * gv.z, o[c][4 * g + 3] * rstd * gv.w);
            *(v2u*)(dst + d) = w; }
}
__device__ __forceinline__ void sbm_unit_prompt(const Args& a, LAS unsigned char* lds, int bh, int qb) {
    const int tid = tid_opaque(), lane = tid & 63, w = __builtin_amdgcn_readfirstlane(tid >> 6);
    const int b = bh >> 3, h = bh & 7, q0 = 256 * qb + 32 * w, idiag = 8 * qb + w;
    const SbLane L = sb_lane_init(lane);
    const bf16* QB = WS_B(WS_QB); const bf16* KB = WS_B(WS_KB); const bf16* VB = WS_B(WS_VB);
    LAS unsigned char* qfl = lds + 65536 + w * 8192 + lane * 16;
    { const bf16* qp = QB + (size_t)(b * SEQ + q0 + (lane & 31)) * DA + h * HD + 8 * (lane >> 5);
#pragma unroll
      for (int s = 0; s < 8; ++s) *(LAS bf16x8*)(qfl + 1024 * s) = *(const bf16x8*)(qp + 16 * s); }
    const float bias2 = IN_F(I_BSB)[h] * LOG2E;
    f32x16 o[4];
#pragma unroll
    for (int c = 0; c < 4; ++c)
#pragma unroll
        for (int r = 0; r < 16; ++r) o[c][r] = 0.f;
    float R = 0.f; const int tq = (lane & 31) - 4 * (lane >> 5);
    const int key0 = tid >> 4, ch = tid & 15;
    const size_t gsrc = (size_t)(b * SEQ + key0) * DA + h * HD + 8 * ch;
    const unsigned ldst = off_a(key0 & 31, ch);
    v4u kr[2], vr[2];
    int j = 4 * qb + 3;
#define SBM_LOAD(jj) do { const size_t o_ = gsrc + (size_t)(jj) * 64 * DA; kr[0] = *(const v4u*)(KB + o_); vr[0] = *(const v4u*)(VB + o_); kr[1] = *(const v4u*)(KB + o_ + 32 * DA); vr[1] = *(const v4u*)(VB + o_ + 32 * DA); } while (0)
#define SBM_WRITE(buf) do { LAS unsigned char* b_ = lds + (buf) * 32768; *(LAS v4u*)(b_ + ldst) = kr[0]; *(LAS v4u*)(b_ + 8192 + ldst) = kr[1]; *(LAS v4u*)(b_ + 16384 + ldst) = vr[0]; *(LAS v4u*)(b_ + 16384 + 8192 + ldst) = vr[1]; } while (0)
    SBM_LOAD(j); SBM_WRITE(0);
    __syncthreads();
    int cur = 0;
    for (; j >= 0; --j) {
        if (j > 0) SBM_LOAD(j - 1);
        const LAS unsigned char* kb_ = lds + cur * 32768; const LAS unsigned char* vb_ = kb_ + 16384;
#pragma unroll 1
        for (int tt = 1; tt >= 0; --tt) { const int ti = 2 * j + tt;
            if (ti <= idiag) sbm_step(kb_ + tt * 8192, vb_ + tt * 8192, qfl, 1024, bias2, L, o, R, lane, ti == idiag ? tq : 64); }
        if (j > 0) SBM_WRITE(cur ^ 1);
        __syncthreads();
        cur ^= 1;
    }
#undef SBM_LOAD
#undef SBM_WRITE
    sbm_finish(a, o, b * SEQ + q0 + (lane & 31), h, lane);
}


constexpr int SEGK = 256, NSEG = PAST / SEGK, PART_STRIDE = 132;
__device__ __forceinline__ void sbm_unit_sample(const Args& a, LAS unsigned char* lds, int b, int seg) {
    const int tid = tid_opaque(), lane = tid & 63, w = __builtin_amdgcn_readfirstlane(tid >> 6);
    const SbLane L = sb_lane_init(lane);
    LAS unsigned char* kimg = lds + w * 16384; LAS unsigned char* vimg = kimg + 8192;
    LAS unsigned char* qreg = lds + 131072 + w * 2048;
    LAS unsigned char* zchunk = lds + 131072 + 16384 + w * 16;
    const int r = lane & 31, hh = lane >> 5;
    if (r < 8) { const bf16* qp = WS_B(WS_QB) + (size_t)(MP + b * DECT + r) * DA + w * HD + 8 * hh;
#pragma unroll
        for (int s = 0; s < 8; ++s) *(LAS bf16x8*)(qreg + (s * 16 + hh * 8 + r) * 16) = *(const bf16x8*)(qp + 16 * s); }
    if (lane == 0) *(LAS v4u*)zchunk = (v4u){0u, 0u, 0u, 0u};
    const LAS unsigned char* qfl = r < 8 ? qreg + (hh * 8 + r) * 16 : zchunk; const int qstride = r < 8 ? 256 : 0;
    const float bias2 = IN_F(I_BSB)[w] * LOG2E;
    f32x16 o[4];
#pragma unroll
    for (int c = 0; c < 4; ++c)
#pragma unroll
        for (int q = 0; q < 16; ++q) o[c][q] = 0.f;
    float R = 0.f;
    LDS_WAIT();
    if (seg == NSEG - 1) {
        { const int j = lane >> 3, c2 = (lane & 7) * 2; const size_t src = (size_t)(MP + b * DECT + j) * DA + w * HD + 8 * c2;
          const v4u k0 = *(const v4u*)(WS_B(WS_KB) + src), k1 = *(const v4u*)(WS_B(WS_KB) + src + 8), v0 = *(const v4u*)(WS_B(WS_VB) + src), v1 = *(const v4u*)(WS_B(WS_VB) + src + 8);
          *(LAS v4u*)(kimg + off_a(j, c2)) = k0; *(LAS v4u*)(kimg + off_a(j, c2 + 1)) = k1; *(LAS v4u*)(vimg + off_a(j, c2)) = v0; *(LAS v4u*)(vimg + off_a(j, c2 + 1)) = v1; }
#pragma unroll
        for (int i = 0; i < 6; ++i) { const int n = lane + 64 * i, row = 8 + (n >> 4), c1 = n & 15; *(LAS v4u*)(kimg + off_a(row, c1)) = (v4u){0u, 0u, 0u, 0u}; *(LAS v4u*)(vimg + off_a(row, c1)) = (v4u){0u, 0u, 0u, 0u}; }
        LDS_WAIT();
        sbm_step(kimg, vimg, qfl, qstride, bias2, L, o, R, lane, r - 4 * hh);
        LDS_WAIT();
    }
    const int* pt = (const int*)a.in[I_PT] + b * NPAGES;
    const float* ck = IN_F(I_CK); const float* cv = IN_F(I_CV);
    const int ch = r >> 1; const unsigned wconst = 512u * (ch >> 2) + 64u * hh + 8u * (lane & 1);
    f32x4 kr[8], vr[8];
#define SBS_LOAD(ti, hf) do { const int p_ = seg * SEGK + 32 * (ti); const size_t base_ = ((size_t)pt[p_ >> 7] * PAGE + (p_ & 127) + 16 * (hf) + hh) * (NHEAD * HD) + w * HD + 4 * r; \
        _Pragma("unroll") for (int i_ = 0; i_ < 8; ++i_) { kr[i_] = *(const f32x4*)(ck + base_ + (size_t)(2 * i_) * (NHEAD * HD)); vr[i_] = *(const f32x4*)(cv + base_ + (size_t)(2 * i_) * (NHEAD * HD)); } } while (0)
#define SBS_WRITE(hf) do { _Pragma("unroll") for (int i_ = 0; i_ < 8; ++i_) { \
        const unsigned off_ = 2048u * (2 * (hf) + (i_ >> 2)) + 64u * (2 * (i_ & 3)) + 16u * ((unsigned)(ch & 3) ^ (unsigned)((i_ >> 1) & 3)) + wconst; \
        v2u kk_, vv_; kk_.x = cvtpk(kr[i_].x, kr[i_].y); kk_.y = cvtpk(kr[i_].z, kr[i_].w); vv_.x = cvtpk(vr[i_].x, vr[i_].y); vv_.y = cvtpk(vr[i_].z, vr[i_].w); \
        *(LAS v2u*)(kimg + off_) = kk_; *(LAS v2u*)(vimg + off_) = vv_; } } while (0)
    SBS_LOAD(SEGK / 32 - 1, 1);
#pragma unroll 1
    for (int ti = SEGK / 32 - 1; ti >= 0; --ti) {
        SBS_WRITE(1);
        SBS_LOAD(ti, 0);
        SBS_WRITE(0);
        if (ti > 0) SBS_LOAD(ti - 1, 1);
        LDS_WAIT();
        sbm_step(kimg, vimg, qfl, qstride, bias2, L, o, R, lane, 64);
        LDS_WAIT();
    }
#undef SBS_LOAD
#undef SBS_WRITE
    if (r < 8) { float* dst = WS_F(WS_PART) + ((((size_t)b * NSEG + seg) * NHEAD + w) * 8 + r) * PART_STRIDE;
#pragma unroll
        for (int c = 0; c < 4; ++c)
#pragma unroll
            for (int g = 0; g < 4; ++g) *(f32x4*)(dst + 32 * c + 8 * g + 4 * hh) = (f32x4){o[c][4 * g], o[c][4 * g + 1], o[c][4 * g + 2], o[c][4 * g + 3]};
        if (hh == 0) dst[128] = R; }
}
__device__ __forceinline__ void phase_sbcombine(const Args& a, int bid, int nblk) {
    const int tid = tid_opaque(), lane = tid & 63, w = tid >> 6;
    static_assert(NSEG == 64, "one lane per segment");
    for (int item = bid * NWAVES + w; item < DECB * NHEAD * 8; item += nblk * NWAVES) {
        const int b = item >> 6, h = (item >> 3) & 7, i = item & 7;
        const float* p0 = WS_F(WS_PART) + (((size_t)b * NSEG * NHEAD + h) * 8 + i) * PART_STRIDE;
        const size_t sstride = (size_t)NHEAD * 8 * PART_STRIDE;
        const float rseg = p0[(size_t)lane * sstride + 128];
        float suf = rseg;
#pragma unroll
        for (int off = 1; off < 64; off <<= 1) { const float t = __shfl_down(suf, off); if (lane + off < 64) suf += t; }
        const float fac = __builtin_amdgcn_exp2f(suf - rseg);
        float o0 = 0.f, o1 = 0.f;
#pragma unroll 8
        for (int s = 0; s < NSEG; ++s) { const float f = __builtin_bit_cast(float, __builtin_amdgcn_readlane(__builtin_bit_cast(int, fac), s));
            o0 += f * p0[(size_t)s * sstride + lane]; o1 += f * p0[(size_t)s * sstride + 64 + lane]; }
        const float ss = wave_sum(o0 * o0 + o1 * o1);
        const float rstd = 1.0f / sqrtf(ss * (1.f / HD) + EPS);
        const float* gw = IN_F(I_GOB) + h * HD; bf16* dst = WS_B(WS_OM) + (size_t)(MP + b * DECT + i) * DM + DA + h * HD;
        dst[lane] = (bf16)f2bf(o0 * rstd * gw[lane]); dst[64 + lane] = (bf16)f2bf(o1 * rstd * gw[64 + lane]);
    }
}

constexpr int CTL_MIXQ = 4096;
__device__ __forceinline__ int queue_next(const Args& a, LAS unsigned char* lds, int tid) {
    LAS int* slot = (LAS int*)(lds + LDS_BYTES - 64);
    __syncthreads();
    if (tid == 0) *slot = (int)__hip_atomic_fetch_add((unsigned*)(a.ws + WS_CTL) + CTL_MIXQ, 1u, __ATOMIC_RELAXED, __HIP_MEMORY_SCOPE_AGENT);
    __syncthreads();
    return *slot;
}
__device__ __forceinline__ void phase_mixer(const Args& a, LAS unsigned char* lds, int bid, int nblk) {
    const int tid = tid_opaque();
    { GAS v4u* o = (GAS v4u*)(WS_B(WS_OM) + (size_t)MREAL * DM);
      for (int i = bid * NTHR + tid; i < (MPAD - MREAL) * DM / 8; i += nblk * NTHR) o[i] = (v4u){0u, 0u, 0u, 0u}; }
    constexpr int U0 = 32, U1 = U0 + 256, U2 = U1 + DECB * NSEG, U3 = U2 + 64;
    for (;;) {
        const int u = queue_next(a, lds, tid);
        if (u >= U3) break;
        if (u < U0) hgrn_unit(a, lds, u);
        else if (u < U1) { const int v = u - U0; sbm_unit_prompt(a, lds, v & 31, 7 - (v >> 5)); }
        else if (u < U2) { const int v = u - U1; sbm_unit_sample(a, lds, v & 7, NSEG - 1 - (v >> 3)); }
        else hgrn_unit(a, lds, 32 + (u - U2));
    }
}

enum { PH_MOD = 0, PH_CVT, PH_NORM1, PH_G1, PH_G2, PH_NORM2, PH_G3, PH_MIX, PH_G4, PH_NORM3, PH_G5, PH_G6, PH_FINAL, N_PHASES };

template <int PH> __device__ __forceinline__ void run_phase(const Args& a, LAS unsigned char* lds, int bid, int nblk) {
    if constexpr (PH == PH_MOD) phase_mod(a, lds, bid, nblk);
    else if constexpr (PH == PH_CVT) phase_cvt(a, lds, bid, nblk, 0, 2);
    else if constexpr (PH == PH_NORM1) phase_norm<false>(a, bid, nblk, true, IN_F(I_N1), WS_F(WS_MOD), NMODC, 0 * DM, 1 * DM);
    else if constexpr (PH == PH_G1) phase_gemm<1>(a, lds, bid, nblk);
    else if constexpr (PH == PH_G2) phase_gemm<2>(a, lds, bid, nblk);
    else if constexpr (PH == PH_NORM2) phase_norm<false>(a, bid, nblk, false, IN_F(I_NM), WS_F(WS_MOD), NMODC, 3 * DM, 4 * DM);
    else if constexpr (PH == PH_G3) phase_gemm<3>(a, lds, bid, nblk);
    else if constexpr (PH == PH_MIX) phase_mixer(a, lds, bid, nblk);
    else if constexpr (PH == PH_G4) phase_gemm<4>(a, lds, bid, nblk);
    else if constexpr (PH == PH_NORM3) phase_norm<false>(a, bid, nblk, false, IN_F(I_N2), WS_F(WS_MOD), NMODC, 6 * DM, 7 * DM);
    else if constexpr (PH == PH_G5) phase_gemm<5>(a, lds, bid, nblk);
    else if constexpr (PH == PH_G6) phase_gemm<6>(a, lds, bid, nblk);
    else phase_norm<true>(a, bid, nblk, false, IN_F(I_NF), WS_F(WS_FMOD), NFMODC, 0, DM);
}

#define XB_TMO      128
#define XB_XCNT(j)  (256  + 64 * (j))
#define XB_XSUB(j)  (1280 + 64 * (j))
#define XB_XGEN(j)  (2304 + 64 * (j))
#define XB_TOP      3328
#define XB_TOPGEN   3392
#define XCD_BAR_WORDS 3456
#define XB_SPIN_CAP (1u << 18)

__device__ __forceinline__ unsigned xb_ld(unsigned* p)              { return __hip_atomic_load(p, __ATOMIC_RELAXED, __HIP_MEMORY_SCOPE_AGENT); }
__device__ __forceinline__ unsigned xb_add(unsigned* p, unsigned v) { return __hip_atomic_fetch_add(p, v, __ATOMIC_RELAXED, __HIP_MEMORY_SCOPE_AGENT); }
__device__ __forceinline__ unsigned xb_xcc_id() { return (unsigned)__builtin_amdgcn_s_getreg((3 << 11) | 20) & 0xFu; }
#define XB_SPIN(cond, bar) do { unsigned _sp = 0; while (cond) { __builtin_amdgcn_s_sleep(1); \
    if ((++_sp & 255u) == 0u) { if (xb_ld(&(bar)[XB_TMO])) break; if (_sp > XB_SPIN_CAP) { atomicAdd(&(bar)[XB_TMO], 1u); break; } } } } while (0)

struct XcdBarrier {
    unsigned* bar; unsigned x;
    volatile LAS unsigned* st;
};

__device__ __forceinline__ XcdBarrier xcd_barrier_post(unsigned* bar, volatile LAS unsigned* st) {
    XcdBarrier b; b.bar = bar; b.x = xb_xcc_id(); b.st = st;
    if (threadIdx.x == 0) (void)xb_add(&bar[XB_XCNT(b.x)], 1u);
    return b;
}
__device__ __forceinline__ void xcd_barrier_complete(unsigned* bar, unsigned x, unsigned& nloc, unsigned& nx) {
    const unsigned G = gridDim.x * gridDim.y * gridDim.z;
    unsigned sum, cnt, mine, sp = 0u;
    for (;;) {
        sum = 0u; cnt = 0u; mine = 0u;
#pragma unroll
        for (unsigned j = 0; j < 16; ++j) { const unsigned c = xb_ld(&bar[XB_XCNT(j)]); sum += c; cnt += (c > 0u) ? 1u : 0u; mine = (j == x) ? c : mine; }
        if (sum == G) break;
        __builtin_amdgcn_s_sleep(1);
        if ((++sp & 255u) == 0u) { if (xb_ld(&bar[XB_TMO])) break; if (sp > XB_SPIN_CAP) { atomicAdd(&bar[XB_TMO], 1u); break; } }
    }
    nloc = mine > 0u ? mine : 1u; nx = cnt > 0u ? cnt : 1u;
}

__device__ __forceinline__ void xcd_barrier(const XcdBarrier& b) {
    asm volatile("s_waitcnt vmcnt(0)" ::: "memory");
    __syncthreads();
    if (threadIdx.x == 0) {
        unsigned* bar = b.bar;
        __builtin_amdgcn_s_waitcnt(0);
        unsigned nloc = b.st[0], nx = b.st[1];
        if (nloc == 0u) { xcd_barrier_complete(bar, b.x, nloc, nx); b.st[0] = nloc; b.st[1] = nx; }
        const unsigned old = xb_add(&bar[XB_XSUB(b.x)], 1u);
        const unsigned gen = old / nloc;
        if (old + 1u == (gen + 1u) * nloc) {
            __builtin_amdgcn_fence(__ATOMIC_RELEASE, "agent");
            asm volatile("s_waitcnt vmcnt(0)" ::: "memory");
            const unsigned og = xb_add(&bar[XB_TOP], 1u);
            const unsigned tg = og / nx;
            if (og + 1u == (tg + 1u) * nx) xb_add(&bar[XB_TOPGEN], 1u);
            else XB_SPIN(xb_ld(&bar[XB_TOPGEN]) == tg, bar);
            __builtin_amdgcn_fence(__ATOMIC_ACQUIRE, "agent");
            xb_add(&bar[XB_XGEN(b.x)], 1u);
            asm volatile("s_waitcnt vmcnt(0)" ::: "memory");
        } else {
            XB_SPIN(xb_ld(&bar[XB_XGEN(b.x)]) == gen, bar);
            __builtin_amdgcn_fence(__ATOMIC_ACQUIRE, "agent");
            asm volatile("s_waitcnt vmcnt(0)" ::: "memory");
        }
    }
    __syncthreads();
}


constexpr int LDS_BAR_OFF = LDS_BYTES;
constexpr int LDS_TOTAL = LDS_BYTES + 64;

__global__ void __launch_bounds__(NTHR, 2) mega_fwd(Args a) {
    extern __shared__ __attribute__((aligned(16))) unsigned char lds_raw[];
    LAS unsigned char* lds = (LAS unsigned char*)lds_raw;
    const int bid = (int)blockIdx.x, nblk = (int)gridDim.x;
    if (threadIdx.x < 16) ((LAS unsigned*)(lds + LDS_BAR_OFF))[threadIdx.x] = 0u;
    __syncthreads();
    XcdBarrier bar = xcd_barrier_post((unsigned*)(a.ws + WS_CTL), (volatile LAS unsigned*)(lds + LDS_BAR_OFF));
    run_phase<PH_MOD>(a, lds, bid, nblk);
    __syncthreads();
    run_phase<PH_CVT>(a, lds, bid, nblk);
    xcd_barrier(bar);
    run_phase<PH_NORM1>(a, lds, bid, nblk);
    xcd_barrier(bar);
    run_phase<PH_G1>(a, lds, bid, nblk);
    xcd_barrier(bar);
    run_phase<PH_G2>(a, lds, bid, nblk);
    xcd_barrier(bar);
    run_phase<PH_NORM2>(a, lds, bid, nblk);
    xcd_barrier(bar);
    run_phase<PH_G3>(a, lds, bid, nblk);
    xcd_barrier(bar);
    run_phase<PH_MIX>(a, lds, bid, nblk);
    xcd_barrier(bar);
    phase_sbcombine(a, bid, nblk);
    xcd_barrier(bar);
    run_phase<PH_G4>(a, lds, bid, nblk);
    xcd_barrier(bar);
    run_phase<PH_NORM3>(a, lds, bid, nblk);
    xcd_barrier(bar);
    run_phase<PH_G5>(a, lds, bid, nblk);
    xcd_barrier(bar);
    run_phase<PH_G6>(a, lds, bid, nblk);
    xcd_barrier(bar);
    run_phase<PH_FINAL>(a, lds, bid, nblk);
}

extern "C" void kernel_launch(void* const* d_in, const int* in_sizes, int n_in, void* d_out, int out_size, void* d_ws, size_t ws_size, hipStream_t stream) {
    static int grid = 0;
    if (grid == 0) {
        if (n_in != N_IN || (size_t)out_size != OUT_TOTAL || ws_size < WS_END) { fprintf(stderr, "kernel_launch: unexpected shapes (n_in %d, out %d, ws %zu)\n", n_in, out_size, ws_size); grid = -1; return; }
        int dev = 0, cus = 0, per_cu = 0;
        if (hipGetDevice(&dev) != hipSuccess || hipDeviceGetAttribute(&cus, hipDeviceAttributeMultiprocessorCount, dev) != hipSuccess) { grid = -1; return; }
        if (hipFuncSetAttribute((const void*)mega_fwd, hipFuncAttributeMaxDynamicSharedMemorySize, LDS_TOTAL) != hipSuccess) { fprintf(stderr, "kernel_launch: hipFuncSetAttribute failed\n"); grid = -1; return; }
        if (hipOccupancyMaxActiveBlocksPerMultiprocessor(&per_cu, (const void*)mega_fwd, NTHR, LDS_TOTAL) != hipSuccess || per_cu < 1) { fprintf(stderr, "kernel_launch: occupancy query says %d blocks per CU\n", per_cu); grid = -1; (void)hipGetLastError(); return; }
        grid = cus;
    }
    if (grid < 0) return;
    (void)hipMemsetAsync((char*)d_ws + WS_CTL, 0, 65536, stream);
    Args a{};
    for (int i = 0; i < N_IN; ++i) a.in[i] = d_in[i];
    a.out = (float*)d_out; a.ws = (unsigned char*)d_ws;
    hipLaunchKernelGGL(mega_fwd, dim3(grid), dim3(NTHR), LDS_TOTAL, stream, a);
}
```

```cpp
#include <hip/hip_runtime.h>
#include <cstdio>
#include <cstdint>

constexpr int DM = 2048, SEQ = 2048, NB = 4, MP = NB * SEQ  , DECB = 8, DECT = 8, MS = DECB * DECT  ;
constexpr int MREAL = MP + MS  , MPAD = 8448  ;
constexpr int DFF = 5632, DIN = 7168, NMODC = 9 * DM  , NFMODC = 2 * DM;
constexpr int DA = 1024, NHEAD = 8, HD = 128, PAST = 16384, PAGE = 128, NPAGES = PAST / PAGE  ;
constexpr float EPS = 1e-6f, QSCALE = 0.08838834764831845f  ;
constexpr float LOG2E = 1.4426950408889634f, LN2 = 0.6931471805599453f;
constexpr size_t OFF_YP = 0, OFF_YS = OFF_YP + (size_t)MP * DM, OFF_KP = OFF_YS + (size_t)MS * DM, OFF_VP = OFF_KP + (size_t)MP * DA,
                 OFF_KS = OFF_VP + (size_t)MP * DA, OFF_VS = OFF_KS + (size_t)MS * DA, OFF_SP = OFF_VS + (size_t)MS * DA,
                 OFF_SS = OFF_SP + (size_t)NB * NHEAD * HD * HD, OUT_TOTAL = OFF_SS + (size_t)DECB * NHEAD * HD * HD;
enum { I_XP = 0, I_XS, I_CK, I_CV, I_ST, I_PT, I_CP, I_CS, I_LB, I_N1, I_NM, I_N2, I_WMOD, I_BMOD, I_WG1, I_WU1, I_WD1, I_WIN, I_GOA, I_GOB, I_BSB, I_WOUT,
       I_WG2, I_WU2, I_WD2, I_NF, I_WFM, I_BFM, N_IN };
constexpr size_t MiB = 1u << 20;
constexpr size_t WS_CTL = 0, CTL_BYTES = 1 * MiB;
constexpr size_t WS_MOD = 1 * MiB;
constexpr size_t WS_FMOD = 2 * MiB;
constexpr size_t WS_LBV = 3 * MiB;
constexpr size_t WS_WGU1 = 4 * MiB, WS_WD1 = 48 * MiB, WS_WIN = 70 * MiB, WS_WOUT = 98 * MiB, WS_WGU2 = 106 * MiB, WS_WD2 = 150 * MiB;
constexpr size_t WS_XN = 172 * MiB;
constexpr size_t WS_H = 206 * MiB;
constexpr size_t WS_X = 298 * MiB;
constexpr size_t WS_QA = 364 * MiB, WS_IA = 381 * MiB, WS_GA = 398 * MiB, WS_QB = 415 * MiB, WS_KB = 432 * MiB, WS_VB = 449 * MiB;
constexpr size_t WS_LF = 466 * MiB;
constexpr size_t WS_OM = 500 * MiB;
constexpr size_t WS_PART = 534 * MiB;
constexpr size_t WS_END = 560 * MiB;

#define GAS __attribute__((address_space(1)))
#define LAS __attribute__((address_space(3)))
typedef unsigned short bf16;
typedef unsigned v4u __attribute__((ext_vector_type(4)));
typedef unsigned v2u __attribute__((ext_vector_type(2)));
typedef float f32x4 __attribute__((ext_vector_type(4)));
typedef float f32x2 __attribute__((ext_vector_type(2)));
typedef short bf16x8 __attribute__((ext_vector_type(8)));

struct Args { const void* in[N_IN]; float* out; unsigned char* ws; };

__device__ __forceinline__ unsigned f2bf(float f) { unsigned u = __builtin_bit_cast(unsigned, f); return (u + 0x7fffu + ((u >> 16) & 1u)) >> 16; }
__device__ __forceinline__ unsigned pk2(float lo, float hi) { return f2bf(lo) | (f2bf(hi) << 16); }
__device__ __forceinline__ float bf2f(unsigned short b) { return __builtin_bit_cast(float, (unsigned)b << 16); }
__device__ __forceinline__ float bflo(unsigned w) { return __builtin_bit_cast(float, w << 16); }
__device__ __forceinline__ float bfhi(unsigned w) { return __builtin_bit_cast(float, w & 0xffff0000u); }
__device__ __forceinline__ float sigmoid_f(float x) { return __builtin_amdgcn_rcpf(1.f + __expf(-x)); }
__device__ __forceinline__ float silu_f(float x) { return x * sigmoid_f(x); }
__device__ __forceinline__ int mod_row(int r) { const int s = 4 + ((r - MP) >> 3); return r < MP ? (r >> 11) : (s > 11 ? 11 : s); }
__device__ __forceinline__ float wave_sum(float v) {
#pragma unroll
    for (int o = 1; o < 64; o <<= 1) v += __shfl_xor(v, o);
    return v;
}
__device__ __forceinline__ int tid_opaque() { int t = (int)threadIdx.x; asm volatile("" : "+v"(t)); return t; }
#define LDS_WAIT() asm volatile("s_waitcnt lgkmcnt(0)" ::: "memory")
#define VM_WAIT() asm volatile("s_waitcnt vmcnt(0)" ::: "memory")

namespace pg8 {
#define PG8_LAS __attribute__((address_space(3)))
typedef unsigned short bf16_t;
typedef short bf16x8 __attribute__((ext_vector_type(8)));
typedef float f32x4 __attribute__((ext_vector_type(4)));
typedef unsigned u32x4 __attribute__((ext_vector_type(4)));
constexpr int BM = 256, BK = 64, HALF = 128, HTB = HALF * BK * 2  , STAGE_BYTES = 8 * HTB, NXCD = 8, WGM = 8;

__host__ __device__ __forceinline__ int lds_byte(int r, int c) { const int st = (r >> 4) * 2 + (c >> 5), rr = r & 15, cc = c & 31, ob = rr * 64 + cc * 2; return st * 1024 + (ob ^ (((ob >> 9) & 1) << 5)); }
__host__ __device__ __forceinline__ void stage_rc(int b, int& R, int& C) { const int st = b / 1024, sb = b % 1024, swz = sb ^ (((sb >> 9) & 1) << 5); R = (st >> 1) * 16 + swz / 64; C = (st & 1) * 32 + (swz % 64) / 2; }
__host__ __device__ __forceinline__ int perm32(int rho) { const int n = rho >> 4, i = rho & 15; return 8 * (i >> 2) + 4 * n + (i & 3); }

struct Unit { int pm, pn; };
struct Gemm { const bf16_t* A; const bf16_t* Bt; int M, N, K; };

struct StaticOrder {
    int nM, nN, nwg, G, c;
    __host__ __device__ void init(int M, int N, int G_, int c_) { nM = M / BM; nN = N / BM; nwg = nM * nN; G = G_; c = c_; }
    __host__ __device__ bool next(int i, Unit& u) const {
        const long L = (long)i * G + c; if (L >= nwg) return false;
        int wgid = (int)L; { const int q = nwg / NXCD, r = nwg % NXCD, xcd = wgid % NXCD, off = wgid / NXCD; wgid = (xcd < r ? xcd * (q + 1) : r * (q + 1) + (xcd - r) * q) + off; }
        const int nig = WGM * nN, gid = wgid / nig, fm = gid * WGM, gsz = (nM - fm) < WGM ? (nM - fm) : WGM;
        u.pm = fm + ((wgid % nig) % gsz); u.pn = (wgid % nig) / gsz; return true;
    }
    __device__ __forceinline__ void a_ready(const Unit&) const {}
    __device__ __forceinline__ void done(const Unit&) const {}
};


__device__ __forceinline__ unsigned cvt_pk_bf16(float lo, float hi) { unsigned r; asm volatile("v_cvt_pk_bf16_f32 %0, %1, %2" : "=v"(r) : "v"(lo), "v"(hi)); return r; }

struct EpiSwiGLU {
    static constexpr bool PERM = true, AFTER_DRAIN = false;
    bf16_t* H; int ldh;
    __device__ __forceinline__ void operator()(const f32x4 (&acc)[2][2][4][2], const Unit& u, int wr, int wc, int fr, int fq) const {
        const int row0 = u.pm * BM + wr * 64 + fr, col0 = u.pn * HALF + wc * 32 + 8 * fq;
#pragma unroll
        for (int ai = 0; ai < 2; ++ai)
#pragma unroll
            for (int m = 0; m < 4; ++m) {
                const f32x4 g0 = acc[ai][0][m][0], g1 = acc[ai][0][m][1], u0 = acc[ai][1][m][0], u1 = acc[ai][1][m][1];
                float v[8];
#pragma unroll
                for (int j = 0; j < 4; ++j) { v[j] = silu_f(g0[j]) * u0[j]; v[4 + j] = silu_f(g1[j]) * u1[j]; }
                u32x4 w; w.x = cvt_pk_bf16(v[0], v[1]); w.y = cvt_pk_bf16(v[2], v[3]); w.z = cvt_pk_bf16(v[4], v[5]); w.w = cvt_pk_bf16(v[6], v[7]);
                *(u32x4*)(H + (size_t)(row0 + ai * HALF + m * 16) * ldh + col0) = w;
            }
    }
};
struct EpiResid {
    static constexpr bool PERM = false, AFTER_DRAIN = false;
    const float* xp; const float* xs; float* X; const float* gate; float scale;
    __device__ __forceinline__ void operator()(const f32x4 (&acc)[2][2][4][2], const Unit& u, int wr, int wc, int fr, int fq) const {
        const int col0 = u.pn * BM + wc * 32 + 4 * fq;
#pragma unroll
        for (int ai = 0; ai < 2; ++ai)
#pragma unroll
            for (int m = 0; m < 4; ++m) {
                const int row = u.pm * BM + ai * HALF + wr * 64 + m * 16 + fr;
                if (row < MREAL) {
                    const float* base = xp ? (row < MP ? xp + (size_t)row * DM : xs + (size_t)(row - MP) * DM) : X + (size_t)row * DM;
                    const float* gr = gate + (size_t)mod_row(row) * NMODC;
#pragma unroll
                    for (int bj = 0; bj < 2; ++bj)
#pragma unroll
                        for (int n = 0; n < 2; ++n) { const int c = col0 + bj * HALF + n * 16;
                            const f32x4 gv = *(const f32x4*)(gr + c), bv = *(const f32x4*)(base + c);
                            *(f32x4*)(X + (size_t)row * DM + c) = bv + (gv * scale) * acc[ai][bj][m][n]; }
                }
            }
    }
};
struct EpiProj {
    static constexpr bool PERM = true, AFTER_DRAIN = false;
    unsigned char* ws; float* LF; float* out; const float* lbv;
    template <int MODE> __device__ __forceinline__ void run(const f32x4 (&acc)[2][2][4][2], const Unit& u, int wr, int wc, int fr, int fq, bf16_t* B, float s, size_t offp, size_t offs) const {
        const int cb = (u.pn & 3) * BM + wc * 32 + 8 * fq;
#pragma unroll
        for (int ai = 0; ai < 2; ++ai)
#pragma unroll
            for (int m = 0; m < 4; ++m) {
                const int row = u.pm * BM + ai * HALF + wr * 64 + m * 16 + fr;
#pragma unroll
                for (int bj = 0; bj < 2; ++bj) {
                    const int c = cb + bj * HALF; const size_t o = (size_t)row * DA + c;
                    f32x4 v0 = acc[ai][bj][m][0], v1 = acc[ai][bj][m][1];
                    if constexpr (MODE == 1) {
                        const f32x4 l0 = *(const f32x4*)(lbv + c), l1 = *(const f32x4*)(lbv + c + 4);
#pragma unroll
                        for (int j = 0; j < 4; ++j) { v0[j] = __builtin_amdgcn_logf(l0[j] + (1.f - l0[j]) * sigmoid_f(v0[j])); v1[j] = __builtin_amdgcn_logf(l1[j] + (1.f - l1[j]) * sigmoid_f(v1[j])); }
                        *(f32x4*)(LF + o) = v0; *(f32x4*)(LF + o + 4) = v1;
                    } else {
                        if constexpr (MODE == 3) {
                            if (row < MREAL) { float* dst = row < MP ? out + offp + o : out + offs + (o - (size_t)MP * DA); *(f32x4*)dst = v0; *(f32x4*)(dst + 4) = v1; }
                        }
                        if constexpr (MODE == 0) { v0 = v0 * s; v1 = v1 * s; }
                        if constexpr (MODE == 2) {
#pragma unroll
                            for (int j = 0; j < 4; ++j) { v0[j] = silu_f(v0[j]); v1[j] = silu_f(v1[j]); }
                        }
                        u32x4 w; w.x = cvt_pk_bf16(v0[0], v0[1]); w.y = cvt_pk_bf16(v0[2], v0[3]); w.z = cvt_pk_bf16(v1[0], v1[1]); w.w = cvt_pk_bf16(v1[2], v1[3]);
                        *(u32x4*)(B + o) = w;
                    }
                }
            }
    }
    __device__ __forceinline__ void operator()(const f32x4 (&acc)[2][2][4][2], const Unit& u, int wr, int wc, int fr, int fq) const {
        const int rng = u.pn >> 2;
        bf16_t* B = (bf16_t*)(ws + WS_QA + (size_t)(rng == 0 ? 0 : rng - 1) * (WS_IA - WS_QA));
        if (rng == 1) run<1>(acc, u, wr, wc, fr, fq, nullptr, 1.f, 0, 0);
        else if (rng == 3) run<2>(acc, u, wr, wc, fr, fq, B, 1.f, 0, 0);
        else if (rng >= 5) run<3>(acc, u, wr, wc, fr, fq, B, 1.f, rng == 5 ? OFF_KP : OFF_VP, rng == 5 ? OFF_KS : OFF_VS);
        else run<0>(acc, u, wr, wc, fr, fq, B, rng == 2 ? 1.f : (rng == 4 ? QSCALE * LOG2E : QSCALE), 0, 0);
    }
};
template <class Epi, class Sched, bool ALIGN_EPI = false, bool SP2 = false>
__device__ __forceinline__ void gemm_phase(PG8_LAS unsigned char* lds, const Gemm g, const Sched& S, const Epi& E) {
    const int tid = tid_opaque(), wid = __builtin_amdgcn_readfirstlane(tid >> 6), lane = tid & 63, wr = wid >> 2, wc = wid & 3, fr = lane & 15, fq = lane >> 4;
    const int K = g.K, nt = K / BK;
    unsigned voffA[2], voffB[2];
#pragma unroll
    for (int i = 0; i < 2; ++i) { int R, C; stage_rc(tid * 16 + i * 8192, R, C); const int Rb = Epi::PERM ? ((R & ~31) + perm32(R & 31)) : R;
        voffA[i] = (unsigned)(R * K + C) * 2u; voffB[i] = (unsigned)(Rb * K + C) * 2u; }
    const size_t kstep = (size_t)(BK * 2);
    const size_t hstep = (size_t)HALF * K * 2;
    const size_t tstep = 2 * hstep;
    const unsigned ldsw = (unsigned)wid * 1024u;
    const int aoff = lds_byte(wr * 64 + fr, fq * 8), boff = lds_byte(wc * 32 + fr, fq * 8);
#define PG8_SA(b, h) (((b) * 2 + (h)) * HTB)
#define PG8_SB(b, h) ((4 + (b) * 2 + (h)) * HTB)
#define PG8_STAGE(bufoff, gbase, voff) do { _Pragma("unroll") for (int _i = 0; _i < 2; ++_i) \
        __builtin_amdgcn_global_load_lds((const unsigned*)((const char*)(gbase) + (voff)[_i]), (PG8_LAS unsigned*)(lds + (bufoff) + ldsw + _i * 8192), 16, 0, 0); } while (0)
#define PG8_LDA(dst, b, h) do { _Pragma("unroll") for (int m = 0; m < 4; ++m) _Pragma("unroll") for (int k = 0; k < 2; ++k) dst[m][k] = *(const PG8_LAS bf16x8*)(lds + PG8_SA(b, h) + aoff + m * 2048 + k * 1024); } while (0)
#define PG8_LDB(dst, b, h) do { _Pragma("unroll") for (int n = 0; n < 2; ++n) _Pragma("unroll") for (int k = 0; k < 2; ++k) dst[n][k] = *(const PG8_LAS bf16x8*)(lds + PG8_SB(b, h) + boff + n * 2048 + k * 1024); } while (0)
#define PG8_MMA(ai, bj, At, Bt) do { __builtin_amdgcn_s_setprio(1); _Pragma("unroll") for (int m = 0; m < 4; ++m) _Pragma("unroll") for (int n = 0; n < 2; ++n) _Pragma("unroll") for (int k = 0; k < 2; ++k) \
        acc[ai][bj][m][n] = __builtin_amdgcn_mfma_f32_16x16x32_bf16(Bt[n][k], At[m][k], acc[ai][bj][m][n], 0, 0, 0); __builtin_amdgcn_s_setprio(0); } while (0)
#define PG8_WAIT_V(n) asm volatile("s_waitcnt vmcnt(" #n ")" ::: "memory")
#define PG8_WAIT_L(n) asm volatile("s_waitcnt lgkmcnt(" #n ")" ::: "memory")
#define PG8_BAR __builtin_amdgcn_s_barrier()
#define PG8_SCHED __builtin_amdgcn_sched_barrier(0)
    Unit cur, nxt; int ui = 0;
    if (!S.next(0, cur)) return;
    f32x4 acc[2][2][4][2];
#pragma unroll
    for (int a = 0; a < 2; ++a)
#pragma unroll
        for (int b = 0; b < 2; ++b)
#pragma unroll
            for (int m = 0; m < 4; ++m)
#pragma unroll
                for (int n = 0; n < 2; ++n) acc[a][b][m][n] = (f32x4){0.f, 0.f, 0.f, 0.f};
    bf16x8 At[4][2], B0[2][2], B1[2][2];
    const char* cA = (const char*)g.A + (size_t)cur.pm * tstep; const char* cB = (const char*)g.Bt + (size_t)cur.pn * tstep;
    S.a_ready(cur);
    if constexpr (SP2) {
        PG8_STAGE(PG8_SB(0, 0), cB, voffB); PG8_STAGE(PG8_SB(0, 1), cB + hstep, voffB); PG8_STAGE(PG8_SA(0, 0), cA, voffA); PG8_STAGE(PG8_SA(0, 1), cA + hstep, voffA);
        if (wr == 1) PG8_BAR;
        PG8_WAIT_V(2); PG8_BAR;
        PG8_STAGE(PG8_SB(1, 0), cB + kstep, voffB); PG8_STAGE(PG8_SA(1, 0), cA + kstep, voffA); PG8_STAGE(PG8_SB(1, 1), cB + hstep + kstep, voffB);
        PG8_WAIT_V(6); PG8_BAR;
    } else {
        PG8_STAGE(PG8_SB(0, 0), cB, voffB); PG8_STAGE(PG8_SA(0, 0), cA, voffA); PG8_STAGE(PG8_SB(0, 1), cB + hstep, voffB); PG8_STAGE(PG8_SA(0, 1), cA + hstep, voffA);
        if (wr == 1) PG8_BAR;
        PG8_WAIT_V(4); PG8_BAR;
        PG8_STAGE(PG8_SB(1, 0), cB + kstep, voffB); PG8_STAGE(PG8_SA(1, 0), cA + kstep, voffA); PG8_STAGE(PG8_SB(1, 1), cB + hstep + kstep, voffB);
        PG8_WAIT_V(6); PG8_BAR;
    }
    for (;;) {
        const bool has_next = S.next(ui + 1, nxt);
        const char* nA = has_next ? (const char*)g.A + (size_t)nxt.pm * tstep : cA; const char* nB = has_next ? (const char*)g.Bt + (size_t)nxt.pn * tstep : cB;
        for (int t = 0; t < nt; t += 2) {
            const bool last = (t == nt - 2);
            const char* a1 = cA + (size_t)(t + 1) * kstep;
            const char* a2 = last ? nA : cA + (size_t)(t + 2) * kstep; const char* b2 = last ? nB : cB + (size_t)(t + 2) * kstep;
            const char* a3 = a2 + kstep; const char* b3 = b2 + kstep;
            if (last && has_next) S.a_ready(nxt);
            if constexpr (SP2) {
            PG8_LDB(B0, 0, 0); PG8_LDB(B1, 0, 1); PG8_SCHED; PG8_LDA(At, 0, 0); PG8_STAGE(PG8_SA(1, 1), a1 + hstep, voffA);
            PG8_WAIT_V(8); PG8_WAIT_L(0); PG8_BAR; PG8_MMA(0, 0, At, B0); PG8_MMA(0, 1, At, B1); PG8_BAR; PG8_SCHED;
            PG8_LDA(At, 0, 1); PG8_STAGE(PG8_SB(0, 0), b2, voffB); PG8_STAGE(PG8_SB(0, 1), b2 + hstep, voffB); PG8_STAGE(PG8_SA(0, 0), a2, voffA);
            PG8_WAIT_V(8); PG8_WAIT_L(0); PG8_BAR; PG8_MMA(1, 0, At, B0); PG8_MMA(1, 1, At, B1); PG8_BAR; PG8_SCHED;
            PG8_LDB(B0, 1, 0); PG8_LDB(B1, 1, 1); PG8_SCHED; PG8_LDA(At, 1, 0); PG8_STAGE(PG8_SA(0, 1), a2 + hstep, voffA);
            PG8_WAIT_V(8); PG8_WAIT_L(0); PG8_BAR; PG8_MMA(0, 0, At, B0); PG8_MMA(0, 1, At, B1); PG8_BAR; PG8_SCHED;
            PG8_LDA(At, 1, 1); PG8_STAGE(PG8_SB(1, 0), b3, voffB); PG8_STAGE(PG8_SB(1, 1), b3 + hstep, voffB); PG8_STAGE(PG8_SA(1, 0), a3, voffA);
            PG8_WAIT_V(8); PG8_WAIT_L(0); PG8_BAR; PG8_MMA(1, 0, At, B0); PG8_MMA(1, 1, At, B1); PG8_BAR; PG8_SCHED;
            } else {
            PG8_LDB(B0, 0, 0); PG8_SCHED; PG8_LDA(At, 0, 0); PG8_STAGE(PG8_SA(1, 1), a1 + hstep, voffA);
            PG8_WAIT_L(8); PG8_BAR; PG8_WAIT_L(0); PG8_MMA(0, 0, At, B0); PG8_BAR; PG8_SCHED;
            PG8_LDB(B1, 0, 1); PG8_STAGE(PG8_SB(0, 0), b2, voffB);
            PG8_BAR; PG8_WAIT_L(0); PG8_MMA(0, 1, At, B1); PG8_BAR;
            PG8_LDA(At, 0, 1); PG8_STAGE(PG8_SA(0, 0), a2, voffA);
            PG8_BAR; PG8_WAIT_L(0); PG8_MMA(1, 0, At, B0); PG8_BAR; PG8_SCHED;
            PG8_STAGE(PG8_SB(0, 1), b2 + hstep, voffB);
            PG8_WAIT_V(6); PG8_BAR; PG8_MMA(1, 1, At, B1); PG8_BAR;
            PG8_LDB(B0, 1, 0); PG8_SCHED; PG8_LDA(At, 1, 0); PG8_STAGE(PG8_SA(0, 1), a2 + hstep, voffA);
            PG8_WAIT_L(8); PG8_BAR; PG8_WAIT_L(0); PG8_MMA(0, 0, At, B0); PG8_BAR; PG8_SCHED;
            PG8_LDB(B1, 1, 1); PG8_STAGE(PG8_SB(1, 0), b3, voffB);
            PG8_BAR; PG8_WAIT_L(0); PG8_MMA(0, 1, At, B1); PG8_BAR;
            PG8_LDA(At, 1, 1); PG8_STAGE(PG8_SA(1, 0), a3, voffA);
            PG8_BAR; PG8_WAIT_L(0); PG8_MMA(1, 0, At, B0); PG8_BAR; PG8_SCHED;
            PG8_STAGE(PG8_SB(1, 1), b3 + hstep, voffB);
            PG8_WAIT_V(6); PG8_BAR; PG8_MMA(1, 1, At, B1); PG8_BAR;
            }
        }
        if constexpr (ALIGN_EPI) { if (wr == 0) PG8_BAR; }
        if constexpr (!Epi::AFTER_DRAIN) { E(acc, cur, wr, wc, fr, fq); S.done(cur); }
        if (!has_next) break;
#pragma unroll
        for (int a = 0; a < 2; ++a)
#pragma unroll
            for (int b = 0; b < 2; ++b)
#pragma unroll
                for (int m = 0; m < 4; ++m)
#pragma unroll
                    for (int n = 0; n < 2; ++n) acc[a][b][m][n] = (f32x4){0.f, 0.f, 0.f, 0.f};
        cur = nxt; cA = nA; cB = nB; ++ui;
        if constexpr (ALIGN_EPI) { if (wr == 1) PG8_BAR; }
    }
    PG8_WAIT_V(0);
    if constexpr (!ALIGN_EPI) { if (wr == 0) PG8_BAR; }
    PG8_BAR;
    if constexpr (Epi::AFTER_DRAIN) { E.fused(acc, cur, wr, wc, fr, fq, lds, wid, lane); S.done(cur); }
#undef PG8_SA
#undef PG8_SB
#undef PG8_STAGE
#undef PG8_LDA
#undef PG8_LDB
#undef PG8_MMA
#undef PG8_WAIT_V
#undef PG8_WAIT_L
#undef PG8_BAR
#undef PG8_SCHED
}
}

constexpr int NTHR = 512, NWAVES = 8;
constexpr int LDS_BYTES = 155648;

#define IN_F(i) ((const float*)a.in[i])
#define WS_F(off) ((float*)(a.ws + (off)))
#define WS_B(off) ((bf16*)(a.ws + (off)))

__device__ __forceinline__ void phase_mod(const Args& a, LAS unsigned char* lds, int bid, int nblk) {
    const int tid = tid_opaque(), lane = tid & 63, w = tid >> 6;
    LAS float* sc = (LAS float*)lds;
    LAS float* red = (LAS float*)(lds + 98304);
    for (int i = tid; i < 12 * DM; i += NTHR) { const int b = i >> 11, k = i & 2047; const float c = b < 4 ? IN_F(I_CP)[b * DM + k] : IN_F(I_CS)[(b - 4) * DM + k]; sc[i] = silu_f(c); }
    if (bid == 0) for (int i = tid; i < DA; i += NTHR) WS_F(WS_LBV)[i] = sigmoid_f(IN_F(I_LB)[i]);
    __syncthreads();
    for (int u = bid; u < 176; u += nblk) {
        const bool fm = u >= 144; const int n0 = (fm ? u - 144 : u) * 128, ld = fm ? NFMODC : NMODC;
        const float* W = fm ? IN_F(I_WFM) : IN_F(I_WMOD); const float* bias = fm ? IN_F(I_BFM) : IN_F(I_BMOD); float* outp = fm ? WS_F(WS_FMOD) : WS_F(WS_MOD);
        f32x2 acc[12];
#pragma unroll
        for (int b = 0; b < 12; ++b) acc[b] = (f32x2){0.f, 0.f};
        const float* wp = W + (size_t)(w * 256) * ld + n0 + 2 * lane;
        for (int k = 0; k < 256; k += 4) {
            const f32x2 w0 = *(const f32x2*)(wp + (size_t)(k + 0) * ld), w1 = *(const f32x2*)(wp + (size_t)(k + 1) * ld), w2 = *(const f32x2*)(wp + (size_t)(k + 2) * ld), w3 = *(const f32x2*)(wp + (size_t)(k + 3) * ld);
#pragma unroll
            for (int b = 0; b < 12; ++b) { const f32x4 s = *(const LAS f32x4*)(sc + b * DM + w * 256 + k); acc[b] += w0 * s.x + w1 * s.y + w2 * s.z + w3 * s.w; }
        }
#pragma unroll
        for (int b = 0; b < 12; ++b) *(LAS f32x2*)(red + (w * 12 + b) * 128 + 2 * lane) = acc[b];
        __syncthreads();
        for (int i = tid; i < 12 * 128; i += NTHR) { const int b = i >> 7, c = i & 127; float s = 0.f;
#pragma unroll
            for (int ww = 0; ww < 8; ++ww) s += red[(ww * 12 + b) * 128 + c];
            outp[(size_t)b * ld + n0 + c] = s + bias[n0 + c]; }
        __syncthreads();
    }
}

__device__ __forceinline__ void cvt_item(const float* W, int K, int N, bf16* WT, int k0, int n0, int drow0, LAS float* scr, int lane) {
#pragma unroll 8
    for (int i = 0; i < 32; ++i) { const int kk = 2 * i + (lane >> 5); scr[kk * 33 + (lane & 31)] = W[(size_t)(k0 + kk) * N + n0 + (lane & 31)]; }
    LDS_WAIT(); asm volatile("" ::: "memory");
    const int c = lane & 7;
#pragma unroll
    for (int j = 0; j < 4; ++j) { const int n = (lane >> 3) + 8 * j; const LAS float* s = scr + (8 * c) * 33 + n;
        v4u o; o.x = pk2(s[0 * 33], s[1 * 33]); o.y = pk2(s[2 * 33], s[3 * 33]); o.z = pk2(s[4 * 33], s[5 * 33]); o.w = pk2(s[6 * 33], s[7 * 33]);
        *(GAS v4u*)(WT + (size_t)(drow0 + n) * K + k0 + 8 * c) = o; }
    LDS_WAIT(); asm volatile("" ::: "memory");
}
__device__ __forceinline__ void cvt_matrix(const float* W, int K, int N, bf16* WT, int mode, LAS float* scr, int gw, int ngw, int lane) {
    const int nblk = N / 32, nitems = (K / 64) * nblk;
    for (int it = gw; it < nitems; it += ngw) { const int kb = it / nblk, nb = it % nblk, n0 = 32 * nb;
        const int drow0 = mode == 0 ? n0 : ((n0 >> 7) * 256 + (mode == 2 ? 128 : 0) + (n0 & 127));
        cvt_item(W, K, N, WT, 64 * kb, n0, drow0, scr, lane); }
}
__device__ __forceinline__ void phase_cvt(const Args& a, LAS unsigned char* lds, int bid, int nblk, int first, int last) {
    const int tid = tid_opaque(), lane = tid & 63, w = tid >> 6;
    LAS float* scr = (LAS float*)(lds + w * 16384);
    const int gw = bid * NWAVES + w, ngw = nblk * NWAVES;
    if (first <= 0 && 0 <= last) { cvt_matrix(IN_F(I_WG1), DM, DFF, WS_B(WS_WGU1), 1, scr, gw, ngw, lane); cvt_matrix(IN_F(I_WU1), DM, DFF, WS_B(WS_WGU1), 2, scr, gw, ngw, lane);
                                   cvt_matrix(IN_F(I_WD1), DFF, DM, WS_B(WS_WD1), 0, scr, gw, ngw, lane); }
    if (first <= 1 && 1 <= last) { cvt_matrix(IN_F(I_WIN), DM, DIN, WS_B(WS_WIN), 0, scr, gw, ngw, lane); cvt_matrix(IN_F(I_WOUT), DM, DM, WS_B(WS_WOUT), 0, scr, gw, ngw, lane); }
    if (first <= 2 && 2 <= last) { cvt_matrix(IN_F(I_WG2), DM, DFF, WS_B(WS_WGU2), 1, scr, gw, ngw, lane); cvt_matrix(IN_F(I_WU2), DM, DFF, WS_B(WS_WGU2), 2, scr, gw, ngw, lane);
                                   cvt_matrix(IN_F(I_WD2), DFF, DM, WS_B(WS_WD2), 0, scr, gw, ngw, lane); }
}

template <bool FINAL>
__device__ __forceinline__ void phase_norm(const Args& a, int bid, int nblk, bool from_inputs, const float* gvec, const float* modp, int ldmod, int sh_off, int sc_off) {
    const int tid = tid_opaque(), lane = tid & 63, w = tid >> 6;
    const int gw = bid * NWAVES + w, ngw = nblk * NWAVES;
    const int nrows = FINAL ? MREAL : MPAD;
    for (int r = gw; r < nrows; r += ngw) {
        if (r >= MREAL) {
            GAS v4u* o = (GAS v4u*)(WS_B(WS_XN) + (size_t)r * DM) + lane;
#pragma unroll
            for (int j = 0; j < 4; ++j) o[64 * j] = (v4u){0u, 0u, 0u, 0u};
            continue;
        }
        const float* xrow = from_inputs ? (r < MP ? IN_F(I_XP) + (size_t)r * DM : IN_F(I_XS) + (size_t)(r - MP) * DM) : WS_F(WS_X) + (size_t)r * DM;
        const GAS f32x4* xr = (const GAS f32x4*)xrow + lane;
        f32x4 v[8]; float s = 0.f;
#pragma unroll
        for (int j = 0; j < 8; ++j) { v[j] = xr[64 * j]; s += (v[j].x * v[j].x + v[j].y * v[j].y) + (v[j].z * v[j].z + v[j].w * v[j].w); }
        const float rstd = 1.0f / sqrtf(wave_sum(s) * (1.f / DM) + EPS);
        const float* mr = modp + (size_t)mod_row(r) * ldmod;
#pragma unroll
        for (int j = 0; j < 8; ++j) {
            const int c = 4 * (lane + 64 * j);
            const f32x4 g = *(const f32x4*)(gvec + c), sh = *(const f32x4*)(mr + sh_off + c), sc = *(const f32x4*)(mr + sc_off + c);
            const f32x4 y = (v[j] * rstd * g) * (1.f + sc) + sh;
            if (FINAL) { float* dst = r < MP ? a.out + OFF_YP + (size_t)r * DM : a.out + OFF_YS + (size_t)(r - MP) * DM; *(f32x4*)(dst + c) = y; }
            else { v2u o; o.x = pk2(y.x, y.y); o.y = pk2(y.z, y.w); *(GAS v2u*)(WS_B(WS_XN) + (size_t)r * DM + c) = o; }
        }
    }
}

template <int WHICH> __device__ __forceinline__ void phase_gemm(const Args& a, LAS unsigned char* lds, int bid, int nblk) {
    using namespace pg8;
    if constexpr (WHICH == 1 || WHICH == 5) {
        Gemm g{WS_B(WS_XN), WS_B(WHICH == 1 ? WS_WGU1 : WS_WGU2), MPAD, 2 * DFF, DM}; StaticOrder S; S.init(MPAD, 2 * DFF, nblk, bid);
        EpiSwiGLU E{WS_B(WS_H), DFF};
        gemm_phase<EpiSwiGLU, StaticOrder, true, true>(lds, g, S, E);
    } else if constexpr (WHICH == 2 || WHICH == 6) {
        Gemm g{WS_B(WS_H), WS_B(WHICH == 2 ? WS_WD1 : WS_WD2), MPAD, DM, DFF}; StaticOrder S; S.init(MPAD, DM, nblk, bid);
        EpiResid E{WHICH == 2 ? IN_F(I_XP) : nullptr, IN_F(I_XS), WS_F(WS_X), WS_F(WS_MOD) + (WHICH == 2 ? 2 : 8) * DM, 0.5f};
        gemm_phase<EpiResid, StaticOrder, true, true>(lds, g, S, E);
    } else if constexpr (WHICH == 3) {
        Gemm g{WS_B(WS_XN), WS_B(WS_WIN), MPAD, DIN, DM}; StaticOrder S; S.init(MPAD, DIN, nblk, bid);
        EpiProj E{a.ws, WS_F(WS_LF), a.out, WS_F(WS_LBV)};
        gemm_phase<EpiProj, StaticOrder, true, true>(lds, g, S, E);
    } else {
        Gemm g{WS_B(WS_OM), WS_B(WS_WOUT), MPAD, DM, DM}; StaticOrder S; S.init(MPAD, DM, nblk, bid);
        EpiResid E{nullptr, IN_F(I_XS), WS_F(WS_X), WS_F(WS_MOD) + 5 * DM, 1.0f};
        gemm_phase<EpiResid, StaticOrder, true, true>(lds, g, S, E);
    }
}

__device__ __forceinline__ void hgrn_unit(const Args& a, LAS unsigned char* lds, int unit) {
    const int tid = tid_opaque(), dv = tid & 127, g = tid >> 7;
    const bool smp = unit >= 32; const int u = smp ? unit - 32 : unit, b = u >> 3, h = u & 7;
    const int T = smp ? DECT : SEQ, row0 = smp ? MP + b * DECT : b * SEQ;
    float* sout = a.out + (smp ? OFF_SS : OFF_SP) + (size_t)u * HD * HD;
    LAS float* fL = (LAS float*)lds; LAS float* kL = fL + 2048; LAS float* qL = kL + 2048; LAS float* vL = qL + 2048; LAS float* red = vL + 2048;
    const bf16* QA = WS_B(WS_QA); const bf16* IA = WS_B(WS_IA); const bf16* GA = WS_B(WS_GA); const float* LF = WS_F(WS_LF);
    float S[32];
#pragma unroll
    for (int i = 0; i < 32; ++i) S[i] = smp ? IN_F(I_ST)[(size_t)u * HD * HD + (size_t)(32 * g + i) * HD + dv] : 0.f;
    for (int t0 = 0; t0 < T; t0 += 16) {
        const int nt = (T - t0) < 16 ? (T - t0) : 16;
        for (int i = tid; i < nt * 128; i += NTHR) { const int tt = i >> 7, ch = i & 127; const size_t o = (size_t)(row0 + t0 + tt) * DA + h * HD + ch;
            const float f = __builtin_amdgcn_exp2f(LF[o]);   fL[i] = f; kL[i] = 1.f - f; qL[i] = bf2f(QA[o]); vL[i] = bf2f(IA[o]); }
        __syncthreads();
        for (int tt = 0; tt < nt; ++tt) {
            const float v = vL[tt * 128 + dv]; float op = 0.f;
#pragma unroll
            for (int i4 = 0; i4 < 8; ++i4) {
                const f32x4 f4 = *(const LAS f32x4*)(fL + tt * 128 + g * 32 + 4 * i4), k4 = *(const LAS f32x4*)(kL + tt * 128 + g * 32 + 4 * i4), q4 = *(const LAS f32x4*)(qL + tt * 128 + g * 32 + 4 * i4);
#pragma unroll
                for (int j = 0; j < 4; ++j) { S[4 * i4 + j] = f4[j] * S[4 * i4 + j] + k4[j] * v; op += S[4 * i4 + j] * q4[j]; }
            }
            red[(g * 16 + tt) * 128 + dv] = op;
        }
        __syncthreads();
        { const int tt = tid >> 5, l32 = tid & 31;
          if (tt < nt) {
            f32x4 o = (f32x4){0.f, 0.f, 0.f, 0.f};
#pragma unroll
            for (int gg = 0; gg < 4; ++gg) o += *(const LAS f32x4*)(red + (gg * 16 + tt) * 128 + 4 * l32);
            float ss = (o.x * o.x + o.y * o.y) + (o.z * o.z + o.w * o.w);
#pragma unroll
            for (int m = 1; m < 32; m <<= 1) ss += __shfl_xor(ss, m);
            const float rstd = 1.0f / sqrtf(ss * (1.f / HD) + EPS);
            const int row = row0 + t0 + tt, col = h * HD + 4 * l32;
            const f32x4 gw = *(const f32x4*)(IN_F(I_GOA) + col); const v2u gt = *(const v2u*)(GA + (size_t)row * DA + col);
            v2u w; w.x = pk2(o.x * rstd * gw.x * bflo(gt.x), o.y * rstd * gw.y * bfhi(gt.x)); w.y = pk2(o.z * rstd * gw.z * bflo(gt.y), o.w * rstd * gw.w * bfhi(gt.y));
            *(v2u*)(WS_B(WS_OM) + (size_t)row * DM + col) = w;
          } }
        __syncthreads();
    }
#pragma unroll
    for (int i = 0; i < 32; ++i) sout[(size_t)(32 * g + i) * HD + dv] = S[i];
}

__device__ __forceinline__ void sb_tile(const LAS float* Kt, const LAS float* Vt, const LAS float* q, float bias, int lane, int nvis  , float& R, float& o0, float& o1) {
    float z = bias;
#pragma unroll 8
    for (int d = 0; d < HD; d += 4) { const f32x4 qv = *(const LAS f32x4*)(q + d);
        z += qv.x * Kt[lane * 129 + d] + qv.y * Kt[lane * 129 + d + 1] + qv.z * Kt[lane * 129 + d + 2] + qv.w * Kt[lane * 129 + d + 3]; }
    const bool vis = lane < nvis;
    const float L = vis ? -(z > 20.f ? z : log1pf(__expf(z))) : 0.f;
    float c = L;
#pragma unroll
    for (int off = 1; off < 64; off <<= 1) { const float t = __shfl_down(c, off); if (lane + off < 64) c += t; }
    const float P = vis ? __expf(z + c + R) : 0.f;
    R += __shfl(c, 0);
#pragma unroll 8
    for (int s = 0; s < 64; ++s) { const float p = __builtin_bit_cast(float, __builtin_amdgcn_readlane(__builtin_bit_cast(int, P), s));
        o0 += p * Vt[s * 128 + lane]; o1 += p * Vt[s * 128 + 64 + lane]; }
}
__device__ __forceinline__ void sb_finish(const Args& a, int row, int h, int lane, float o0, float o1) {
    const float ss = wave_sum(o0 * o0 + o1 * o1);
    const float rstd = 1.0f / sqrtf(ss * (1.f / HD) + EPS);
    const float* gw = IN_F(I_GOB) + h * HD; bf16* dst = WS_B(WS_OM) + (size_t)row * DM + DA + h * HD;
    dst[lane] = (bf16)f2bf(o0 * rstd * gw[lane]); dst[64 + lane] = (bf16)f2bf(o1 * rstd * gw[64 + lane]);
}
__device__ __forceinline__ void sb_stage_bf16(const Args& a, LAS float* Kt, LAS float* Vt, int krow0, int nvalid, int h, int tid) {
    const bf16* KB = WS_B(WS_KB); const bf16* VB = WS_B(WS_VB);
#pragma unroll
    for (int i = 0; i < 2; ++i) { const int ch = tid + i * NTHR, r = ch >> 4, d0 = (ch & 15) * 8;
        v4u kv = (v4u){0u, 0u, 0u, 0u}, vv = (v4u){0u, 0u, 0u, 0u};
        if (r < nvalid) { const size_t o = (size_t)(krow0 + r) * DA + h * HD + d0; kv = *(const v4u*)(KB + o); vv = *(const v4u*)(VB + o); }
        LAS float* kd = Kt + r * 129 + d0; LAS float* vd = Vt + r * 128 + d0;
        kd[0] = bflo(kv.x); kd[1] = bfhi(kv.x); kd[2] = bflo(kv.y); kd[3] = bfhi(kv.y); kd[4] = bflo(kv.z); kd[5] = bfhi(kv.z); kd[6] = bflo(kv.w); kd[7] = bfhi(kv.w);
        vd[0] = bflo(vv.x); vd[1] = bfhi(vv.x); vd[2] = bflo(vv.y); vd[3] = bfhi(vv.y); vd[4] = bflo(vv.z); vd[5] = bfhi(vv.z); vd[6] = bflo(vv.w); vd[7] = bfhi(vv.w); }
}
__device__ __forceinline__ void sb_unit_prompt(const Args& a, LAS unsigned char* lds, int unit) {
    const int tid = tid_opaque(), lane = tid & 63, w = tid >> 6;
    const int bh = unit >> 8, qb = unit & 255, b = bh >> 3, h = bh & 7, t = qb * 8 + w, row = b * SEQ + t;
    LAS float* Kt = (LAS float*)lds; LAS float* Vt = Kt + 64 * 129; LAS float* qs = Vt + 64 * 128;
    if (lane < 32) { const v2u qv = *(const v2u*)(WS_B(WS_QB) + (size_t)row * DA + h * HD + 4 * lane); LAS float* q = qs + w * HD + 4 * lane; q[0] = bflo(qv.x) * LN2; q[1] = bfhi(qv.x) * LN2; q[2] = bflo(qv.y) * LN2; q[3] = bfhi(qv.y) * LN2; }
    const float bias = IN_F(I_BSB)[h];
    float R = 0.f, o0 = 0.f, o1 = 0.f;
    for (int j = (qb * 8 + 6) >> 6; j >= 0; --j) {
        __syncthreads();
        sb_stage_bf16(a, Kt, Vt, b * SEQ + 64 * j, 64, h, tid);
        __syncthreads();
        int nvis = t - 64 * j; nvis = nvis < 0 ? 0 : (nvis > 64 ? 64 : nvis);
        sb_tile(Kt, Vt, qs + w * HD, bias, lane, nvis, R, o0, o1);
    }
    sb_finish(a, row, h, lane, o0, o1);
    __syncthreads();
}
__device__ __forceinline__ void sb_unit_sample(const Args& a, LAS unsigned char* lds, int unit) {
    const int tid = tid_opaque(), lane = tid & 63, w = tid >> 6;
    const int b = unit >> 3, h = unit & 7, row = MP + b * DECT + w;
    LAS float* Kt = (LAS float*)lds; LAS float* Vt = Kt + 64 * 129; LAS float* qs = Vt + 64 * 128;
    if (lane < 32) { const v2u qv = *(const v2u*)(WS_B(WS_QB) + (size_t)row * DA + h * HD + 4 * lane); LAS float* q = qs + w * HD + 4 * lane; q[0] = bflo(qv.x) * LN2; q[1] = bfhi(qv.x) * LN2; q[2] = bflo(qv.y) * LN2; q[3] = bfhi(qv.y) * LN2; }
    const float bias = IN_F(I_BSB)[h];
    float R = 0.f, o0 = 0.f, o1 = 0.f;
    __syncthreads();
    sb_stage_bf16(a, Kt, Vt, MP + b * DECT, DECT, h, tid);
    __syncthreads();
    sb_tile(Kt, Vt, qs + w * HD, bias, lane, w, R, o0, o1);
    const int* pt = (const int*)a.in[I_PT] + b * NPAGES;
    for (int j = PAST / 64 - 1; j >= 0; --j) {
        __syncthreads();
        { const int page = pt[j >> 1]; const size_t base = ((size_t)page * PAGE + (j & 1) * 64) * (NHEAD * HD) + h * HD;
          const float* ck = IN_F(I_CK) + base; const float* cv = IN_F(I_CV) + base;
#pragma unroll
          for (int i = 0; i < 4; ++i) { const int ch = tid + i * NTHR, r = ch >> 5, d0 = (ch & 31) * 4;
              const f32x4 kv = *(const f32x4*)(ck + (size_t)r * (NHEAD * HD) + d0), vv = *(const f32x4*)(cv + (size_t)r * (NHEAD * HD) + d0);
              LAS float* kd = Kt + r * 129 + d0; kd[0] = kv.x; kd[1] = kv.y; kd[2] = kv.z; kd[3] = kv.w;
              *(LAS f32x4*)(Vt + r * 128 + d0) = vv; } }
        __syncthreads();
        sb_tile(Kt, Vt, qs + w * HD, bias, lane, 64, R, o0, o1);
    }
    sb_finish(a, row, h, lane, o0, o1);
    __syncthreads();
}

typedef float f32x16 __attribute__((ext_vector_type(16)));
typedef short s16x4 __attribute__((ext_vector_type(4)));
typedef short v4i16_t __attribute__((ext_vector_type(4)));
typedef __bf16 bf16x2_t __attribute__((ext_vector_type(2)));
#define MFMA32(a, b, c) __builtin_amdgcn_mfma_f32_32x32x16_bf16((a), (b), (c), 0, 0, 0)

__device__ __forceinline__ unsigned cvtpk(float lo, float hi) { f32x2 v = {lo, hi}; bf16x2_t b = __builtin_convertvector(v, bf16x2_t); return __builtin_bit_cast(unsigned, b); }
template <int S> __device__ __forceinline__ bf16x8 pack8(const f32x16& x) {
    v4u p; p.x = cvtpk(x[8 * S + 0], x[8 * S + 1]); p.y = cvtpk(x[8 * S + 2], x[8 * S + 3]); p.z = cvtpk(x[8 * S + 4], x[8 * S + 5]); p.w = cvtpk(x[8 * S + 6], x[8 * S + 7]);
    return __builtin_bit_cast(bf16x8, p);
}
__device__ __forceinline__ unsigned off_a(unsigned row, unsigned ch) { return 2048u * (row >> 3) + 512u * (ch >> 2) + 64u * (row & 7) + 16u * ((ch & 3) ^ ((row >> 2) & 3)); }
__device__ __forceinline__ s16x4 vtr(const LAS unsigned char* p) { return __builtin_bit_cast(s16x4, __builtin_amdgcn_ds_read_tr16_b64_v4i16((LAS v4i16_t*)p)); }


constexpr int HG_BUF = 33792, HG_QD = 0, HG_KI = 8192, HG_KE = 16384, HG_VV = 24576, HG_DEC = 32768, HG_SSX = 2 * HG_BUF;

__device__ __forceinline__ void hgrn_chain_prompt(const Args& a, LAS unsigned char* lds, int u) {
    const int tid = tid_opaque(), lane = tid & 63, w = __builtin_amdgcn_readfirstlane(tid >> 6);
    const int b = u >> 3, h = u & 7, row00 = b * SEQ;
    const float* LF = WS_F(WS_LF); const bf16* QA = WS_B(WS_QA); const bf16* IA = WS_B(WS_IA); const bf16* GA = WS_B(WS_GA);
    constexpr int NCH = SEQ / 32;
    if (w >= 4) {
        const int tq = w - 4, cp = lane, pt = tid - 256;
        const unsigned wbase = 512u * ((cp >> 2) >> 2) + 4u * (cp & 3);
        for (int c = 0; c < NCH; ++c) {
            LAS unsigned char* buf = lds + (c & 1) * HG_BUF;
            const size_t g0 = (size_t)(row00 + 32 * c) * DA + h * HD;
            f32x2 pre = (f32x2){0.f, 0.f}, tot = (f32x2){0.f, 0.f};
#pragma unroll
            for (int t = 0; t < 32; ++t) { const f32x2 v = *(const f32x2*)(LF + g0 + (size_t)t * DA + 2 * cp); tot += v; if (t < 8 * tq) pre += v; }
            f32x2 own[8];
#pragma unroll
            for (int i = 0; i < 8; ++i) own[i] = *(const f32x2*)(LF + g0 + (size_t)(8 * tq + i) * DA + 2 * cp);
            f32x2 bc = pre;
#pragma unroll
            for (int i = 0; i < 8; ++i) {
                const f32x2 l = own[i];
                bc += l;
                const int t = 8 * tq + i;
                const unsigned qw = *(const unsigned*)(QA + g0 + (size_t)t * DA + 2 * cp);
                const float q0 = bflo(qw), q1 = bfhi(qw);
                const float k0 = 1.f - __builtin_amdgcn_exp2f(l.x), k1 = 1.f - __builtin_amdgcn_exp2f(l.y);
                const float e0 = __builtin_amdgcn_exp2f(bc.x), e1 = __builtin_amdgcn_exp2f(bc.y);
                const float n0 = __builtin_amdgcn_exp2f(-bc.x), n1 = __builtin_amdgcn_exp2f(-bc.y);
                const float d0 = __builtin_amdgcn_exp2f(tot.x - bc.x), d1 = __builtin_amdgcn_exp2f(tot.y - bc.y);
                const unsigned off = 2048u * (t >> 3) + 64u * (t & 7) + 16u * (((unsigned)(cp >> 2) & 3u) ^ (unsigned)((t >> 2) & 3)) + wbase;
                *(LAS unsigned*)(buf + HG_QD + off) = cvtpk(q0 * e0, q1 * e1);
                *(LAS unsigned*)(buf + HG_KI + off) = cvtpk(k0 * n0, k1 * n1);
                *(LAS unsigned*)(buf + HG_KE + off) = cvtpk(k0 * d0, k1 * d1);
            }
            if (tq == 0) *(LAS f32x2*)(buf + HG_DEC + 8 * cp) = (f32x2){__builtin_amdgcn_exp2f(tot.x), __builtin_amdgcn_exp2f(tot.y)};
#pragma unroll
            for (int i = 0; i < 2; ++i) { const int n = pt + 256 * i, row = n >> 4, ch = n & 15;
                *(LAS v4u*)(buf + HG_VV + off_a(row, ch)) = *(const v4u*)(IA + g0 + (size_t)row * DA + 8 * ch); }
            __syncthreads();
        }
        __syncthreads();
    } else {
        const int r = lane & 31, hh = lane >> 5, q4 = (lane & 15) >> 2, p4 = lane & 3, blk = (lane >> 4) & 1;
        int pb[4];
#pragma unroll
        for (int x = 0; x < 4; ++x) pb[x] = (int)(2048u * (r >> 3) + 64u * (r & 7) + 16u * ((unsigned)x ^ ((r >> 2) & 3)) + 8u * hh);
        const int vp0 = (int)(64u * (4 * hh + q4) + 16u * ((2 * blk + (p4 >> 1)) ^ ((0u + hh) & 3)) + 8u * (p4 & 1));
        const int vp1 = (int)(2048u + 64u * (4 * hh + q4) + 16u * ((2 * blk + (p4 >> 1)) ^ ((2u + hh) & 3)) + 8u * (p4 & 1));
        const int nb0 = (int)(2048u * hh + 64u * q4 + 16u * ((2 * blk + (p4 >> 1)) ^ ((2u * hh) & 3)) + 8u * (p4 & 1));
        const int nb1 = (int)(2048u * hh + 64u * (4 + q4) + 16u * ((2 * blk + (p4 >> 1)) ^ ((2u * hh + 1) & 3)) + 8u * (p4 & 1));
        const int tm = r - 4 * hh;
        f32x16 S[4];
#pragma unroll
        for (int kt = 0; kt < 4; ++kt)
#pragma unroll
            for (int i = 0; i < 16; ++i) S[kt][i] = 0.f;
        f32x16 oprev;
#pragma unroll
        for (int i = 0; i < 16; ++i) oprev[i] = 0.f;
        const float* gwv = IN_F(I_GOA) + h * HD + 32 * w;
        __syncthreads();
        for (int c = 0; c < NCH; ++c) {
            const LAS unsigned char* buf = lds + (c & 1) * HG_BUF;
            if (c > 0) {
                const LAS float* sx = (const LAS float*)(lds + HG_SSX) + ((c - 1) & 1) * 128 + r;
                const float ss = (sx[0] + sx[32]) + (sx[64] + sx[96]);
                const float rstd = 1.0f / sqrtf(ss * (1.f / HD) + EPS);
                const size_t row = (size_t)(row00 + 32 * (c - 1) + r);
#pragma unroll
                for (int g = 0; g < 4; ++g) { const int dv = 32 * w + 8 * g + 4 * hh; const f32x4 gv = *(const f32x4*)(gwv + 8 * g + 4 * hh);
                    const v2u gt = *(const v2u*)(GA + row * DA + h * HD + dv);
                    v2u o2; o2.x = cvtpk(oprev[4 * g] * rstd * gv.x * bflo(gt.x), oprev[4 * g + 1] * rstd * gv.y * bfhi(gt.x));
                    o2.y = cvtpk(oprev[4 * g + 2] * rstd * gv.z * bflo(gt.y), oprev[4 * g + 3] * rstd * gv.w * bfhi(gt.y));
                    *(v2u*)(WS_B(WS_OM) + row * DM + h * HD + dv) = o2; }
            }
            bf16x8 qd[8];
#pragma unroll
            for (int ks = 0; ks < 8; ++ks) { const v2u lo = *(const LAS v2u*)(buf + HG_QD + pb[2 * (ks & 1)] + 512 * (ks >> 1)), hi = *(const LAS v2u*)(buf + HG_QD + pb[2 * (ks & 1) + 1] + 512 * (ks >> 1));
                qd[ks] = __builtin_bit_cast(bf16x8, (v4u){lo.x, lo.y, hi.x, hi.y}); }
            f32x16 at;
#pragma unroll
            for (int i = 0; i < 16; ++i) at[i] = 0.f;
#pragma unroll
            for (int ks = 0; ks < 8; ++ks) { const v2u lo = *(const LAS v2u*)(buf + HG_KI + pb[2 * (ks & 1)] + 512 * (ks >> 1)), hi = *(const LAS v2u*)(buf + HG_KI + pb[2 * (ks & 1) + 1] + 512 * (ks >> 1));
                at = MFMA32(__builtin_bit_cast(bf16x8, (v4u){lo.x, lo.y, hi.x, hi.y}), qd[ks], at); }
            f32x16 o;
#pragma unroll
            for (int i = 0; i < 16; ++i) o[i] = 0.f;
#pragma unroll
            for (int kt = 0; kt < 4; ++kt) { o = MFMA32(pack8<0>(S[kt]), qd[2 * kt], o); o = MFMA32(pack8<1>(S[kt]), qd[2 * kt + 1], o); }
#pragma unroll
            for (int i = 0; i < 16; ++i) at[i] = ((i & 3) + 8 * (i >> 2) <= tm) ? at[i] : 0.f;
            { const bf16x8 p0 = pack8<0>(at), p1 = pack8<1>(at);
              const LAS unsigned char* vv = buf + HG_VV + 512 * w;
              { const s16x4 lo = vtr(vv + vp0), hi = vtr(vv + vp1); o = MFMA32(__builtin_shufflevector(lo, hi, 0, 1, 2, 3, 4, 5, 6, 7), p0, o); }
              { const s16x4 lo = vtr(vv + vp0 + 4096), hi = vtr(vv + vp1 + 4096); o = MFMA32(__builtin_shufflevector(lo, hi, 0, 1, 2, 3, 4, 5, 6, 7), p1, o); } }
            { const LAS unsigned char* vv = buf + HG_VV + 512 * w;
              const s16x4 a0 = vtr(vv + nb0), a1 = vtr(vv + nb1), a2 = vtr(vv + nb0 + 4096), a3 = vtr(vv + nb1 + 4096);
              const bf16x8 vf0 = __builtin_shufflevector(a0, a1, 0, 1, 2, 3, 4, 5, 6, 7), vf1 = __builtin_shufflevector(a2, a3, 0, 1, 2, 3, 4, 5, 6, 7);
#pragma unroll
              for (int kt = 0; kt < 4; ++kt) {
#pragma unroll
                  for (int g = 0; g < 4; ++g) { const f32x4 dc = *(const LAS f32x4*)(buf + HG_DEC + 4 * (32 * kt + 8 * g + 4 * hh));
                      S[kt][4 * g] *= dc.x; S[kt][4 * g + 1] *= dc.y; S[kt][4 * g + 2] *= dc.z; S[kt][4 * g + 3] *= dc.w; }
                  const LAS unsigned char* ke = buf + HG_KE + 512 * kt;
                  const s16x4 k0 = vtr(ke + nb0), k1 = vtr(ke + nb1), k2 = vtr(ke + nb0 + 4096), k3 = vtr(ke + nb1 + 4096);
                  S[kt] = MFMA32(__builtin_shufflevector(k0, k1, 0, 1, 2, 3, 4, 5, 6, 7), vf0, S[kt]);
                  S[kt] = MFMA32(__builtin_shufflevector(k2, k3, 0, 1, 2, 3, 4, 5, 6, 7), vf1, S[kt]);
              } }
            { float ss = 0.f;
#pragma unroll
              for (int i = 0; i < 16; ++i) ss += o[i] * o[i];
              ss += __shfl_xor(ss, 32);
              if (hh == 0) ((LAS float*)(lds + HG_SSX))[(c & 1) * 128 + w * 32 + r] = ss; }
            oprev = o;
            __syncthreads();
        }
        {
            const LAS float* sx = (const LAS float*)(lds + HG_SSX) + ((NCH - 1) & 1) * 128 + r;
            const float ss = (sx[0] + sx[32]) + (sx[64] + sx[96]);
            const float rstd = 1.0f / sqrtf(ss * (1.f / HD) + EPS);
            const size_t row = (size_t)(row00 + 32 * (NCH - 1) + r);
#pragma unroll
            for (int g = 0; g < 4; ++g) { const int dv = 32 * w + 8 * g + 4 * hh; const f32x4 gv = *(const f32x4*)(gwv + 8 * g + 4 * hh);
                const v2u gt = *(const v2u*)(GA + row * DA + h * HD + dv);
                v2u o2; o2.x = cvtpk(oprev[4 * g] * rstd * gv.x * bflo(gt.x), oprev[4 * g + 1] * rstd * gv.y * bfhi(gt.x));
                o2.y = cvtpk(oprev[4 * g + 2] * rstd * gv.z * bflo(gt.y), oprev[4 * g + 3] * rstd * gv.w * bfhi(gt.y));
                *(v2u*)(WS_B(WS_OM) + row * DM + h * HD + dv) = o2; }
        }
        float* sout = a.out + OFF_SP + (size_t)u * HD * HD;
#pragma unroll
        for (int kt = 0; kt < 4; ++kt)
#pragma unroll
            for (int i = 0; i < 16; ++i) sout[(size_t)(32 * kt + (i & 3) + 8 * (i >> 2) + 4 * hh) * HD + 32 * w + r] = S[kt][i];
    }
}
struct SbLane {
    int kb0, kb1;
    int vb0, vb1;
    bf16x8 nu0, nu1;
};
__device__ __forceinline__ SbLane sb_lane_init(int lane) {
    SbLane L; const unsigned r = lane & 31, h = lane >> 5, q = (lane & 15) >> 2, p = lane & 3, blk = (lane >> 4) & 1;
    L.kb0 = (int)(2048u * (r >> 3) + 64u * (r & 7) + 16u * ((0u + h) ^ ((r >> 2) & 3)));
    L.kb1 = (int)(2048u * (r >> 3) + 64u * (r & 7) + 16u * ((2u + h) ^ ((r >> 2) & 3)));
    L.vb0 = (int)(64u * (4 * h + q) + 16u * ((2 * blk + (p >> 1)) ^ ((0u + h) & 3)) + 8u * (p & 1));
    L.vb1 = (int)(2048u + 64u * (4 * h + q) + 16u * ((2 * blk + (p >> 1)) ^ ((2u + h) & 3)) + 8u * (p & 1));
#pragma unroll
    for (int j = 0; j < 8; ++j) { const unsigned k0 = 8 * (j >> 2) + 4 * h + (j & 3), k1 = 16 + k0;
        L.nu0[j] = (k0 >= r) ? (short)0xBF80 : (short)0; L.nu1[j] = (k1 >= r) ? (short)0xBF80 : (short)0; }
    return L;
}
__device__ __forceinline__ void sbm_step(const LAS unsigned char* kt, const LAS unsigned char* vt, const LAS unsigned char* qfl  , int qstride, float bias2, const SbLane& L, f32x16 (&o)[4], float& R, int lane, int tq) {
    f32x16 zt;
#pragma unroll
    for (int r = 0; r < 16; ++r) zt[r] = bias2;
#pragma unroll
    for (int s = 0; s < 8; ++s) { const bf16x8 kf = *(const LAS bf16x8*)(kt + ((s & 1) ? L.kb1 : L.kb0) + 512 * (s >> 1)); const bf16x8 qf = *(const LAS bf16x8*)(qfl + qstride * s); zt = MFMA32(kf, qf, zt); }
    f32x16 sp, cin;
#pragma unroll
    for (int r = 0; r < 16; ++r) {
        const float e = __builtin_amdgcn_exp2f(zt[r]); float l = __builtin_amdgcn_logf(1.f + e); l = zt[r] > 30.f ? zt[r] : l;
        l = ((r & 3) + 8 * (r >> 2) < tq) ? l : 0.f;
        sp[r] = l; cin[r] = zt[r] + R;
    }
    f32x16 out = MFMA32(L.nu0, pack8<0>(sp), cin);
    out = MFMA32(L.nu1, pack8<1>(sp), out);
    const float rn = out[0] - zt[0];
    R = __shfl(rn, lane & 31);
    f32x16 p;
#pragma unroll
    for (int r = 0; r < 16; ++r) { float v = __builtin_amdgcn_exp2f(out[r]); v = ((r & 3) + 8 * (r >> 2) < tq) ? v : 0.f; p[r] = v; }
    const bf16x8 p0 = pack8<0>(p), p1 = pack8<1>(p);
#pragma unroll
    for (int c = 0; c < 4; ++c) {
        { const s16x4 lo = vtr(vt + L.vb0 + 512 * c), hi = vtr(vt + L.vb1 + 512 * c); const bf16x8 vf = __builtin_shufflevector(lo, hi, 0, 1, 2, 3, 4, 5, 6, 7); o[c] = MFMA32(vf, p0, o[c]); }
        { const s16x4 lo = vtr(vt + L.vb0 + 4096 + 512 * c), hi = vtr(vt + L.vb1 + 4096 + 512 * c); const bf16x8 vf = __builtin_shufflevector(lo, hi, 0, 1, 2, 3, 4, 5, 6, 7); o[c] = MFMA32(vf, p1, o[c]); }
    }
}
__device__ __forceinline__ void sbm_finish(const Args& a, const f32x16 (&o)[4], int row, int h, int lane) {
    float ss = 0.f;
#pragma unroll
    for (int c = 0; c < 4; ++c)
#pragma unroll
        for (int r = 0; r < 16; ++r) ss += o[c][r] * o[c][r];
    ss += __shfl_xor(ss, 32);
    const float rstd = 1.0f / sqrtf(ss * (1.f / HD) + EPS);
    const int hh = lane >> 5; const float* gw = IN_F(I_GOB) + h * HD; bf16* dst = WS_B(WS_OM) + (size_t)row * DM + DA + h * HD;
#pragma unroll
    for (int c = 0; c < 4; ++c)
#pragma unroll
        for (int g = 0; g < 4; ++g) { const int d = 32 * c + 8 * g + 4 * hh; const f32x4 gv = *(const f32x4*)(gw + d);
            v2u w; w.x = cvtpk(o[c][4 * g + 0] * rstd * gv.x, o[c][4 * g + 1] * rstd * gv.y); w.y = cvtpk(o[c][4 * g + 2] * rstd * gv.z, o[c][4 * g + 3] * rstd * gv.w);
            *(v2u*)(dst + d) = w; }
}
__device__ __forceinline__ void sbm_unit_prompt(const Args& a, LAS unsigned char* lds, int bh, int qb) {
    const int tid = tid_opaque(), lane = tid & 63, w = __builtin_amdgcn_readfirstlane(tid >> 6);
    const int b = bh >> 3, h = bh & 7, q0 = 256 * qb + 32 * w, idiag = 8 * qb + w;
    const SbLane L = sb_lane_init(lane);
    const bf16* QB = WS_B(WS_QB); const bf16* KB = WS_B(WS_KB); const bf16* VB = WS_B(WS_VB);
    LAS unsigned char* qfl = lds + 65536 + w * 8192 + lane * 16;
    { const bf16* qp = QB + (size_t)(b * SEQ + q0 + (lane & 31)) * DA + h * HD + 8 * (lane >> 5);
#pragma unroll
      for (int s = 0; s < 8; ++s) *(LAS bf16x8*)(qfl + 1024 * s) = *(const bf16x8*)(qp + 16 * s); }
    const float bias2 = IN_F(I_BSB)[h] * LOG2E;
    f32x16 o[4];
#pragma unroll
    for (int c = 0; c < 4; ++c)
#pragma unroll
        for (int r = 0; r < 16; ++r) o[c][r] = 0.f;
    float R = 0.f; const int tq = (lane & 31) - 4 * (lane >> 5);
    const int key0 = tid >> 4, ch = tid & 15;
    const size_t gsrc = (size_t)(b * SEQ + key0) * DA + h * HD + 8 * ch;
    const unsigned ldst = off_a(key0 & 31, ch);
    v4u kr[2], vr[2];
    int j = 4 * qb + 3;
#define SBM_LOAD(jj) do { const size_t o_ = gsrc + (size_t)(jj) * 64 * DA; kr[0] = *(const v4u*)(KB + o_); vr[0] = *(const v4u*)(VB + o_); kr[1] = *(const v4u*)(KB + o_ + 32 * DA); vr[1] = *(const v4u*)(VB + o_ + 32 * DA); } while (0)
#define SBM_WRITE(buf) do { LAS unsigned char* b_ = lds + (buf) * 32768; *(LAS v4u*)(b_ + ldst) = kr[0]; *(LAS v4u*)(b_ + 8192 + ldst) = kr[1]; *(LAS v4u*)(b_ + 16384 + ldst) = vr[0]; *(LAS v4u*)(b_ + 16384 + 8192 + ldst) = vr[1]; } while (0)
    SBM_LOAD(j); SBM_WRITE(0);
    __syncthreads();
    int cur = 0;
    for (; j >= 0; --j) {
        if (j > 0) SBM_LOAD(j - 1);
        const LAS unsigned char* kb_ = lds + cur * 32768; const LAS unsigned char* vb_ = kb_ + 16384;
#pragma unroll 1
        for (int tt = 1; tt >= 0; --tt) { const int ti = 2 * j + tt;
            if (ti <= idiag) sbm_step(kb_ + tt * 8192, vb_ + tt * 8192, qfl, 1024, bias2, L, o, R, lane, ti == idiag ? tq : 64); }
        if (j > 0) SBM_WRITE(cur ^ 1);
        __syncthreads();
        cur ^= 1;
    }
#undef SBM_LOAD
#undef SBM_WRITE
    sbm_finish(a, o, b * SEQ + q0 + (lane & 31), h, lane);
}


constexpr int SEGK = 256, NSEG = PAST / SEGK, PART_STRIDE = 132;
__device__ __forceinline__ void sbm_unit_sample(const Args& a, LAS unsigned char* lds, int b, int seg) {
    const int tid = tid_opaque(), lane = tid & 63, w = __builtin_amdgcn_readfirstlane(tid >> 6);
    const SbLane L = sb_lane_init(lane);
    LAS unsigned char* kimg = lds + w * 16384; LAS unsigned char* vimg = kimg + 8192;
    LAS unsigned char* qreg = lds + 131072 + w * 2048;
    LAS unsigned char* zchunk = lds + 131072 + 16384 + w * 16;
    const int r = lane & 31, hh = lane >> 5;
    if (r < 8) { const bf16* qp = WS_B(WS_QB) + (size_t)(MP + b * DECT + r) * DA + w * HD + 8 * hh;
#pragma unroll
        for (int s = 0; s < 8; ++s) *(LAS bf16x8*)(qreg + (s * 16 + hh * 8 + r) * 16) = *(const bf16x8*)(qp + 16 * s); }
    if (lane == 0) *(LAS v4u*)zchunk = (v4u){0u, 0u, 0u, 0u};
    const LAS unsigned char* qfl = r < 8 ? qreg + (hh * 8 + r) * 16 : zchunk; const int qstride = r < 8 ? 256 : 0;
    const float bias2 = IN_F(I_BSB)[w] * LOG2E;
    f32x16 o[4];
#pragma unroll
    for (int c = 0; c < 4; ++c)
#pragma unroll
        for (int q = 0; q < 16; ++q) o[c][q] = 0.f;
    float R = 0.f;
    LDS_WAIT();
    if (seg == NSEG - 1) {
        { const int j = lane >> 3, c2 = (lane & 7) * 2; const size_t src = (size_t)(MP + b * DECT + j) * DA + w * HD + 8 * c2;
          const v4u k0 = *(const v4u*)(WS_B(WS_KB) + src), k1 = *(const v4u*)(WS_B(WS_KB) + src + 8), v0 = *(const v4u*)(WS_B(WS_VB) + src), v1 = *(const v4u*)(WS_B(WS_VB) + src + 8);
          *(LAS v4u*)(kimg + off_a(j, c2)) = k0; *(LAS v4u*)(kimg + off_a(j, c2 + 1)) = k1; *(LAS v4u*)(vimg + off_a(j, c2)) = v0; *(LAS v4u*)(vimg + off_a(j, c2 + 1)) = v1; }
#pragma unroll
        for (int i = 0; i < 6; ++i) { const int n = lane + 64 * i, row = 8 + (n >> 4), c1 = n & 15; *(LAS v4u*)(kimg + off_a(row, c1)) = (v4u){0u, 0u, 0u, 0u}; *(LAS v4u*)(vimg + off_a(row, c1)) = (v4u){0u, 0u, 0u, 0u}; }
        LDS_WAIT();
        sbm_step(kimg, vimg, qfl, qstride, bias2, L, o, R, lane, r - 4 * hh);
        LDS_WAIT();
    }
    const int* pt = (const int*)a.in[I_PT] + b * NPAGES;
    const float* ck = IN_F(I_CK); const float* cv = IN_F(I_CV);
    const int ch = r >> 1; const unsigned wconst = 512u * (ch >> 2) + 64u * hh + 8u * (lane & 1);
    f32x4 kr[8], vr[8];
#define SBS_LOAD(ti, hf) do { const int p_ = seg * SEGK + 32 * (ti); const size_t base_ = ((size_t)pt[p_ >> 7] * PAGE + (p_ & 127) + 16 * (hf) + hh) * (NHEAD * HD) + w * HD + 4 * r; \
        _Pragma("unroll") for (int i_ = 0; i_ < 8; ++i_) { kr[i_] = *(const f32x4*)(ck + base_ + (size_t)(2 * i_) * (NHEAD * HD)); vr[i_] = *(const f32x4*)(cv + base_ + (size_t)(2 * i_) * (NHEAD * HD)); } } while (0)
#define SBS_WRITE(hf) do { _Pragma("unroll") for (int i_ = 0; i_ < 8; ++i_) { \
        const unsigned off_ = 2048u * (2 * (hf) + (i_ >> 2)) + 64u * (2 * (i_ & 3)) + 16u * ((unsigned)(ch & 3) ^ (unsigned)((i_ >> 1) & 3)) + wconst; \
        v2u kk_, vv_; kk_.x = cvtpk(kr[i_].x, kr[i_].y); kk_.y = cvtpk(kr[i_].z, kr[i_].w); vv_.x = cvtpk(vr[i_].x, vr[i_].y); vv_.y = cvtpk(vr[i_].z, vr[i_].w); \
        *(LAS v2u*)(kimg + off_) = kk_; *(LAS v2u*)(vimg + off_) = vv_; } } while (0)
    SBS_LOAD(SEGK / 32 - 1, 1);
#pragma unroll 1
    for (int ti = SEGK / 32 - 1; ti >= 0; --ti) {
        SBS_WRITE(1);
        SBS_LOAD(ti, 0);
        SBS_WRITE(0);
        if (ti > 0) SBS_LOAD(ti - 1, 1);
        LDS_WAIT();
        sbm_step(kimg, vimg, qfl, qstride, bias2, L, o, R, lane, 64);
        LDS_WAIT();
    }
#undef SBS_LOAD
#undef SBS_WRITE
    if (r < 8) { float* dst = WS_F(WS_PART) + ((((size_t)b * NSEG + seg) * NHEAD + w) * 8 + r) * PART_STRIDE;
#pragma unroll
        for (int c = 0; c < 4; ++c)
#pragma unroll
            for (int g = 0; g < 4; ++g) *(f32x4*)(dst + 32 * c + 8 * g + 4 * hh) = (f32x4){o[c][4 * g], o[c][4 * g + 1], o[c][4 * g + 2], o[c][4 * g + 3]};
        if (hh == 0) dst[128] = R; }
}
__device__ __forceinline__ void phase_sbcombine(const Args& a, int bid, int nblk) {
    const int tid = tid_opaque(), lane = tid & 63, w = tid >> 6;
    static_assert(NSEG == 64, "one lane per segment");
    for (int item = bid * NWAVES + w; item < DECB * NHEAD * 8; item += nblk * NWAVES) {
        const int b = item >> 6, h = (item >> 3) & 7, i = item & 7;
        const float* p0 = WS_F(WS_PART) + (((size_t)b * NSEG * NHEAD + h) * 8 + i) * PART_STRIDE;
        const size_t sstride = (size_t)NHEAD * 8 * PART_STRIDE;
        const float rseg = p0[(size_t)lane * sstride + 128];
        float suf = rseg;
#pragma unroll
        for (int off = 1; off < 64; off <<= 1) { const float t = __shfl_down(suf, off); if (lane + off < 64) suf += t; }
        const float fac = __builtin_amdgcn_exp2f(suf - rseg);
        float o0 = 0.f, o1 = 0.f;
#pragma unroll 8
        for (int s = 0; s < NSEG; ++s) { const float f = __builtin_bit_cast(float, __builtin_amdgcn_readlane(__builtin_bit_cast(int, fac), s));
            o0 += f * p0[(size_t)s * sstride + lane]; o1 += f * p0[(size_t)s * sstride + 64 + lane]; }
        const float ss = wave_sum(o0 * o0 + o1 * o1);
        const float rstd = 1.0f / sqrtf(ss * (1.f / HD) + EPS);
        const float* gw = IN_F(I_GOB) + h * HD; bf16* dst = WS_B(WS_OM) + (size_t)(MP + b * DECT + i) * DM + DA + h * HD;
        dst[lane] = (bf16)f2bf(o0 * rstd * gw[lane]); dst[64 + lane] = (bf16)f2bf(o1 * rstd * gw[64 + lane]);
    }
}

constexpr int CTL_MIXQ = 4096;
__device__ __forceinline__ int queue_next(const Args& a, LAS unsigned char* lds, int tid) {
    LAS int* slot = (LAS int*)(lds + LDS_BYTES - 64);
    __syncthreads();
    if (tid == 0) *slot = (int)__hip_atomic_fetch_add((unsigned*)(a.ws + WS_CTL) + CTL_MIXQ, 1u, __ATOMIC_RELAXED, __HIP_MEMORY_SCOPE_AGENT);
    __syncthreads();
    return *slot;
}
__device__ __forceinline__ void phase_mixer(const Args& a, LAS unsigned char* lds, int bid, int nblk) {
    const int tid = tid_opaque();
    { GAS v4u* o = (GAS v4u*)(WS_B(WS_OM) + (size_t)MREAL * DM);
      for (int i = bid * NTHR + tid; i < (MPAD - MREAL) * DM / 8; i += nblk * NTHR) o[i] = (v4u){0u, 0u, 0u, 0u}; }
    constexpr int U0 = 32, U1 = U0 + 256, U2 = U1 + DECB * NSEG, U3 = U2 + 64;
    for (;;) {
        const int u = queue_next(a, lds, tid);
        if (u >= U3) break;
        if (u < U0) hgrn_chain_prompt(a, lds, u);
        else if (u < U1) { const int v = u - U0; sbm_unit_prompt(a, lds, v & 31, 7 - (v >> 5)); }
        else if (u < U2) { const int v = u - U1; sbm_unit_sample(a, lds, v & 7, NSEG - 1 - (v >> 3)); }
        else hgrn_unit(a, lds, 32 + (u - U2));
    }
}

enum { PH_MOD = 0, PH_CVT, PH_NORM1, PH_G1, PH_G2, PH_NORM2, PH_G3, PH_MIX, PH_G4, PH_NORM3, PH_G5, PH_G6, PH_FINAL, N_PHASES };

template <int PH> __device__ __forceinline__ void run_phase(const Args& a, LAS unsigned char* lds, int bid, int nblk) {
    if constexpr (PH == PH_MOD) phase_mod(a, lds, bid, nblk);
    else if constexpr (PH == PH_CVT) phase_cvt(a, lds, bid, nblk, 0, 2);
    else if constexpr (PH == PH_NORM1) phase_norm<false>(a, bid, nblk, true, IN_F(I_N1), WS_F(WS_MOD), NMODC, 0 * DM, 1 * DM);
    else if constexpr (PH == PH_G1) phase_gemm<1>(a, lds, bid, nblk);
    else if constexpr (PH == PH_G2) phase_gemm<2>(a, lds, bid, nblk);
    else if constexpr (PH == PH_NORM2) phase_norm<false>(a, bid, nblk, false, IN_F(I_NM), WS_F(WS_MOD), NMODC, 3 * DM, 4 * DM);
    else if constexpr (PH == PH_G3) phase_gemm<3>(a, lds, bid, nblk);
    else if constexpr (PH == PH_MIX) phase_mixer(a, lds, bid, nblk);
    else if constexpr (PH == PH_G4) phase_gemm<4>(a, lds, bid, nblk);
    else if constexpr (PH == PH_NORM3) phase_norm<false>(a, bid, nblk, false, IN_F(I_N2), WS_F(WS_MOD), NMODC, 6 * DM, 7 * DM);
    else if constexpr (PH == PH_G5) phase_gemm<5>(a, lds, bid, nblk);
    else if constexpr (PH == PH_G6) phase_gemm<6>(a, lds, bid, nblk);
    else phase_norm<true>(a, bid, nblk, false, IN_F(I_NF), WS_F(WS_FMOD), NFMODC, 0, DM);
}

#define XB_TMO      128
#define XB_XCNT(j)  (256  + 64 * (j))
#define XB_XSUB(j)  (1280 + 64 * (j))
#define XB_XGEN(j)  (2304 + 64 * (j))
#define XB_TOP      3328
#define XB_TOPGEN   3392
#define XCD_BAR_WORDS 3456
#define XB_SPIN_CAP (1u << 18)

__device__ __forceinline__ unsigned xb_ld(unsigned* p)              { return __hip_atomic_load(p, __ATOMIC_RELAXED, __HIP_MEMORY_SCOPE_AGENT); }
__device__ __forceinline__ unsigned xb_add(unsigned* p, unsigned v) { return __hip_atomic_fetch_add(p, v, __ATOMIC_RELAXED, __HIP_MEMORY_SCOPE_AGENT); }
__device__ __forceinline__ unsigned xb_xcc_id() { return (unsigned)__builtin_amdgcn_s_getreg((3 << 11) | 20) & 0xFu; }
#define XB_SPIN(cond, bar) do { unsigned _sp = 0; while (cond) { __builtin_amdgcn_s_sleep(1); \
    if ((++_sp & 255u) == 0u) { if (xb_ld(&(bar)[XB_TMO])) break; if (_sp > XB_SPIN_CAP) { atomicAdd(&(bar)[XB_TMO], 1u); break; } } } } while (0)

struct XcdBarrier {
    unsigned* bar; unsigned x;
    volatile LAS unsigned* st;
};

__device__ __forceinline__ XcdBarrier xcd_barrier_post(unsigned* bar, volatile LAS unsigned* st) {
    XcdBarrier b; b.bar = bar; b.x = xb_xcc_id(); b.st = st;
    if (threadIdx.x == 0) (void)xb_add(&bar[XB_XCNT(b.x)], 1u);
    return b;
}
__device__ __forceinline__ void xcd_barrier_complete(unsigned* bar, unsigned x, unsigned& nloc, unsigned& nx) {
    const unsigned G = gridDim.x * gridDim.y * gridDim.z;
    unsigned sum, cnt, mine, sp = 0u;
    for (;;) {
        sum = 0u; cnt = 0u; mine = 0u;
#pragma unroll
        for (unsigned j = 0; j < 16; ++j) { const unsigned c = xb_ld(&bar[XB_XCNT(j)]); sum += c; cnt += (c > 0u) ? 1u : 0u; mine = (j == x) ? c : mine; }
        if (sum == G) break;
        __builtin_amdgcn_s_sleep(1);
        if ((++sp & 255u) == 0u) { if (xb_ld(&bar[XB_TMO])) break; if (sp > XB_SPIN_CAP) { atomicAdd(&bar[XB_TMO], 1u); break; } }
    }
    nloc = mine > 0u ? mine : 1u; nx = cnt > 0u ? cnt : 1u;
}

__device__ __forceinline__ void xcd_barrier(const XcdBarrier& b) {
    asm volatile("s_waitcnt vmcnt(0)" ::: "memory");
    __syncthreads();
    if (threadIdx.x == 0) {
        unsigned* bar = b.bar;
        __builtin_amdgcn_s_waitcnt(0);
        unsigned nloc = b.st[0], nx = b.st[1];
        if (nloc == 0u) { xcd_barrier_complete(bar, b.x, nloc, nx); b.st[0] = nloc; b.st[1] = nx; }
        const unsigned old = xb_add(&bar[XB_XSUB(b.x)], 1u);
        const unsigned gen = old / nloc;
        if (old + 1u == (gen + 1u) * nloc) {
            __builtin_amdgcn_fence(__ATOMIC_RELEASE, "agent");
            asm volatile("s_waitcnt vmcnt(0)" ::: "memory");
            const unsigned og = xb_add(&bar[XB_TOP], 1u);
            const unsigned tg = og / nx;
            if (og + 1u == (tg + 1u) * nx) xb_add(&bar[XB_TOPGEN], 1u);
            else XB_SPIN(xb_ld(&bar[XB_TOPGEN]) == tg, bar);
            __builtin_amdgcn_fence(__ATOMIC_ACQUIRE, "agent");
            xb_add(&bar[XB_XGEN(b.x)], 1u);
            asm volatile("s_waitcnt vmcnt(0)" ::: "memory");
        } else {
            XB_SPIN(xb_ld(&bar[XB_XGEN(b.x)]) == gen, bar);
            __builtin_amdgcn_fence(__ATOMIC_ACQUIRE, "agent");
            asm volatile("s_waitcnt vmcnt(0)" ::: "memory");
        }
    }
    __syncthreads();
}


constexpr int LDS_BAR_OFF = LDS_BYTES;
constexpr int LDS_TOTAL = LDS_BYTES + 64;

__global__ void __launch_bounds__(NTHR, 2) mega_fwd(Args a) {
    extern __shared__ __attribute__((aligned(16))) unsigned char lds_raw[];
    LAS unsigned char* lds = (LAS unsigned char*)lds_raw;
    const int bid = (int)blockIdx.x, nblk = (int)gridDim.x;
    if (threadIdx.x < 16) ((LAS unsigned*)(lds + LDS_BAR_OFF))[threadIdx.x] = 0u;
    __syncthreads();
    XcdBarrier bar = xcd_barrier_post((unsigned*)(a.ws + WS_CTL), (volatile LAS unsigned*)(lds + LDS_BAR_OFF));
    run_phase<PH_MOD>(a, lds, bid, nblk);
    __syncthreads();
    run_phase<PH_CVT>(a, lds, bid, nblk);
    xcd_barrier(bar);
    run_phase<PH_NORM1>(a, lds, bid, nblk);
    xcd_barrier(bar);
    run_phase<PH_G1>(a, lds, bid, nblk);
    xcd_barrier(bar);
    run_phase<PH_G2>(a, lds, bid, nblk);
    xcd_barrier(bar);
    run_phase<PH_NORM2>(a, lds, bid, nblk);
    xcd_barrier(bar);
    run_phase<PH_G3>(a, lds, bid, nblk);
    xcd_barrier(bar);
    run_phase<PH_MIX>(a, lds, bid, nblk);
    xcd_barrier(bar);
    phase_sbcombine(a, bid, nblk);
    xcd_barrier(bar);
    run_phase<PH_G4>(a, lds, bid, nblk);
    xcd_barrier(bar);
    run_phase<PH_NORM3>(a, lds, bid, nblk);
    xcd_barrier(bar);
    run_phase<PH_G5>(a, lds, bid, nblk);
    xcd_barrier(bar);
    run_phase<PH_G6>(a, lds, bid, nblk);
    xcd_barrier(bar);
    run_phase<PH_FINAL>(a, lds, bid, nblk);
}

extern "C" void kernel_launch(void* const* d_in, const int* in_sizes, int n_in, void* d_out, int out_size, void* d_ws, size_t ws_size, hipStream_t stream) {
    static int grid = 0;
    if (grid == 0) {
        if (n_in != N_IN || (size_t)out_size != OUT_TOTAL || ws_size < WS_END) { fprintf(stderr, "kernel_launch: unexpected shapes (n_in %d, out %d, ws %zu)\n", n_in, out_size, ws_size); grid = -1; return; }
        int dev = 0, cus = 0, per_cu = 0;
        if (hipGetDevice(&dev) != hipSuccess || hipDeviceGetAttribute(&cus, hipDeviceAttributeMultiprocessorCount, dev) != hipSuccess) { grid = -1; return; }
        if (hipFuncSetAttribute((const void*)mega_fwd, hipFuncAttributeMaxDynamicSharedMemorySize, LDS_TOTAL) != hipSuccess) { fprintf(stderr, "kernel_launch: hipFuncSetAttribute failed\n"); grid = -1; return; }
        if (hipOccupancyMaxActiveBlocksPerMultiprocessor(&per_cu, (const void*)mega_fwd, NTHR, LDS_TOTAL) != hipSuccess || per_cu < 1) { fprintf(stderr, "kernel_launch: occupancy query says %d blocks per CU\n", per_cu); grid = -1; (void)hipGetLastError(); return; }
        grid = cus;
    }
    if (grid < 0) return;
    (void)hipMemsetAsync((char*)d_ws + WS_CTL, 0, 65536, stream);
    Args a{};
    for (int i = 0; i < N_IN; ++i) a.in[i] = d_in[i];
    a.out = (float*)d_out; a.ws = (unsigned char*)d_ws;
    hipLaunchKernelGGL(mega_fwd, dim3(grid), dim3(NTHR), LDS_TOTAL, stream, a);
}
```

```cpp
#include <hip/hip_runtime.h>
#include <cstdio>
#include <cstdint>

constexpr int DM = 2048, SEQ = 2048, NB = 4, MP = NB * SEQ  , DECB = 8, DECT = 8, MS = DECB * DECT  ;
constexpr int MREAL = MP + MS  , MPAD = 8448  ;
constexpr int DFF = 5632, DIN = 7168, NMODC = 9 * DM  , NFMODC = 2 * DM;
constexpr int DA = 1024, NHEAD = 8, HD = 128, PAST = 16384, PAGE = 128, NPAGES = PAST / PAGE  ;
constexpr float EPS = 1e-6f, QSCALE = 0.08838834764831845f  ;
constexpr float LOG2E = 1.4426950408889634f, LN2 = 0.6931471805599453f;
constexpr size_t OFF_YP = 0, OFF_YS = OFF_YP + (size_t)MP * DM, OFF_KP = OFF_YS + (size_t)MS * DM, OFF_VP = OFF_KP + (size_t)MP * DA,
                 OFF_KS = OFF_VP + (size_t)MP * DA, OFF_VS = OFF_KS + (size_t)MS * DA, OFF_SP = OFF_VS + (size_t)MS * DA,
                 OFF_SS = OFF_SP + (size_t)NB * NHEAD * HD * HD, OUT_TOTAL = OFF_SS + (size_t)DECB * NHEAD * HD * HD;
enum { I_XP = 0, I_XS, I_CK, I_CV, I_ST, I_PT, I_CP, I_CS, I_LB, I_N1, I_NM, I_N2, I_WMOD, I_BMOD, I_WG1, I_WU1, I_WD1, I_WIN, I_GOA, I_GOB, I_BSB, I_WOUT,
       I_WG2, I_WU2, I_WD2, I_NF, I_WFM, I_BFM, N_IN };
constexpr size_t MiB = 1u << 20;
constexpr size_t WS_CTL = 0, CTL_BYTES = 1 * MiB;
constexpr size_t WS_MOD = 1 * MiB;
constexpr size_t WS_FMOD = 2 * MiB;
constexpr size_t WS_LBV = 3 * MiB;
constexpr size_t WS_WGU1 = 4 * MiB, WS_WD1 = 48 * MiB, WS_WIN = 70 * MiB, WS_WOUT = 98 * MiB, WS_WGU2 = 106 * MiB, WS_WD2 = 150 * MiB;
constexpr size_t WS_XN = 172 * MiB;
constexpr size_t WS_H = 206 * MiB;
constexpr size_t WS_X = 298 * MiB;
constexpr size_t WS_QA = 364 * MiB, WS_IA = 381 * MiB, WS_GA = 398 * MiB, WS_QB = 415 * MiB, WS_KB = 432 * MiB, WS_VB = 449 * MiB;
constexpr size_t WS_LF = 466 * MiB;
constexpr size_t WS_OM = 500 * MiB;
constexpr size_t WS_PART = 534 * MiB;
constexpr size_t WS_END = 700 * MiB;

#define GAS __attribute__((address_space(1)))
#define LAS __attribute__((address_space(3)))
typedef unsigned short bf16;
typedef unsigned v4u __attribute__((ext_vector_type(4)));
typedef unsigned v2u __attribute__((ext_vector_type(2)));
typedef float f32x4 __attribute__((ext_vector_type(4)));
typedef float f32x2 __attribute__((ext_vector_type(2)));
typedef short bf16x8 __attribute__((ext_vector_type(8)));

struct Args { const void* in[N_IN]; float* out; unsigned char* ws; };

__device__ __forceinline__ unsigned f2bf(float f) { unsigned u = __builtin_bit_cast(unsigned, f); return (u + 0x7fffu + ((u >> 16) & 1u)) >> 16; }
__device__ __forceinline__ unsigned pk2(float lo, float hi) { return f2bf(lo) | (f2bf(hi) << 16); }
__device__ __forceinline__ float bf2f(unsigned short b) { return __builtin_bit_cast(float, (unsigned)b << 16); }
__device__ __forceinline__ float bflo(unsigned w) { return __builtin_bit_cast(float, w << 16); }
__device__ __forceinline__ float bfhi(unsigned w) { return __builtin_bit_cast(float, w & 0xffff0000u); }
__device__ __forceinline__ float sigmoid_f(float x) { return __builtin_amdgcn_rcpf(1.f + __expf(-x)); }
__device__ __forceinline__ float silu_f(float x) { return x * sigmoid_f(x); }
__device__ __forceinline__ int mod_row(int r) { const int s = 4 + ((r - MP) >> 3); return r < MP ? (r >> 11) : (s > 11 ? 11 : s); }
__device__ __forceinline__ float wave_sum(float v) {
#pragma unroll
    for (int o = 1; o < 64; o <<= 1) v += __shfl_xor(v, o);
    return v;
}
__device__ __forceinline__ int tid_opaque() { int t = (int)threadIdx.x; asm volatile("" : "+v"(t)); return t; }
#define LDS_WAIT() asm volatile("s_waitcnt lgkmcnt(0)" ::: "memory")
#define VM_WAIT() asm volatile("s_waitcnt vmcnt(0)" ::: "memory")

namespace pg8 {
#define PG8_LAS __attribute__((address_space(3)))
typedef unsigned short bf16_t;
typedef short bf16x8 __attribute__((ext_vector_type(8)));
typedef float f32x4 __attribute__((ext_vector_type(4)));
typedef unsigned u32x4 __attribute__((ext_vector_type(4)));
constexpr int BM = 256, BK = 64, HALF = 128, HTB = HALF * BK * 2  , STAGE_BYTES = 8 * HTB, NXCD = 8, WGM = 8;

__host__ __device__ __forceinline__ int lds_byte(int r, int c) { const int st = (r >> 4) * 2 + (c >> 5), rr = r & 15, cc = c & 31, ob = rr * 64 + cc * 2; return st * 1024 + (ob ^ (((ob >> 9) & 1) << 5)); }
__host__ __device__ __forceinline__ void stage_rc(int b, int& R, int& C) { const int st = b / 1024, sb = b % 1024, swz = sb ^ (((sb >> 9) & 1) << 5); R = (st >> 1) * 16 + swz / 64; C = (st & 1) * 32 + (swz % 64) / 2; }
__host__ __device__ __forceinline__ int perm32(int rho) { const int n = rho >> 4, i = rho & 15; return 8 * (i >> 2) + 4 * n + (i & 3); }

struct Unit { int pm, pn; };
struct Gemm { const bf16_t* A; const bf16_t* Bt; int M, N, K; };

struct StaticOrder {
    int nM, nN, nwg, G, c;
    __host__ __device__ void init(int M, int N, int G_, int c_) { nM = M / BM; nN = N / BM; nwg = nM * nN; G = G_; c = c_; }
    __host__ __device__ bool next(int i, Unit& u) const {
        const long L = (long)i * G + c; if (L >= nwg) return false;
        int wgid = (int)L; { const int q = nwg / NXCD, r = nwg % NXCD, xcd = wgid % NXCD, off = wgid / NXCD; wgid = (xcd < r ? xcd * (q + 1) : r * (q + 1) + (xcd - r) * q) + off; }
        const int nig = WGM * nN, gid = wgid / nig, fm = gid * WGM, gsz = (nM - fm) < WGM ? (nM - fm) : WGM;
        u.pm = fm + ((wgid % nig) % gsz); u.pn = (wgid % nig) / gsz; return true;
    }
    __device__ __forceinline__ void a_ready(const Unit&) const {}
    __device__ __forceinline__ void done(const Unit&) const {}
};


__device__ __forceinline__ unsigned cvt_pk_bf16(float lo, float hi) { unsigned r; asm volatile("v_cvt_pk_bf16_f32 %0, %1, %2" : "=v"(r) : "v"(lo), "v"(hi)); return r; }

struct EpiSwiGLU {
    static constexpr bool PERM = true, AFTER_DRAIN = false;
    bf16_t* H; int ldh;
    __device__ __forceinline__ void operator()(const f32x4 (&acc)[2][2][4][2], const Unit& u, int wr, int wc, int fr, int fq) const {
        const int row0 = u.pm * BM + wr * 64 + fr, col0 = u.pn * HALF + wc * 32 + 8 * fq;
#pragma unroll
        for (int ai = 0; ai < 2; ++ai)
#pragma unroll
            for (int m = 0; m < 4; ++m) {
                const f32x4 g0 = acc[ai][0][m][0], g1 = acc[ai][0][m][1], u0 = acc[ai][1][m][0], u1 = acc[ai][1][m][1];
                float v[8];
#pragma unroll
                for (int j = 0; j < 4; ++j) { v[j] = silu_f(g0[j]) * u0[j]; v[4 + j] = silu_f(g1[j]) * u1[j]; }
                u32x4 w; w.x = cvt_pk_bf16(v[0], v[1]); w.y = cvt_pk_bf16(v[2], v[3]); w.z = cvt_pk_bf16(v[4], v[5]); w.w = cvt_pk_bf16(v[6], v[7]);
                *(u32x4*)(H + (size_t)(row0 + ai * HALF + m * 16) * ldh + col0) = w;
            }
    }
};
struct EpiResid {
    static constexpr bool PERM = false, AFTER_DRAIN = false;
    const float* xp; const float* xs; float* X; const float* gate; float scale;
    __device__ __forceinline__ void operator()(const f32x4 (&acc)[2][2][4][2], const Unit& u, int wr, int wc, int fr, int fq) const {
        const int col0 = u.pn * BM + wc * 32 + 4 * fq;
#pragma unroll
        for (int ai = 0; ai < 2; ++ai)
#pragma unroll
            for (int m = 0; m < 4; ++m) {
                const int row = u.pm * BM + ai * HALF + wr * 64 + m * 16 + fr;
                if (row < MREAL) {
                    const float* base = xp ? (row < MP ? xp + (size_t)row * DM : xs + (size_t)(row - MP) * DM) : X + (size_t)row * DM;
                    const float* gr = gate + (size_t)mod_row(row) * NMODC;
#pragma unroll
                    for (int bj = 0; bj < 2; ++bj)
#pragma unroll
                        for (int n = 0; n < 2; ++n) { const int c = col0 + bj * HALF + n * 16;
                            const f32x4 gv = *(const f32x4*)(gr + c), bv = *(const f32x4*)(base + c);
                            *(f32x4*)(X + (size_t)row * DM + c) = bv + (gv * scale) * acc[ai][bj][m][n]; }
                }
            }
    }
};
struct EpiProj {
    static constexpr bool PERM = true, AFTER_DRAIN = false;
    unsigned char* ws; float* LF; float* out; const float* lbv;
    template <int MODE> __device__ __forceinline__ void run(const f32x4 (&acc)[2][2][4][2], const Unit& u, int wr, int wc, int fr, int fq, bf16_t* B, float s, size_t offp, size_t offs) const {
        const int cb = (u.pn & 3) * BM + wc * 32 + 8 * fq;
#pragma unroll
        for (int ai = 0; ai < 2; ++ai)
#pragma unroll
            for (int m = 0; m < 4; ++m) {
                const int row = u.pm * BM + ai * HALF + wr * 64 + m * 16 + fr;
#pragma unroll
                for (int bj = 0; bj < 2; ++bj) {
                    const int c = cb + bj * HALF; const size_t o = (size_t)row * DA + c;
                    f32x4 v0 = acc[ai][bj][m][0], v1 = acc[ai][bj][m][1];
                    if constexpr (MODE == 1) {
                        const f32x4 l0 = *(const f32x4*)(lbv + c), l1 = *(const f32x4*)(lbv + c + 4);
#pragma unroll
                        for (int j = 0; j < 4; ++j) { v0[j] = __builtin_amdgcn_logf(l0[j] + (1.f - l0[j]) * sigmoid_f(v0[j])); v1[j] = __builtin_amdgcn_logf(l1[j] + (1.f - l1[j]) * sigmoid_f(v1[j])); }
                        *(f32x4*)(LF + o) = v0; *(f32x4*)(LF + o + 4) = v1;
                    } else {
                        if constexpr (MODE == 3) {
                            if (row < MREAL) { float* dst = row < MP ? out + offp + o : out + offs + (o - (size_t)MP * DA); *(f32x4*)dst = v0; *(f32x4*)(dst + 4) = v1; }
                        }
                        if constexpr (MODE == 0) { v0 = v0 * s; v1 = v1 * s; }
                        if constexpr (MODE == 2) {
#pragma unroll
                            for (int j = 0; j < 4; ++j) { v0[j] = silu_f(v0[j]); v1[j] = silu_f(v1[j]); }
                        }
                        u32x4 w; w.x = cvt_pk_bf16(v0[0], v0[1]); w.y = cvt_pk_bf16(v0[2], v0[3]); w.z = cvt_pk_bf16(v1[0], v1[1]); w.w = cvt_pk_bf16(v1[2], v1[3]);
                        *(u32x4*)(B + o) = w;
                    }
                }
            }
    }
    __device__ __forceinline__ void operator()(const f32x4 (&acc)[2][2][4][2], const Unit& u, int wr, int wc, int fr, int fq) const {
        const int rng = u.pn >> 2;
        bf16_t* B = (bf16_t*)(ws + WS_QA + (size_t)(rng == 0 ? 0 : rng - 1) * (WS_IA - WS_QA));
        if (rng == 1) run<1>(acc, u, wr, wc, fr, fq, nullptr, 1.f, 0, 0);
        else if (rng == 3) run<2>(acc, u, wr, wc, fr, fq, B, 1.f, 0, 0);
        else if (rng >= 5) run<3>(acc, u, wr, wc, fr, fq, B, 1.f, rng == 5 ? OFF_KP : OFF_VP, rng == 5 ? OFF_KS : OFF_VS);
        else run<0>(acc, u, wr, wc, fr, fq, B, rng == 2 ? 1.f : (rng == 4 ? QSCALE * LOG2E : QSCALE), 0, 0);
    }
};
template <class Epi, class Sched, bool ALIGN_EPI = false, bool SP2 = false>
__device__ __forceinline__ void gemm_phase(PG8_LAS unsigned char* lds, const Gemm g, const Sched& S, const Epi& E) {
    const int tid = tid_opaque(), wid = __builtin_amdgcn_readfirstlane(tid >> 6), lane = tid & 63, wr = wid >> 2, wc = wid & 3, fr = lane & 15, fq = lane >> 4;
    const int K = g.K, nt = K / BK;
    unsigned voffA[2], voffB[2];
#pragma unroll
    for (int i = 0; i < 2; ++i) { int R, C; stage_rc(tid * 16 + i * 8192, R, C); const int Rb = Epi::PERM ? ((R & ~31) + perm32(R & 31)) : R;
        voffA[i] = (unsigned)(R * K + C) * 2u; voffB[i] = (unsigned)(Rb * K + C) * 2u; }
    const size_t kstep = (size_t)(BK * 2);
    const size_t hstep = (size_t)HALF * K * 2;
    const size_t tstep = 2 * hstep;
    const unsigned ldsw = (unsigned)wid * 1024u;
    const int aoff = lds_byte(wr * 64 + fr, fq * 8), boff = lds_byte(wc * 32 + fr, fq * 8);
#define PG8_SA(b, h) (((b) * 2 + (h)) * HTB)
#define PG8_SB(b, h) ((4 + (b) * 2 + (h)) * HTB)
#define PG8_STAGE(bufoff, gbase, voff) do { _Pragma("unroll") for (int _i = 0; _i < 2; ++_i) \
        __builtin_amdgcn_global_load_lds((const unsigned*)((const char*)(gbase) + (voff)[_i]), (PG8_LAS unsigned*)(lds + (bufoff) + ldsw + _i * 8192), 16, 0, 0); } while (0)
#define PG8_LDA(dst, b, h) do { _Pragma("unroll") for (int m = 0; m < 4; ++m) _Pragma("unroll") for (int k = 0; k < 2; ++k) dst[m][k] = *(const PG8_LAS bf16x8*)(lds + PG8_SA(b, h) + aoff + m * 2048 + k * 1024); } while (0)
#define PG8_LDB(dst, b, h) do { _Pragma("unroll") for (int n = 0; n < 2; ++n) _Pragma("unroll") for (int k = 0; k < 2; ++k) dst[n][k] = *(const PG8_LAS bf16x8*)(lds + PG8_SB(b, h) + boff + n * 2048 + k * 1024); } while (0)
#define PG8_MMA(ai, bj, At, Bt) do { __builtin_amdgcn_s_setprio(1); _Pragma("unroll") for (int m = 0; m < 4; ++m) _Pragma("unroll") for (int n = 0; n < 2; ++n) _Pragma("unroll") for (int k = 0; k < 2; ++k) \
        acc[ai][bj][m][n] = __builtin_amdgcn_mfma_f32_16x16x32_bf16(Bt[n][k], At[m][k], acc[ai][bj][m][n], 0, 0, 0); __builtin_amdgcn_s_setprio(0); } while (0)
#define PG8_WAIT_V(n) asm volatile("s_waitcnt vmcnt(" #n ")" ::: "memory")
#define PG8_WAIT_L(n) asm volatile("s_waitcnt lgkmcnt(" #n ")" ::: "memory")
#define PG8_BAR __builtin_amdgcn_s_barrier()
#define PG8_SCHED __builtin_amdgcn_sched_barrier(0)
    Unit cur, nxt; int ui = 0;
    if (!S.next(0, cur)) return;
    f32x4 acc[2][2][4][2];
#pragma unroll
    for (int a = 0; a < 2; ++a)
#pragma unroll
        for (int b = 0; b < 2; ++b)
#pragma unroll
            for (int m = 0; m < 4; ++m)
#pragma unroll
                for (int n = 0; n < 2; ++n) acc[a][b][m][n] = (f32x4){0.f, 0.f, 0.f, 0.f};
    bf16x8 At[4][2], B0[2][2], B1[2][2];
    const char* cA = (const char*)g.A + (size_t)cur.pm * tstep; const char* cB = (const char*)g.Bt + (size_t)cur.pn * tstep;
    S.a_ready(cur);
    if constexpr (SP2) {
        PG8_STAGE(PG8_SB(0, 0), cB, voffB); PG8_STAGE(PG8_SB(0, 1), cB + hstep, voffB); PG8_STAGE(PG8_SA(0, 0), cA, voffA); PG8_STAGE(PG8_SA(0, 1), cA + hstep, voffA);
        if (wr == 1) PG8_BAR;
        PG8_WAIT_V(2); PG8_BAR;
        PG8_STAGE(PG8_SB(1, 0), cB + kstep, voffB); PG8_STAGE(PG8_SA(1, 0), cA + kstep, voffA); PG8_STAGE(PG8_SB(1, 1), cB + hstep + kstep, voffB);
        PG8_WAIT_V(6); PG8_BAR;
    } else {
        PG8_STAGE(PG8_SB(0, 0), cB, voffB); PG8_STAGE(PG8_SA(0, 0), cA, voffA); PG8_STAGE(PG8_SB(0, 1), cB + hstep, voffB); PG8_STAGE(PG8_SA(0, 1), cA + hstep, voffA);
        if (wr == 1) PG8_BAR;
        PG8_WAIT_V(4); PG8_BAR;
        PG8_STAGE(PG8_SB(1, 0), cB + kstep, voffB); PG8_STAGE(PG8_SA(1, 0), cA + kstep, voffA); PG8_STAGE(PG8_SB(1, 1), cB + hstep + kstep, voffB);
        PG8_WAIT_V(6); PG8_BAR;
    }
    for (;;) {
        const bool has_next = S.next(ui + 1, nxt);
        const char* nA = has_next ? (const char*)g.A + (size_t)nxt.pm * tstep : cA; const char* nB = has_next ? (const char*)g.Bt + (size_t)nxt.pn * tstep : cB;
        for (int t = 0; t < nt; t += 2) {
            const bool last = (t == nt - 2);
            const char* a1 = cA + (size_t)(t + 1) * kstep;
            const char* a2 = last ? nA : cA + (size_t)(t + 2) * kstep; const char* b2 = last ? nB : cB + (size_t)(t + 2) * kstep;
            const char* a3 = a2 + kstep; const char* b3 = b2 + kstep;
            if (last && has_next) S.a_ready(nxt);
            if constexpr (SP2) {
            PG8_LDB(B0, 0, 0); PG8_LDB(B1, 0, 1); PG8_SCHED; PG8_LDA(At, 0, 0); PG8_STAGE(PG8_SA(1, 1), a1 + hstep, voffA);
            PG8_WAIT_V(8); PG8_WAIT_L(0); PG8_BAR; PG8_MMA(0, 0, At, B0); PG8_MMA(0, 1, At, B1); PG8_BAR; PG8_SCHED;
            PG8_LDA(At, 0, 1); PG8_STAGE(PG8_SB(0, 0), b2, voffB); PG8_STAGE(PG8_SB(0, 1), b2 + hstep, voffB); PG8_STAGE(PG8_SA(0, 0), a2, voffA);
            PG8_WAIT_V(8); PG8_WAIT_L(0); PG8_BAR; PG8_MMA(1, 0, At, B0); PG8_MMA(1, 1, At, B1); PG8_BAR; PG8_SCHED;
            PG8_LDB(B0, 1, 0); PG8_LDB(B1, 1, 1); PG8_SCHED; PG8_LDA(At, 1, 0); PG8_STAGE(PG8_SA(0, 1), a2 + hstep, voffA);
            PG8_WAIT_V(8); PG8_WAIT_L(0); PG8_BAR; PG8_MMA(0, 0, At, B0); PG8_MMA(0, 1, At, B1); PG8_BAR; PG8_SCHED;
            PG8_LDA(At, 1, 1); PG8_STAGE(PG8_SB(1, 0), b3, voffB); PG8_STAGE(PG8_SB(1, 1), b3 + hstep, voffB); PG8_STAGE(PG8_SA(1, 0), a3, voffA);
            PG8_WAIT_V(8); PG8_WAIT_L(0); PG8_BAR; PG8_MMA(1, 0, At, B0); PG8_MMA(1, 1, At, B1); PG8_BAR; PG8_SCHED;
            } else {
            PG8_LDB(B0, 0, 0); PG8_SCHED; PG8_LDA(At, 0, 0); PG8_STAGE(PG8_SA(1, 1), a1 + hstep, voffA);
            PG8_WAIT_L(8); PG8_BAR; PG8_WAIT_L(0); PG8_MMA(0, 0, At, B0); PG8_BAR; PG8_SCHED;
            PG8_LDB(B1, 0, 1); PG8_STAGE(PG8_SB(0, 0), b2, voffB);
            PG8_BAR; PG8_WAIT_L(0); PG8_MMA(0, 1, At, B1); PG8_BAR;
            PG8_LDA(At, 0, 1); PG8_STAGE(PG8_SA(0, 0), a2, voffA);
            PG8_BAR; PG8_WAIT_L(0); PG8_MMA(1, 0, At, B0); PG8_BAR; PG8_SCHED;
            PG8_STAGE(PG8_SB(0, 1), b2 + hstep, voffB);
            PG8_WAIT_V(6); PG8_BAR; PG8_MMA(1, 1, At, B1); PG8_BAR;
            PG8_LDB(B0, 1, 0); PG8_SCHED; PG8_LDA(At, 1, 0); PG8_STAGE(PG8_SA(0, 1), a2 + hstep, voffA);
            PG8_WAIT_L(8); PG8_BAR; PG8_WAIT_L(0); PG8_MMA(0, 0, At, B0); PG8_BAR; PG8_SCHED;
            PG8_LDB(B1, 1, 1); PG8_STAGE(PG8_SB(1, 0), b3, voffB);
            PG8_BAR; PG8_WAIT_L(0); PG8_MMA(0, 1, At, B1); PG8_BAR;
            PG8_LDA(At, 1, 1); PG8_STAGE(PG8_SA(1, 0), a3, voffA);
            PG8_BAR; PG8_WAIT_L(0); PG8_MMA(1, 0, At, B0); PG8_BAR; PG8_SCHED;
            PG8_STAGE(PG8_SB(1, 1), b3 + hstep, voffB);
            PG8_WAIT_V(6); PG8_BAR; PG8_MMA(1, 1, At, B1); PG8_BAR;
            }
        }
        if constexpr (ALIGN_EPI) { if (wr == 0) PG8_BAR; }
        if constexpr (!Epi::AFTER_DRAIN) { E(acc, cur, wr, wc, fr, fq); S.done(cur); }
        if (!has_next) break;
#pragma unroll
        for (int a = 0; a < 2; ++a)
#pragma unroll
            for (int b = 0; b < 2; ++b)
#pragma unroll
                for (int m = 0; m < 4; ++m)
#pragma unroll
                    for (int n = 0; n < 2; ++n) acc[a][b][m][n] = (f32x4){0.f, 0.f, 0.f, 0.f};
        cur = nxt; cA = nA; cB = nB; ++ui;
        if constexpr (ALIGN_EPI) { if (wr == 1) PG8_BAR; }
    }
    PG8_WAIT_V(0);
    if constexpr (!ALIGN_EPI) { if (wr == 0) PG8_BAR; }
    PG8_BAR;
    if constexpr (Epi::AFTER_DRAIN) { E.fused(acc, cur, wr, wc, fr, fq, lds, wid, lane); S.done(cur); }
#undef PG8_SA
#undef PG8_SB
#undef PG8_STAGE
#undef PG8_LDA
#undef PG8_LDB
#undef PG8_MMA
#undef PG8_WAIT_V
#undef PG8_WAIT_L
#undef PG8_BAR
#undef PG8_SCHED
}
}

constexpr int NTHR = 512, NWAVES = 8;
constexpr int LDS_BYTES = 155648;

#define IN_F(i) ((const float*)a.in[i])
#define WS_F(off) ((float*)(a.ws + (off)))
#define WS_B(off) ((bf16*)(a.ws + (off)))

__device__ __forceinline__ void phase_mod(const Args& a, LAS unsigned char* lds, int bid, int nblk) {
    const int tid = tid_opaque(), lane = tid & 63, w = tid >> 6;
    LAS float* sc = (LAS float*)lds;
    LAS float* red = (LAS float*)(lds + 98304);
    for (int i = tid; i < 12 * DM; i += NTHR) { const int b = i >> 11, k = i & 2047; const float c = b < 4 ? IN_F(I_CP)[b * DM + k] : IN_F(I_CS)[(b - 4) * DM + k]; sc[i] = silu_f(c); }
    if (bid == 0) for (int i = tid; i < DA; i += NTHR) WS_F(WS_LBV)[i] = sigmoid_f(IN_F(I_LB)[i]);
    __syncthreads();
    for (int u = bid; u < 176; u += nblk) {
        const bool fm = u >= 144; const int n0 = (fm ? u - 144 : u) * 128, ld = fm ? NFMODC : NMODC;
        const float* W = fm ? IN_F(I_WFM) : IN_F(I_WMOD); const float* bias = fm ? IN_F(I_BFM) : IN_F(I_BMOD); float* outp = fm ? WS_F(WS_FMOD) : WS_F(WS_MOD);
        f32x2 acc[12];
#pragma unroll
        for (int b = 0; b < 12; ++b) acc[b] = (f32x2){0.f, 0.f};
        const float* wp = W + (size_t)(w * 256) * ld + n0 + 2 * lane;
        for (int k = 0; k < 256; k += 4) {
            const f32x2 w0 = *(const f32x2*)(wp + (size_t)(k + 0) * ld), w1 = *(const f32x2*)(wp + (size_t)(k + 1) * ld), w2 = *(const f32x2*)(wp + (size_t)(k + 2) * ld), w3 = *(const f32x2*)(wp + (size_t)(k + 3) * ld);
#pragma unroll
            for (int b = 0; b < 12; ++b) { const f32x4 s = *(const LAS f32x4*)(sc + b * DM + w * 256 + k); acc[b] += w0 * s.x + w1 * s.y + w2 * s.z + w3 * s.w; }
        }
#pragma unroll
        for (int b = 0; b < 12; ++b) *(LAS f32x2*)(red + (w * 12 + b) * 128 + 2 * lane) = acc[b];
        __syncthreads();
        for (int i = tid; i < 12 * 128; i += NTHR) { const int b = i >> 7, c = i & 127; float s = 0.f;
#pragma unroll
            for (int ww = 0; ww < 8; ++ww) s += red[(ww * 12 + b) * 128 + c];
            outp[(size_t)b * ld + n0 + c] = s + bias[n0 + c]; }
        __syncthreads();
    }
}

__device__ __forceinline__ void cvt_item(const float* W, int K, int N, bf16* WT, int k0, int n0, int drow0, LAS float* scr, int lane) {
#pragma unroll 8
    for (int i = 0; i < 32; ++i) { const int kk = 2 * i + (lane >> 5); scr[kk * 33 + (lane & 31)] = W[(size_t)(k0 + kk) * N + n0 + (lane & 31)]; }
    LDS_WAIT(); asm volatile("" ::: "memory");
    const int c = lane & 7;
#pragma unroll
    for (int j = 0; j < 4; ++j) { const int n = (lane >> 3) + 8 * j; const LAS float* s = scr + (8 * c) * 33 + n;
        v4u o; o.x = pk2(s[0 * 33], s[1 * 33]); o.y = pk2(s[2 * 33], s[3 * 33]); o.z = pk2(s[4 * 33], s[5 * 33]); o.w = pk2(s[6 * 33], s[7 * 33]);
        *(GAS v4u*)(WT + (size_t)(drow0 + n) * K + k0 + 8 * c) = o; }
    LDS_WAIT(); asm volatile("" ::: "memory");
}
__device__ __forceinline__ void cvt_matrix(const float* W, int K, int N, bf16* WT, int mode, LAS float* scr, int gw, int ngw, int lane) {
    const int nblk = N / 32, nitems = (K / 64) * nblk;
    for (int it = gw; it < nitems; it += ngw) { const int kb = it / nblk, nb = it % nblk, n0 = 32 * nb;
        const int drow0 = mode == 0 ? n0 : ((n0 >> 7) * 256 + (mode == 2 ? 128 : 0) + (n0 & 127));
        cvt_item(W, K, N, WT, 64 * kb, n0, drow0, scr, lane); }
}
__device__ __forceinline__ void phase_cvt(const Args& a, LAS unsigned char* lds, int bid, int nblk, int first, int last) {
    const int tid = tid_opaque(), lane = tid & 63, w = tid >> 6;
    LAS float* scr = (LAS float*)(lds + w * 16384);
    const int gw = bid * NWAVES + w, ngw = nblk * NWAVES;
    if (first <= 0 && 0 <= last) { cvt_matrix(IN_F(I_WG1), DM, DFF, WS_B(WS_WGU1), 1, scr, gw, ngw, lane); cvt_matrix(IN_F(I_WU1), DM, DFF, WS_B(WS_WGU1), 2, scr, gw, ngw, lane);
                                   cvt_matrix(IN_F(I_WD1), DFF, DM, WS_B(WS_WD1), 0, scr, gw, ngw, lane); }
    if (first <= 1 && 1 <= last) { cvt_matrix(IN_F(I_WIN), DM, DIN, WS_B(WS_WIN), 0, scr, gw, ngw, lane); cvt_matrix(IN_F(I_WOUT), DM, DM, WS_B(WS_WOUT), 0, scr, gw, ngw, lane); }
    if (first <= 2 && 2 <= last) { cvt_matrix(IN_F(I_WG2), DM, DFF, WS_B(WS_WGU2), 1, scr, gw, ngw, lane); cvt_matrix(IN_F(I_WU2), DM, DFF, WS_B(WS_WGU2), 2, scr, gw, ngw, lane);
                                   cvt_matrix(IN_F(I_WD2), DFF, DM, WS_B(WS_WD2), 0, scr, gw, ngw, lane); }
}

template <bool FINAL>
__device__ __forceinline__ void phase_norm(const Args& a, int bid, int nblk, bool from_inputs, const float* gvec, const float* modp, int ldmod, int sh_off, int sc_off) {
    const int tid = tid_opaque(), lane = tid & 63, w = tid >> 6;
    const int gw = bid * NWAVES + w, ngw = nblk * NWAVES;
    const int nrows = MREAL;
    for (int r = gw; r < nrows; r += ngw) {
        if (r >= MREAL) {
            GAS v4u* o = (GAS v4u*)(WS_B(WS_XN) + (size_t)r * DM) + lane;
#pragma unroll
            for (int j = 0; j < 4; ++j) o[64 * j] = (v4u){0u, 0u, 0u, 0u};
            continue;
        }
        const float* xrow = from_inputs ? (r < MP ? IN_F(I_XP) + (size_t)r * DM : IN_F(I_XS) + (size_t)(r - MP) * DM) : WS_F(WS_X) + (size_t)r * DM;
        const GAS f32x4* xr = (const GAS f32x4*)xrow + lane;
        f32x4 v[8]; float s = 0.f;
#pragma unroll
        for (int j = 0; j < 8; ++j) { v[j] = xr[64 * j]; s += (v[j].x * v[j].x + v[j].y * v[j].y) + (v[j].z * v[j].z + v[j].w * v[j].w); }
        const float rstd = 1.0f / sqrtf(wave_sum(s) * (1.f / DM) + EPS);
        const float* mr = modp + (size_t)mod_row(r) * ldmod;
#pragma unroll
        for (int j = 0; j < 8; ++j) {
            const int c = 4 * (lane + 64 * j);
            const f32x4 g = *(const f32x4*)(gvec + c), sh = *(const f32x4*)(mr + sh_off + c), sc = *(const f32x4*)(mr + sc_off + c);
            const f32x4 y = (v[j] * rstd * g) * (1.f + sc) + sh;
            if (FINAL) { float* dst = r < MP ? a.out + OFF_YP + (size_t)r * DM : a.out + OFF_YS + (size_t)(r - MP) * DM; *(f32x4*)(dst + c) = y; }
            else { v2u o; o.x = pk2(y.x, y.y); o.y = pk2(y.z, y.w); *(GAS v2u*)(WS_B(WS_XN) + (size_t)r * DM + c) = o; }
        }
    }
}

__device__ __forceinline__ void hgrn_unit(const Args& a, LAS unsigned char* lds, int unit) {
    const int tid = tid_opaque(), dv = tid & 127, g = tid >> 7;
    const bool smp = unit >= 32; const int u = smp ? unit - 32 : unit, b = u >> 3, h = u & 7;
    const int T = smp ? DECT : SEQ, row0 = smp ? MP + b * DECT : b * SEQ;
    float* sout = a.out + (smp ? OFF_SS : OFF_SP) + (size_t)u * HD * HD;
    LAS float* fL = (LAS float*)lds; LAS float* kL = fL + 2048; LAS float* qL = kL + 2048; LAS float* vL = qL + 2048; LAS float* red = vL + 2048;
    const bf16* QA = WS_B(WS_QA); const bf16* IA = WS_B(WS_IA); const bf16* GA = WS_B(WS_GA); const float* LF = WS_F(WS_LF);
    float S[32];
#pragma unroll
    for (int i = 0; i < 32; ++i) S[i] = smp ? IN_F(I_ST)[(size_t)u * HD * HD + (size_t)(32 * g + i) * HD + dv] : 0.f;
    for (int t0 = 0; t0 < T; t0 += 16) {
        const int nt = (T - t0) < 16 ? (T - t0) : 16;
        for (int i = tid; i < nt * 128; i += NTHR) { const int tt = i >> 7, ch = i & 127; const size_t o = (size_t)(row0 + t0 + tt) * DA + h * HD + ch;
            const float f = __builtin_amdgcn_exp2f(LF[o]);   fL[i] = f; kL[i] = 1.f - f; qL[i] = bf2f(QA[o]); vL[i] = bf2f(IA[o]); }
        __syncthreads();
        for (int tt = 0; tt < nt; ++tt) {
            const float v = vL[tt * 128 + dv]; float op = 0.f;
#pragma unroll
            for (int i4 = 0; i4 < 8; ++i4) {
                const f32x4 f4 = *(const LAS f32x4*)(fL + tt * 128 + g * 32 + 4 * i4), k4 = *(const LAS f32x4*)(kL + tt * 128 + g * 32 + 4 * i4), q4 = *(const LAS f32x4*)(qL + tt * 128 + g * 32 + 4 * i4);
#pragma unroll
                for (int j = 0; j < 4; ++j) { S[4 * i4 + j] = f4[j] * S[4 * i4 + j] + k4[j] * v; op += S[4 * i4 + j] * q4[j]; }
            }
            red[(g * 16 + tt) * 128 + dv] = op;
        }
        __syncthreads();
        { const int tt = tid >> 5, l32 = tid & 31;
          if (tt < nt) {
            f32x4 o = (f32x4){0.f, 0.f, 0.f, 0.f};
#pragma unroll
            for (int gg = 0; gg < 4; ++gg) o += *(const LAS f32x4*)(red + (gg * 16 + tt) * 128 + 4 * l32);
            float ss = (o.x * o.x + o.y * o.y) + (o.z * o.z + o.w * o.w);
#pragma unroll
            for (int m = 1; m < 32; m <<= 1) ss += __shfl_xor(ss, m);
            const float rstd = 1.0f / sqrtf(ss * (1.f / HD) + EPS);
            const int row = row0 + t0 + tt, col = h * HD + 4 * l32;
            const f32x4 gw = *(const f32x4*)(IN_F(I_GOA) + col); const v2u gt = *(const v2u*)(GA + (size_t)row * DA + col);
            v2u w; w.x = pk2(o.x * rstd * gw.x * bflo(gt.x), o.y * rstd * gw.y * bfhi(gt.x)); w.y = pk2(o.z * rstd * gw.z * bflo(gt.y), o.w * rstd * gw.w * bfhi(gt.y));
            *(v2u*)(WS_B(WS_OM) + (size_t)row * DM + col) = w;
          } }
        __syncthreads();
    }
#pragma unroll
    for (int i = 0; i < 32; ++i) sout[(size_t)(32 * g + i) * HD + dv] = S[i];
}

__device__ __forceinline__ void sb_tile(const LAS float* Kt, const LAS float* Vt, const LAS float* q, float bias, int lane, int nvis  , float& R, float& o0, float& o1) {
    float z = bias;
#pragma unroll 8
    for (int d = 0; d < HD; d += 4) { const f32x4 qv = *(const LAS f32x4*)(q + d);
        z += qv.x * Kt[lane * 129 + d] + qv.y * Kt[lane * 129 + d + 1] + qv.z * Kt[lane * 129 + d + 2] + qv.w * Kt[lane * 129 + d + 3]; }
    const bool vis = lane < nvis;
    const float L = vis ? -(z > 20.f ? z : log1pf(__expf(z))) : 0.f;
    float c = L;
#pragma unroll
    for (int off = 1; off < 64; off <<= 1) { const float t = __shfl_down(c, off); if (lane + off < 64) c += t; }
    const float P = vis ? __expf(z + c + R) : 0.f;
    R += __shfl(c, 0);
#pragma unroll 8
    for (int s = 0; s < 64; ++s) { const float p = __builtin_bit_cast(float, __builtin_amdgcn_readlane(__builtin_bit_cast(int, P), s));
        o0 += p * Vt[s * 128 + lane]; o1 += p * Vt[s * 128 + 64 + lane]; }
}
__device__ __forceinline__ void sb_finish(const Args& a, int row, int h, int lane, float o0, float o1) {
    const float ss = wave_sum(o0 * o0 + o1 * o1);
    const float rstd = 1.0f / sqrtf(ss * (1.f / HD) + EPS);
    const float* gw = IN_F(I_GOB) + h * HD; bf16* dst = WS_B(WS_OM) + (size_t)row * DM + DA + h * HD;
    dst[lane] = (bf16)f2bf(o0 * rstd * gw[lane]); dst[64 + lane] = (bf16)f2bf(o1 * rstd * gw[64 + lane]);
}
__device__ __forceinline__ void sb_stage_bf16(const Args& a, LAS float* Kt, LAS float* Vt, int krow0, int nvalid, int h, int tid) {
    const bf16* KB = WS_B(WS_KB); const bf16* VB = WS_B(WS_VB);
#pragma unroll
    for (int i = 0; i < 2; ++i) { const int ch = tid + i * NTHR, r = ch >> 4, d0 = (ch & 15) * 8;
        v4u kv = (v4u){0u, 0u, 0u, 0u}, vv = (v4u){0u, 0u, 0u, 0u};
        if (r < nvalid) { const size_t o = (size_t)(krow0 + r) * DA + h * HD + d0; kv = *(const v4u*)(KB + o); vv = *(const v4u*)(VB + o); }
        LAS float* kd = Kt + r * 129 + d0; LAS float* vd = Vt + r * 128 + d0;
        kd[0] = bflo(kv.x); kd[1] = bfhi(kv.x); kd[2] = bflo(kv.y); kd[3] = bfhi(kv.y); kd[4] = bflo(kv.z); kd[5] = bfhi(kv.z); kd[6] = bflo(kv.w); kd[7] = bfhi(kv.w);
        vd[0] = bflo(vv.x); vd[1] = bfhi(vv.x); vd[2] = bflo(vv.y); vd[3] = bfhi(vv.y); vd[4] = bflo(vv.z); vd[5] = bfhi(vv.z); vd[6] = bflo(vv.w); vd[7] = bfhi(vv.w); }
}
__device__ __forceinline__ void sb_unit_prompt(const Args& a, LAS unsigned char* lds, int unit) {
    const int tid = tid_opaque(), lane = tid & 63, w = tid >> 6;
    const int bh = unit >> 8, qb = unit & 255, b = bh >> 3, h = bh & 7, t = qb * 8 + w, row = b * SEQ + t;
    LAS float* Kt = (LAS float*)lds; LAS float* Vt = Kt + 64 * 129; LAS float* qs = Vt + 64 * 128;
    if (lane < 32) { const v2u qv = *(const v2u*)(WS_B(WS_QB) + (size_t)row * DA + h * HD + 4 * lane); LAS float* q = qs + w * HD + 4 * lane; q[0] = bflo(qv.x) * LN2; q[1] = bfhi(qv.x) * LN2; q[2] = bflo(qv.y) * LN2; q[3] = bfhi(qv.y) * LN2; }
    const float bias = IN_F(I_BSB)[h];
    float R = 0.f, o0 = 0.f, o1 = 0.f;
    for (int j = (qb * 8 + 6) >> 6; j >= 0; --j) {
        __syncthreads();
        sb_stage_bf16(a, Kt, Vt, b * SEQ + 64 * j, 64, h, tid);
        __syncthreads();
        int nvis = t - 64 * j; nvis = nvis < 0 ? 0 : (nvis > 64 ? 64 : nvis);
        sb_tile(Kt, Vt, qs + w * HD, bias, lane, nvis, R, o0, o1);
    }
    sb_finish(a, row, h, lane, o0, o1);
    __syncthreads();
}
__device__ __forceinline__ void sb_unit_sample(const Args& a, LAS unsigned char* lds, int unit) {
    const int tid = tid_opaque(), lane = tid & 63, w = tid >> 6;
    const int b = unit >> 3, h = unit & 7, row = MP + b * DECT + w;
    LAS float* Kt = (LAS float*)lds; LAS float* Vt = Kt + 64 * 129; LAS float* qs = Vt + 64 * 128;
    if (lane < 32) { const v2u qv = *(const v2u*)(WS_B(WS_QB) + (size_t)row * DA + h * HD + 4 * lane); LAS float* q = qs + w * HD + 4 * lane; q[0] = bflo(qv.x) * LN2; q[1] = bfhi(qv.x) * LN2; q[2] = bflo(qv.y) * LN2; q[3] = bfhi(qv.y) * LN2; }
    const float bias = IN_F(I_BSB)[h];
    float R = 0.f, o0 = 0.f, o1 = 0.f;
    __syncthreads();
    sb_stage_bf16(a, Kt, Vt, MP + b * DECT, DECT, h, tid);
    __syncthreads();
    sb_tile(Kt, Vt, qs + w * HD, bias, lane, w, R, o0, o1);
    const int* pt = (const int*)a.in[I_PT] + b * NPAGES;
    for (int j = PAST / 64 - 1; j >= 0; --j) {
        __syncthreads();
        { const int page = pt[j >> 1]; const size_t base = ((size_t)page * PAGE + (j & 1) * 64) * (NHEAD * HD) + h * HD;
          const float* ck = IN_F(I_CK) + base; const float* cv = IN_F(I_CV) + base;
#pragma unroll
          for (int i = 0; i < 4; ++i) { const int ch = tid + i * NTHR, r = ch >> 5, d0 = (ch & 31) * 4;
              const f32x4 kv = *(const f32x4*)(ck + (size_t)r * (NHEAD * HD) + d0), vv = *(const f32x4*)(cv + (size_t)r * (NHEAD * HD) + d0);
              LAS float* kd = Kt + r * 129 + d0; kd[0] = kv.x; kd[1] = kv.y; kd[2] = kv.z; kd[3] = kv.w;
              *(LAS f32x4*)(Vt + r * 128 + d0) = vv; } }
        __syncthreads();
        sb_tile(Kt, Vt, qs + w * HD, bias, lane, 64, R, o0, o1);
    }
    sb_finish(a, row, h, lane, o0, o1);
    __syncthreads();
}

typedef float f32x16 __attribute__((ext_vector_type(16)));
typedef short s16x4 __attribute__((ext_vector_type(4)));
typedef short v4i16_t __attribute__((ext_vector_type(4)));
typedef __bf16 bf16x2_t __attribute__((ext_vector_type(2)));
#define MFMA32(a, b, c) __builtin_amdgcn_mfma_f32_32x32x16_bf16((a), (b), (c), 0, 0, 0)

__device__ __forceinline__ unsigned cvtpk(float lo, float hi) { f32x2 v = {lo, hi}; bf16x2_t b = __builtin_convertvector(v, bf16x2_t); return __builtin_bit_cast(unsigned, b); }
template <int S> __device__ __forceinline__ bf16x8 pack8(const f32x16& x) {
    v4u p; p.x = cvtpk(x[8 * S + 0], x[8 * S + 1]); p.y = cvtpk(x[8 * S + 2], x[8 * S + 3]); p.z = cvtpk(x[8 * S + 4], x[8 * S + 5]); p.w = cvtpk(x[8 * S + 6], x[8 * S + 7]);
    return __builtin_bit_cast(bf16x8, p);
}
__device__ __forceinline__ unsigned off_a(unsigned row, unsigned ch) { return 2048u * (row >> 3) + 512u * (ch >> 2) + 64u * (row & 7) + 16u * ((ch & 3) ^ ((row >> 2) & 3)); }
__device__ __forceinline__ s16x4 vtr(const LAS unsigned char* p) { return __builtin_bit_cast(s16x4, __builtin_amdgcn_ds_read_tr16_b64_v4i16((LAS v4i16_t*)p)); }


template <bool DUAL, class Epi>
__device__ __forceinline__ void sgemm64_unit(const bf16* A, int K, const bf16* B0, const bf16* B1, LAS unsigned char* lds, const Epi& E) {
    const int tid = tid_opaque(), lane = tid & 63, w = tid >> 6, r = lane & 31, hh = lane >> 5;
    const int kw = K >> 3, k0 = w * kw, steps = kw >> 4;
    const bf16* pa0 = A + (size_t)r * K + k0 + 8 * hh; const bf16* pa1 = pa0 + (size_t)32 * K;
    const bf16* pb0 = B0 + (size_t)r * K + k0 + 8 * hh; const bf16* pb1 = B1 + (size_t)r * K + k0 + 8 * hh;
    f32x16 c00, c10, c01, c11;
#pragma unroll
    for (int i = 0; i < 16; ++i) { c00[i] = 0.f; c10[i] = 0.f; c01[i] = 0.f; c11[i] = 0.f; }
#pragma unroll 4
    for (int s = 0; s < steps; ++s) {
        const bf16x8 a0 = *(const bf16x8*)(pa0 + 16 * s), a1 = *(const bf16x8*)(pa1 + 16 * s), b0 = *(const bf16x8*)(pb0 + 16 * s);
        c00 = MFMA32(a0, b0, c00); c10 = MFMA32(a1, b0, c10);
        if constexpr (DUAL) { const bf16x8 b1 = *(const bf16x8*)(pb1 + 16 * s); c01 = MFMA32(a0, b1, c01); c11 = MFMA32(a1, b1, c11); }
    }
    constexpr int NT = DUAL ? 4 : 2;
    LAS float* red = (LAS float*)lds;
    __syncthreads();
#pragma unroll
    for (int i = 0; i < 16; ++i) { red[((w * NT + 0) * 16 + i) * 64 + lane] = c00[i]; red[((w * NT + 1) * 16 + i) * 64 + lane] = c10[i];
        if constexpr (DUAL) { red[((w * NT + 2) * 16 + i) * 64 + lane] = c01[i]; red[((w * NT + 3) * 16 + i) * 64 + lane] = c11[i]; } }
    __syncthreads();
#pragma unroll
    for (int j = 0; j < 4; ++j) { const int idx = tid + NTHR * j, mt = idx >> 10, reg = (idx >> 6) & 15, ln = idx & 63;
        float v0 = 0.f, v1 = 0.f;
#pragma unroll
        for (int ww = 0; ww < 8; ++ww) { v0 += red[((ww * NT + mt) * 16 + reg) * 64 + ln]; if constexpr (DUAL) v1 += red[((ww * NT + 2 + mt) * 16 + reg) * 64 + ln]; }
        E(32 * mt + (reg & 3) + 8 * (reg >> 2) + 4 * (ln >> 5), ln & 31, v0, v1); }
}
__device__ __forceinline__ void proj_store_sample(unsigned char* ws, float* out, int sr, int c, float v) {
    const int rng = c >> 10, cc = c & 1023; const size_t o = (size_t)(MP + sr) * DA + cc;
    if (rng == 1) { const float l = ((const float*)(ws + WS_LBV))[cc]; ((float*)(ws + WS_LF))[o] = __builtin_amdgcn_logf(l + (1.f - l) * sigmoid_f(v)); return; }
    if (rng == 5) out[OFF_KS + (size_t)sr * DA + cc] = v;
    if (rng == 6) out[OFF_VS + (size_t)sr * DA + cc] = v;
    if (rng == 0) v *= QSCALE; if (rng == 4) v *= QSCALE * LOG2E; if (rng == 3) v = silu_f(v);
    bf16* B = (bf16*)(ws + WS_QA + (size_t)(rng == 0 ? 0 : rng - 1) * (WS_IA - WS_QA));
    B[o] = (bf16)f2bf(v);
}
struct SEpiSwiGLU { bf16* H; int col0; __device__ __forceinline__ void operator()(int row, int col, float g, float u) const { H[(size_t)(MP + row) * DFF + col0 + col] = (bf16)f2bf(silu_f(g) * u); } };
struct SEpiResid { const float* base  ; float* X; const float* gate; float scale; int col0;
    __device__ __forceinline__ void operator()(int row, int col, float v, float) const { const int c = col0 + col;
        X[(size_t)(MP + row) * DM + c] = base[(size_t)row * DM + c] + scale * gate[(size_t)(4 + (row >> 3)) * NMODC + c] * v; } };
struct SEpiProj { unsigned char* ws; float* out; int col0; __device__ __forceinline__ void operator()(int row, int col, float v, float) const { proj_store_sample(ws, out, row, col0 + col, v); } };

template <int WHICH> __device__ __forceinline__ void phase_gemm(const Args& a, LAS unsigned char* lds, int bid, int nblk) {
    using namespace pg8;
    if constexpr (WHICH == 1 || WHICH == 5) {
        const bf16* W = WS_B(WHICH == 1 ? WS_WGU1 : WS_WGU2);
        Gemm g{WS_B(WS_XN), W, MP, 2 * DFF, DM}; StaticOrder S; S.init(MP, 2 * DFF, nblk, bid);
        EpiSwiGLU E{WS_B(WS_H), DFF};
        gemm_phase<EpiSwiGLU, StaticOrder, true, true>(lds, g, S, E);
        for (int j = bid - nblk / 2; j >= 0 && j < DFF / 32; j += nblk / 2) { const int n0 = 32 * j, wrow = (n0 >> 7) * 256 + (n0 & 127);
            SEpiSwiGLU SE{WS_B(WS_H), n0};
            sgemm64_unit<true>(WS_B(WS_XN) + (size_t)MP * DM, DM, W + (size_t)wrow * DM, W + (size_t)(wrow + 128) * DM, lds, SE); }
    } else if constexpr (WHICH == 2 || WHICH == 6) {
        const bf16* W = WS_B(WHICH == 2 ? WS_WD1 : WS_WD2);
        Gemm g{WS_B(WS_H), W, MP, DM, DFF}; StaticOrder S; S.init(MP, DM, nblk, bid);
        EpiResid E{WHICH == 2 ? IN_F(I_XP) : nullptr, IN_F(I_XS), WS_F(WS_X), WS_F(WS_MOD) + (WHICH == 2 ? 2 : 8) * DM, 0.5f};
        gemm_phase<EpiResid, StaticOrder, true, true>(lds, g, S, E);
        for (int j = bid; j < DM / 32; j += nblk) {
            SEpiResid SE{WHICH == 2 ? IN_F(I_XS) : WS_F(WS_X) + (size_t)MP * DM, WS_F(WS_X), WS_F(WS_MOD) + (WHICH == 2 ? 2 : 8) * DM, 0.5f, 32 * j};
            sgemm64_unit<false>(WS_B(WS_H) + (size_t)MP * DFF, DFF, W + (size_t)(32 * j) * DFF, W, lds, SE); }
    } else if constexpr (WHICH == 3) {
        Gemm g{WS_B(WS_XN), WS_B(WS_WIN), MP, DIN, DM}; StaticOrder S; S.init(MP, DIN, nblk, bid);
        EpiProj E{a.ws, WS_F(WS_LF), a.out, WS_F(WS_LBV)};
        gemm_phase<EpiProj, StaticOrder, true, true>(lds, g, S, E);
        for (int j = bid - nblk / 2; j >= 0 && j < DIN / 32; j += nblk / 2) {
            SEpiProj SE{a.ws, a.out, 32 * j};
            sgemm64_unit<false>(WS_B(WS_XN) + (size_t)MP * DM, DM, WS_B(WS_WIN) + (size_t)(32 * j) * DM, WS_B(WS_WIN), lds, SE); }
    } else {
        Gemm g{WS_B(WS_OM), WS_B(WS_WOUT), MP, DM, DM}; StaticOrder S; S.init(MP, DM, nblk, bid);
        EpiResid E{nullptr, IN_F(I_XS), WS_F(WS_X), WS_F(WS_MOD) + 5 * DM, 1.0f};
        gemm_phase<EpiResid, StaticOrder, true, true>(lds, g, S, E);
        for (int j = bid; j < DM / 32; j += nblk) {
            SEpiResid SE{WS_F(WS_X) + (size_t)MP * DM, WS_F(WS_X), WS_F(WS_MOD) + 5 * DM, 1.0f, 32 * j};
            sgemm64_unit<false>(WS_B(WS_OM) + (size_t)MP * DM, DM, WS_B(WS_WOUT) + (size_t)(32 * j) * DM, WS_B(WS_WOUT), lds, SE); }
    }
}

constexpr size_t WS_QD = WS_PART + 48 * MiB, WS_KI = WS_QD + 17 * MiB, WS_DEC = WS_KI + 17 * MiB;
static_assert(WS_DEC + 2 * MiB <= 700 * MiB, "workspace map");
__device__ __forceinline__ void phase_hprep(const Args& a, int bid, int nblk) {
    const int tid = tid_opaque(), lane = tid & 63, w = tid >> 6;
    const float* LF = WS_F(WS_LF); const bf16* QA = WS_B(WS_QA);
    for (int item = bid * NWAVES + w; item < NB * NHEAD * (SEQ / 32); item += nblk * NWAVES) {
        const int u = item >> 6, c = item & 63, b = u >> 3, h = u & 7;
        const size_t g0 = (size_t)(b * SEQ + 32 * c) * DA + h * HD + 2 * lane;
        f32x2 bc = (f32x2){0.f, 0.f};
#pragma unroll 8
        for (int t = 0; t < 32; ++t) {
            const size_t o = g0 + (size_t)t * DA;
            const f32x2 l = *(const f32x2*)(LF + o); const unsigned q = *(const unsigned*)(QA + o);
            bc += l;
            const float k0 = 1.f - __builtin_amdgcn_exp2f(l.x), k1 = 1.f - __builtin_amdgcn_exp2f(l.y);
            const float e0 = __builtin_amdgcn_exp2f(bc.x), e1 = __builtin_amdgcn_exp2f(bc.y);
            const float n0 = __builtin_amdgcn_exp2f(-bc.x), n1 = __builtin_amdgcn_exp2f(-bc.y);
            *(unsigned*)(WS_B(WS_QD) + o) = cvtpk(bflo(q) * e0, bfhi(q) * e1);
            *(unsigned*)(WS_B(WS_KI) + o) = cvtpk(k0 * n0, k1 * n1);
        }
        const f32x2 tot = bc;
        *(f32x2*)(WS_F(WS_DEC) + ((size_t)u * 64 + c) * HD + 2 * lane) = (f32x2){__builtin_amdgcn_exp2f(tot.x), __builtin_amdgcn_exp2f(tot.y)};
    }
}

constexpr int HG_BUF = 25600, HG_QD = 0, HG_KI = 8192, HG_VV = 16384, HG_DEC = 24576, HG_SSX = 2 * HG_BUF;

__device__ __forceinline__ void hgrn_chain_prompt(const Args& a, LAS unsigned char* lds, int u) {
    const int tid = tid_opaque(), lane = tid & 63, w = __builtin_amdgcn_readfirstlane(tid >> 6);
    const int b = u >> 3, h = u & 7, row00 = b * SEQ;
    const bf16* IA = WS_B(WS_IA); const bf16* GA = WS_B(WS_GA);
    constexpr int NCH = SEQ / 32;
    if (w >= 4) {
        const int pt = tid - 256;
        const bf16* QD = WS_B(WS_QD); const bf16* KI = WS_B(WS_KI); const float* DEC = WS_F(WS_DEC) + (size_t)u * 64 * HD;
        const int row0 = pt >> 4, ch = pt & 15;
        const size_t gsrc = (size_t)(row00 + row0) * DA + h * HD + 8 * ch;
        const unsigned ld0 = off_a(row0, ch), ld1 = off_a(row0 + 16, ch);
        v4u rA[6], rB[6]; float dA = 0.f, dB = 0.f;
#define HG_LOAD(R, D, cc) do { const size_t o_ = gsrc + (size_t)(cc) * 32 * DA; R[0] = *(const v4u*)(QD + o_); R[1] = *(const v4u*)(QD + o_ + 16 * DA); R[2] = *(const v4u*)(KI + o_); R[3] = *(const v4u*)(KI + o_ + 16 * DA); \
            R[4] = *(const v4u*)(IA + o_); R[5] = *(const v4u*)(IA + o_ + 16 * DA); if (pt < 128) D = DEC[(size_t)(cc) * HD + pt]; } while (0)
#define HG_WRITE(R, D, cc) do { LAS unsigned char* b_ = lds + ((cc) & 1) * HG_BUF; *(LAS v4u*)(b_ + HG_QD + ld0) = R[0]; *(LAS v4u*)(b_ + HG_QD + ld1) = R[1]; *(LAS v4u*)(b_ + HG_KI + ld0) = R[2]; *(LAS v4u*)(b_ + HG_KI + ld1) = R[3]; \
            *(LAS v4u*)(b_ + HG_VV + ld0) = R[4]; *(LAS v4u*)(b_ + HG_VV + ld1) = R[5]; if (pt < 128) *(LAS float*)(b_ + HG_DEC + 4 * pt) = D; } while (0)
        HG_LOAD(rA, dA, 0); HG_LOAD(rB, dB, 1);
        for (int c = 0; c < NCH; c += 2) {
            HG_WRITE(rA, dA, c); if (c + 2 < NCH) HG_LOAD(rA, dA, c + 2);
            __syncthreads();
            HG_WRITE(rB, dB, c + 1); if (c + 3 < NCH) HG_LOAD(rB, dB, c + 3);
            __syncthreads();
        }
#undef HG_LOAD
#undef HG_WRITE
        __syncthreads();
    } else {
        const int r = lane & 31, hh = lane >> 5, q4 = (lane & 15) >> 2, p4 = lane & 3, blk = (lane >> 4) & 1;
        int pb[4];
#pragma unroll
        for (int x = 0; x < 4; ++x) pb[x] = (int)(2048u * (r >> 3) + 64u * (r & 7) + 16u * ((unsigned)x ^ ((r >> 2) & 3)) + 8u * hh);
        const int vp0 = (int)(64u * (4 * hh + q4) + 16u * ((2 * blk + (p4 >> 1)) ^ ((0u + hh) & 3)) + 8u * (p4 & 1));
        const int vp1 = (int)(2048u + 64u * (4 * hh + q4) + 16u * ((2 * blk + (p4 >> 1)) ^ ((2u + hh) & 3)) + 8u * (p4 & 1));
        const int nb0 = (int)(2048u * hh + 64u * q4 + 16u * ((2 * blk + (p4 >> 1)) ^ ((2u * hh) & 3)) + 8u * (p4 & 1));
        const int nb1 = (int)(2048u * hh + 64u * (4 + q4) + 16u * ((2 * blk + (p4 >> 1)) ^ ((2u * hh + 1) & 3)) + 8u * (p4 & 1));
        const int tm = r - 4 * hh;
        f32x16 S[4];
#pragma unroll
        for (int kt = 0; kt < 4; ++kt)
#pragma unroll
            for (int i = 0; i < 16; ++i) S[kt][i] = 0.f;
        f32x16 oprev;
#pragma unroll
        for (int i = 0; i < 16; ++i) oprev[i] = 0.f;
        const float* gwv = IN_F(I_GOA) + h * HD + 32 * w;
        __syncthreads();
        for (int c = 0; c < NCH; ++c) {
            const LAS unsigned char* buf = lds + (c & 1) * HG_BUF;
            if (c > 0) {
                const LAS float* sx = (const LAS float*)(lds + HG_SSX) + ((c - 1) & 1) * 128 + r;
                const float ss = (sx[0] + sx[32]) + (sx[64] + sx[96]);
                const float rstd = 1.0f / sqrtf(ss * (1.f / HD) + EPS);
                const size_t row = (size_t)(row00 + 32 * (c - 1) + r);
#pragma unroll
                for (int g = 0; g < 4; ++g) { const int dv = 32 * w + 8 * g + 4 * hh; const f32x4 gv = *(const f32x4*)(gwv + 8 * g + 4 * hh);
                    const v2u gt = *(const v2u*)(GA + row * DA + h * HD + dv);
                    v2u o2; o2.x = cvtpk(oprev[4 * g] * rstd * gv.x * bflo(gt.x), oprev[4 * g + 1] * rstd * gv.y * bfhi(gt.x));
                    o2.y = cvtpk(oprev[4 * g + 2] * rstd * gv.z * bflo(gt.y), oprev[4 * g + 3] * rstd * gv.w * bfhi(gt.y));
                    *(v2u*)(WS_B(WS_OM) + row * DM + h * HD + dv) = o2; }
            }
            bf16x8 qd[8];
#pragma unroll
            for (int ks = 0; ks < 8; ++ks) { const v2u lo = *(const LAS v2u*)(buf + HG_QD + pb[2 * (ks & 1)] + 512 * (ks >> 1)), hi = *(const LAS v2u*)(buf + HG_QD + pb[2 * (ks & 1) + 1] + 512 * (ks >> 1));
                qd[ks] = __builtin_bit_cast(bf16x8, (v4u){lo.x, lo.y, hi.x, hi.y}); }
            f32x16 at;
#pragma unroll
            for (int i = 0; i < 16; ++i) at[i] = 0.f;
#pragma unroll
            for (int ks = 0; ks < 8; ++ks) { const v2u lo = *(const LAS v2u*)(buf + HG_KI + pb[2 * (ks & 1)] + 512 * (ks >> 1)), hi = *(const LAS v2u*)(buf + HG_KI + pb[2 * (ks & 1) + 1] + 512 * (ks >> 1));
                at = MFMA32(__builtin_bit_cast(bf16x8, (v4u){lo.x, lo.y, hi.x, hi.y}), qd[ks], at); }
            f32x16 o;
#pragma unroll
            for (int i = 0; i < 16; ++i) o[i] = 0.f;
#pragma unroll
            for (int kt = 0; kt < 4; ++kt) { o = MFMA32(pack8<0>(S[kt]), qd[2 * kt], o); o = MFMA32(pack8<1>(S[kt]), qd[2 * kt + 1], o); }
#pragma unroll
            for (int i = 0; i < 16; ++i) at[i] = ((i & 3) + 8 * (i >> 2) <= tm) ? at[i] : 0.f;
            { const bf16x8 p0 = pack8<0>(at), p1 = pack8<1>(at);
              const LAS unsigned char* vv = buf + HG_VV + 512 * w;
              { const s16x4 lo = vtr(vv + vp0), hi = vtr(vv + vp1); o = MFMA32(__builtin_shufflevector(lo, hi, 0, 1, 2, 3, 4, 5, 6, 7), p0, o); }
              { const s16x4 lo = vtr(vv + vp0 + 4096), hi = vtr(vv + vp1 + 4096); o = MFMA32(__builtin_shufflevector(lo, hi, 0, 1, 2, 3, 4, 5, 6, 7), p1, o); } }
            { const LAS unsigned char* vv = buf + HG_VV + 512 * w;
              const s16x4 a0 = vtr(vv + nb0), a1 = vtr(vv + nb1), a2 = vtr(vv + nb0 + 4096), a3 = vtr(vv + nb1 + 4096);
              const bf16x8 vf0 = __builtin_shufflevector(a0, a1, 0, 1, 2, 3, 4, 5, 6, 7), vf1 = __builtin_shufflevector(a2, a3, 0, 1, 2, 3, 4, 5, 6, 7);
#pragma unroll
              for (int kt = 0; kt < 4; ++kt) {
                  const LAS unsigned char* ki = buf + HG_KI + 512 * kt;
                  const s16x4 k0 = vtr(ki + nb0), k1 = vtr(ki + nb1), k2 = vtr(ki + nb0 + 4096), k3 = vtr(ki + nb1 + 4096);
                  S[kt] = MFMA32(__builtin_shufflevector(k0, k1, 0, 1, 2, 3, 4, 5, 6, 7), vf0, S[kt]);
                  S[kt] = MFMA32(__builtin_shufflevector(k2, k3, 0, 1, 2, 3, 4, 5, 6, 7), vf1, S[kt]);
#pragma unroll
                  for (int g = 0; g < 4; ++g) { const f32x4 dc = *(const LAS f32x4*)(buf + HG_DEC + 4 * (32 * kt + 8 * g + 4 * hh));
                      S[kt][4 * g] *= dc.x; S[kt][4 * g + 1] *= dc.y; S[kt][4 * g + 2] *= dc.z; S[kt][4 * g + 3] *= dc.w; }
              } }
            { float ss = 0.f;
#pragma unroll
              for (int i = 0; i < 16; ++i) ss += o[i] * o[i];
              ss += __shfl_xor(ss, 32);
              if (hh == 0) ((LAS float*)(lds + HG_SSX))[(c & 1) * 128 + w * 32 + r] = ss; }
            oprev = o;
            __syncthreads();
        }
        {
            const LAS float* sx = (const LAS float*)(lds + HG_SSX) + ((NCH - 1) & 1) * 128 + r;
            const float ss = (sx[0] + sx[32]) + (sx[64] + sx[96]);
            const float rstd = 1.0f / sqrtf(ss * (1.f / HD) + EPS);
            const size_t row = (size_t)(row00 + 32 * (NCH - 1) + r);
#pragma unroll
            for (int g = 0; g < 4; ++g) { const int dv = 32 * w + 8 * g + 4 * hh; const f32x4 gv = *(const f32x4*)(gwv + 8 * g + 4 * hh);
                const v2u gt = *(const v2u*)(GA + row * DA + h * HD + dv);
                v2u o2; o2.x = cvtpk(oprev[4 * g] * rstd * gv.x * bflo(gt.x), oprev[4 * g + 1] * rstd * gv.y * bfhi(gt.x));
                o2.y = cvtpk(oprev[4 * g + 2] * rstd * gv.z * bflo(gt.y), oprev[4 * g + 3] * rstd * gv.w * bfhi(gt.y));
                *(v2u*)(WS_B(WS_OM) + row * DM + h * HD + dv) = o2; }
        }
        float* sout = a.out + OFF_SP + (size_t)u * HD * HD;
#pragma unroll
        for (int kt = 0; kt < 4; ++kt)
#pragma unroll
            for (int i = 0; i < 16; ++i) sout[(size_t)(32 * kt + (i & 3) + 8 * (i >> 2) + 4 * hh) * HD + 32 * w + r] = S[kt][i];
    }
}
struct SbLane {
    int kb0, kb1;
    int vb0, vb1;
    bf16x8 nu0, nu1;
};
__device__ __forceinline__ SbLane sb_lane_init(int lane) {
    SbLane L; const unsigned r = lane & 31, h = lane >> 5, q = (lane & 15) >> 2, p = lane & 3, blk = (lane >> 4) & 1;
    L.kb0 = (int)(2048u * (r >> 3) + 64u * (r & 7) + 16u * ((0u + h) ^ ((r >> 2) & 3)));
    L.kb1 = (int)(2048u * (r >> 3) + 64u * (r & 7) + 16u * ((2u + h) ^ ((r >> 2) & 3)));
    L.vb0 = (int)(64u * (4 * h + q) + 16u * ((2 * blk + (p >> 1)) ^ ((0u + h) & 3)) + 8u * (p & 1));
    L.vb1 = (int)(2048u + 64u * (4 * h + q) + 16u * ((2 * blk + (p >> 1)) ^ ((2u + h) & 3)) + 8u * (p & 1));
#pragma unroll
    for (int j = 0; j < 8; ++j) { const unsigned k0 = 8 * (j >> 2) + 4 * h + (j & 3), k1 = 16 + k0;
        L.nu0[j] = (k0 >= r) ? (short)0xBF80 : (short)0; L.nu1[j] = (k1 >= r) ? (short)0xBF80 : (short)0; }
    return L;
}
__device__ __forceinline__ void sbm_step(const LAS unsigned char* kt, const LAS unsigned char* vt, const LAS unsigned char* qfl  , int qstride, float bias2, const SbLane& L, f32x16 (&o)[4], float& R, int lane, int tq) {
    f32x16 zt;
#pragma unroll
    for (int r = 0; r < 16; ++r) zt[r] = bias2;
#pragma unroll
    for (int s = 0; s < 8; ++s) { const bf16x8 kf = *(const LAS bf16x8*)(kt + ((s & 1) ? L.kb1 : L.kb0) + 512 * (s >> 1)); const bf16x8 qf = *(const LAS bf16x8*)(qfl + qstride * s); zt = MFMA32(kf, qf, zt); }
    f32x16 sp, cin;
#pragma unroll
    for (int r = 0; r < 16; ++r) {
        const float e = __builtin_amdgcn_exp2f(zt[r]); float l = __builtin_amdgcn_logf(1.f + e); l = zt[r] > 30.f ? zt[r] : l;
        l = ((r & 3) + 8 * (r >> 2) < tq) ? l : 0.f;
        sp[r] = l; cin[r] = zt[r] + R;
    }
    f32x16 out = MFMA32(L.nu0, pack8<0>(sp), cin);
    out = MFMA32(L.nu1, pack8<1>(sp), out);
    const float rn = out[0] - zt[0];
    R = __shfl(rn, lane & 31);
    f32x16 p;
#pragma unroll
    for (int r = 0; r < 16; ++r) { float v = __builtin_amdgcn_exp2f(out[r]); v = ((r & 3) + 8 * (r >> 2) < tq) ? v : 0.f; p[r] = v; }
    const bf16x8 p0 = pack8<0>(p), p1 = pack8<1>(p);
#pragma unroll
    for (int c = 0; c < 4; ++c) {
        { const s16x4 lo = vtr(vt + L.vb0 + 512 * c), hi = vtr(vt + L.vb1 + 512 * c); const bf16x8 vf = __builtin_shufflevector(lo, hi, 0, 1, 2, 3, 4, 5, 6, 7); o[c] = MFMA32(vf, p0, o[c]); }
        { const s16x4 lo = vtr(vt + L.vb0 + 4096 + 512 * c), hi = vtr(vt + L.vb1 + 4096 + 512 * c); const bf16x8 vf = __builtin_shufflevector(lo, hi, 0, 1, 2, 3, 4, 5, 6, 7); o[c] = MFMA32(vf, p1, o[c]); }
    }
}
__device__ __forceinline__ void sbm_finish(const Args& a, const f32x16 (&o)[4], int row, int h, int lane) {
    float ss = 0.f;
#pragma unroll
    for (int c = 0; c < 4; ++c)
#pragma unroll
        for (int r = 0; r < 16; ++r) ss += o[c][r] * o[c][r];
    ss += __shfl_xor(ss, 32);
    const float rstd = 1.0f / sqrtf(ss * (1.f / HD) + EPS);
    const int hh = lane >> 5; const float* gw = IN_F(I_GOB) + h * HD; bf16* dst = WS_B(WS_OM) + (size_t)row * DM + DA + h * HD;
#pragma unroll
    for (int c = 0; c < 4; ++c)
#pragma unroll
        for (int g = 0; g < 4; ++g) { const int d = 32 * c + 8 * g + 4 * hh; const f32x4 gv = *(const f32x4*)(gw + d);
            v2u w; w.x = cvtpk(o[c][4 * g + 0] * rstd * gv.x, o[c][4 * g + 1] * rstd * gv.y); w.y = cvtpk(o[c][4 * g + 2] * rstd * gv.z, o[c][4 * g + 3] * rstd * gv.w);
            *(v2u*)(dst + d) = w; }
}
__device__ __forceinline__ void sbm_unit_prompt(const Args& a, LAS unsigned char* lds, int bh, int qb) {
    const int tid = tid_opaque(), lane = tid & 63, w = __builtin_amdgcn_readfirstlane(tid >> 6);
    const int b = bh >> 3, h = bh & 7, q0 = 256 * qb + 32 * w, idiag = 8 * qb + w;
    const SbLane L = sb_lane_init(lane);
    const bf16* QB = WS_B(WS_QB); const bf16* KB = WS_B(WS_KB); const bf16* VB = WS_B(WS_VB);
    LAS unsigned char* qfl = lds + 65536 + w * 8192 + lane * 16;
    { const bf16* qp = QB + (size_t)(b * SEQ + q0 + (lane & 31)) * DA + h * HD + 8 * (lane >> 5);
#pragma unroll
      for (int s = 0; s < 8; ++s) *(LAS bf16x8*)(qfl + 1024 * s) = *(const bf16x8*)(qp + 16 * s); }
    const float bias2 = IN_F(I_BSB)[h] * LOG2E;
    f32x16 o[4];
#pragma unroll
    for (int c = 0; c < 4; ++c)
#pragma unroll
        for (int r = 0; r < 16; ++r) o[c][r] = 0.f;
    float R = 0.f; const int tq = (lane & 31) - 4 * (lane >> 5);
    const int key0 = tid >> 4, ch = tid & 15;
    const size_t gsrc = (size_t)(b * SEQ + key0) * DA + h * HD + 8 * ch;
    const unsigned ldst = off_a(key0 & 31, ch);
    v4u kr[2], vr[2];
    int j = 4 * qb + 3;
#define SBM_LOAD(jj) do { const size_t o_ = gsrc + (size_t)(jj) * 64 * DA; kr[0] = *(const v4u*)(KB + o_); vr[0] = *(const v4u*)(VB + o_); kr[1] = *(const v4u*)(KB + o_ + 32 * DA); vr[1] = *(const v4u*)(VB + o_ + 32 * DA); } while (0)
#define SBM_WRITE(buf) do { LAS unsigned char* b_ = lds + (buf) * 32768; *(LAS v4u*)(b_ + ldst) = kr[0]; *(LAS v4u*)(b_ + 8192 + ldst) = kr[1]; *(LAS v4u*)(b_ + 16384 + ldst) = vr[0]; *(LAS v4u*)(b_ + 16384 + 8192 + ldst) = vr[1]; } while (0)
    SBM_LOAD(j); SBM_WRITE(0);
    __syncthreads();
    int cur = 0;
    for (; j >= 0; --j) {
        if (j > 0) SBM_LOAD(j - 1);
        const LAS unsigned char* kb_ = lds + cur * 32768; const LAS unsigned char* vb_ = kb_ + 16384;
#pragma unroll 1
        for (int tt = 1; tt >= 0; --tt) { const int ti = 2 * j + tt;
            if (ti <= idiag) sbm_step(kb_ + tt * 8192, vb_ + tt * 8192, qfl, 1024, bias2, L, o, R, lane, ti == idiag ? tq : 64); }
        if (j > 0) SBM_WRITE(cur ^ 1);
        __syncthreads();
        cur ^= 1;
    }
#undef SBM_LOAD
#undef SBM_WRITE
    sbm_finish(a, o, b * SEQ + q0 + (lane & 31), h, lane);
}


constexpr int SEGK = 256, NSEG = PAST / SEGK, PART_STRIDE = 132;
__device__ __forceinline__ void sbm_unit_sample(const Args& a, LAS unsigned char* lds, int b, int seg) {
    const int tid = tid_opaque(), lane = tid & 63, w = __builtin_amdgcn_readfirstlane(tid >> 6);
    const SbLane L = sb_lane_init(lane);
    LAS unsigned char* kimg = lds + w * 16384; LAS unsigned char* vimg = kimg + 8192;
    LAS unsigned char* qreg = lds + 131072 + w * 2048;
    LAS unsigned char* zchunk = lds + 131072 + 16384 + w * 16;
    const int r = lane & 31, hh = lane >> 5;
    if (r < 8) { const bf16* qp = WS_B(WS_QB) + (size_t)(MP + b * DECT + r) * DA + w * HD + 8 * hh;
#pragma unroll
        for (int s = 0; s < 8; ++s) *(LAS bf16x8*)(qreg + (s * 16 + hh * 8 + r) * 16) = *(const bf16x8*)(qp + 16 * s); }
    if (lane == 0) { unsigned z_ = 0u; asm volatile("" : "+v"(z_)); *(LAS v4u*)zchunk = (v4u){z_, z_, z_, z_}; }
    const LAS unsigned char* qfl = r < 8 ? qreg + (hh * 8 + r) * 16 : zchunk; const int qstride = r < 8 ? 256 : 0;
    const float bias2 = IN_F(I_BSB)[w] * LOG2E;
    f32x16 o[4];
#pragma unroll
    for (int c = 0; c < 4; ++c)
#pragma unroll
        for (int q = 0; q < 16; ++q) o[c][q] = 0.f;
    float R = 0.f;
    LDS_WAIT();
    if (seg == NSEG - 1) {
        { const int j = lane >> 3, c2 = (lane & 7) * 2; const size_t src = (size_t)(MP + b * DECT + j) * DA + w * HD + 8 * c2;
          const v4u k0 = *(const v4u*)(WS_B(WS_KB) + src), k1 = *(const v4u*)(WS_B(WS_KB) + src + 8), v0 = *(const v4u*)(WS_B(WS_VB) + src), v1 = *(const v4u*)(WS_B(WS_VB) + src + 8);
          *(LAS v4u*)(kimg + off_a(j, c2)) = k0; *(LAS v4u*)(kimg + off_a(j, c2 + 1)) = k1; *(LAS v4u*)(vimg + off_a(j, c2)) = v0; *(LAS v4u*)(vimg + off_a(j, c2 + 1)) = v1; }
        { unsigned z_ = 0u; asm volatile("" : "+v"(z_)); const v4u zz = (v4u){z_, z_, z_, z_};
#pragma unroll
        for (int i = 0; i < 6; ++i) { const int n = lane + 64 * i, row = 8 + (n >> 4), c1 = n & 15; *(LAS v4u*)(kimg + off_a(row, c1)) = zz; *(LAS v4u*)(vimg + off_a(row, c1)) = zz; } }
        LDS_WAIT();
        sbm_step(kimg, vimg, qfl, qstride, bias2, L, o, R, lane, r - 4 * hh);
        LDS_WAIT();
    }
    const int* pt = (const int*)a.in[I_PT] + b * NPAGES;
    const float* ck = IN_F(I_CK); const float* cv = IN_F(I_CV);
    const int ch = r >> 1; const unsigned wconst = 512u * (ch >> 2) + 64u * hh + 8u * (lane & 1);
    f32x4 kr[8], vr[8];
#define SBS_LOAD(ti, hf) do { const int p_ = seg * SEGK + 32 * (ti); const size_t base_ = ((size_t)pt[p_ >> 7] * PAGE + (p_ & 127) + 16 * (hf) + hh) * (NHEAD * HD) + w * HD + 4 * r; \
        _Pragma("unroll") for (int i_ = 0; i_ < 8; ++i_) { kr[i_] = *(const f32x4*)(ck + base_ + (size_t)(2 * i_) * (NHEAD * HD)); vr[i_] = *(const f32x4*)(cv + base_ + (size_t)(2 * i_) * (NHEAD * HD)); } } while (0)
#define SBS_WRITE(hf) do { _Pragma("unroll") for (int i_ = 0; i_ < 8; ++i_) { \
        const unsigned off_ = 2048u * (2 * (hf) + (i_ >> 2)) + 64u * (2 * (i_ & 3)) + 16u * ((unsigned)(ch & 3) ^ (unsigned)((i_ >> 1) & 3)) + wconst; \
        v2u kk_, vv_; kk_.x = cvtpk(kr[i_].x, kr[i_].y); kk_.y = cvtpk(kr[i_].z, kr[i_].w); vv_.x = cvtpk(vr[i_].x, vr[i_].y); vv_.y = cvtpk(vr[i_].z, vr[i_].w); \
        *(LAS v2u*)(kimg + off_) = kk_; *(LAS v2u*)(vimg + off_) = vv_; } } while (0)
    SBS_LOAD(SEGK / 32 - 1, 1);
#pragma unroll 1
    for (int ti = SEGK / 32 - 1; ti >= 0; --ti) {
        SBS_WRITE(1);
        SBS_LOAD(ti, 0);
        SBS_WRITE(0);
        if (ti > 0) SBS_LOAD(ti - 1, 1);
        LDS_WAIT();
        sbm_step(kimg, vimg, qfl, qstride, bias2, L, o, R, lane, 64);
        LDS_WAIT();
    }
#undef SBS_LOAD
#undef SBS_WRITE
    if (r < 8) { float* dst = WS_F(WS_PART) + ((((size_t)b * NSEG + seg) * NHEAD + w) * 8 + r) * PART_STRIDE;
#pragma unroll
        for (int c = 0; c < 4; ++c)
#pragma unroll
            for (int g = 0; g < 4; ++g) *(f32x4*)(dst + 32 * c + 8 * g + 4 * hh) = (f32x4){o[c][4 * g], o[c][4 * g + 1], o[c][4 * g + 2], o[c][4 * g + 3]};
        if (hh == 0) dst[128] = R; }
}
__device__ __forceinline__ void phase_sbcombine(const Args& a, int bid, int nblk) {
    const int tid = tid_opaque(), lane = tid & 63, w = tid >> 6;
    static_assert(NSEG == 64, "one lane per segment");
    for (int item = bid * NWAVES + w; item < DECB * NHEAD * 8; item += nblk * NWAVES) {
        const int b = item >> 6, h = (item >> 3) & 7, i = item & 7;
        const float* p0 = WS_F(WS_PART) + (((size_t)b * NSEG * NHEAD + h) * 8 + i) * PART_STRIDE;
        const size_t sstride = (size_t)NHEAD * 8 * PART_STRIDE;
        const float rseg = p0[(size_t)lane * sstride + 128];
        float suf = rseg;
#pragma unroll
        for (int off = 1; off < 64; off <<= 1) { const float t = __shfl_down(suf, off); if (lane + off < 64) suf += t; }
        const float fac = __builtin_amdgcn_exp2f(suf - rseg);
        float o0 = 0.f, o1 = 0.f;
#pragma unroll 8
        for (int s = 0; s < NSEG; ++s) { const float f = __builtin_bit_cast(float, __builtin_amdgcn_readlane(__builtin_bit_cast(int, fac), s));
            o0 += f * p0[(size_t)s * sstride + lane]; o1 += f * p0[(size_t)s * sstride + 64 + lane]; }
        const float ss = wave_sum(o0 * o0 + o1 * o1);
        const float rstd = 1.0f / sqrtf(ss * (1.f / HD) + EPS);
        const float* gw = IN_F(I_GOB) + h * HD; bf16* dst = WS_B(WS_OM) + (size_t)(MP + b * DECT + i) * DM + DA + h * HD;
        dst[lane] = (bf16)f2bf(o0 * rstd * gw[lane]); dst[64 + lane] = (bf16)f2bf(o1 * rstd * gw[64 + lane]);
    }
}

constexpr int CTL_MIXQ = 4096;
__device__ __forceinline__ int queue_next(const Args& a, LAS unsigned char* lds, int tid, int qword) {
    LAS int* slot = (LAS int*)(lds + LDS_BYTES - 64);
    __syncthreads();
    if (tid == 0) *slot = (int)__hip_atomic_fetch_add((unsigned*)(a.ws + WS_CTL) + qword, 1u, __ATOMIC_RELAXED, __HIP_MEMORY_SCOPE_AGENT);
    __syncthreads();
    return *slot;
}
__device__ __forceinline__ void phase_mixer(const Args& a, LAS unsigned char* lds, int bid, int nblk, int qword = CTL_MIXQ, int ulo = 0, int uhi = 1 << 30) {
    const int tid = tid_opaque();
    constexpr int U0 = 32, U1 = U0 + 256, U2 = U1 + DECB * NSEG, U3 = U2 + 64;
    for (;;) {
        const int u = queue_next(a, lds, tid, qword) + ulo;
        if (u >= U3 || u >= uhi) break;
        if (u < U0) hgrn_chain_prompt(a, lds, u);
        else if (u < U1) { const int v = u - U0; sbm_unit_prompt(a, lds, v & 31, 7 - (v >> 5)); }
        else if (u < U2) { const int v = u - U1; sbm_unit_sample(a, lds, v & 7, NSEG - 1 - (v >> 3)); }
        else hgrn_unit(a, lds, 32 + (u - U2));
    }
}

enum { PH_MOD = 0, PH_CVT, PH_NORM1, PH_G1, PH_G2, PH_NORM2, PH_G3, PH_MIX, PH_G4, PH_NORM3, PH_G5, PH_G6, PH_FINAL, N_PHASES };

template <int PH> __device__ __forceinline__ void run_phase(const Args& a, LAS unsigned char* lds, int bid, int nblk) {
    if constexpr (PH == PH_MOD) phase_mod(a, lds, bid, nblk);
    else if constexpr (PH == PH_CVT) phase_cvt(a, lds, bid, nblk, 0, 2);
    else if constexpr (PH == PH_NORM1) phase_norm<false>(a, bid, nblk, true, IN_F(I_N1), WS_F(WS_MOD), NMODC, 0 * DM, 1 * DM);
    else if constexpr (PH == PH_G1) phase_gemm<1>(a, lds, bid, nblk);
    else if constexpr (PH == PH_G2) phase_gemm<2>(a, lds, bid, nblk);
    else if constexpr (PH == PH_NORM2) phase_norm<false>(a, bid, nblk, false, IN_F(I_NM), WS_F(WS_MOD), NMODC, 3 * DM, 4 * DM);
    else if constexpr (PH == PH_G3) phase_gemm<3>(a, lds, bid, nblk);
    else if constexpr (PH == PH_MIX) phase_mixer(a, lds, bid, nblk);
    else if constexpr (PH == PH_G4) phase_gemm<4>(a, lds, bid, nblk);
    else if constexpr (PH == PH_NORM3) phase_norm<false>(a, bid, nblk, false, IN_F(I_N2), WS_F(WS_MOD), NMODC, 6 * DM, 7 * DM);
    else if constexpr (PH == PH_G5) phase_gemm<5>(a, lds, bid, nblk);
    else if constexpr (PH == PH_G6) phase_gemm<6>(a, lds, bid, nblk);
    else phase_norm<true>(a, bid, nblk, false, IN_F(I_NF), WS_F(WS_FMOD), NFMODC, 0, DM);
}

#define XB_TMO      128
#define XB_XCNT(j)  (256  + 64 * (j))
#define XB_XSUB(j)  (1280 + 64 * (j))
#define XB_XGEN(j)  (2304 + 64 * (j))
#define XB_TOP      3328
#define XB_TOPGEN   3392
#define XCD_BAR_WORDS 3456
#define XB_SPIN_CAP (1u << 18)

__device__ __forceinline__ unsigned xb_ld(unsigned* p)              { return __hip_atomic_load(p, __ATOMIC_RELAXED, __HIP_MEMORY_SCOPE_AGENT); }
__device__ __forceinline__ unsigned xb_add(unsigned* p, unsigned v) { return __hip_atomic_fetch_add(p, v, __ATOMIC_RELAXED, __HIP_MEMORY_SCOPE_AGENT); }
__device__ __forceinline__ unsigned xb_xcc_id() { return (unsigned)__builtin_amdgcn_s_getreg((3 << 11) | 20) & 0xFu; }
#define XB_SPIN(cond, bar) do { unsigned _sp = 0; while (cond) { __builtin_amdgcn_s_sleep(1); \
    if ((++_sp & 255u) == 0u) { if (xb_ld(&(bar)[XB_TMO])) break; if (_sp > XB_SPIN_CAP) { atomicAdd(&(bar)[XB_TMO], 1u); break; } } } } while (0)

struct XcdBarrier {
    unsigned* bar; unsigned x;
    volatile LAS unsigned* st;
};

__device__ __forceinline__ XcdBarrier xcd_barrier_post(unsigned* bar, volatile LAS unsigned* st) {
    XcdBarrier b; b.bar = bar; b.x = xb_xcc_id(); b.st = st;
    if (threadIdx.x == 0) (void)xb_add(&bar[XB_XCNT(b.x)], 1u);
    return b;
}
__device__ __forceinline__ void xcd_barrier_complete(unsigned* bar, unsigned x, unsigned& nloc, unsigned& nx) {
    const unsigned G = gridDim.x * gridDim.y * gridDim.z;
    unsigned sum, cnt, mine, sp = 0u;
    for (;;) {
        sum = 0u; cnt = 0u; mine = 0u;
#pragma unroll
        for (unsigned j = 0; j < 16; ++j) { const unsigned c = xb_ld(&bar[XB_XCNT(j)]); sum += c; cnt += (c > 0u) ? 1u : 0u; mine = (j == x) ? c : mine; }
        if (sum == G) break;
        __builtin_amdgcn_s_sleep(1);
        if ((++sp & 255u) == 0u) { if (xb_ld(&bar[XB_TMO])) break; if (sp > XB_SPIN_CAP) { atomicAdd(&bar[XB_TMO], 1u); break; } }
    }
    nloc = mine > 0u ? mine : 1u; nx = cnt > 0u ? cnt : 1u;
}

__device__ __forceinline__ void xcd_barrier(const XcdBarrier& b) {
    asm volatile("s_waitcnt vmcnt(0)" ::: "memory");
    __syncthreads();
    if (threadIdx.x == 0) {
        unsigned* bar = b.bar;
        __builtin_amdgcn_s_waitcnt(0);
        unsigned nloc = b.st[0], nx = b.st[1];
        if (nloc == 0u) { xcd_barrier_complete(bar, b.x, nloc, nx); b.st[0] = nloc; b.st[1] = nx; }
        const unsigned old = xb_add(&bar[XB_XSUB(b.x)], 1u);
        const unsigned gen = old / nloc;
        if (old + 1u == (gen + 1u) * nloc) {
            __builtin_amdgcn_fence(__ATOMIC_RELEASE, "agent");
            asm volatile("s_waitcnt vmcnt(0)" ::: "memory");
            const unsigned og = xb_add(&bar[XB_TOP], 1u);
            const unsigned tg = og / nx;
            if (og + 1u == (tg + 1u) * nx) xb_add(&bar[XB_TOPGEN], 1u);
            else XB_SPIN(xb_ld(&bar[XB_TOPGEN]) == tg, bar);
            __builtin_amdgcn_fence(__ATOMIC_ACQUIRE, "agent");
            xb_add(&bar[XB_XGEN(b.x)], 1u);
            asm volatile("s_waitcnt vmcnt(0)" ::: "memory");
        } else {
            XB_SPIN(xb_ld(&bar[XB_XGEN(b.x)]) == gen, bar);
            __builtin_amdgcn_fence(__ATOMIC_ACQUIRE, "agent");
            asm volatile("s_waitcnt vmcnt(0)" ::: "memory");
        }
    }
    __syncthreads();
}


constexpr int LDS_BAR_OFF = LDS_BYTES;
constexpr int LDS_TOTAL = LDS_BYTES + 64;

__global__ void __launch_bounds__(NTHR, 2) mega_fwd(Args a) {
    extern __shared__ __attribute__((aligned(16))) unsigned char lds_raw[];
    LAS unsigned char* lds = (LAS unsigned char*)lds_raw;
    const int bid = (int)blockIdx.x, nblk = (int)gridDim.x;
    if (threadIdx.x < 16) ((LAS unsigned*)(lds + LDS_BAR_OFF))[threadIdx.x] = 0u;
    __syncthreads();
    XcdBarrier bar = xcd_barrier_post((unsigned*)(a.ws + WS_CTL), (volatile LAS unsigned*)(lds + LDS_BAR_OFF));
    run_phase<PH_MOD>(a, lds, bid, nblk);
    __syncthreads();
    run_phase<PH_CVT>(a, lds, bid, nblk);
    xcd_barrier(bar);
#ifdef PROBE_DUP_P0
    run_phase<PH_MOD>(a, lds, bid, nblk);
    __syncthreads();
    run_phase<PH_CVT>(a, lds, bid, nblk);
    xcd_barrier(bar);
#endif
    run_phase<PH_NORM1>(a, lds, bid, nblk);
    xcd_barrier(bar);
    run_phase<PH_G1>(a, lds, bid, nblk);
    xcd_barrier(bar);
#ifdef PROBE_DUP_G1
    run_phase<PH_G1>(a, lds, bid, nblk);
    xcd_barrier(bar);
#endif
    run_phase<PH_G2>(a, lds, bid, nblk);
    xcd_barrier(bar);
#ifdef PROBE_DUP_G2
    run_phase<PH_G2>(a, lds, bid, nblk);
    xcd_barrier(bar);
#endif
    run_phase<PH_NORM2>(a, lds, bid, nblk);
    xcd_barrier(bar);
#ifdef PROBE_DUP_N2
    run_phase<PH_NORM2>(a, lds, bid, nblk);
    xcd_barrier(bar);
#endif
    run_phase<PH_G3>(a, lds, bid, nblk);
    xcd_barrier(bar);
#ifdef PROBE_DUP_G3
    run_phase<PH_G3>(a, lds, bid, nblk);
    xcd_barrier(bar);
#endif
    phase_hprep(a, bid, nblk);
    xcd_barrier(bar);
    run_phase<PH_MIX>(a, lds, bid, nblk);
    xcd_barrier(bar);
#ifdef PROBE_DUP_MIX
    phase_mixer(a, lds, bid, nblk, CTL_MIXQ + 64, PROBE_MIX_LO, PROBE_MIX_HI);
    xcd_barrier(bar);
#endif
    phase_sbcombine(a, bid, nblk);
    xcd_barrier(bar);
    run_phase<PH_G4>(a, lds, bid, nblk);
    xcd_barrier(bar);
    run_phase<PH_NORM3>(a, lds, bid, nblk);
    xcd_barrier(bar);
    run_phase<PH_G5>(a, lds, bid, nblk);
    xcd_barrier(bar);
    run_phase<PH_G6>(a, lds, bid, nblk);
    xcd_barrier(bar);
    run_phase<PH_FINAL>(a, lds, bid, nblk);
}

extern "C" void kernel_launch(void* const* d_in, const int* in_sizes, int n_in, void* d_out, int out_size, void* d_ws, size_t ws_size, hipStream_t stream) {
    static int grid = 0;
    if (grid == 0) {
        if (n_in != N_IN || (size_t)out_size != OUT_TOTAL || ws_size < WS_END) { fprintf(stderr, "kernel_launch: unexpected shapes (n_in %d, out %d, ws %zu)\n", n_in, out_size, ws_size); grid = -1; return; }
        int dev = 0, cus = 0, per_cu = 0;
        if (hipGetDevice(&dev) != hipSuccess || hipDeviceGetAttribute(&cus, hipDeviceAttributeMultiprocessorCount, dev) != hipSuccess) { grid = -1; return; }
        if (hipFuncSetAttribute((const void*)mega_fwd, hipFuncAttributeMaxDynamicSharedMemorySize, LDS_TOTAL) != hipSuccess) { fprintf(stderr, "kernel_launch: hipFuncSetAttribute failed\n"); grid = -1; return; }
        if (hipOccupancyMaxActiveBlocksPerMultiprocessor(&per_cu, (const void*)mega_fwd, NTHR, LDS_TOTAL) != hipSuccess || per_cu < 1) { fprintf(stderr, "kernel_launch: occupancy query says %d blocks per CU\n", per_cu); grid = -1; (void)hipGetLastError(); return; }
        grid = cus;
    }
    if (grid < 0) return;
    (void)hipMemsetAsync((char*)d_ws + WS_CTL, 0, 65536, stream);
    Args a{};
    for (int i = 0; i < N_IN; ++i) a.in[i] = d_in[i];
    a.out = (float*)d_out; a.ws = (unsigned char*)d_ws;
    hipLaunchKernelGGL(mega_fwd, dim3(grid), dim3(NTHR), LDS_TOTAL, stream, a);
}
```

```cpp
#include <hip/hip_runtime.h>
#include <cstdio>
#include <cstdint>

constexpr int DM = 2048, SEQ = 2048, NB = 4, MP = NB * SEQ  , DECB = 8, DECT = 8, MS = DECB * DECT  ;
constexpr int MREAL = MP + MS  , MPAD = 8448  ;
constexpr int DFF = 5632, DIN = 7168, NMODC = 9 * DM  , NFMODC = 2 * DM;
constexpr int DA = 1024, NHEAD = 8, HD = 128, PAST = 16384, PAGE = 128, NPAGES = PAST / PAGE  ;
constexpr float EPS = 1e-6f, QSCALE = 0.08838834764831845f  ;
constexpr float LOG2E = 1.4426950408889634f, LN2 = 0.6931471805599453f;
constexpr size_t OFF_YP = 0, OFF_YS = OFF_YP + (size_t)MP * DM, OFF_KP = OFF_YS + (size_t)MS * DM, OFF_VP = OFF_KP + (size_t)MP * DA,
                 OFF_KS = OFF_VP + (size_t)MP * DA, OFF_VS = OFF_KS + (size_t)MS * DA, OFF_SP = OFF_VS + (size_t)MS * DA,
                 OFF_SS = OFF_SP + (size_t)NB * NHEAD * HD * HD, OUT_TOTAL = OFF_SS + (size_t)DECB * NHEAD * HD * HD;
enum { I_XP = 0, I_XS, I_CK, I_CV, I_ST, I_PT, I_CP, I_CS, I_LB, I_N1, I_NM, I_N2, I_WMOD, I_BMOD, I_WG1, I_WU1, I_WD1, I_WIN, I_GOA, I_GOB, I_BSB, I_WOUT,
       I_WG2, I_WU2, I_WD2, I_NF, I_WFM, I_BFM, N_IN };
constexpr size_t MiB = 1u << 20;
constexpr size_t WS_CTL = 0, CTL_BYTES = 1 * MiB;
constexpr size_t WS_MOD = 1 * MiB;
constexpr size_t WS_FMOD = 2 * MiB;
constexpr size_t WS_LBV = 3 * MiB;
constexpr size_t WS_WGU1 = 4 * MiB, WS_WD1 = 48 * MiB, WS_WIN = 70 * MiB, WS_WOUT = 98 * MiB, WS_WGU2 = 106 * MiB, WS_WD2 = 150 * MiB;
constexpr size_t WS_XN = 172 * MiB;
constexpr size_t WS_H = 206 * MiB;
constexpr size_t WS_X = 298 * MiB;
constexpr size_t WS_QA = 364 * MiB, WS_IA = 381 * MiB, WS_GA = 398 * MiB, WS_QB = 415 * MiB, WS_KB = 432 * MiB, WS_VB = 449 * MiB;
constexpr size_t WS_LF = 466 * MiB;
constexpr size_t WS_OM = 500 * MiB;
constexpr size_t WS_PART = 534 * MiB;
constexpr size_t WS_END = 700 * MiB;

#define GAS __attribute__((address_space(1)))
#define LAS __attribute__((address_space(3)))
typedef unsigned short bf16;
typedef unsigned v4u __attribute__((ext_vector_type(4)));
typedef unsigned v2u __attribute__((ext_vector_type(2)));
typedef float f32x4 __attribute__((ext_vector_type(4)));
typedef float f32x2 __attribute__((ext_vector_type(2)));
typedef short bf16x8 __attribute__((ext_vector_type(8)));

struct Args { const void* in[N_IN]; float* out; unsigned char* ws; };

__device__ __forceinline__ unsigned f2bf(float f) { unsigned u = __builtin_bit_cast(unsigned, f); return (u + 0x7fffu + ((u >> 16) & 1u)) >> 16; }
__device__ __forceinline__ unsigned pk2(float lo, float hi) { return f2bf(lo) | (f2bf(hi) << 16); }
__device__ __forceinline__ float bf2f(unsigned short b) { return __builtin_bit_cast(float, (unsigned)b << 16); }
__device__ __forceinline__ float bflo(unsigned w) { return __builtin_bit_cast(float, w << 16); }
__device__ __forceinline__ float bfhi(unsigned w) { return __builtin_bit_cast(float, w & 0xffff0000u); }
__device__ __forceinline__ float sigmoid_f(float x) { return __builtin_amdgcn_rcpf(1.f + __expf(-x)); }
__device__ __forceinline__ float silu_f(float x) { return x * sigmoid_f(x); }
__device__ __forceinline__ int mod_row(int r) { const int s = 4 + ((r - MP) >> 3); return r < MP ? (r >> 11) : (s > 11 ? 11 : s); }
__device__ __forceinline__ float wave_sum(float v) {
#pragma unroll
    for (int o = 1; o < 64; o <<= 1) v += __shfl_xor(v, o);
    return v;
}
__device__ __forceinline__ int tid_opaque() { int t = (int)threadIdx.x; asm volatile("" : "+v"(t)); return t; }
#define LDS_WAIT() asm volatile("s_waitcnt lgkmcnt(0)" ::: "memory")
#define VM_WAIT() asm volatile("s_waitcnt vmcnt(0)" ::: "memory")

namespace pg8 {
#define PG8_LAS __attribute__((address_space(3)))
typedef unsigned short bf16_t;
typedef short bf16x8 __attribute__((ext_vector_type(8)));
typedef float f32x4 __attribute__((ext_vector_type(4)));
typedef unsigned u32x4 __attribute__((ext_vector_type(4)));
constexpr int BM = 256, BK = 64, HALF = 128, HTB = HALF * BK * 2  , STAGE_BYTES = 8 * HTB, NXCD = 8, WGM = 8;

__host__ __device__ __forceinline__ int lds_byte(int r, int c) { const int st = (r >> 4) * 2 + (c >> 5), rr = r & 15, cc = c & 31, ob = rr * 64 + cc * 2; return st * 1024 + (ob ^ (((ob >> 9) & 1) << 5)); }
__host__ __device__ __forceinline__ void stage_rc(int b, int& R, int& C) { const int st = b / 1024, sb = b % 1024, swz = sb ^ (((sb >> 9) & 1) << 5); R = (st >> 1) * 16 + swz / 64; C = (st & 1) * 32 + (swz % 64) / 2; }
__host__ __device__ __forceinline__ int perm32(int rho) { const int n = rho >> 4, i = rho & 15; return 8 * (i >> 2) + 4 * n + (i & 3); }

struct Unit { int pm, pn; };
struct Gemm { const bf16_t* A; const bf16_t* Bt; int M, N, K; };

struct StaticOrder {
    int nM, nN, nwg, G, c;
    __host__ __device__ void init(int M, int N, int G_, int c_) { nM = M / BM; nN = N / BM; nwg = nM * nN; G = G_; c = c_; }
    __host__ __device__ bool next(int i, Unit& u) const {
        const long L = (long)i * G + c; if (L >= nwg) return false;
        int wgid = (int)L; { const int q = nwg / NXCD, r = nwg % NXCD, xcd = wgid % NXCD, off = wgid / NXCD; wgid = (xcd < r ? xcd * (q + 1) : r * (q + 1) + (xcd - r) * q) + off; }
        const int nig = WGM * nN, gid = wgid / nig, fm = gid * WGM, gsz = (nM - fm) < WGM ? (nM - fm) : WGM;
        u.pm = fm + ((wgid % nig) % gsz); u.pn = (wgid % nig) / gsz; return true;
    }
    __device__ __forceinline__ void a_ready(const Unit&) const {}
    __device__ __forceinline__ void done(const Unit&) const {}
};


__device__ __forceinline__ unsigned cvt_pk_bf16(float lo, float hi) { unsigned r; asm volatile("v_cvt_pk_bf16_f32 %0, %1, %2" : "=v"(r) : "v"(lo), "v"(hi)); return r; }

struct EpiSwiGLU {
    static constexpr bool PERM = true, AFTER_DRAIN = false;
    bf16_t* H; int ldh;
    __device__ __forceinline__ void operator()(const f32x4 (&acc)[2][2][4][2], const Unit& u, int wr, int wc, int fr, int fq) const {
        const int row0 = u.pm * BM + wr * 64 + fr, col0 = u.pn * HALF + wc * 32 + 8 * fq;
#pragma unroll
        for (int ai = 0; ai < 2; ++ai)
#pragma unroll
            for (int m = 0; m < 4; ++m) {
                const f32x4 g0 = acc[ai][0][m][0], g1 = acc[ai][0][m][1], u0 = acc[ai][1][m][0], u1 = acc[ai][1][m][1];
                float v[8];
#pragma unroll
                for (int j = 0; j < 4; ++j) { v[j] = silu_f(g0[j]) * u0[j]; v[4 + j] = silu_f(g1[j]) * u1[j]; }
                u32x4 w; w.x = cvt_pk_bf16(v[0], v[1]); w.y = cvt_pk_bf16(v[2], v[3]); w.z = cvt_pk_bf16(v[4], v[5]); w.w = cvt_pk_bf16(v[6], v[7]);
                *(u32x4*)(H + (size_t)(row0 + ai * HALF + m * 16) * ldh + col0) = w;
            }
    }
};
struct EpiResid {
    static constexpr bool PERM = false, AFTER_DRAIN = false;
    const float* xp; const float* xs; float* X; const float* gate; float scale;
    __device__ __forceinline__ void operator()(const f32x4 (&acc)[2][2][4][2], const Unit& u, int wr, int wc, int fr, int fq) const {
        const int col0 = u.pn * BM + wc * 32 + 4 * fq;
#pragma unroll
        for (int ai = 0; ai < 2; ++ai)
#pragma unroll
            for (int m = 0; m < 4; ++m) {
                const int row = u.pm * BM + ai * HALF + wr * 64 + m * 16 + fr;
                if (row < MREAL) {
                    const float* base = xp ? (row < MP ? xp + (size_t)row * DM : xs + (size_t)(row - MP) * DM) : X + (size_t)row * DM;
                    const float* gr = gate + (size_t)mod_row(row) * NMODC;
#pragma unroll
                    for (int bj = 0; bj < 2; ++bj)
#pragma unroll
                        for (int n = 0; n < 2; ++n) { const int c = col0 + bj * HALF + n * 16;
                            const f32x4 gv = *(const f32x4*)(gr + c), bv = *(const f32x4*)(base + c);
                            *(f32x4*)(X + (size_t)row * DM + c) = bv + (gv * scale) * acc[ai][bj][m][n]; }
                }
            }
    }
};
struct EpiProj {
    static constexpr bool PERM = true, AFTER_DRAIN = false;
    unsigned char* ws; float* LF; float* out; const float* lbv;
    template <int MODE> __device__ __forceinline__ void run(const f32x4 (&acc)[2][2][4][2], const Unit& u, int wr, int wc, int fr, int fq, bf16_t* B, float s, size_t offp, size_t offs) const {
        const int cb = (u.pn & 3) * BM + wc * 32 + 8 * fq;
#pragma unroll
        for (int ai = 0; ai < 2; ++ai)
#pragma unroll
            for (int m = 0; m < 4; ++m) {
                const int row = u.pm * BM + ai * HALF + wr * 64 + m * 16 + fr;
#pragma unroll
                for (int bj = 0; bj < 2; ++bj) {
                    const int c = cb + bj * HALF; const size_t o = (size_t)row * DA + c;
                    f32x4 v0 = acc[ai][bj][m][0], v1 = acc[ai][bj][m][1];
                    if constexpr (MODE == 1) {
                        const f32x4 l0 = *(const f32x4*)(lbv + c), l1 = *(const f32x4*)(lbv + c + 4);
#pragma unroll
                        for (int j = 0; j < 4; ++j) { v0[j] = __builtin_amdgcn_logf(l0[j] + (1.f - l0[j]) * sigmoid_f(v0[j])); v1[j] = __builtin_amdgcn_logf(l1[j] + (1.f - l1[j]) * sigmoid_f(v1[j])); }
                        *(f32x4*)(LF + o) = v0; *(f32x4*)(LF + o + 4) = v1;
                    } else {
                        if constexpr (MODE == 3) {
                            if (row < MREAL) { float* dst = row < MP ? out + offp + o : out + offs + (o - (size_t)MP * DA); *(f32x4*)dst = v0; *(f32x4*)(dst + 4) = v1; }
                        }
                        if constexpr (MODE == 0) { v0 = v0 * s; v1 = v1 * s; }
                        if constexpr (MODE == 2) {
#pragma unroll
                            for (int j = 0; j < 4; ++j) { v0[j] = silu_f(v0[j]); v1[j] = silu_f(v1[j]); }
                        }
                        u32x4 w; w.x = cvt_pk_bf16(v0[0], v0[1]); w.y = cvt_pk_bf16(v0[2], v0[3]); w.z = cvt_pk_bf16(v1[0], v1[1]); w.w = cvt_pk_bf16(v1[2], v1[3]);
                        *(u32x4*)(B + o) = w;
                    }
                }
            }
    }
    __device__ __forceinline__ void operator()(const f32x4 (&acc)[2][2][4][2], const Unit& u, int wr, int wc, int fr, int fq) const {
        const int rng = u.pn >> 2;
        bf16_t* B = (bf16_t*)(ws + WS_QA + (size_t)(rng == 0 ? 0 : rng - 1) * (WS_IA - WS_QA));
        if (rng == 1) run<1>(acc, u, wr, wc, fr, fq, nullptr, 1.f, 0, 0);
        else if (rng == 3) run<2>(acc, u, wr, wc, fr, fq, B, 1.f, 0, 0);
        else if (rng >= 5) run<3>(acc, u, wr, wc, fr, fq, B, 1.f, rng == 5 ? OFF_KP : OFF_VP, rng == 5 ? OFF_KS : OFF_VS);
        else run<0>(acc, u, wr, wc, fr, fq, B, rng == 2 ? 1.f : (rng == 4 ? QSCALE * LOG2E : QSCALE), 0, 0);
    }
};
template <class Epi, class Sched, bool ALIGN_EPI = false, bool SP2 = false>
__device__ __forceinline__ void gemm_phase(PG8_LAS unsigned char* lds, const Gemm g, const Sched& S, const Epi& E) {
    const int tid = tid_opaque(), wid = __builtin_amdgcn_readfirstlane(tid >> 6), lane = tid & 63, wr = wid >> 2, wc = wid & 3, fr = lane & 15, fq = lane >> 4;
    const int K = g.K, nt = K / BK;
    unsigned voffA[2], voffB[2];
#pragma unroll
    for (int i = 0; i < 2; ++i) { int R, C; stage_rc(tid * 16 + i * 8192, R, C); const int Rb = Epi::PERM ? ((R & ~31) + perm32(R & 31)) : R;
        voffA[i] = (unsigned)(R * K + C) * 2u; voffB[i] = (unsigned)(Rb * K + C) * 2u; }
    const size_t kstep = (size_t)(BK * 2);
    const size_t hstep = (size_t)HALF * K * 2;
    const size_t tstep = 2 * hstep;
    const unsigned ldsw = (unsigned)wid * 1024u;
    const int aoff = lds_byte(wr * 64 + fr, fq * 8), boff = lds_byte(wc * 32 + fr, fq * 8);
#define PG8_SA(b, h) (((b) * 2 + (h)) * HTB)
#define PG8_SB(b, h) ((4 + (b) * 2 + (h)) * HTB)
#define PG8_STAGE(bufoff, gbase, voff) do { _Pragma("unroll") for (int _i = 0; _i < 2; ++_i) \
        __builtin_amdgcn_global_load_lds((const unsigned*)((const char*)(gbase) + (voff)[_i]), (PG8_LAS unsigned*)(lds + (bufoff) + ldsw + _i * 8192), 16, 0, 0); } while (0)
#define PG8_LDA(dst, b, h) do { _Pragma("unroll") for (int m = 0; m < 4; ++m) _Pragma("unroll") for (int k = 0; k < 2; ++k) dst[m][k] = *(const PG8_LAS bf16x8*)(lds + PG8_SA(b, h) + aoff + m * 2048 + k * 1024); } while (0)
#define PG8_LDB(dst, b, h) do { _Pragma("unroll") for (int n = 0; n < 2; ++n) _Pragma("unroll") for (int k = 0; k < 2; ++k) dst[n][k] = *(const PG8_LAS bf16x8*)(lds + PG8_SB(b, h) + boff + n * 2048 + k * 1024); } while (0)
#define PG8_MMA(ai, bj, At, Bt) do { __builtin_amdgcn_s_setprio(1); _Pragma("unroll") for (int m = 0; m < 4; ++m) _Pragma("unroll") for (int n = 0; n < 2; ++n) _Pragma("unroll") for (int k = 0; k < 2; ++k) \
        acc[ai][bj][m][n] = __builtin_amdgcn_mfma_f32_16x16x32_bf16(Bt[n][k], At[m][k], acc[ai][bj][m][n], 0, 0, 0); __builtin_amdgcn_s_setprio(0); } while (0)
#define PG8_WAIT_V(n) asm volatile("s_waitcnt vmcnt(" #n ")" ::: "memory")
#define PG8_WAIT_L(n) asm volatile("s_waitcnt lgkmcnt(" #n ")" ::: "memory")
#define PG8_BAR __builtin_amdgcn_s_barrier()
#define PG8_SCHED __builtin_amdgcn_sched_barrier(0)
    Unit cur, nxt; int ui = 0;
    if (!S.next(0, cur)) return;
    f32x4 acc[2][2][4][2];
#pragma unroll
    for (int a = 0; a < 2; ++a)
#pragma unroll
        for (int b = 0; b < 2; ++b)
#pragma unroll
            for (int m = 0; m < 4; ++m)
#pragma unroll
                for (int n = 0; n < 2; ++n) acc[a][b][m][n] = (f32x4){0.f, 0.f, 0.f, 0.f};
    bf16x8 At[4][2], B0[2][2], B1[2][2];
    const char* cA = (const char*)g.A + (size_t)cur.pm * tstep; const char* cB = (const char*)g.Bt + (size_t)cur.pn * tstep;
    S.a_ready(cur);
    if constexpr (SP2) {
        PG8_STAGE(PG8_SB(0, 0), cB, voffB); PG8_STAGE(PG8_SB(0, 1), cB + hstep, voffB); PG8_STAGE(PG8_SA(0, 0), cA, voffA); PG8_STAGE(PG8_SA(0, 1), cA + hstep, voffA);
        if (wr == 1) PG8_BAR;
        PG8_WAIT_V(2); PG8_BAR;
        PG8_STAGE(PG8_SB(1, 0), cB + kstep, voffB); PG8_STAGE(PG8_SA(1, 0), cA + kstep, voffA); PG8_STAGE(PG8_SB(1, 1), cB + hstep + kstep, voffB);
        PG8_WAIT_V(6); PG8_BAR;
    } else {
        PG8_STAGE(PG8_SB(0, 0), cB, voffB); PG8_STAGE(PG8_SA(0, 0), cA, voffA); PG8_STAGE(PG8_SB(0, 1), cB + hstep, voffB); PG8_STAGE(PG8_SA(0, 1), cA + hstep, voffA);
        if (wr == 1) PG8_BAR;
        PG8_WAIT_V(4); PG8_BAR;
        PG8_STAGE(PG8_SB(1, 0), cB + kstep, voffB); PG8_STAGE(PG8_SA(1, 0), cA + kstep, voffA); PG8_STAGE(PG8_SB(1, 1), cB + hstep + kstep, voffB);
        PG8_WAIT_V(6); PG8_BAR;
    }
    for (;;) {
        const bool has_next = S.next(ui + 1, nxt);
        const char* nA = has_next ? (const char*)g.A + (size_t)nxt.pm * tstep : cA; const char* nB = has_next ? (const char*)g.Bt + (size_t)nxt.pn * tstep : cB;
        for (int t = 0; t < nt; t += 2) {
            const bool last = (t == nt - 2);
            const char* a1 = cA + (size_t)(t + 1) * kstep;
            const char* a2 = last ? nA : cA + (size_t)(t + 2) * kstep; const char* b2 = last ? nB : cB + (size_t)(t + 2) * kstep;
            const char* a3 = a2 + kstep; const char* b3 = b2 + kstep;
            if (last && has_next) S.a_ready(nxt);
            if constexpr (SP2) {
            PG8_LDB(B0, 0, 0); PG8_LDB(B1, 0, 1); PG8_SCHED; PG8_LDA(At, 0, 0); PG8_STAGE(PG8_SA(1, 1), a1 + hstep, voffA);
            PG8_WAIT_V(8); PG8_WAIT_L(0); PG8_BAR; PG8_MMA(0, 0, At, B0); PG8_MMA(0, 1, At, B1); PG8_BAR; PG8_SCHED;
            PG8_LDA(At, 0, 1); PG8_STAGE(PG8_SB(0, 0), b2, voffB); PG8_STAGE(PG8_SB(0, 1), b2 + hstep, voffB); PG8_STAGE(PG8_SA(0, 0), a2, voffA);
            PG8_WAIT_V(8); PG8_WAIT_L(0); PG8_BAR; PG8_MMA(1, 0, At, B0); PG8_MMA(1, 1, At, B1); PG8_BAR; PG8_SCHED;
            PG8_LDB(B0, 1, 0); PG8_LDB(B1, 1, 1); PG8_SCHED; PG8_LDA(At, 1, 0); PG8_STAGE(PG8_SA(0, 1), a2 + hstep, voffA);
            PG8_WAIT_V(8); PG8_WAIT_L(0); PG8_BAR; PG8_MMA(0, 0, At, B0); PG8_MMA(0, 1, At, B1); PG8_BAR; PG8_SCHED;
            PG8_LDA(At, 1, 1); PG8_STAGE(PG8_SB(1, 0), b3, voffB); PG8_STAGE(PG8_SB(1, 1), b3 + hstep, voffB); PG8_STAGE(PG8_SA(1, 0), a3, voffA);
            PG8_WAIT_V(8); PG8_WAIT_L(0); PG8_BAR; PG8_MMA(1, 0, At, B0); PG8_MMA(1, 1, At, B1); PG8_BAR; PG8_SCHED;
            } else {
            PG8_LDB(B0, 0, 0); PG8_SCHED; PG8_LDA(At, 0, 0); PG8_STAGE(PG8_SA(1, 1), a1 + hstep, voffA);
            PG8_WAIT_L(8); PG8_BAR; PG8_WAIT_L(0); PG8_MMA(0, 0, At, B0); PG8_BAR; PG8_SCHED;
            PG8_LDB(B1, 0, 1); PG8_STAGE(PG8_SB(0, 0), b2, voffB);
            PG8_BAR; PG8_WAIT_L(0); PG8_MMA(0, 1, At, B1); PG8_BAR;
            PG8_LDA(At, 0, 1); PG8_STAGE(PG8_SA(0, 0), a2, voffA);
            PG8_BAR; PG8_WAIT_L(0); PG8_MMA(1, 0, At, B0); PG8_BAR; PG8_SCHED;
            PG8_STAGE(PG8_SB(0, 1), b2 + hstep, voffB);
            PG8_WAIT_V(6); PG8_BAR; PG8_MMA(1, 1, At, B1); PG8_BAR;
            PG8_LDB(B0, 1, 0); PG8_SCHED; PG8_LDA(At, 1, 0); PG8_STAGE(PG8_SA(0, 1), a2 + hstep, voffA);
            PG8_WAIT_L(8); PG8_BAR; PG8_WAIT_L(0); PG8_MMA(0, 0, At, B0); PG8_BAR; PG8_SCHED;
            PG8_LDB(B1, 1, 1); PG8_STAGE(PG8_SB(1, 0), b3, voffB);
            PG8_BAR; PG8_WAIT_L(0); PG8_MMA(0, 1, At, B1); PG8_BAR;
            PG8_LDA(At, 1, 1); PG8_STAGE(PG8_SA(1, 0), a3, voffA);
            PG8_BAR; PG8_WAIT_L(0); PG8_MMA(1, 0, At, B0); PG8_BAR; PG8_SCHED;
            PG8_STAGE(PG8_SB(1, 1), b3 + hstep, voffB);
            PG8_WAIT_V(6); PG8_BAR; PG8_MMA(1, 1, At, B1); PG8_BAR;
            }
        }
        if constexpr (ALIGN_EPI) { if (wr == 0) PG8_BAR; }
        if constexpr (!Epi::AFTER_DRAIN) { E(acc, cur, wr, wc, fr, fq); S.done(cur); }
        if (!has_next) break;
#pragma unroll
        for (int a = 0; a < 2; ++a)
#pragma unroll
            for (int b = 0; b < 2; ++b)
#pragma unroll
                for (int m = 0; m < 4; ++m)
#pragma unroll
                    for (int n = 0; n < 2; ++n) acc[a][b][m][n] = (f32x4){0.f, 0.f, 0.f, 0.f};
        cur = nxt; cA = nA; cB = nB; ++ui;
        if constexpr (ALIGN_EPI) { if (wr == 1) PG8_BAR; }
    }
    PG8_WAIT_V(0);
    if constexpr (!ALIGN_EPI) { if (wr == 0) PG8_BAR; }
    PG8_BAR;
    if constexpr (Epi::AFTER_DRAIN) { E.fused(acc, cur, wr, wc, fr, fq, lds, wid, lane); S.done(cur); }
#undef PG8_SA
#undef PG8_SB
#undef PG8_STAGE
#undef PG8_LDA
#undef PG8_LDB
#undef PG8_MMA
#undef PG8_WAIT_V
#undef PG8_WAIT_L
#undef PG8_BAR
#undef PG8_SCHED
}
}

constexpr int NTHR = 512, NWAVES = 8;
constexpr int LDS_BYTES = 155648;

#define IN_F(i) ((const float*)a.in[i])
#define WS_F(off) ((float*)(a.ws + (off)))
#define WS_B(off) ((bf16*)(a.ws + (off)))

__device__ __forceinline__ void phase_mod(const Args& a, LAS unsigned char* lds, int bid, int nblk) {
    const int tid = tid_opaque(), lane = tid & 63, w = tid >> 6;
    LAS float* sc = (LAS float*)lds;
    LAS float* red = (LAS float*)(lds + 98304);
    for (int i = tid; i < 12 * DM; i += NTHR) { const int b = i >> 11, k = i & 2047; const float c = b < 4 ? IN_F(I_CP)[b * DM + k] : IN_F(I_CS)[(b - 4) * DM + k]; sc[i] = silu_f(c); }
    if (bid == 0) for (int i = tid; i < DA; i += NTHR) WS_F(WS_LBV)[i] = sigmoid_f(IN_F(I_LB)[i]);
    __syncthreads();
    for (int u = bid; u < 176; u += nblk) {
        const bool fm = u >= 144; const int n0 = (fm ? u - 144 : u) * 128, ld = fm ? NFMODC : NMODC;
        const float* W = fm ? IN_F(I_WFM) : IN_F(I_WMOD); const float* bias = fm ? IN_F(I_BFM) : IN_F(I_BMOD); float* outp = fm ? WS_F(WS_FMOD) : WS_F(WS_MOD);
        f32x2 acc[12];
#pragma unroll
        for (int b = 0; b < 12; ++b) acc[b] = (f32x2){0.f, 0.f};
        const float* wp = W + (size_t)(w * 256) * ld + n0 + 2 * lane;
        for (int k = 0; k < 256; k += 4) {
            const f32x2 w0 = *(const f32x2*)(wp + (size_t)(k + 0) * ld), w1 = *(const f32x2*)(wp + (size_t)(k + 1) * ld), w2 = *(const f32x2*)(wp + (size_t)(k + 2) * ld), w3 = *(const f32x2*)(wp + (size_t)(k + 3) * ld);
#pragma unroll
            for (int b = 0; b < 12; ++b) { const f32x4 s = *(const LAS f32x4*)(sc + b * DM + w * 256 + k); acc[b] += w0 * s.x + w1 * s.y + w2 * s.z + w3 * s.w; }
        }
#pragma unroll
        for (int b = 0; b < 12; ++b) *(LAS f32x2*)(red + (w * 12 + b) * 128 + 2 * lane) = acc[b];
        __syncthreads();
        for (int i = tid; i < 12 * 128; i += NTHR) { const int b = i >> 7, c = i & 127; float s = 0.f;
#pragma unroll
            for (int ww = 0; ww < 8; ++ww) s += red[(ww * 12 + b) * 128 + c];
            outp[(size_t)b * ld + n0 + c] = s + bias[n0 + c]; }
        __syncthreads();
    }
}

__device__ __forceinline__ void cvt_item(const float* W, int K, int N, bf16* WT, int k0, int n0, int drow0, LAS float* scr, int lane) {
#pragma unroll 8
    for (int i = 0; i < 32; ++i) { const int kk = 2 * i + (lane >> 5); scr[kk * 33 + (lane & 31)] = W[(size_t)(k0 + kk) * N + n0 + (lane & 31)]; }
    LDS_WAIT(); asm volatile("" ::: "memory");
    const int c = lane & 7;
#pragma unroll
    for (int j = 0; j < 4; ++j) { const int n = (lane >> 3) + 8 * j; const LAS float* s = scr + (8 * c) * 33 + n;
        v4u o; o.x = pk2(s[0 * 33], s[1 * 33]); o.y = pk2(s[2 * 33], s[3 * 33]); o.z = pk2(s[4 * 33], s[5 * 33]); o.w = pk2(s[6 * 33], s[7 * 33]);
        *(GAS v4u*)(WT + (size_t)(drow0 + n) * K + k0 + 8 * c) = o; }
    LDS_WAIT(); asm volatile("" ::: "memory");
}
__device__ __forceinline__ void cvt_matrix(const float* W, int K, int N, bf16* WT, int mode, LAS float* scr, int gw, int ngw, int lane) {
    const int nblk = N / 32, nitems = (K / 64) * nblk;
    for (int it = gw; it < nitems; it += ngw) { const int kb = it / nblk, nb = it % nblk, n0 = 32 * nb;
        const int drow0 = mode == 0 ? n0 : ((n0 >> 7) * 256 + (mode == 2 ? 128 : 0) + (n0 & 127));
        cvt_item(W, K, N, WT, 64 * kb, n0, drow0, scr, lane); }
}
__device__ __forceinline__ void phase_cvt(const Args& a, LAS unsigned char* lds, int bid, int nblk, int first, int last) {
    const int tid = tid_opaque(), lane = tid & 63, w = tid >> 6;
    LAS float* scr = (LAS float*)(lds + w * 16384);
    const int gw = bid * NWAVES + w, ngw = nblk * NWAVES;
    if (first <= 0 && 0 <= last) { cvt_matrix(IN_F(I_WG1), DM, DFF, WS_B(WS_WGU1), 1, scr, gw, ngw, lane); cvt_matrix(IN_F(I_WU1), DM, DFF, WS_B(WS_WGU1), 2, scr, gw, ngw, lane);
                                   cvt_matrix(IN_F(I_WD1), DFF, DM, WS_B(WS_WD1), 0, scr, gw, ngw, lane); }
    if (first <= 1 && 1 <= last) { cvt_matrix(IN_F(I_WIN), DM, DIN, WS_B(WS_WIN), 0, scr, gw, ngw, lane); cvt_matrix(IN_F(I_WOUT), DM, DM, WS_B(WS_WOUT), 0, scr, gw, ngw, lane); }
    if (first <= 2 && 2 <= last) { cvt_matrix(IN_F(I_WG2), DM, DFF, WS_B(WS_WGU2), 1, scr, gw, ngw, lane); cvt_matrix(IN_F(I_WU2), DM, DFF, WS_B(WS_WGU2), 2, scr, gw, ngw, lane);
                                   cvt_matrix(IN_F(I_WD2), DFF, DM, WS_B(WS_WD2), 0, scr, gw, ngw, lane); }
}

template <bool FINAL>
__device__ __forceinline__ void phase_norm(const Args& a, int bid, int nblk, bool from_inputs, const float* gvec, const float* modp, int ldmod, int sh_off, int sc_off) {
    const int tid = tid_opaque(), lane = tid & 63, w = tid >> 6;
    const int gw = bid * NWAVES + w, ngw = nblk * NWAVES;
    const int nrows = MREAL;
    for (int r = gw; r < nrows; r += ngw) {
        if (r >= MREAL) {
            GAS v4u* o = (GAS v4u*)(WS_B(WS_XN) + (size_t)r * DM) + lane;
#pragma unroll
            for (int j = 0; j < 4; ++j) o[64 * j] = (v4u){0u, 0u, 0u, 0u};
            continue;
        }
        const float* xrow = from_inputs ? (r < MP ? IN_F(I_XP) + (size_t)r * DM : IN_F(I_XS) + (size_t)(r - MP) * DM) : WS_F(WS_X) + (size_t)r * DM;
        const GAS f32x4* xr = (const GAS f32x4*)xrow + lane;
        f32x4 v[8]; float s = 0.f;
#pragma unroll
        for (int j = 0; j < 8; ++j) { v[j] = xr[64 * j]; s += (v[j].x * v[j].x + v[j].y * v[j].y) + (v[j].z * v[j].z + v[j].w * v[j].w); }
        const float rstd = 1.0f / sqrtf(wave_sum(s) * (1.f / DM) + EPS);
        const float* mr = modp + (size_t)mod_row(r) * ldmod;
#pragma unroll
        for (int j = 0; j < 8; ++j) {
            const int c = 4 * (lane + 64 * j);
            const f32x4 g = *(const f32x4*)(gvec + c), sh = *(const f32x4*)(mr + sh_off + c), sc = *(const f32x4*)(mr + sc_off + c);
            const f32x4 y = (v[j] * rstd * g) * (1.f + sc) + sh;
            if (FINAL) { float* dst = r < MP ? a.out + OFF_YP + (size_t)r * DM : a.out + OFF_YS + (size_t)(r - MP) * DM; *(f32x4*)(dst + c) = y; }
            else { v2u o; o.x = pk2(y.x, y.y); o.y = pk2(y.z, y.w); *(GAS v2u*)(WS_B(WS_XN) + (size_t)r * DM + c) = o; }
        }
    }
}

__device__ __forceinline__ void hgrn_unit(const Args& a, LAS unsigned char* lds, int unit) {
    const int tid = tid_opaque(), dv = tid & 127, g = tid >> 7;
    const bool smp = unit >= 32; const int u = smp ? unit - 32 : unit, b = u >> 3, h = u & 7;
    const int T = smp ? DECT : SEQ, row0 = smp ? MP + b * DECT : b * SEQ;
    float* sout = a.out + (smp ? OFF_SS : OFF_SP) + (size_t)u * HD * HD;
    LAS float* fL = (LAS float*)lds; LAS float* kL = fL + 2048; LAS float* qL = kL + 2048; LAS float* vL = qL + 2048; LAS float* red = vL + 2048;
    const bf16* QA = WS_B(WS_QA); const bf16* IA = WS_B(WS_IA); const bf16* GA = WS_B(WS_GA); const float* LF = WS_F(WS_LF);
    float S[32];
#pragma unroll
    for (int i = 0; i < 32; ++i) S[i] = smp ? IN_F(I_ST)[(size_t)u * HD * HD + (size_t)(32 * g + i) * HD + dv] : 0.f;
    for (int t0 = 0; t0 < T; t0 += 16) {
        const int nt = (T - t0) < 16 ? (T - t0) : 16;
        for (int i = tid; i < nt * 128; i += NTHR) { const int tt = i >> 7, ch = i & 127; const size_t o = (size_t)(row0 + t0 + tt) * DA + h * HD + ch;
            const float f = __builtin_amdgcn_exp2f(LF[o]);   fL[i] = f; kL[i] = 1.f - f; qL[i] = bf2f(QA[o]); vL[i] = bf2f(IA[o]); }
        __syncthreads();
        for (int tt = 0; tt < nt; ++tt) {
            const float v = vL[tt * 128 + dv]; float op = 0.f;
#pragma unroll
            for (int i4 = 0; i4 < 8; ++i4) {
                const f32x4 f4 = *(const LAS f32x4*)(fL + tt * 128 + g * 32 + 4 * i4), k4 = *(const LAS f32x4*)(kL + tt * 128 + g * 32 + 4 * i4), q4 = *(const LAS f32x4*)(qL + tt * 128 + g * 32 + 4 * i4);
#pragma unroll
                for (int j = 0; j < 4; ++j) { S[4 * i4 + j] = f4[j] * S[4 * i4 + j] + k4[j] * v; op += S[4 * i4 + j] * q4[j]; }
            }
            red[(g * 16 + tt) * 128 + dv] = op;
        }
        __syncthreads();
        { const int tt = tid >> 5, l32 = tid & 31;
          if (tt < nt) {
            f32x4 o = (f32x4){0.f, 0.f, 0.f, 0.f};
#pragma unroll
            for (int gg = 0; gg < 4; ++gg) o += *(const LAS f32x4*)(red + (gg * 16 + tt) * 128 + 4 * l32);
            float ss = (o.x * o.x + o.y * o.y) + (o.z * o.z + o.w * o.w);
#pragma unroll
            for (int m = 1; m < 32; m <<= 1) ss += __shfl_xor(ss, m);
            const float rstd = 1.0f / sqrtf(ss * (1.f / HD) + EPS);
            const int row = row0 + t0 + tt, col = h * HD + 4 * l32;
            const f32x4 gw = *(const f32x4*)(IN_F(I_GOA) + col); const v2u gt = *(const v2u*)(GA + (size_t)row * DA + col);
            v2u w; w.x = pk2(o.x * rstd * gw.x * bflo(gt.x), o.y * rstd * gw.y * bfhi(gt.x)); w.y = pk2(o.z * rstd * gw.z * bflo(gt.y), o.w * rstd * gw.w * bfhi(gt.y));
            *(v2u*)(WS_B(WS_OM) + (size_t)row * DM + col) = w;
          } }
        __syncthreads();
    }
#pragma unroll
    for (int i = 0; i < 32; ++i) sout[(size_t)(32 * g + i) * HD + dv] = S[i];
}

__device__ __forceinline__ void sb_tile(const LAS float* Kt, const LAS float* Vt, const LAS float* q, float bias, int lane, int nvis  , float& R, float& o0, float& o1) {
    float z = bias;
#pragma unroll 8
    for (int d = 0; d < HD; d += 4) { const f32x4 qv = *(const LAS f32x4*)(q + d);
        z += qv.x * Kt[lane * 129 + d] + qv.y * Kt[lane * 129 + d + 1] + qv.z * Kt[lane * 129 + d + 2] + qv.w * Kt[lane * 129 + d + 3]; }
    const bool vis = lane < nvis;
    const float L = vis ? -(z > 20.f ? z : log1pf(__expf(z))) : 0.f;
    float c = L;
#pragma unroll
    for (int off = 1; off < 64; off <<= 1) { const float t = __shfl_down(c, off); if (lane + off < 64) c += t; }
    const float P = vis ? __expf(z + c + R) : 0.f;
    R += __shfl(c, 0);
#pragma unroll 8
    for (int s = 0; s < 64; ++s) { const float p = __builtin_bit_cast(float, __builtin_amdgcn_readlane(__builtin_bit_cast(int, P), s));
        o0 += p * Vt[s * 128 + lane]; o1 += p * Vt[s * 128 + 64 + lane]; }
}
__device__ __forceinline__ void sb_finish(const Args& a, int row, int h, int lane, float o0, float o1) {
    const float ss = wave_sum(o0 * o0 + o1 * o1);
    const float rstd = 1.0f / sqrtf(ss * (1.f / HD) + EPS);
    const float* gw = IN_F(I_GOB) + h * HD; bf16* dst = WS_B(WS_OM) + (size_t)row * DM + DA + h * HD;
    dst[lane] = (bf16)f2bf(o0 * rstd * gw[lane]); dst[64 + lane] = (bf16)f2bf(o1 * rstd * gw[64 + lane]);
}
__device__ __forceinline__ void sb_stage_bf16(const Args& a, LAS float* Kt, LAS float* Vt, int krow0, int nvalid, int h, int tid) {
    const bf16* KB = WS_B(WS_KB); const bf16* VB = WS_B(WS_VB);
#pragma unroll
    for (int i = 0; i < 2; ++i) { const int ch = tid + i * NTHR, r = ch >> 4, d0 = (ch & 15) * 8;
        v4u kv = (v4u){0u, 0u, 0u, 0u}, vv = (v4u){0u, 0u, 0u, 0u};
        if (r < nvalid) { const size_t o = (size_t)(krow0 + r) * DA + h * HD + d0; kv = *(const v4u*)(KB + o); vv = *(const v4u*)(VB + o); }
        LAS float* kd = Kt + r * 129 + d0; LAS float* vd = Vt + r * 128 + d0;
        kd[0] = bflo(kv.x); kd[1] = bfhi(kv.x); kd[2] = bflo(kv.y); kd[3] = bfhi(kv.y); kd[4] = bflo(kv.z); kd[5] = bfhi(kv.z); kd[6] = bflo(kv.w); kd[7] = bfhi(kv.w);
        vd[0] = bflo(vv.x); vd[1] = bfhi(vv.x); vd[2] = bflo(vv.y); vd[3] = bfhi(vv.y); vd[4] = bflo(vv.z); vd[5] = bfhi(vv.z); vd[6] = bflo(vv.w); vd[7] = bfhi(vv.w); }
}
__device__ __forceinline__ void sb_unit_prompt(const Args& a, LAS unsigned char* lds, int unit) {
    const int tid = tid_opaque(), lane = tid & 63, w = tid >> 6;
    const int bh = unit >> 8, qb = unit & 255, b = bh >> 3, h = bh & 7, t = qb * 8 + w, row = b * SEQ + t;
    LAS float* Kt = (LAS float*)lds; LAS float* Vt = Kt + 64 * 129; LAS float* qs = Vt + 64 * 128;
    if (lane < 32) { const v2u qv = *(const v2u*)(WS_B(WS_QB) + (size_t)row * DA + h * HD + 4 * lane); LAS float* q = qs + w * HD + 4 * lane; q[0] = bflo(qv.x) * LN2; q[1] = bfhi(qv.x) * LN2; q[2] = bflo(qv.y) * LN2; q[3] = bfhi(qv.y) * LN2; }
    const float bias = IN_F(I_BSB)[h];
    float R = 0.f, o0 = 0.f, o1 = 0.f;
    for (int j = (qb * 8 + 6) >> 6; j >= 0; --j) {
        __syncthreads();
        sb_stage_bf16(a, Kt, Vt, b * SEQ + 64 * j, 64, h, tid);
        __syncthreads();
        int nvis = t - 64 * j; nvis = nvis < 0 ? 0 : (nvis > 64 ? 64 : nvis);
        sb_tile(Kt, Vt, qs + w * HD, bias, lane, nvis, R, o0, o1);
    }
    sb_finish(a, row, h, lane, o0, o1);
    __syncthreads();
}
__device__ __forceinline__ void sb_unit_sample(const Args& a, LAS unsigned char* lds, int unit) {
    const int tid = tid_opaque(), lane = tid & 63, w = tid >> 6;
    const int b = unit >> 3, h = unit & 7, row = MP + b * DECT + w;
    LAS float* Kt = (LAS float*)lds; LAS float* Vt = Kt + 64 * 129; LAS float* qs = Vt + 64 * 128;
    if (lane < 32) { const v2u qv = *(const v2u*)(WS_B(WS_QB) + (size_t)row * DA + h * HD + 4 * lane); LAS float* q = qs + w * HD + 4 * lane; q[0] = bflo(qv.x) * LN2; q[1] = bfhi(qv.x) * LN2; q[2] = bflo(qv.y) * LN2; q[3] = bfhi(qv.y) * LN2; }
    const float bias = IN_F(I_BSB)[h];
    float R = 0.f, o0 = 0.f, o1 = 0.f;
    __syncthreads();
    sb_stage_bf16(a, Kt, Vt, MP + b * DECT, DECT, h, tid);
    __syncthreads();
    sb_tile(Kt, Vt, qs + w * HD, bias, lane, w, R, o0, o1);
    const int* pt = (const int*)a.in[I_PT] + b * NPAGES;
    for (int j = PAST / 64 - 1; j >= 0; --j) {
        __syncthreads();
        { const int page = pt[j >> 1]; const size_t base = ((size_t)page * PAGE + (j & 1) * 64) * (NHEAD * HD) + h * HD;
          const float* ck = IN_F(I_CK) + base; const float* cv = IN_F(I_CV) + base;
#pragma unroll
          for (int i = 0; i < 4; ++i) { const int ch = tid + i * NTHR, r = ch >> 5, d0 = (ch & 31) * 4;
              const f32x4 kv = *(const f32x4*)(ck + (size_t)r * (NHEAD * HD) + d0), vv = *(const f32x4*)(cv + (size_t)r * (NHEAD * HD) + d0);
              LAS float* kd = Kt + r * 129 + d0; kd[0] = kv.x; kd[1] = kv.y; kd[2] = kv.z; kd[3] = kv.w;
              *(LAS f32x4*)(Vt + r * 128 + d0) = vv; } }
        __syncthreads();
        sb_tile(Kt, Vt, qs + w * HD, bias, lane, 64, R, o0, o1);
    }
    sb_finish(a, row, h, lane, o0, o1);
    __syncthreads();
}

typedef float f32x16 __attribute__((ext_vector_type(16)));
typedef short s16x4 __attribute__((ext_vector_type(4)));
typedef short v4i16_t __attribute__((ext_vector_type(4)));
typedef __bf16 bf16x2_t __attribute__((ext_vector_type(2)));
#define MFMA32(a, b, c) __builtin_amdgcn_mfma_f32_32x32x16_bf16((a), (b), (c), 0, 0, 0)

__device__ __forceinline__ unsigned cvtpk(float lo, float hi) { f32x2 v = {lo, hi}; bf16x2_t b = __builtin_convertvector(v, bf16x2_t); return __builtin_bit_cast(unsigned, b); }
template <int S> __device__ __forceinline__ bf16x8 pack8(const f32x16& x) {
    v4u p; p.x = cvtpk(x[8 * S + 0], x[8 * S + 1]); p.y = cvtpk(x[8 * S + 2], x[8 * S + 3]); p.z = cvtpk(x[8 * S + 4], x[8 * S + 5]); p.w = cvtpk(x[8 * S + 6], x[8 * S + 7]);
    return __builtin_bit_cast(bf16x8, p);
}
__device__ __forceinline__ unsigned off_a(unsigned row, unsigned ch) { return 2048u * (row >> 3) + 512u * (ch >> 2) + 64u * (row & 7) + 16u * ((ch & 3) ^ ((row >> 2) & 3)); }
__device__ __forceinline__ s16x4 vtr(const LAS unsigned char* p) { return __builtin_bit_cast(s16x4, __builtin_amdgcn_ds_read_tr16_b64_v4i16((LAS v4i16_t*)p)); }


template <bool DUAL, class Epi>
__device__ __forceinline__ void sgemm64_unit(const bf16* A, int K, const bf16* B0, const bf16* B1, LAS unsigned char* lds, const Epi& E) {
    const int tid = tid_opaque(), lane = tid & 63, w = tid >> 6, r = lane & 31, hh = lane >> 5;
    const int kw = K >> 3, k0 = w * kw, steps = kw >> 4;
    const bf16* pa0 = A + (size_t)r * K + k0 + 8 * hh; const bf16* pa1 = pa0 + (size_t)32 * K;
    const bf16* pb0 = B0 + (size_t)r * K + k0 + 8 * hh; const bf16* pb1 = B1 + (size_t)r * K + k0 + 8 * hh;
    f32x16 c00, c10, c01, c11;
#pragma unroll
    for (int i = 0; i < 16; ++i) { c00[i] = 0.f; c10[i] = 0.f; c01[i] = 0.f; c11[i] = 0.f; }
#pragma unroll 4
    for (int s = 0; s < steps; ++s) {
        const bf16x8 a0 = *(const bf16x8*)(pa0 + 16 * s), a1 = *(const bf16x8*)(pa1 + 16 * s), b0 = *(const bf16x8*)(pb0 + 16 * s);
        c00 = MFMA32(a0, b0, c00); c10 = MFMA32(a1, b0, c10);
        if constexpr (DUAL) { const bf16x8 b1 = *(const bf16x8*)(pb1 + 16 * s); c01 = MFMA32(a0, b1, c01); c11 = MFMA32(a1, b1, c11); }
    }
    constexpr int NT = DUAL ? 4 : 2;
    LAS float* red = (LAS float*)lds;
    __syncthreads();
#pragma unroll
    for (int i = 0; i < 16; ++i) { red[((w * NT + 0) * 16 + i) * 64 + lane] = c00[i]; red[((w * NT + 1) * 16 + i) * 64 + lane] = c10[i];
        if constexpr (DUAL) { red[((w * NT + 2) * 16 + i) * 64 + lane] = c01[i]; red[((w * NT + 3) * 16 + i) * 64 + lane] = c11[i]; } }
    __syncthreads();
#pragma unroll
    for (int j = 0; j < 4; ++j) { const int idx = tid + NTHR * j, mt = idx >> 10, reg = (idx >> 6) & 15, ln = idx & 63;
        float v0 = 0.f, v1 = 0.f;
#pragma unroll
        for (int ww = 0; ww < 8; ++ww) { v0 += red[((ww * NT + mt) * 16 + reg) * 64 + ln]; if constexpr (DUAL) v1 += red[((ww * NT + 2 + mt) * 16 + reg) * 64 + ln]; }
        E(32 * mt + (reg & 3) + 8 * (reg >> 2) + 4 * (ln >> 5), ln & 31, v0, v1); }
}
__device__ __forceinline__ void proj_store_sample(unsigned char* ws, float* out, int sr, int c, float v) {
    const int rng = c >> 10, cc = c & 1023; const size_t o = (size_t)(MP + sr) * DA + cc;
    if (rng == 1) { const float l = ((const float*)(ws + WS_LBV))[cc]; ((float*)(ws + WS_LF))[o] = __builtin_amdgcn_logf(l + (1.f - l) * sigmoid_f(v)); return; }
    if (rng == 5) out[OFF_KS + (size_t)sr * DA + cc] = v;
    if (rng == 6) out[OFF_VS + (size_t)sr * DA + cc] = v;
    if (rng == 0) v *= QSCALE; if (rng == 4) v *= QSCALE * LOG2E; if (rng == 3) v = silu_f(v);
    bf16* B = (bf16*)(ws + WS_QA + (size_t)(rng == 0 ? 0 : rng - 1) * (WS_IA - WS_QA));
    B[o] = (bf16)f2bf(v);
}
struct SEpiSwiGLU { bf16* H; int col0; __device__ __forceinline__ void operator()(int row, int col, float g, float u) const { H[(size_t)(MP + row) * DFF + col0 + col] = (bf16)f2bf(silu_f(g) * u); } };
struct SEpiResid { const float* base  ; float* X; const float* gate; float scale; int col0;
    __device__ __forceinline__ void operator()(int row, int col, float v, float) const { const int c = col0 + col;
        X[(size_t)(MP + row) * DM + c] = base[(size_t)row * DM + c] + scale * gate[(size_t)(4 + (row >> 3)) * NMODC + c] * v; } };
struct SEpiProj { unsigned char* ws; float* out; int col0; __device__ __forceinline__ void operator()(int row, int col, float v, float) const { proj_store_sample(ws, out, row, col0 + col, v); } };

template <int WHICH> __device__ __forceinline__ void phase_gemm(const Args& a, LAS unsigned char* lds, int bid, int nblk) {
    using namespace pg8;
    if constexpr (WHICH == 1 || WHICH == 5) {
        const bf16* W = WS_B(WHICH == 1 ? WS_WGU1 : WS_WGU2);
        Gemm g{WS_B(WS_XN), W, MP, 2 * DFF, DM}; StaticOrder S; S.init(MP, 2 * DFF, nblk, bid);
        EpiSwiGLU E{WS_B(WS_H), DFF};
        gemm_phase<EpiSwiGLU, StaticOrder, true, true>(lds, g, S, E);
        for (int j = bid - nblk / 2; j >= 0 && j < DFF / 32; j += nblk / 2) { const int n0 = 32 * j, wrow = (n0 >> 7) * 256 + (n0 & 127);
            SEpiSwiGLU SE{WS_B(WS_H), n0};
            sgemm64_unit<true>(WS_B(WS_XN) + (size_t)MP * DM, DM, W + (size_t)wrow * DM, W + (size_t)(wrow + 128) * DM, lds, SE); }
    } else if constexpr (WHICH == 2 || WHICH == 6) {
        const bf16* W = WS_B(WHICH == 2 ? WS_WD1 : WS_WD2);
        Gemm g{WS_B(WS_H), W, MP, DM, DFF}; StaticOrder S; S.init(MP, DM, nblk, bid);
        EpiResid E{WHICH == 2 ? IN_F(I_XP) : nullptr, IN_F(I_XS), WS_F(WS_X), WS_F(WS_MOD) + (WHICH == 2 ? 2 : 8) * DM, 0.5f};
        gemm_phase<EpiResid, StaticOrder, true, true>(lds, g, S, E);
        for (int j = bid; j < DM / 32; j += nblk) {
            SEpiResid SE{WHICH == 2 ? IN_F(I_XS) : WS_F(WS_X) + (size_t)MP * DM, WS_F(WS_X), WS_F(WS_MOD) + (WHICH == 2 ? 2 : 8) * DM, 0.5f, 32 * j};
            sgemm64_unit<false>(WS_B(WS_H) + (size_t)MP * DFF, DFF, W + (size_t)(32 * j) * DFF, W, lds, SE); }
    } else if constexpr (WHICH == 3) {
        Gemm g{WS_B(WS_XN), WS_B(WS_WIN), MP, DIN, DM}; StaticOrder S; S.init(MP, DIN, nblk, bid);
        EpiProj E{a.ws, WS_F(WS_LF), a.out, WS_F(WS_LBV)};
        gemm_phase<EpiProj, StaticOrder, true, true>(lds, g, S, E);
        for (int j = bid - nblk / 2; j >= 0 && j < DIN / 32; j += nblk / 2) {
            SEpiProj SE{a.ws, a.out, 32 * j};
            sgemm64_unit<false>(WS_B(WS_XN) + (size_t)MP * DM, DM, WS_B(WS_WIN) + (size_t)(32 * j) * DM, WS_B(WS_WIN), lds, SE); }
    } else {
        Gemm g{WS_B(WS_OM), WS_B(WS_WOUT), MP, DM, DM}; StaticOrder S; S.init(MP, DM, nblk, bid);
        EpiResid E{nullptr, IN_F(I_XS), WS_F(WS_X), WS_F(WS_MOD) + 5 * DM, 1.0f};
        gemm_phase<EpiResid, StaticOrder, true, true>(lds, g, S, E);
        for (int j = bid; j < DM / 32; j += nblk) {
            SEpiResid SE{WS_F(WS_X) + (size_t)MP * DM, WS_F(WS_X), WS_F(WS_MOD) + 5 * DM, 1.0f, 32 * j};
            sgemm64_unit<false>(WS_B(WS_OM) + (size_t)MP * DM, DM, WS_B(WS_WOUT) + (size_t)(32 * j) * DM, WS_B(WS_WOUT), lds, SE); }
    }
}

constexpr size_t WS_QD = WS_PART + 48 * MiB, WS_KI = WS_QD + 17 * MiB, WS_DEC = WS_KI + 17 * MiB;
static_assert(WS_DEC + 2 * MiB <= 700 * MiB, "workspace map");
__device__ __forceinline__ void phase_hprep(const Args& a, int bid, int nblk) {
    const int tid = tid_opaque(), lane = tid & 63, w = tid >> 6;
    const float* LF = WS_F(WS_LF); const bf16* QA = WS_B(WS_QA);
    for (int item = bid * NWAVES + w; item < NB * NHEAD * (SEQ / 32); item += nblk * NWAVES) {
        const int u = item >> 6, c = item & 63, b = u >> 3, h = u & 7;
        const size_t g0 = (size_t)(b * SEQ + 32 * c) * DA + h * HD + 2 * lane;
        f32x2 bc = (f32x2){0.f, 0.f};
#pragma unroll 8
        for (int t = 0; t < 32; ++t) {
            const size_t o = g0 + (size_t)t * DA;
            const f32x2 l = *(const f32x2*)(LF + o); const unsigned q = *(const unsigned*)(QA + o);
            bc += l;
            const float k0 = 1.f - __builtin_amdgcn_exp2f(l.x), k1 = 1.f - __builtin_amdgcn_exp2f(l.y);
            const float e0 = __builtin_amdgcn_exp2f(bc.x), e1 = __builtin_amdgcn_exp2f(bc.y);
            const float n0 = __builtin_amdgcn_exp2f(-bc.x), n1 = __builtin_amdgcn_exp2f(-bc.y);
            *(unsigned*)(WS_B(WS_QD) + o) = cvtpk(bflo(q) * e0, bfhi(q) * e1);
            *(unsigned*)(WS_B(WS_KI) + o) = cvtpk(k0 * n0, k1 * n1);
        }
        const f32x2 tot = bc;
        *(f32x2*)(WS_F(WS_DEC) + ((size_t)u * 64 + c) * HD + 2 * lane) = (f32x2){__builtin_amdgcn_exp2f(tot.x), __builtin_amdgcn_exp2f(tot.y)};
    }
}

constexpr int HG_BUF = 25600, HG_QD = 0, HG_KI = 8192, HG_VV = 16384, HG_DEC = 24576, HG_SSX = 2 * HG_BUF;

__device__ __forceinline__ void hgrn_chain_prompt(const Args& a, LAS unsigned char* lds, int u) {
    const int tid = tid_opaque(), lane = tid & 63, w = __builtin_amdgcn_readfirstlane(tid >> 6);
    const int b = u >> 3, h = u & 7, row00 = b * SEQ;
    const bf16* IA = WS_B(WS_IA); const bf16* GA = WS_B(WS_GA);
    constexpr int NCH = SEQ / 32;
    if (w >= 4) {
        const int pt = tid - 256;
        const bf16* QD = WS_B(WS_QD); const bf16* KI = WS_B(WS_KI); const float* DEC = WS_F(WS_DEC) + (size_t)u * 64 * HD;
        const int row0 = pt >> 4, ch = pt & 15;
        const size_t gsrc = (size_t)(row00 + row0) * DA + h * HD + 8 * ch;
        const unsigned ld0 = off_a(row0, ch), ld1 = off_a(row0 + 16, ch);
        v4u rA[6], rB[6]; float dA = 0.f, dB = 0.f;
#define HG_LOAD(R, D, cc) do { const size_t o_ = gsrc + (size_t)(cc) * 32 * DA; R[0] = *(const v4u*)(QD + o_); R[1] = *(const v4u*)(QD + o_ + 16 * DA); R[2] = *(const v4u*)(KI + o_); R[3] = *(const v4u*)(KI + o_ + 16 * DA); \
            R[4] = *(const v4u*)(IA + o_); R[5] = *(const v4u*)(IA + o_ + 16 * DA); if (pt < 128) D = DEC[(size_t)(cc) * HD + pt]; } while (0)
#define HG_WRITE(R, D, cc) do { LAS unsigned char* b_ = lds + ((cc) & 1) * HG_BUF; *(LAS v4u*)(b_ + HG_QD + ld0) = R[0]; *(LAS v4u*)(b_ + HG_QD + ld1) = R[1]; *(LAS v4u*)(b_ + HG_KI + ld0) = R[2]; *(LAS v4u*)(b_ + HG_KI + ld1) = R[3]; \
            *(LAS v4u*)(b_ + HG_VV + ld0) = R[4]; *(LAS v4u*)(b_ + HG_VV + ld1) = R[5]; if (pt < 128) *(LAS float*)(b_ + HG_DEC + 4 * pt) = D; } while (0)
        HG_LOAD(rA, dA, 0); HG_LOAD(rB, dB, 1);
        for (int c = 0; c < NCH; c += 2) {
            HG_WRITE(rA, dA, c); if (c + 2 < NCH) HG_LOAD(rA, dA, c + 2);
            __syncthreads();
            HG_WRITE(rB, dB, c + 1); if (c + 3 < NCH) HG_LOAD(rB, dB, c + 3);
            __syncthreads();
        }
#undef HG_LOAD
#undef HG_WRITE
        __syncthreads();
    } else {
        const int r = lane & 31, hh = lane >> 5, q4 = (lane & 15) >> 2, p4 = lane & 3, blk = (lane >> 4) & 1;
        int pb[4];
#pragma unroll
        for (int x = 0; x < 4; ++x) pb[x] = (int)(2048u * (r >> 3) + 64u * (r & 7) + 16u * ((unsigned)x ^ ((r >> 2) & 3)) + 8u * hh);
        const int vp0 = (int)(64u * (4 * hh + q4) + 16u * ((2 * blk + (p4 >> 1)) ^ ((0u + hh) & 3)) + 8u * (p4 & 1));
        const int vp1 = (int)(2048u + 64u * (4 * hh + q4) + 16u * ((2 * blk + (p4 >> 1)) ^ ((2u + hh) & 3)) + 8u * (p4 & 1));
        const int nb0 = (int)(2048u * hh + 64u * q4 + 16u * ((2 * blk + (p4 >> 1)) ^ ((2u * hh) & 3)) + 8u * (p4 & 1));
        const int nb1 = (int)(2048u * hh + 64u * (4 + q4) + 16u * ((2 * blk + (p4 >> 1)) ^ ((2u * hh + 1) & 3)) + 8u * (p4 & 1));
        const int tm = r - 4 * hh;
        f32x16 S[4];
#pragma unroll
        for (int kt = 0; kt < 4; ++kt)
#pragma unroll
            for (int i = 0; i < 16; ++i) S[kt][i] = 0.f;
        f32x16 oprev;
#pragma unroll
        for (int i = 0; i < 16; ++i) oprev[i] = 0.f;
        const float* gwv = IN_F(I_GOA) + h * HD + 32 * w;
        __syncthreads();
        for (int c = 0; c < NCH; ++c) {
            const LAS unsigned char* buf = lds + (c & 1) * HG_BUF;
            if (c > 0) {
                const LAS float* sx = (const LAS float*)(lds + HG_SSX) + ((c - 1) & 1) * 128 + r;
                const float ss = (sx[0] + sx[32]) + (sx[64] + sx[96]);
                const float rstd = 1.0f / sqrtf(ss * (1.f / HD) + EPS);
                const size_t row = (size_t)(row00 + 32 * (c - 1) + r);
#pragma unroll
                for (int g = 0; g < 4; ++g) { const int dv = 32 * w + 8 * g + 4 * hh; const f32x4 gv = *(const f32x4*)(gwv + 8 * g + 4 * hh);
                    const v2u gt = *(const v2u*)(GA + row * DA + h * HD + dv);
                    v2u o2; o2.x = cvtpk(oprev[4 * g] * rstd * gv.x * bflo(gt.x), oprev[4 * g + 1] * rstd * gv.y * bfhi(gt.x));
                    o2.y = cvtpk(oprev[4 * g + 2] * rstd * gv.z * bflo(gt.y), oprev[4 * g + 3] * rstd * gv.w * bfhi(gt.y));
                    *(v2u*)(WS_B(WS_OM) + row * DM + h * HD + dv) = o2; }
            }
            bf16x8 qd[8];
#pragma unroll
            for (int ks = 0; ks < 8; ++ks) { const v2u lo = *(const LAS v2u*)(buf + HG_QD + pb[2 * (ks & 1)] + 512 * (ks >> 1)), hi = *(const LAS v2u*)(buf + HG_QD + pb[2 * (ks & 1) + 1] + 512 * (ks >> 1));
                qd[ks] = __builtin_bit_cast(bf16x8, (v4u){lo.x, lo.y, hi.x, hi.y}); }
            f32x16 at;
#pragma unroll
            for (int i = 0; i < 16; ++i) at[i] = 0.f;
#pragma unroll
            for (int ks = 0; ks < 8; ++ks) { const v2u lo = *(const LAS v2u*)(buf + HG_KI + pb[2 * (ks & 1)] + 512 * (ks >> 1)), hi = *(const LAS v2u*)(buf + HG_KI + pb[2 * (ks & 1) + 1] + 512 * (ks >> 1));
                at = MFMA32(__builtin_bit_cast(bf16x8, (v4u){lo.x, lo.y, hi.x, hi.y}), qd[ks], at); }
            f32x16 o;
#pragma unroll
            for (int i = 0; i < 16; ++i) o[i] = 0.f;
#pragma unroll
            for (int kt = 0; kt < 4; ++kt) { o = MFMA32(pack8<0>(S[kt]), qd[2 * kt], o); o = MFMA32(pack8<1>(S[kt]), qd[2 * kt + 1], o); }
#pragma unroll
            for (int i = 0; i < 16; ++i) at[i] = ((i & 3) + 8 * (i >> 2) <= tm) ? at[i] : 0.f;
            { const bf16x8 p0 = pack8<0>(at), p1 = pack8<1>(at);
              const LAS unsigned char* vv = buf + HG_VV + 512 * w;
              { const s16x4 lo = vtr(vv + vp0), hi = vtr(vv + vp1); o = MFMA32(__builtin_shufflevector(lo, hi, 0, 1, 2, 3, 4, 5, 6, 7), p0, o); }
              { const s16x4 lo = vtr(vv + vp0 + 4096), hi = vtr(vv + vp1 + 4096); o = MFMA32(__builtin_shufflevector(lo, hi, 0, 1, 2, 3, 4, 5, 6, 7), p1, o); } }
            { const LAS unsigned char* vv = buf + HG_VV + 512 * w;
              const s16x4 a0 = vtr(vv + nb0), a1 = vtr(vv + nb1), a2 = vtr(vv + nb0 + 4096), a3 = vtr(vv + nb1 + 4096);
              const bf16x8 vf0 = __builtin_shufflevector(a0, a1, 0, 1, 2, 3, 4, 5, 6, 7), vf1 = __builtin_shufflevector(a2, a3, 0, 1, 2, 3, 4, 5, 6, 7);
#pragma unroll
              for (int kt = 0; kt < 4; ++kt) {
                  const LAS unsigned char* ki = buf + HG_KI + 512 * kt;
                  const s16x4 k0 = vtr(ki + nb0), k1 = vtr(ki + nb1), k2 = vtr(ki + nb0 + 4096), k3 = vtr(ki + nb1 + 4096);
                  S[kt] = MFMA32(__builtin_shufflevector(k0, k1, 0, 1, 2, 3, 4, 5, 6, 7), vf0, S[kt]);
                  S[kt] = MFMA32(__builtin_shufflevector(k2, k3, 0, 1, 2, 3, 4, 5, 6, 7), vf1, S[kt]);
#pragma unroll
                  for (int g = 0; g < 4; ++g) { const f32x4 dc = *(const LAS f32x4*)(buf + HG_DEC + 4 * (32 * kt + 8 * g + 4 * hh));
                      S[kt][4 * g] *= dc.x; S[kt][4 * g + 1] *= dc.y; S[kt][4 * g + 2] *= dc.z; S[kt][4 * g + 3] *= dc.w; }
              } }
            { float ss = 0.f;
#pragma unroll
              for (int i = 0; i < 16; ++i) ss += o[i] * o[i];
              ss += __shfl_xor(ss, 32);
              if (hh == 0) ((LAS float*)(lds + HG_SSX))[(c & 1) * 128 + w * 32 + r] = ss; }
            oprev = o;
            __syncthreads();
        }
        {
            const LAS float* sx = (const LAS float*)(lds + HG_SSX) + ((NCH - 1) & 1) * 128 + r;
            const float ss = (sx[0] + sx[32]) + (sx[64] + sx[96]);
            const float rstd = 1.0f / sqrtf(ss * (1.f / HD) + EPS);
            const size_t row = (size_t)(row00 + 32 * (NCH - 1) + r);
#pragma unroll
            for (int g = 0; g < 4; ++g) { const int dv = 32 * w + 8 * g + 4 * hh; const f32x4 gv = *(const f32x4*)(gwv + 8 * g + 4 * hh);
                const v2u gt = *(const v2u*)(GA + row * DA + h * HD + dv);
                v2u o2; o2.x = cvtpk(oprev[4 * g] * rstd * gv.x * bflo(gt.x), oprev[4 * g + 1] * rstd * gv.y * bfhi(gt.x));
                o2.y = cvtpk(oprev[4 * g + 2] * rstd * gv.z * bflo(gt.y), oprev[4 * g + 3] * rstd * gv.w * bfhi(gt.y));
                *(v2u*)(WS_B(WS_OM) + row * DM + h * HD + dv) = o2; }
        }
        float* sout = a.out + OFF_SP + (size_t)u * HD * HD;
#pragma unroll
        for (int kt = 0; kt < 4; ++kt)
#pragma unroll
            for (int i = 0; i < 16; ++i) sout[(size_t)(32 * kt + (i & 3) + 8 * (i >> 2) + 4 * hh) * HD + 32 * w + r] = S[kt][i];
    }
}
struct SbLane {
    int kb0, kb1;
    int vb0, vb1;
    bf16x8 nu0, nu1;
};
__device__ __forceinline__ SbLane sb_lane_init(int lane) {
    SbLane L; const unsigned r = lane & 31, h = lane >> 5, q = (lane & 15) >> 2, p = lane & 3, blk = (lane >> 4) & 1;
    L.kb0 = (int)(2048u * (r >> 3) + 64u * (r & 7) + 16u * ((0u + h) ^ ((r >> 2) & 3)));
    L.kb1 = (int)(2048u * (r >> 3) + 64u * (r & 7) + 16u * ((2u + h) ^ ((r >> 2) & 3)));
    L.vb0 = (int)(64u * (4 * h + q) + 16u * ((2 * blk + (p >> 1)) ^ ((0u + h) & 3)) + 8u * (p & 1));
    L.vb1 = (int)(2048u + 64u * (4 * h + q) + 16u * ((2 * blk + (p >> 1)) ^ ((2u + h) & 3)) + 8u * (p & 1));
#pragma unroll
    for (int j = 0; j < 8; ++j) { const unsigned k0 = 8 * (j >> 2) + 4 * h + (j & 3), k1 = 16 + k0;
        L.nu0[j] = (k0 >= r) ? (short)0xBF80 : (short)0; L.nu1[j] = (k1 >= r) ? (short)0xBF80 : (short)0; }
    return L;
}
__device__ __forceinline__ void sbm_step(const LAS unsigned char* kt, const LAS unsigned char* vt, const LAS unsigned char* qfl  , int qstride, float bias2, const SbLane& L, f32x16 (&o)[4], float& R, int lane, int tq) {
    f32x16 zt;
#pragma unroll
    for (int r = 0; r < 16; ++r) zt[r] = bias2;
#pragma unroll
    for (int s = 0; s < 8; ++s) { const bf16x8 kf = *(const LAS bf16x8*)(kt + ((s & 1) ? L.kb1 : L.kb0) + 512 * (s >> 1)); const bf16x8 qf = *(const LAS bf16x8*)(qfl + qstride * s); zt = MFMA32(kf, qf, zt); }
    f32x16 sp, cin;
#pragma unroll
    for (int r = 0; r < 16; ++r) {
        const float e = __builtin_amdgcn_exp2f(zt[r]); float l = __builtin_amdgcn_logf(1.f + e); l = zt[r] > 30.f ? zt[r] : l;
        l = ((r & 3) + 8 * (r >> 2) < tq) ? l : 0.f;
        sp[r] = l; cin[r] = zt[r] + R;
    }
    f32x16 out = MFMA32(L.nu0, pack8<0>(sp), cin);
    out = MFMA32(L.nu1, pack8<1>(sp), out);
    const float rn = out[0] - zt[0];
    R = __shfl(rn, lane & 31);
    f32x16 p;
#pragma unroll
    for (int r = 0; r < 16; ++r) { float v = __builtin_amdgcn_exp2f(out[r]); v = ((r & 3) + 8 * (r >> 2) < tq) ? v : 0.f; p[r] = v; }
    const bf16x8 p0 = pack8<0>(p), p1 = pack8<1>(p);
#pragma unroll
    for (int c = 0; c < 4; ++c) {
        { const s16x4 lo = vtr(vt + L.vb0 + 512 * c), hi = vtr(vt + L.vb1 + 512 * c); const bf16x8 vf = __builtin_shufflevector(lo, hi, 0, 1, 2, 3, 4, 5, 6, 7); o[c] = MFMA32(vf, p0, o[c]); }
        { const s16x4 lo = vtr(vt + L.vb0 + 4096 + 512 * c), hi = vtr(vt + L.vb1 + 4096 + 512 * c); const bf16x8 vf = __builtin_shufflevector(lo, hi, 0, 1, 2, 3, 4, 5, 6, 7); o[c] = MFMA32(vf, p1, o[c]); }
    }
}
__device__ __forceinline__ void sbm_finish(const Args& a, const f32x16 (&o)[4], int row, int h, int lane) {
    float ss = 0.f;
#pragma unroll
    for (int c = 0; c < 4; ++c)
#pragma unroll
        for (int r = 0; r < 16; ++r) ss += o[c][r] * o[c][r];
    ss += __shfl_xor(ss, 32);
    const float rstd = 1.0f / sqrtf(ss * (1.f / HD) + EPS);
    const int hh = lane >> 5; const float* gw = IN_F(I_GOB) + h * HD; bf16* dst = WS_B(WS_OM) + (size_t)row * DM + DA + h * HD;
#pragma unroll
    for (int c = 0; c < 4; ++c)
#pragma unroll
        for (int g = 0; g < 4; ++g) { const int d = 32 * c + 8 * g + 4 * hh; const f32x4 gv = *(const f32x4*)(gw + d);
            v2u w; w.x = cvtpk(o[c][4 * g + 0] * rstd * gv.x, o[c][4 * g + 1] * rstd * gv.y); w.y = cvtpk(o[c][4 * g + 2] * rstd * gv.z, o[c][4 * g + 3] * rstd * gv.w);
            *(v2u*)(dst + d) = w; }
}
__device__ __forceinline__ void sbm_unit_prompt(const Args& a, LAS unsigned char* lds, int bh, int qb) {
    const int tid = tid_opaque(), lane = tid & 63, w = __builtin_amdgcn_readfirstlane(tid >> 6);
    const int b = bh >> 3, h = bh & 7, q0 = 256 * qb + 32 * w, idiag = 8 * qb + w;
    const SbLane L = sb_lane_init(lane);
    const bf16* QB = WS_B(WS_QB); const bf16* KB = WS_B(WS_KB); const bf16* VB = WS_B(WS_VB);
    LAS unsigned char* qfl = lds + 65536 + w * 8192 + lane * 16;
    { const bf16* qp = QB + (size_t)(b * SEQ + q0 + (lane & 31)) * DA + h * HD + 8 * (lane >> 5);
#pragma unroll
      for (int s = 0; s < 8; ++s) *(LAS bf16x8*)(qfl + 1024 * s) = *(const bf16x8*)(qp + 16 * s); }
    const float bias2 = IN_F(I_BSB)[h] * LOG2E;
    f32x16 o[4];
#pragma unroll
    for (int c = 0; c < 4; ++c)
#pragma unroll
        for (int r = 0; r < 16; ++r) o[c][r] = 0.f;
    float R = 0.f; const int tq = (lane & 31) - 4 * (lane >> 5);
    const int key0 = tid >> 4, ch = tid & 15;
    const size_t gsrc = (size_t)(b * SEQ + key0) * DA + h * HD + 8 * ch;
    const unsigned ldst = off_a(key0 & 31, ch);
    v4u kr[2], vr[2];
    int j = 4 * qb + 3;
#define SBM_LOAD(jj) do { const size_t o_ = gsrc + (size_t)(jj) * 64 * DA; kr[0] = *(const v4u*)(KB + o_); vr[0] = *(const v4u*)(VB + o_); kr[1] = *(const v4u*)(KB + o_ + 32 * DA); vr[1] = *(const v4u*)(VB + o_ + 32 * DA); } while (0)
#define SBM_WRITE(buf) do { LAS unsigned char* b_ = lds + (buf) * 32768; *(LAS v4u*)(b_ + ldst) = kr[0]; *(LAS v4u*)(b_ + 8192 + ldst) = kr[1]; *(LAS v4u*)(b_ + 16384 + ldst) = vr[0]; *(LAS v4u*)(b_ + 16384 + 8192 + ldst) = vr[1]; } while (0)
    SBM_LOAD(j); SBM_WRITE(0);
    __syncthreads();
    int cur = 0;
    for (; j >= 0; --j) {
        if (j > 0) SBM_LOAD(j - 1);
        const LAS unsigned char* kb_ = lds + cur * 32768; const LAS unsigned char* vb_ = kb_ + 16384;
#pragma unroll 1
        for (int tt = 1; tt >= 0; --tt) { const int ti = 2 * j + tt;
            if (ti <= idiag) sbm_step(kb_ + tt * 8192, vb_ + tt * 8192, qfl, 1024, bias2, L, o, R, lane, ti == idiag ? tq : 64); }
        if (j > 0) SBM_WRITE(cur ^ 1);
        __syncthreads();
        cur ^= 1;
    }
#undef SBM_LOAD
#undef SBM_WRITE
    sbm_finish(a, o, b * SEQ + q0 + (lane & 31), h, lane);
}


constexpr int SEGK = 256, NSEG = PAST / SEGK, PART_STRIDE = 132;
__device__ __forceinline__ void sbm_unit_sample(const Args& a, LAS unsigned char* lds, int b, int seg) {
    const int tid = tid_opaque(), lane = tid & 63, w = __builtin_amdgcn_readfirstlane(tid >> 6);
    const SbLane L = sb_lane_init(lane);
    LAS unsigned char* kimg = lds + w * 16384; LAS unsigned char* vimg = kimg + 8192;
    LAS unsigned char* qreg = lds + 131072 + w * 2048;
    LAS unsigned char* zchunk = lds + 131072 + 16384 + w * 16;
    const int r = lane & 31, hh = lane >> 5;
    if (r < 8) { const bf16* qp = WS_B(WS_QB) + (size_t)(MP + b * DECT + r) * DA + w * HD + 8 * hh;
#pragma unroll
        for (int s = 0; s < 8; ++s) *(LAS bf16x8*)(qreg + (s * 16 + hh * 8 + r) * 16) = *(const bf16x8*)(qp + 16 * s); }
    if (lane == 0) { unsigned z_ = 0u; asm volatile("" : "+v"(z_)); *(LAS v4u*)zchunk = (v4u){z_, z_, z_, z_}; }
    const LAS unsigned char* qfl = r < 8 ? qreg + (hh * 8 + r) * 16 : zchunk; const int qstride = r < 8 ? 256 : 0;
    const float bias2 = IN_F(I_BSB)[w] * LOG2E;
    f32x16 o[4];
#pragma unroll
    for (int c = 0; c < 4; ++c)
#pragma unroll
        for (int q = 0; q < 16; ++q) o[c][q] = 0.f;
    float R = 0.f;
    LDS_WAIT();
    if (seg == NSEG - 1) {
        { const int j = lane >> 3, c2 = (lane & 7) * 2; const size_t src = (size_t)(MP + b * DECT + j) * DA + w * HD + 8 * c2;
          const v4u k0 = *(const v4u*)(WS_B(WS_KB) + src), k1 = *(const v4u*)(WS_B(WS_KB) + src + 8), v0 = *(const v4u*)(WS_B(WS_VB) + src), v1 = *(const v4u*)(WS_B(WS_VB) + src + 8);
          *(LAS v4u*)(kimg + off_a(j, c2)) = k0; *(LAS v4u*)(kimg + off_a(j, c2 + 1)) = k1; *(LAS v4u*)(vimg + off_a(j, c2)) = v0; *(LAS v4u*)(vimg + off_a(j, c2 + 1)) = v1; }
        { unsigned z_ = 0u; asm volatile("" : "+v"(z_)); const v4u zz = (v4u){z_, z_, z_, z_};
#pragma unroll
        for (int i = 0; i < 6; ++i) { const int n = lane + 64 * i, row = 8 + (n >> 4), c1 = n & 15; *(LAS v4u*)(kimg + off_a(row, c1)) = zz; *(LAS v4u*)(vimg + off_a(row, c1)) = zz; } }
        LDS_WAIT();
        sbm_step(kimg, vimg, qfl, qstride, bias2, L, o, R, lane, r - 4 * hh);
        LDS_WAIT();
    }
    const int* pt = (const int*)a.in[I_PT] + b * NPAGES;
    const float* ck = IN_F(I_CK); const float* cv = IN_F(I_CV);
    const int ch = r >> 1; const unsigned wconst = 512u * (ch >> 2) + 64u * hh + 8u * (lane & 1);
    f32x4 kr[8], vr[8];
#define SBS_LOAD(ti, hf) do { const int p_ = seg * SEGK + 32 * (ti); const size_t base_ = ((size_t)pt[p_ >> 7] * PAGE + (p_ & 127) + 16 * (hf) + hh) * (NHEAD * HD) + w * HD + 4 * r; \
        _Pragma("unroll") for (int i_ = 0; i_ < 8; ++i_) { kr[i_] = *(const f32x4*)(ck + base_ + (size_t)(2 * i_) * (NHEAD * HD)); vr[i_] = *(const f32x4*)(cv + base_ + (size_t)(2 * i_) * (NHEAD * HD)); } } while (0)
#define SBS_WRITE(hf) do { _Pragma("unroll") for (int i_ = 0; i_ < 8; ++i_) { \
        const unsigned off_ = 2048u * (2 * (hf) + (i_ >> 2)) + 64u * (2 * (i_ & 3)) + 16u * ((unsigned)(ch & 3) ^ (unsigned)((i_ >> 1) & 3)) + wconst; \
        v2u kk_, vv_; kk_.x = cvtpk(kr[i_].x, kr[i_].y); kk_.y = cvtpk(kr[i_].z, kr[i_].w); vv_.x = cvtpk(vr[i_].x, vr[i_].y); vv_.y = cvtpk(vr[i_].z, vr[i_].w); \
        *(LAS v2u*)(kimg + off_) = kk_; *(LAS v2u*)(vimg + off_) = vv_; } } while (0)
    SBS_LOAD(SEGK / 32 - 1, 1);
#pragma unroll 1
    for (int ti = SEGK / 32 - 1; ti >= 0; --ti) {
        SBS_WRITE(1);
        SBS_LOAD(ti, 0);
        SBS_WRITE(0);
        if (ti > 0) SBS_LOAD(ti - 1, 1);
        LDS_WAIT();
        sbm_step(kimg, vimg, qfl, qstride, bias2, L, o, R, lane, 64);
        LDS_WAIT();
    }
#undef SBS_LOAD
#undef SBS_WRITE
    if (r < 8) { float* dst = WS_F(WS_PART) + ((((size_t)b * NSEG + seg) * NHEAD + w) * 8 + r) * PART_STRIDE;
#pragma unroll
        for (int c = 0; c < 4; ++c)
#pragma unroll
            for (int g = 0; g < 4; ++g) *(f32x4*)(dst + 32 * c + 8 * g + 4 * hh) = (f32x4){o[c][4 * g], o[c][4 * g + 1], o[c][4 * g + 2], o[c][4 * g + 3]};
        if (hh == 0) dst[128] = R; }
}
__device__ __forceinline__ void phase_sbcombine(const Args& a, int bid, int nblk) {
    const int tid = tid_opaque(), lane = tid & 63, w = tid >> 6;
    static_assert(NSEG == 64, "one lane per segment");
    for (int item = bid * NWAVES + w; item < DECB * NHEAD * 8; item += nblk * NWAVES) {
        const int b = item >> 6, h = (item >> 3) & 7, i = item & 7;
        const float* p0 = WS_F(WS_PART) + (((size_t)b * NSEG * NHEAD + h) * 8 + i) * PART_STRIDE;
        const size_t sstride = (size_t)NHEAD * 8 * PART_STRIDE;
        const float rseg = p0[(size_t)lane * sstride + 128];
        float suf = rseg;
#pragma unroll
        for (int off = 1; off < 64; off <<= 1) { const float t = __shfl_down(suf, off); if (lane + off < 64) suf += t; }
        const float fac = __builtin_amdgcn_exp2f(suf - rseg);
        float o0 = 0.f, o1 = 0.f;
#pragma unroll 8
        for (int s = 0; s < NSEG; ++s) { const float f = __builtin_bit_cast(float, __builtin_amdgcn_readlane(__builtin_bit_cast(int, fac), s));
            o0 += f * p0[(size_t)s * sstride + lane]; o1 += f * p0[(size_t)s * sstride + 64 + lane]; }
        const float ss = wave_sum(o0 * o0 + o1 * o1);
        const float rstd = 1.0f / sqrtf(ss * (1.f / HD) + EPS);
        const float* gw = IN_F(I_GOB) + h * HD; bf16* dst = WS_B(WS_OM) + (size_t)(MP + b * DECT + i) * DM + DA + h * HD;
        dst[lane] = (bf16)f2bf(o0 * rstd * gw[lane]); dst[64 + lane] = (bf16)f2bf(o1 * rstd * gw[64 + lane]);
    }
}

constexpr int CTL_MIXQ = 4096;
__device__ __forceinline__ int queue_next(const Args& a, LAS unsigned char* lds, int tid, int qword) {
    LAS int* slot = (LAS int*)(lds + LDS_BYTES - 64);
    __syncthreads();
    if (tid == 0) *slot = (int)__hip_atomic_fetch_add((unsigned*)(a.ws + WS_CTL) + qword, 1u, __ATOMIC_RELAXED, __HIP_MEMORY_SCOPE_AGENT);
    __syncthreads();
    return *slot;
}
__device__ __forceinline__ void phase_mixer(const Args& a, LAS unsigned char* lds, int bid, int nblk, int qword = CTL_MIXQ, int ulo = 0, int uhi = 1 << 30) {
    const int tid = tid_opaque();
    constexpr int U0 = 32, U2 = U0 + 256 + DECB * NSEG, U3 = U2 + 64;
    static_assert(DECB * NSEG == 512, "two streaming units per prompt block");
    for (;;) {
        const int u = queue_next(a, lds, tid, qword) + ulo;
        if (u >= U3 || u >= uhi) break;
        if (u < U0) hgrn_chain_prompt(a, lds, u);
        else if (u < U2) { const int k = u - U0, g = k / 3, r3 = k - 3 * g;
            if (r3 == 0) sbm_unit_prompt(a, lds, g & 31, 7 - (g >> 5));
            else { const int v = 2 * g + r3 - 1; sbm_unit_sample(a, lds, v & 7, NSEG - 1 - (v >> 3)); } }
        else hgrn_unit(a, lds, 32 + (u - U2));
    }
}

enum { PH_MOD = 0, PH_CVT, PH_NORM1, PH_G1, PH_G2, PH_NORM2, PH_G3, PH_MIX, PH_G4, PH_NORM3, PH_G5, PH_G6, PH_FINAL, N_PHASES };

template <int PH> __device__ __forceinline__ void run_phase(const Args& a, LAS unsigned char* lds, int bid, int nblk) {
    if constexpr (PH == PH_MOD) phase_mod(a, lds, bid, nblk);
    else if constexpr (PH == PH_CVT) phase_cvt(a, lds, bid, nblk, 0, 2);
    else if constexpr (PH == PH_NORM1) phase_norm<false>(a, bid, nblk, true, IN_F(I_N1), WS_F(WS_MOD), NMODC, 0 * DM, 1 * DM);
    else if constexpr (PH == PH_G1) phase_gemm<1>(a, lds, bid, nblk);
    else if constexpr (PH == PH_G2) phase_gemm<2>(a, lds, bid, nblk);
    else if constexpr (PH == PH_NORM2) phase_norm<false>(a, bid, nblk, false, IN_F(I_NM), WS_F(WS_MOD), NMODC, 3 * DM, 4 * DM);
    else if constexpr (PH == PH_G3) phase_gemm<3>(a, lds, bid, nblk);
    else if constexpr (PH == PH_MIX) phase_mixer(a, lds, bid, nblk);
    else if constexpr (PH == PH_G4) phase_gemm<4>(a, lds, bid, nblk);
    else if constexpr (PH == PH_NORM3) phase_norm<false>(a, bid, nblk, false, IN_F(I_N2), WS_F(WS_MOD), NMODC, 6 * DM, 7 * DM);
    else if constexpr (PH == PH_G5) phase_gemm<5>(a, lds, bid, nblk);
    else if constexpr (PH == PH_G6) phase_gemm<6>(a, lds, bid, nblk);
    else phase_norm<true>(a, bid, nblk, false, IN_F(I_NF), WS_F(WS_FMOD), NFMODC, 0, DM);
}

#define XB_TMO      128
#define XB_XCNT(j)  (256  + 64 * (j))
#define XB_XSUB(j)  (1280 + 64 * (j))
#define XB_XGEN(j)  (2304 + 64 * (j))
#define XB_TOP      3328
#define XB_TOPGEN   3392
#define XCD_BAR_WORDS 3456
#define XB_SPIN_CAP (1u << 18)

__device__ __forceinline__ unsigned xb_ld(unsigned* p)              { return __hip_atomic_load(p, __ATOMIC_RELAXED, __HIP_MEMORY_SCOPE_AGENT); }
__device__ __forceinline__ unsigned xb_add(unsigned* p, unsigned v) { return __hip_atomic_fetch_add(p, v, __ATOMIC_RELAXED, __HIP_MEMORY_SCOPE_AGENT); }
__device__ __forceinline__ unsigned xb_xcc_id() { return (unsigned)__builtin_amdgcn_s_getreg((3 << 11) | 20) & 0xFu; }
#define XB_SPIN(cond, bar) do { unsigned _sp = 0; while (cond) { __builtin_amdgcn_s_sleep(1); \
    if ((++_sp & 255u) == 0u) { if (xb_ld(&(bar)[XB_TMO])) break; if (_sp > XB_SPIN_CAP) { atomicAdd(&(bar)[XB_TMO], 1u); break; } } } } while (0)

struct XcdBarrier {
    unsigned* bar; unsigned x;
    volatile LAS unsigned* st;
};

__device__ __forceinline__ XcdBarrier xcd_barrier_post(unsigned* bar, volatile LAS unsigned* st) {
    XcdBarrier b; b.bar = bar; b.x = xb_xcc_id(); b.st = st;
    if (threadIdx.x == 0) (void)xb_add(&bar[XB_XCNT(b.x)], 1u);
    return b;
}
__device__ __forceinline__ void xcd_barrier_complete(unsigned* bar, unsigned x, unsigned& nloc, unsigned& nx) {
    const unsigned G = gridDim.x * gridDim.y * gridDim.z;
    unsigned sum, cnt, mine, sp = 0u;
    for (;;) {
        sum = 0u; cnt = 0u; mine = 0u;
#pragma unroll
        for (unsigned j = 0; j < 16; ++j) { const unsigned c = xb_ld(&bar[XB_XCNT(j)]); sum += c; cnt += (c > 0u) ? 1u : 0u; mine = (j == x) ? c : mine; }
        if (sum == G) break;
        __builtin_amdgcn_s_sleep(1);
        if ((++sp & 255u) == 0u) { if (xb_ld(&bar[XB_TMO])) break; if (sp > XB_SPIN_CAP) { atomicAdd(&bar[XB_TMO], 1u); break; } }
    }
    nloc = mine > 0u ? mine : 1u; nx = cnt > 0u ? cnt : 1u;
}

__device__ __forceinline__ void xcd_barrier(const XcdBarrier& b) {
    asm volatile("s_waitcnt vmcnt(0)" ::: "memory");
    __syncthreads();
    if (threadIdx.x == 0) {
        unsigned* bar = b.bar;
        __builtin_amdgcn_s_waitcnt(0);
        unsigned nloc = b.st[0], nx = b.st[1];
        if (nloc == 0u) { xcd_barrier_complete(bar, b.x, nloc, nx); b.st[0] = nloc; b.st[1] = nx; }
        const unsigned old = xb_add(&bar[XB_XSUB(b.x)], 1u);
        const unsigned gen = old / nloc;
        if (old + 1u == (gen + 1u) * nloc) {
            __builtin_amdgcn_fence(__ATOMIC_RELEASE, "agent");
            asm volatile("s_waitcnt vmcnt(0)" ::: "memory");
            const unsigned og = xb_add(&bar[XB_TOP], 1u);
            const unsigned tg = og / nx;
            if (og + 1u == (tg + 1u) * nx) xb_add(&bar[XB_TOPGEN], 1u);
            else XB_SPIN(xb_ld(&bar[XB_TOPGEN]) == tg, bar);
            __builtin_amdgcn_fence(__ATOMIC_ACQUIRE, "agent");
            xb_add(&bar[XB_XGEN(b.x)], 1u);
            asm volatile("s_waitcnt vmcnt(0)" ::: "memory");
        } else {
            XB_SPIN(xb_ld(&bar[XB_XGEN(b.x)]) == gen, bar);
            __builtin_amdgcn_fence(__ATOMIC_ACQUIRE, "agent");
            asm volatile("s_waitcnt vmcnt(0)" ::: "memory");
        }
    }
    __syncthreads();
}


constexpr int LDS_BAR_OFF = LDS_BYTES;
constexpr int LDS_TOTAL = LDS_BYTES + 64;

__global__ void __launch_bounds__(NTHR, 2) mega_fwd(Args a) {
    extern __shared__ __attribute__((aligned(16))) unsigned char lds_raw[];
    LAS unsigned char* lds = (LAS unsigned char*)lds_raw;
    const int bid = (int)blockIdx.x, nblk = (int)gridDim.x;
    if (threadIdx.x < 16) ((LAS unsigned*)(lds + LDS_BAR_OFF))[threadIdx.x] = 0u;
    __syncthreads();
    XcdBarrier bar = xcd_barrier_post((unsigned*)(a.ws + WS_CTL), (volatile LAS unsigned*)(lds + LDS_BAR_OFF));
    run_phase<PH_MOD>(a, lds, bid, nblk);
    __syncthreads();
    run_phase<PH_CVT>(a, lds, bid, nblk);
    xcd_barrier(bar);
#ifdef PROBE_DUP_P0
    run_phase<PH_MOD>(a, lds, bid, nblk);
    __syncthreads();
    run_phase<PH_CVT>(a, lds, bid, nblk);
    xcd_barrier(bar);
#endif
    run_phase<PH_NORM1>(a, lds, bid, nblk);
    xcd_barrier(bar);
    run_phase<PH_G1>(a, lds, bid, nblk);
    xcd_barrier(bar);
#ifdef PROBE_DUP_G1
    run_phase<PH_G1>(a, lds, bid, nblk);
    xcd_barrier(bar);
#endif
    run_phase<PH_G2>(a, lds, bid, nblk);
    xcd_barrier(bar);
#ifdef PROBE_DUP_G2
    run_phase<PH_G2>(a, lds, bid, nblk);
    xcd_barrier(bar);
#endif
    run_phase<PH_NORM2>(a, lds, bid, nblk);
    xcd_barrier(bar);
#ifdef PROBE_DUP_N2
    run_phase<PH_NORM2>(a, lds, bid, nblk);
    xcd_barrier(bar);
#endif
    run_phase<PH_G3>(a, lds, bid, nblk);
    xcd_barrier(bar);
#ifdef PROBE_DUP_G3
    run_phase<PH_G3>(a, lds, bid, nblk);
    xcd_barrier(bar);
#endif
    phase_hprep(a, bid, nblk);
    xcd_barrier(bar);
    run_phase<PH_MIX>(a, lds, bid, nblk);
    xcd_barrier(bar);
#ifdef PROBE_DUP_MIX
    phase_mixer(a, lds, bid, nblk, CTL_MIXQ + 64, PROBE_MIX_LO, PROBE_MIX_HI);
    xcd_barrier(bar);
#endif
    phase_sbcombine(a, bid, nblk);
    xcd_barrier(bar);
    run_phase<PH_G4>(a, lds, bid, nblk);
    xcd_barrier(bar);
    run_phase<PH_NORM3>(a, lds, bid, nblk);
    xcd_barrier(bar);
    run_phase<PH_G5>(a, lds, bid, nblk);
    xcd_barrier(bar);
    run_phase<PH_G6>(a, lds, bid, nblk);
    xcd_barrier(bar);
    run_phase<PH_FINAL>(a, lds, bid, nblk);
}

extern "C" void kernel_launch(void* const* d_in, const int* in_sizes, int n_in, void* d_out, int out_size, void* d_ws, size_t ws_size, hipStream_t stream) {
    static int grid = 0;
    if (grid == 0) {
        if (n_in != N_IN || (size_t)out_size != OUT_TOTAL || ws_size < WS_END) { fprintf(stderr, "kernel_launch: unexpected shapes (n_in %d, out %d, ws %zu)\n", n_in, out_size, ws_size); grid = -1; return; }
        int dev = 0, cus = 0, per_cu = 0;
        if (hipGetDevice(&dev) != hipSuccess || hipDeviceGetAttribute(&cus, hipDeviceAttributeMultiprocessorCount, dev) != hipSuccess) { grid = -1; return; }
        if (hipFuncSetAttribute((const void*)mega_fwd, hipFuncAttributeMaxDynamicSharedMemorySize, LDS_TOTAL) != hipSuccess) { fprintf(stderr, "kernel_launch: hipFuncSetAttribute failed\n"); grid = -1; return; }
        if (hipOccupancyMaxActiveBlocksPerMultiprocessor(&per_cu, (const void*)mega_fwd, NTHR, LDS_TOTAL) != hipSuccess || per_cu < 1) { fprintf(stderr, "kernel_launch: occupancy query says %d blocks per CU\n", per_cu); grid = -1; (void)hipGetLastError(); return; }
        grid = cus;
    }
    if (grid < 0) return;
    (void)hipMemsetAsync((char*)d_ws + WS_CTL, 0, 65536, stream);
    Args a{};
    for (int i = 0; i < N_IN; ++i) a.in[i] = d_in[i];
    a.out = (float*)d_out; a.ws = (unsigned char*)d_ws;
    hipLaunchKernelGGL(mega_fwd, dim3(grid), dim3(NTHR), LDS_TOTAL, stream, a);
}
```

```cpp
#include <hip/hip_runtime.h>
#include <cstdio>
#include <cstdint>

constexpr int DM = 2048, SEQ = 2048, NB = 4, MP = NB * SEQ  , DECB = 8, DECT = 8, MS = DECB * DECT  ;
constexpr int MREAL = MP + MS  , MPAD = 8448  ;
constexpr int DFF = 5632, DIN = 7168, NMODC = 9 * DM  , NFMODC = 2 * DM;
constexpr int DA = 1024, NHEAD = 8, HD = 128, PAST = 16384, PAGE = 128, NPAGES = PAST / PAGE  ;
constexpr float EPS = 1e-6f, QSCALE = 0.08838834764831845f  ;
constexpr float LOG2E = 1.4426950408889634f, LN2 = 0.6931471805599453f;
constexpr size_t OFF_YP = 0, OFF_YS = OFF_YP + (size_t)MP * DM, OFF_KP = OFF_YS + (size_t)MS * DM, OFF_VP = OFF_KP + (size_t)MP * DA,
                 OFF_KS = OFF_VP + (size_t)MP * DA, OFF_VS = OFF_KS + (size_t)MS * DA, OFF_SP = OFF_VS + (size_t)MS * DA,
                 OFF_SS = OFF_SP + (size_t)NB * NHEAD * HD * HD, OUT_TOTAL = OFF_SS + (size_t)DECB * NHEAD * HD * HD;
enum { I_XP = 0, I_XS, I_CK, I_CV, I_ST, I_PT, I_CP, I_CS, I_LB, I_N1, I_NM, I_N2, I_WMOD, I_BMOD, I_WG1, I_WU1, I_WD1, I_WIN, I_GOA, I_GOB, I_BSB, I_WOUT,
       I_WG2, I_WU2, I_WD2, I_NF, I_WFM, I_BFM, N_IN };
constexpr size_t MiB = 1u << 20;
constexpr size_t WS_CTL = 0, CTL_BYTES = 1 * MiB;
constexpr size_t WS_MOD = 1 * MiB;
constexpr size_t WS_FMOD = 2 * MiB;
constexpr size_t WS_LBV = 3 * MiB;
constexpr size_t WS_WGU1 = 4 * MiB, WS_WD1 = 48 * MiB, WS_WIN = 70 * MiB, WS_WOUT = 98 * MiB, WS_WGU2 = 106 * MiB, WS_WD2 = 150 * MiB;
constexpr size_t WS_XN = 172 * MiB;
constexpr size_t WS_H = 206 * MiB;
constexpr size_t WS_X = 298 * MiB;
constexpr size_t WS_QA = 364 * MiB, WS_IA = 381 * MiB, WS_GA = 398 * MiB, WS_QB = 415 * MiB, WS_KB = 432 * MiB, WS_VB = 449 * MiB;
constexpr size_t WS_LF = 466 * MiB;
constexpr size_t WS_OM = 500 * MiB;
constexpr size_t WS_PART = 534 * MiB;
constexpr size_t WS_END = 900 * MiB;

#define GAS __attribute__((address_space(1)))
#define LAS __attribute__((address_space(3)))
typedef unsigned short bf16;
typedef unsigned v4u __attribute__((ext_vector_type(4)));
typedef unsigned v2u __attribute__((ext_vector_type(2)));
typedef float f32x4 __attribute__((ext_vector_type(4)));
typedef float f32x2 __attribute__((ext_vector_type(2)));
typedef short bf16x8 __attribute__((ext_vector_type(8)));

struct Args { const void* in[N_IN]; float* out; unsigned char* ws; };
typedef const __attribute__((address_space(4))) Args& ArgsRef;
typedef const __attribute__((address_space(4))) Args* ArgsPtr;

__device__ __forceinline__ unsigned f2bf(float f) { unsigned u = __builtin_bit_cast(unsigned, f); return (u + 0x7fffu + ((u >> 16) & 1u)) >> 16; }
__device__ __forceinline__ unsigned pk2(float lo, float hi) { return f2bf(lo) | (f2bf(hi) << 16); }
__device__ __forceinline__ float bf2f(unsigned short b) { return __builtin_bit_cast(float, (unsigned)b << 16); }
__device__ __forceinline__ float bflo(unsigned w) { return __builtin_bit_cast(float, w << 16); }
__device__ __forceinline__ float bfhi(unsigned w) { return __builtin_bit_cast(float, w & 0xffff0000u); }
__device__ __forceinline__ float sigmoid_f(float x) { return __builtin_amdgcn_rcpf(1.f + __expf(-x)); }
__device__ __forceinline__ float silu_f(float x) { return x * sigmoid_f(x); }
__device__ __forceinline__ int mod_row(int r) { const int s = 4 + ((r - MP) >> 3); return r < MP ? (r >> 11) : (s > 11 ? 11 : s); }
__device__ __forceinline__ float wave_sum(float v) {
#pragma unroll
    for (int o = 1; o < 64; o <<= 1) v += __shfl_xor(v, o);
    return v;
}
__device__ __forceinline__ int tid_opaque() { int t = (int)threadIdx.x; asm volatile("" : "+v"(t)); return t; }
#define LDS_WAIT() asm volatile("s_waitcnt lgkmcnt(0)" ::: "memory")
#define VM_WAIT() asm volatile("s_waitcnt vmcnt(0)" ::: "memory")

namespace pg8 {
#define PG8_LAS __attribute__((address_space(3)))
typedef unsigned short bf16_t;
typedef short bf16x8 __attribute__((ext_vector_type(8)));
typedef float f32x4 __attribute__((ext_vector_type(4)));
typedef unsigned u32x4 __attribute__((ext_vector_type(4)));
constexpr int BM = 256, BK = 64, HALF = 128, HTB = HALF * BK * 2  , STAGE_BYTES = 8 * HTB, NXCD = 8, WGM = 8;

__host__ __device__ __forceinline__ int lds_byte(int r, int c) { const int st = (r >> 4) * 2 + (c >> 5), rr = r & 15, cc = c & 31, ob = rr * 64 + cc * 2; return st * 1024 + (ob ^ (((ob >> 9) & 1) << 5)); }
__host__ __device__ __forceinline__ void stage_rc(int b, int& R, int& C) { const int st = b / 1024, sb = b % 1024, swz = sb ^ (((sb >> 9) & 1) << 5); R = (st >> 1) * 16 + swz / 64; C = (st & 1) * 32 + (swz % 64) / 2; }
__host__ __device__ __forceinline__ int perm32(int rho) { const int n = rho >> 4, i = rho & 15; return 8 * (i >> 2) + 4 * n + (i & 3); }

struct Unit { int pm, pn; };
struct Gemm { const bf16_t* A; const bf16_t* Bt; int M, N, K; };

struct StaticOrder {
    int nM, nN, nwg, G, c;
    __host__ __device__ void init(int M, int N, int G_, int c_) { nM = M / BM; nN = N / BM; nwg = nM * nN; G = G_; c = c_; }
    __host__ __device__ bool next(int i, Unit& u) const {
        const long L = (long)i * G + c; if (L >= nwg) return false;
        int wgid = (int)L; { const int q = nwg / NXCD, r = nwg % NXCD, xcd = wgid % NXCD, off = wgid / NXCD; wgid = (xcd < r ? xcd * (q + 1) : r * (q + 1) + (xcd - r) * q) + off; }
        const int nig = WGM * nN, gid = wgid / nig, fm = gid * WGM, gsz = (nM - fm) < WGM ? (nM - fm) : WGM;
        u.pm = fm + ((wgid % nig) % gsz); u.pn = (wgid % nig) / gsz; return true;
    }
    __device__ __forceinline__ void a_ready(const Unit&) const {}
    __device__ __forceinline__ void done(const Unit&) const {}
};


__device__ __forceinline__ unsigned cvt_pk_bf16(float lo, float hi) { unsigned r; asm volatile("v_cvt_pk_bf16_f32 %0, %1, %2" : "=v"(r) : "v"(lo), "v"(hi)); return r; }

struct EpiSwiGLU {
    static constexpr bool PERM = true, AFTER_DRAIN = false;
    bf16_t* H; int ldh;
    __device__ __forceinline__ void operator()(const f32x4 (&acc)[2][2][4][2], const Unit& u, int wr, int wc, int fr, int fq) const {
        const int row0 = u.pm * BM + wr * 64 + fr, col0 = u.pn * HALF + wc * 32 + 8 * fq;
#pragma unroll
        for (int ai = 0; ai < 2; ++ai)
#pragma unroll
            for (int m = 0; m < 4; ++m) {
                const f32x4 g0 = acc[ai][0][m][0], g1 = acc[ai][0][m][1], u0 = acc[ai][1][m][0], u1 = acc[ai][1][m][1];
                float v[8];
#pragma unroll
                for (int j = 0; j < 4; ++j) { v[j] = silu_f(g0[j]) * u0[j]; v[4 + j] = silu_f(g1[j]) * u1[j]; }
                u32x4 w; w.x = cvt_pk_bf16(v[0], v[1]); w.y = cvt_pk_bf16(v[2], v[3]); w.z = cvt_pk_bf16(v[4], v[5]); w.w = cvt_pk_bf16(v[6], v[7]);
                *(u32x4*)(H + (size_t)(row0 + ai * HALF + m * 16) * ldh + col0) = w;
            }
    }
};
template <bool BASE_F32> struct EpiResid {
    static constexpr bool PERM = true, AFTER_DRAIN = false;
    const void* base; bf16_t* Xo; const float* gate; float scale;
    __device__ __forceinline__ void operator()(const f32x4 (&acc)[2][2][4][2], const Unit& u, int wr, int wc, int fr, int fq) const {
        const int col0 = u.pn * BM + wc * 32 + 8 * fq;
        const float* gr = gate + (size_t)(u.pm >> 3) * NMODC;
        f32x4 gv[2][2];
#pragma unroll
        for (int bj = 0; bj < 2; ++bj)
#pragma unroll
            for (int n = 0; n < 2; ++n) gv[bj][n] = *(const f32x4*)(gr + col0 + bj * HALF + 4 * n) * scale;
#pragma unroll
        for (int ai = 0; ai < 2; ++ai)
#pragma unroll
            for (int m = 0; m < 4; ++m) { const size_t ro = (size_t)(u.pm * BM + ai * HALF + wr * 64 + m * 16 + fr) * DM + col0;
#pragma unroll
                for (int bj = 0; bj < 2; ++bj) { const size_t o = ro + bj * HALF;
                    f32x4 b0, b1;
                    if constexpr (BASE_F32) { b0 = *(const f32x4*)((const float*)base + o); b1 = *(const f32x4*)((const float*)base + o + 4); }
                    else { const u32x4 h = *(const u32x4*)((const bf16_t*)base + o); b0 = (f32x4){bflo(h.x), bfhi(h.x), bflo(h.y), bfhi(h.y)}; b1 = (f32x4){bflo(h.z), bfhi(h.z), bflo(h.w), bfhi(h.w)}; }
                    const f32x4 y0 = b0 + gv[bj][0] * acc[ai][bj][m][0], y1 = b1 + gv[bj][1] * acc[ai][bj][m][1];
                    u32x4 w; w.x = cvt_pk_bf16(y0[0], y0[1]); w.y = cvt_pk_bf16(y0[2], y0[3]); w.z = cvt_pk_bf16(y1[0], y1[1]); w.w = cvt_pk_bf16(y1[2], y1[3]);
                    *(u32x4*)(Xo + o) = w; } }
    }
};
struct EpiProj {
    static constexpr bool PERM = true, AFTER_DRAIN = false;
    unsigned char* ws; float* LF; float* out; const float* lbv;
    template <int MODE> __device__ __forceinline__ void run(const f32x4 (&acc)[2][2][4][2], const Unit& u, int wr, int wc, int fr, int fq, bf16_t* B, float s, size_t offp, size_t offs) const {
        const int cb = (u.pn & 3) * BM + wc * 32 + 8 * fq;
#pragma unroll
        for (int ai = 0; ai < 2; ++ai)
#pragma unroll
            for (int m = 0; m < 4; ++m) {
                const int row = u.pm * BM + ai * HALF + wr * 64 + m * 16 + fr;
#pragma unroll
                for (int bj = 0; bj < 2; ++bj) {
                    const int c = cb + bj * HALF; const size_t o = (size_t)row * DA + c;
                    f32x4 v0 = acc[ai][bj][m][0], v1 = acc[ai][bj][m][1];
                    if constexpr (MODE == 1) {
                        const f32x4 l0 = *(const f32x4*)(lbv + c), l1 = *(const f32x4*)(lbv + c + 4);
#pragma unroll
                        for (int j = 0; j < 4; ++j) { v0[j] = __builtin_amdgcn_logf(l0[j] + (1.f - l0[j]) * sigmoid_f(v0[j])); v1[j] = __builtin_amdgcn_logf(l1[j] + (1.f - l1[j]) * sigmoid_f(v1[j])); }
                        *(f32x4*)(LF + o) = v0; *(f32x4*)(LF + o + 4) = v1;
                    } else {
                        if constexpr (MODE == 3) {
                            if (row < MREAL) { float* dst = row < MP ? out + offp + o : out + offs + (o - (size_t)MP * DA); *(f32x4*)dst = v0; *(f32x4*)(dst + 4) = v1; }
                        }
                        if constexpr (MODE == 0) { v0 = v0 * s; v1 = v1 * s; }
                        if constexpr (MODE == 2) {
#pragma unroll
                            for (int j = 0; j < 4; ++j) { v0[j] = silu_f(v0[j]); v1[j] = silu_f(v1[j]); }
                        }
                        u32x4 w; w.x = cvt_pk_bf16(v0[0], v0[1]); w.y = cvt_pk_bf16(v0[2], v0[3]); w.z = cvt_pk_bf16(v1[0], v1[1]); w.w = cvt_pk_bf16(v1[2], v1[3]);
                        *(u32x4*)(B + o) = w;
                    }
                }
            }
    }
    __device__ __forceinline__ void operator()(const f32x4 (&acc)[2][2][4][2], const Unit& u, int wr, int wc, int fr, int fq) const {
        const int rng = u.pn >> 2;
        bf16_t* B = (bf16_t*)(ws + WS_QA + (size_t)(rng == 0 ? 0 : rng - 1) * (WS_IA - WS_QA));
        if (rng == 1) run<1>(acc, u, wr, wc, fr, fq, nullptr, 1.f, 0, 0);
        else if (rng == 3) run<2>(acc, u, wr, wc, fr, fq, B, 1.f, 0, 0);
        else if (rng >= 5) run<3>(acc, u, wr, wc, fr, fq, B, 1.f, rng == 5 ? OFF_KP : OFF_VP, rng == 5 ? OFF_KS : OFF_VS);
        else run<0>(acc, u, wr, wc, fr, fq, B, rng == 2 ? 1.f : (rng == 4 ? QSCALE * LOG2E : QSCALE), 0, 0);
    }
};
template <class Epi, class Sched, bool ALIGN_EPI = false, bool SP2 = false>
__device__ __forceinline__ void gemm_phase(PG8_LAS unsigned char* lds, const Gemm g, const Sched& S, const Epi& E) {
    const int tid = tid_opaque(), wid = __builtin_amdgcn_readfirstlane(tid >> 6), lane = tid & 63, wr = wid >> 2, wc = wid & 3, fr = lane & 15, fq = lane >> 4;
    const int K = g.K, nt = K / BK;
    unsigned voffA[2], voffB[2];
#pragma unroll
    for (int i = 0; i < 2; ++i) { int R, C; stage_rc(tid * 16 + i * 8192, R, C); const int Rb = Epi::PERM ? ((R & ~31) + perm32(R & 31)) : R;
        voffA[i] = (unsigned)(R * K + C) * 2u; voffB[i] = (unsigned)(Rb * K + C) * 2u; }
    const size_t kstep = (size_t)(BK * 2);
    const size_t hstep = (size_t)HALF * K * 2;
    const size_t tstep = 2 * hstep;
    const unsigned ldsw = (unsigned)wid * 1024u;
    const int aoff = lds_byte(wr * 64 + fr, fq * 8), boff = lds_byte(wc * 32 + fr, fq * 8);
#define PG8_SA(b, h) (((b) * 2 + (h)) * HTB)
#define PG8_SB(b, h) ((4 + (b) * 2 + (h)) * HTB)
#define PG8_STAGE(bufoff, gbase, voff) do { _Pragma("unroll") for (int _i = 0; _i < 2; ++_i) \
        __builtin_amdgcn_global_load_lds((const unsigned*)((const char*)(gbase) + (voff)[_i]), (PG8_LAS unsigned*)(lds + (bufoff) + ldsw + _i * 8192), 16, 0, 0); } while (0)
#define PG8_LDA(dst, b, h) do { _Pragma("unroll") for (int m = 0; m < 4; ++m) _Pragma("unroll") for (int k = 0; k < 2; ++k) dst[m][k] = *(const PG8_LAS bf16x8*)(lds + PG8_SA(b, h) + aoff + m * 2048 + k * 1024); } while (0)
#define PG8_LDB(dst, b, h) do { _Pragma("unroll") for (int n = 0; n < 2; ++n) _Pragma("unroll") for (int k = 0; k < 2; ++k) dst[n][k] = *(const PG8_LAS bf16x8*)(lds + PG8_SB(b, h) + boff + n * 2048 + k * 1024); } while (0)
#define PG8_MMA(ai, bj, At, Bt) do { __builtin_amdgcn_s_setprio(1); _Pragma("unroll") for (int m = 0; m < 4; ++m) _Pragma("unroll") for (int n = 0; n < 2; ++n) _Pragma("unroll") for (int k = 0; k < 2; ++k) \
        acc[ai][bj][m][n] = __builtin_amdgcn_mfma_f32_16x16x32_bf16(Bt[n][k], At[m][k], acc[ai][bj][m][n], 0, 0, 0); __builtin_amdgcn_s_setprio(0); } while (0)
#define PG8_WAIT_V(n) asm volatile("s_waitcnt vmcnt(" #n ")" ::: "memory")
#define PG8_WAIT_L(n) asm volatile("s_waitcnt lgkmcnt(" #n ")" ::: "memory")
#define PG8_BAR __builtin_amdgcn_s_barrier()
#define PG8_SCHED __builtin_amdgcn_sched_barrier(0)
    Unit cur, nxt; int ui = 0;
    if (!S.next(0, cur)) return;
    f32x4 acc[2][2][4][2];
#pragma unroll
    for (int a = 0; a < 2; ++a)
#pragma unroll
        for (int b = 0; b < 2; ++b)
#pragma unroll
            for (int m = 0; m < 4; ++m)
#pragma unroll
                for (int n = 0; n < 2; ++n) acc[a][b][m][n] = (f32x4){0.f, 0.f, 0.f, 0.f};
    bf16x8 At[4][2], B0[2][2], B1[2][2];
    const char* cA = (const char*)g.A + (size_t)cur.pm * tstep; const char* cB = (const char*)g.Bt + (size_t)cur.pn * tstep;
    S.a_ready(cur);
    if constexpr (SP2) {
        PG8_STAGE(PG8_SB(0, 0), cB, voffB); PG8_STAGE(PG8_SB(0, 1), cB + hstep, voffB); PG8_STAGE(PG8_SA(0, 0), cA, voffA); PG8_STAGE(PG8_SA(0, 1), cA + hstep, voffA);
        if (wr == 1) PG8_BAR;
        PG8_WAIT_V(2); PG8_BAR;
        PG8_STAGE(PG8_SB(1, 0), cB + kstep, voffB); PG8_STAGE(PG8_SA(1, 0), cA + kstep, voffA); PG8_STAGE(PG8_SB(1, 1), cB + hstep + kstep, voffB);
        PG8_WAIT_V(6); PG8_BAR;
    } else {
        PG8_STAGE(PG8_SB(0, 0), cB, voffB); PG8_STAGE(PG8_SA(0, 0), cA, voffA); PG8_STAGE(PG8_SB(0, 1), cB + hstep, voffB); PG8_STAGE(PG8_SA(0, 1), cA + hstep, voffA);
        if (wr == 1) PG8_BAR;
        PG8_WAIT_V(4); PG8_BAR;
        PG8_STAGE(PG8_SB(1, 0), cB + kstep, voffB); PG8_STAGE(PG8_SA(1, 0), cA + kstep, voffA); PG8_STAGE(PG8_SB(1, 1), cB + hstep + kstep, voffB);
        PG8_WAIT_V(6); PG8_BAR;
    }
    for (;;) {
        const bool has_next = S.next(ui + 1, nxt);
        const char* nA = has_next ? (const char*)g.A + (size_t)nxt.pm * tstep : cA; const char* nB = has_next ? (const char*)g.Bt + (size_t)nxt.pn * tstep : cB;
        for (int t = 0; t < nt; t += 2) {
            const bool last = (t == nt - 2);
            const char* a1 = cA + (size_t)(t + 1) * kstep;
            const char* a2 = last ? nA : cA + (size_t)(t + 2) * kstep; const char* b2 = last ? nB : cB + (size_t)(t + 2) * kstep;
            const char* a3 = a2 + kstep; const char* b3 = b2 + kstep;
            if (last && has_next) S.a_ready(nxt);
            if constexpr (SP2) {
            PG8_LDB(B0, 0, 0); PG8_LDB(B1, 0, 1); PG8_SCHED; PG8_LDA(At, 0, 0); PG8_STAGE(PG8_SA(1, 1), a1 + hstep, voffA);
            PG8_WAIT_V(8); PG8_WAIT_L(0); PG8_BAR; PG8_MMA(0, 0, At, B0); PG8_MMA(0, 1, At, B1); PG8_BAR; PG8_SCHED;
            PG8_LDA(At, 0, 1); PG8_STAGE(PG8_SB(0, 0), b2, voffB); PG8_STAGE(PG8_SB(0, 1), b2 + hstep, voffB); PG8_STAGE(PG8_SA(0, 0), a2, voffA);
            PG8_WAIT_V(8); PG8_WAIT_L(0); PG8_BAR; PG8_MMA(1, 0, At, B0); PG8_MMA(1, 1, At, B1); PG8_BAR; PG8_SCHED;
            PG8_LDB(B0, 1, 0); PG8_LDB(B1, 1, 1); PG8_SCHED; PG8_LDA(At, 1, 0); PG8_STAGE(PG8_SA(0, 1), a2 + hstep, voffA);
            PG8_WAIT_V(8); PG8_WAIT_L(0); PG8_BAR; PG8_MMA(0, 0, At, B0); PG8_MMA(0, 1, At, B1); PG8_BAR; PG8_SCHED;
            PG8_LDA(At, 1, 1); PG8_STAGE(PG8_SB(1, 0), b3, voffB); PG8_STAGE(PG8_SB(1, 1), b3 + hstep, voffB); PG8_STAGE(PG8_SA(1, 0), a3, voffA);
            PG8_WAIT_V(8); PG8_WAIT_L(0); PG8_BAR; PG8_MMA(1, 0, At, B0); PG8_MMA(1, 1, At, B1); PG8_BAR; PG8_SCHED;
            } else {
            PG8_LDB(B0, 0, 0); PG8_SCHED; PG8_LDA(At, 0, 0); PG8_STAGE(PG8_SA(1, 1), a1 + hstep, voffA);
            PG8_WAIT_L(8); PG8_BAR; PG8_WAIT_L(0); PG8_MMA(0, 0, At, B0); PG8_BAR; PG8_SCHED;
            PG8_LDB(B1, 0, 1); PG8_STAGE(PG8_SB(0, 0), b2, voffB);
            PG8_BAR; PG8_WAIT_L(0); PG8_MMA(0, 1, At, B1); PG8_BAR;
            PG8_LDA(At, 0, 1); PG8_STAGE(PG8_SA(0, 0), a2, voffA);
            PG8_BAR; PG8_WAIT_L(0); PG8_MMA(1, 0, At, B0); PG8_BAR; PG8_SCHED;
            PG8_STAGE(PG8_SB(0, 1), b2 + hstep, voffB);
            PG8_WAIT_V(6); PG8_BAR; PG8_MMA(1, 1, At, B1); PG8_BAR;
            PG8_LDB(B0, 1, 0); PG8_SCHED; PG8_LDA(At, 1, 0); PG8_STAGE(PG8_SA(0, 1), a2 + hstep, voffA);
            PG8_WAIT_L(8); PG8_BAR; PG8_WAIT_L(0); PG8_MMA(0, 0, At, B0); PG8_BAR; PG8_SCHED;
            PG8_LDB(B1, 1, 1); PG8_STAGE(PG8_SB(1, 0), b3, voffB);
            PG8_BAR; PG8_WAIT_L(0); PG8_MMA(0, 1, At, B1); PG8_BAR;
            PG8_LDA(At, 1, 1); PG8_STAGE(PG8_SA(1, 0), a3, voffA);
            PG8_BAR; PG8_WAIT_L(0); PG8_MMA(1, 0, At, B0); PG8_BAR; PG8_SCHED;
            PG8_STAGE(PG8_SB(1, 1), b3 + hstep, voffB);
            PG8_WAIT_V(6); PG8_BAR; PG8_MMA(1, 1, At, B1); PG8_BAR;
            }
        }
        if constexpr (ALIGN_EPI) { if (wr == 0) PG8_BAR; }
        if constexpr (!Epi::AFTER_DRAIN) { E(acc, cur, wr, wc, fr, fq); S.done(cur); }
        if (!has_next) break;
#pragma unroll
        for (int a = 0; a < 2; ++a)
#pragma unroll
            for (int b = 0; b < 2; ++b)
#pragma unroll
                for (int m = 0; m < 4; ++m)
#pragma unroll
                    for (int n = 0; n < 2; ++n) acc[a][b][m][n] = (f32x4){0.f, 0.f, 0.f, 0.f};
        cur = nxt; cA = nA; cB = nB; ++ui;
        if constexpr (ALIGN_EPI) { if (wr == 1) PG8_BAR; }
    }
    PG8_WAIT_V(0);
    if constexpr (!ALIGN_EPI) { if (wr == 0) PG8_BAR; }
    PG8_BAR;
    if constexpr (Epi::AFTER_DRAIN) { E.fused(acc, cur, wr, wc, fr, fq, lds, wid, lane); S.done(cur); }
#undef PG8_SA
#undef PG8_SB
#undef PG8_STAGE
#undef PG8_LDA
#undef PG8_LDB
#undef PG8_MMA
#undef PG8_WAIT_V
#undef PG8_WAIT_L
#undef PG8_BAR
#undef PG8_SCHED
}
}

constexpr int NTHR = 512, NWAVES = 8;
constexpr int LDS_BYTES = 155648;

#define IN_F(i) ((const float*)a.in[i])
#define WS_F(off) ((float*)(a.ws + (off)))
#define WS_B(off) ((bf16*)(a.ws + (off)))

__device__ __forceinline__ void phase_mod(ArgsRef a, LAS unsigned char* lds, int bid, int nblk) {
    const int tid = tid_opaque(), lane = tid & 63, w = tid >> 6;
    LAS float* sc = (LAS float*)lds;
    LAS float* red = (LAS float*)(lds + 98304);
    for (int i = tid; i < 12 * DM; i += NTHR) { const int b = i >> 11, k = i & 2047; const float c = b < 4 ? IN_F(I_CP)[b * DM + k] : IN_F(I_CS)[(b - 4) * DM + k]; sc[i] = silu_f(c); }
    if (bid == 0) for (int i = tid; i < DA; i += NTHR) WS_F(WS_LBV)[i] = sigmoid_f(IN_F(I_LB)[i]);
    __syncthreads();
    for (int u = bid; u < 176; u += nblk) {
        const bool fm = u >= 144; const int n0 = (fm ? u - 144 : u) * 128, ld = fm ? NFMODC : NMODC;
        const float* W = fm ? IN_F(I_WFM) : IN_F(I_WMOD); const float* bias = fm ? IN_F(I_BFM) : IN_F(I_BMOD); float* outp = fm ? WS_F(WS_FMOD) : WS_F(WS_MOD);
        f32x2 acc[12];
#pragma unroll
        for (int b = 0; b < 12; ++b) acc[b] = (f32x2){0.f, 0.f};
        const float* wp = W + (size_t)(w * 256) * ld + n0 + 2 * lane;
        for (int k = 0; k < 256; k += 4) {
            const f32x2 w0 = *(const f32x2*)(wp + (size_t)(k + 0) * ld), w1 = *(const f32x2*)(wp + (size_t)(k + 1) * ld), w2 = *(const f32x2*)(wp + (size_t)(k + 2) * ld), w3 = *(const f32x2*)(wp + (size_t)(k + 3) * ld);
#pragma unroll
            for (int b = 0; b < 12; ++b) { const f32x4 s = *(const LAS f32x4*)(sc + b * DM + w * 256 + k); acc[b] += w0 * s.x + w1 * s.y + w2 * s.z + w3 * s.w; }
        }
#pragma unroll
        for (int b = 0; b < 12; ++b) *(LAS f32x2*)(red + (w * 12 + b) * 128 + 2 * lane) = acc[b];
        __syncthreads();
        for (int i = tid; i < 12 * 128; i += NTHR) { const int b = i >> 7, c = i & 127; float s = 0.f;
#pragma unroll
            for (int ww = 0; ww < 8; ++ww) s += red[(ww * 12 + b) * 128 + c];
            outp[(size_t)b * ld + n0 + c] = s + bias[n0 + c]; }
        __syncthreads();
    }
}

__device__ __forceinline__ void cvt_item(const float* W, int K, int N, bf16* WT, int k0, int n0, int drow0, LAS float* scr, int lane) {
#pragma unroll 8
    for (int i = 0; i < 32; ++i) { const int kk = 2 * i + (lane >> 5); scr[kk * 33 + (lane & 31)] = W[(size_t)(k0 + kk) * N + n0 + (lane & 31)]; }
    LDS_WAIT(); asm volatile("" ::: "memory");
    const int c = lane & 7;
#pragma unroll
    for (int j = 0; j < 4; ++j) { const int n = (lane >> 3) + 8 * j; const LAS float* s = scr + (8 * c) * 33 + n;
        v4u o; o.x = pk2(s[0 * 33], s[1 * 33]); o.y = pk2(s[2 * 33], s[3 * 33]); o.z = pk2(s[4 * 33], s[5 * 33]); o.w = pk2(s[6 * 33], s[7 * 33]);
        *(GAS v4u*)(WT + (size_t)(drow0 + n) * K + k0 + 8 * c) = o; }
    LDS_WAIT(); asm volatile("" ::: "memory");
}
__device__ __forceinline__ void cvt_matrix(const float* W, int K, int N, bf16* WT, int mode, LAS float* scr, int gw, int ngw, int lane) {
    const int nblk = N / 32, nitems = (K / 64) * nblk;
    for (int it = gw; it < nitems; it += ngw) { const int kb = it / nblk, nb = it % nblk, n0 = 32 * nb;
        const int drow0 = mode == 0 ? n0 : ((n0 >> 7) * 256 + (mode == 2 ? 128 : 0) + (n0 & 127));
        cvt_item(W, K, N, WT, 64 * kb, n0, drow0, scr, lane); }
}
template <int SEL> __device__ __forceinline__ void phase_cvt(ArgsRef a, LAS unsigned char* lds, int bid, int nblk) {
    const int tid = tid_opaque(), lane = tid & 63, w = tid >> 6;
    LAS float* scr = (LAS float*)(lds + w * 16384);
    const int gw = bid * NWAVES + w, ngw = nblk * NWAVES;
    if constexpr (SEL == 0) { cvt_matrix(IN_F(I_WG1), DM, DFF, WS_B(WS_WGU1), 1, scr, gw, ngw, lane); cvt_matrix(IN_F(I_WU1), DM, DFF, WS_B(WS_WGU1), 2, scr, gw, ngw, lane); }
    if constexpr (SEL == 1) { cvt_matrix(IN_F(I_WD1), DFF, DM, WS_B(WS_WD1), 0, scr, gw, ngw, lane);
                              cvt_matrix(IN_F(I_WIN), DM, DIN, WS_B(WS_WIN), 0, scr, gw, ngw, lane); cvt_matrix(IN_F(I_WOUT), DM, DM, WS_B(WS_WOUT), 0, scr, gw, ngw, lane); }
    if constexpr (SEL == 2) { cvt_matrix(IN_F(I_WG2), DM, DFF, WS_B(WS_WGU2), 1, scr, gw, ngw, lane); cvt_matrix(IN_F(I_WU2), DM, DFF, WS_B(WS_WGU2), 2, scr, gw, ngw, lane);
                              cvt_matrix(IN_F(I_WD2), DFF, DM, WS_B(WS_WD2), 0, scr, gw, ngw, lane); }
}

template <bool SRC_F32> struct NormRaw { f32x4 f[SRC_F32 ? 8 : 1]; v4u h[SRC_F32 ? 1 : 4]; };
template <bool SRC_F32> __device__ __forceinline__ void norm_issue(NormRaw<SRC_F32>& R, ArgsRef a, int r, int lane) {
    if constexpr (SRC_F32) { const float* xrow = r < MP ? IN_F(I_XP) + (size_t)r * DM : IN_F(I_XS) + (size_t)(r - MP) * DM; const GAS f32x4* p = (const GAS f32x4*)xrow + 2 * lane;
#pragma unroll
        for (int j = 0; j < 4; ++j) { R.f[2 * j] = p[128 * j]; R.f[2 * j + 1] = p[128 * j + 1]; } }
    else { const GAS v4u* p = (const GAS v4u*)(WS_B(WS_X) + (size_t)r * DM) + lane;
#pragma unroll
        for (int j = 0; j < 4; ++j) R.h[j] = p[64 * j]; }
}
template <bool FINAL, bool SRC_F32> __device__ __forceinline__ void norm_finish(const NormRaw<SRC_F32>& R, ArgsRef a, int r, int lane, const float* gvec, const float* shp, const float* scp) {
    f32x4 v[8];
#pragma unroll
    for (int j = 0; j < 4; ++j) {
        if constexpr (SRC_F32) { v[2 * j] = R.f[2 * j]; v[2 * j + 1] = R.f[2 * j + 1]; }
        else { const v4u h = R.h[j]; v[2 * j] = (f32x4){bflo(h.x), bfhi(h.x), bflo(h.y), bfhi(h.y)}; v[2 * j + 1] = (f32x4){bflo(h.z), bfhi(h.z), bflo(h.w), bfhi(h.w)}; } }
    float s = 0.f;
#pragma unroll
    for (int j = 0; j < 8; ++j) s += (v[j].x * v[j].x + v[j].y * v[j].y) + (v[j].z * v[j].z + v[j].w * v[j].w);
    const float rstd = 1.0f / sqrtf(wave_sum(s) * (1.f / DM) + EPS);
#pragma unroll
    for (int j = 0; j < 4; ++j) {
        const int c = 8 * lane + 512 * j;
        const f32x4 g0 = *(const f32x4*)(gvec + c), g1 = *(const f32x4*)(gvec + c + 4), c0 = *(const f32x4*)(scp + c), c1 = *(const f32x4*)(scp + c + 4), h0 = *(const f32x4*)(shp + c), h1 = *(const f32x4*)(shp + c + 4);
        const f32x4 y0 = (v[2 * j] * rstd * g0) * (1.f + c0) + h0, y1 = (v[2 * j + 1] * rstd * g1) * (1.f + c1) + h1;
        if constexpr (FINAL) { float* dst = (r < MP ? a.out + OFF_YP + (size_t)r * DM : a.out + OFF_YS + (size_t)(r - MP) * DM) + c; *(f32x4*)dst = y0; *(f32x4*)(dst + 4) = y1; }
        else { v4u o; o.x = pk2(y0.x, y0.y); o.y = pk2(y0.z, y0.w); o.z = pk2(y1.x, y1.y); o.w = pk2(y1.z, y1.w); *(GAS v4u*)(WS_B(WS_XN) + (size_t)r * DM + c) = o; }
        asm volatile("" ::: "memory");
    }
}
template <bool FINAL, bool SRC_F32>
__device__ __forceinline__ void phase_norm(ArgsRef a, int bid, int nblk, const float* gvec, const float* modp, int ldmod, int sh_off, int sc_off) {
    const int tid = tid_opaque(), lane = tid & 63, w = tid >> 6;
    const int gw = bid * NWAVES + w, ngw = nblk * NWAVES;
    for (int r0 = 4 * gw; r0 < MREAL; r0 += 4 * ngw) {
        NormRaw<SRC_F32> A, B;
        norm_issue<SRC_F32>(A, a, r0, lane); norm_issue<SRC_F32>(B, a, r0 + 1, lane);
        const float* mr = modp + (size_t)mod_row(r0) * ldmod; const float* shp = mr + sh_off; const float* scp = mr + sc_off;
        norm_finish<FINAL, SRC_F32>(A, a, r0, lane, gvec, shp, scp); norm_issue<SRC_F32>(A, a, r0 + 2, lane);
        norm_finish<FINAL, SRC_F32>(B, a, r0 + 1, lane, gvec, shp, scp); norm_issue<SRC_F32>(B, a, r0 + 3, lane);
        norm_finish<FINAL, SRC_F32>(A, a, r0 + 2, lane, gvec, shp, scp);
        norm_finish<FINAL, SRC_F32>(B, a, r0 + 3, lane, gvec, shp, scp);
    }
}

__device__ __forceinline__ void hgrn_unit(ArgsRef a, LAS unsigned char* lds, int unit) {
    const int tid = tid_opaque(), dv = tid & 127, g = tid >> 7;
    const bool smp = unit >= 32; const int u = smp ? unit - 32 : unit, b = u >> 3, h = u & 7;
    const int T = smp ? DECT : SEQ, row0 = smp ? MP + b * DECT : b * SEQ;
    float* sout = a.out + (smp ? OFF_SS : OFF_SP) + (size_t)u * HD * HD;
    LAS float* fL = (LAS float*)lds; LAS float* kL = fL + 2048; LAS float* qL = kL + 2048; LAS float* vL = qL + 2048; LAS float* red = vL + 2048;
    const bf16* QA = WS_B(WS_QA); const bf16* IA = WS_B(WS_IA); const bf16* GA = WS_B(WS_GA); const float* LF = WS_F(WS_LF);
    float S[32];
#pragma unroll
    for (int i = 0; i < 32; ++i) S[i] = smp ? IN_F(I_ST)[(size_t)u * HD * HD + (size_t)(32 * g + i) * HD + dv] : 0.f;
    for (int t0 = 0; t0 < T; t0 += 16) {
        const int nt = (T - t0) < 16 ? (T - t0) : 16;
        for (int i = tid; i < nt * 128; i += NTHR) { const int tt = i >> 7, ch = i & 127; const size_t o = (size_t)(row0 + t0 + tt) * DA + h * HD + ch;
            const float f = __builtin_amdgcn_exp2f(LF[o]);   fL[i] = f; kL[i] = 1.f - f; qL[i] = bf2f(QA[o]); vL[i] = bf2f(IA[o]); }
        __syncthreads();
        for (int tt = 0; tt < nt; ++tt) {
            const float v = vL[tt * 128 + dv]; float op = 0.f;
#pragma unroll
            for (int i4 = 0; i4 < 8; ++i4) {
                const f32x4 f4 = *(const LAS f32x4*)(fL + tt * 128 + g * 32 + 4 * i4), k4 = *(const LAS f32x4*)(kL + tt * 128 + g * 32 + 4 * i4), q4 = *(const LAS f32x4*)(qL + tt * 128 + g * 32 + 4 * i4);
#pragma unroll
                for (int j = 0; j < 4; ++j) { S[4 * i4 + j] = f4[j] * S[4 * i4 + j] + k4[j] * v; op += S[4 * i4 + j] * q4[j]; }
            }
            red[(g * 16 + tt) * 128 + dv] = op;
        }
        __syncthreads();
        { const int tt = tid >> 5, l32 = tid & 31;
          if (tt < nt) {
            f32x4 o = (f32x4){0.f, 0.f, 0.f, 0.f};
#pragma unroll
            for (int gg = 0; gg < 4; ++gg) o += *(const LAS f32x4*)(red + (gg * 16 + tt) * 128 + 4 * l32);
            float ss = (o.x * o.x + o.y * o.y) + (o.z * o.z + o.w * o.w);
#pragma unroll
            for (int m = 1; m < 32; m <<= 1) ss += __shfl_xor(ss, m);
            const float rstd = 1.0f / sqrtf(ss * (1.f / HD) + EPS);
            const int row = row0 + t0 + tt, col = h * HD + 4 * l32;
            const f32x4 gw = *(const f32x4*)(IN_F(I_GOA) + col); const v2u gt = *(const v2u*)(GA + (size_t)row * DA + col);
            v2u w; w.x = pk2(o.x * rstd * gw.x * bflo(gt.x), o.y * rstd * gw.y * bfhi(gt.x)); w.y = pk2(o.z * rstd * gw.z * bflo(gt.y), o.w * rstd * gw.w * bfhi(gt.y));
            *(v2u*)(WS_B(WS_OM) + (size_t)row * DM + col) = w;
          } }
        __syncthreads();
    }
#pragma unroll
    for (int i = 0; i < 32; ++i) sout[(size_t)(32 * g + i) * HD + dv] = S[i];
}

__device__ __forceinline__ void sb_tile(const LAS float* Kt, const LAS float* Vt, const LAS float* q, float bias, int lane, int nvis  , float& R, float& o0, float& o1) {
    float z = bias;
#pragma unroll 8
    for (int d = 0; d < HD; d += 4) { const f32x4 qv = *(const LAS f32x4*)(q + d);
        z += qv.x * Kt[lane * 129 + d] + qv.y * Kt[lane * 129 + d + 1] + qv.z * Kt[lane * 129 + d + 2] + qv.w * Kt[lane * 129 + d + 3]; }
    const bool vis = lane < nvis;
    const float L = vis ? -(z > 20.f ? z : log1pf(__expf(z))) : 0.f;
    float c = L;
#pragma unroll
    for (int off = 1; off < 64; off <<= 1) { const float t = __shfl_down(c, off); if (lane + off < 64) c += t; }
    const float P = vis ? __expf(z + c + R) : 0.f;
    R += __shfl(c, 0);
#pragma unroll 8
    for (int s = 0; s < 64; ++s) { const float p = __builtin_bit_cast(float, __builtin_amdgcn_readlane(__builtin_bit_cast(int, P), s));
        o0 += p * Vt[s * 128 + lane]; o1 += p * Vt[s * 128 + 64 + lane]; }
}
__device__ __forceinline__ void sb_finish(ArgsRef a, int row, int h, int lane, float o0, float o1) {
    const float ss = wave_sum(o0 * o0 + o1 * o1);
    const float rstd = 1.0f / sqrtf(ss * (1.f / HD) + EPS);
    const float* gw = IN_F(I_GOB) + h * HD; bf16* dst = WS_B(WS_OM) + (size_t)row * DM + DA + h * HD;
    dst[lane] = (bf16)f2bf(o0 * rstd * gw[lane]); dst[64 + lane] = (bf16)f2bf(o1 * rstd * gw[64 + lane]);
}
__device__ __forceinline__ void sb_stage_bf16(ArgsRef a, LAS float* Kt, LAS float* Vt, int krow0, int nvalid, int h, int tid) {
    const bf16* KB = WS_B(WS_KB); const bf16* VB = WS_B(WS_VB);
#pragma unroll
    for (int i = 0; i < 2; ++i) { const int ch = tid + i * NTHR, r = ch >> 4, d0 = (ch & 15) * 8;
        v4u kv = (v4u){0u, 0u, 0u, 0u}, vv = (v4u){0u, 0u, 0u, 0u};
        if (r < nvalid) { const size_t o = (size_t)(krow0 + r) * DA + h * HD + d0; kv = *(const v4u*)(KB + o); vv = *(const v4u*)(VB + o); }
        LAS float* kd = Kt + r * 129 + d0; LAS float* vd = Vt + r * 128 + d0;
        kd[0] = bflo(kv.x); kd[1] = bfhi(kv.x); kd[2] = bflo(kv.y); kd[3] = bfhi(kv.y); kd[4] = bflo(kv.z); kd[5] = bfhi(kv.z); kd[6] = bflo(kv.w); kd[7] = bfhi(kv.w);
        vd[0] = bflo(vv.x); vd[1] = bfhi(vv.x); vd[2] = bflo(vv.y); vd[3] = bfhi(vv.y); vd[4] = bflo(vv.z); vd[5] = bfhi(vv.z); vd[6] = bflo(vv.w); vd[7] = bfhi(vv.w); }
}
__device__ __forceinline__ void sb_unit_prompt(ArgsRef a, LAS unsigned char* lds, int unit) {
    const int tid = tid_opaque(), lane = tid & 63, w = tid >> 6;
    const int bh = unit >> 8, qb = unit & 255, b = bh >> 3, h = bh & 7, t = qb * 8 + w, row = b * SEQ + t;
    LAS float* Kt = (LAS float*)lds; LAS float* Vt = Kt + 64 * 129; LAS float* qs = Vt + 64 * 128;
    if (lane < 32) { const v2u qv = *(const v2u*)(WS_B(WS_QB) + (size_t)row * DA + h * HD + 4 * lane); LAS float* q = qs + w * HD + 4 * lane; q[0] = bflo(qv.x) * LN2; q[1] = bfhi(qv.x) * LN2; q[2] = bflo(qv.y) * LN2; q[3] = bfhi(qv.y) * LN2; }
    const float bias = IN_F(I_BSB)[h];
    float R = 0.f, o0 = 0.f, o1 = 0.f;
    for (int j = (qb * 8 + 6) >> 6; j >= 0; --j) {
        __syncthreads();
        sb_stage_bf16(a, Kt, Vt, b * SEQ + 64 * j, 64, h, tid);
        __syncthreads();
        int nvis = t - 64 * j; nvis = nvis < 0 ? 0 : (nvis > 64 ? 64 : nvis);
        sb_tile(Kt, Vt, qs + w * HD, bias, lane, nvis, R, o0, o1);
    }
    sb_finish(a, row, h, lane, o0, o1);
    __syncthreads();
}
__device__ __forceinline__ void sb_unit_sample(ArgsRef a, LAS unsigned char* lds, int unit) {
    const int tid = tid_opaque(), lane = tid & 63, w = tid >> 6;
    const int b = unit >> 3, h = unit & 7, row = MP + b * DECT + w;
    LAS float* Kt = (LAS float*)lds; LAS float* Vt = Kt + 64 * 129; LAS float* qs = Vt + 64 * 128;
    if (lane < 32) { const v2u qv = *(const v2u*)(WS_B(WS_QB) + (size_t)row * DA + h * HD + 4 * lane); LAS float* q = qs + w * HD + 4 * lane; q[0] = bflo(qv.x) * LN2; q[1] = bfhi(qv.x) * LN2; q[2] = bflo(qv.y) * LN2; q[3] = bfhi(qv.y) * LN2; }
    const float bias = IN_F(I_BSB)[h];
    float R = 0.f, o0 = 0.f, o1 = 0.f;
    __syncthreads();
    sb_stage_bf16(a, Kt, Vt, MP + b * DECT, DECT, h, tid);
    __syncthreads();
    sb_tile(Kt, Vt, qs + w * HD, bias, lane, w, R, o0, o1);
    const int* pt = (const int*)a.in[I_PT] + b * NPAGES;
    for (int j = PAST / 64 - 1; j >= 0; --j) {
        __syncthreads();
        { const int page = pt[j >> 1]; const size_t base = ((size_t)page * PAGE + (j & 1) * 64) * (NHEAD * HD) + h * HD;
          const float* ck = IN_F(I_CK) + base; const float* cv = IN_F(I_CV) + base;
#pragma unroll
          for (int i = 0; i < 4; ++i) { const int ch = tid + i * NTHR, r = ch >> 5, d0 = (ch & 31) * 4;
              const f32x4 kv = *(const f32x4*)(ck + (size_t)r * (NHEAD * HD) + d0), vv = *(const f32x4*)(cv + (size_t)r * (NHEAD * HD) + d0);
              LAS float* kd = Kt + r * 129 + d0; kd[0] = kv.x; kd[1] = kv.y; kd[2] = kv.z; kd[3] = kv.w;
              *(LAS f32x4*)(Vt + r * 128 + d0) = vv; } }
        __syncthreads();
        sb_tile(Kt, Vt, qs + w * HD, bias, lane, 64, R, o0, o1);
    }
    sb_finish(a, row, h, lane, o0, o1);
    __syncthreads();
}

typedef float f32x16 __attribute__((ext_vector_type(16)));
typedef short s16x4 __attribute__((ext_vector_type(4)));
typedef short v4i16_t __attribute__((ext_vector_type(4)));
typedef __bf16 bf16x2_t __attribute__((ext_vector_type(2)));
#define MFMA32(a, b, c) __builtin_amdgcn_mfma_f32_32x32x16_bf16((a), (b), (c), 0, 0, 0)

__device__ __forceinline__ unsigned cvtpk(float lo, float hi) { f32x2 v = {lo, hi}; bf16x2_t b = __builtin_convertvector(v, bf16x2_t); return __builtin_bit_cast(unsigned, b); }
template <int S> __device__ __forceinline__ bf16x8 pack8(const f32x16& x) {
    v4u p; p.x = cvtpk(x[8 * S + 0], x[8 * S + 1]); p.y = cvtpk(x[8 * S + 2], x[8 * S + 3]); p.z = cvtpk(x[8 * S + 4], x[8 * S + 5]); p.w = cvtpk(x[8 * S + 6], x[8 * S + 7]);
    return __builtin_bit_cast(bf16x8, p);
}
__device__ __forceinline__ unsigned off_a(unsigned row, unsigned ch) { return 2048u * (row >> 3) + 512u * (ch >> 2) + 64u * (row & 7) + 16u * ((ch & 3) ^ ((row >> 2) & 3)); }
__device__ __forceinline__ s16x4 vtr(const LAS unsigned char* p) { return __builtin_bit_cast(s16x4, __builtin_amdgcn_ds_read_tr16_b64_v4i16((LAS v4i16_t*)p)); }


template <bool DUAL, class Epi>
__device__ __forceinline__ void sgemm64_unit(const bf16* A, int K, const bf16* B0, const bf16* B1, LAS unsigned char* lds, const Epi& E) {
    const int tid = tid_opaque(), lane = tid & 63, w = tid >> 6, r = lane & 31, hh = lane >> 5;
    const int kw = K >> 3, k0 = w * kw, steps = kw >> 4;
    const bf16* pa0 = A + (size_t)r * K + k0 + 8 * hh; const bf16* pa1 = pa0 + (size_t)32 * K;
    const bf16* pb0 = B0 + (size_t)r * K + k0 + 8 * hh; const bf16* pb1 = B1 + (size_t)r * K + k0 + 8 * hh;
    f32x16 c00, c10, c01, c11;
#pragma unroll
    for (int i = 0; i < 16; ++i) { c00[i] = 0.f; c10[i] = 0.f; c01[i] = 0.f; c11[i] = 0.f; }
#pragma unroll 4
    for (int s = 0; s < steps; ++s) {
        const bf16x8 a0 = *(const bf16x8*)(pa0 + 16 * s), a1 = *(const bf16x8*)(pa1 + 16 * s), b0 = *(const bf16x8*)(pb0 + 16 * s);
        c00 = MFMA32(a0, b0, c00); c10 = MFMA32(a1, b0, c10);
        if constexpr (DUAL) { const bf16x8 b1 = *(const bf16x8*)(pb1 + 16 * s); c01 = MFMA32(a0, b1, c01); c11 = MFMA32(a1, b1, c11); }
    }
    constexpr int NT = DUAL ? 4 : 2;
    LAS float* red = (LAS float*)lds;
    __syncthreads();
#pragma unroll
    for (int i = 0; i < 16; ++i) { red[((w * NT + 0) * 16 + i) * 64 + lane] = c00[i]; red[((w * NT + 1) * 16 + i) * 64 + lane] = c10[i];
        if constexpr (DUAL) { red[((w * NT + 2) * 16 + i) * 64 + lane] = c01[i]; red[((w * NT + 3) * 16 + i) * 64 + lane] = c11[i]; } }
    __syncthreads();
#pragma unroll
    for (int j = 0; j < 4; ++j) { const int idx = tid + NTHR * j, mt = idx >> 10, reg = (idx >> 6) & 15, ln = idx & 63;
        float v0 = 0.f, v1 = 0.f;
#pragma unroll
        for (int ww = 0; ww < 8; ++ww) { v0 += red[((ww * NT + mt) * 16 + reg) * 64 + ln]; if constexpr (DUAL) v1 += red[((ww * NT + 2 + mt) * 16 + reg) * 64 + ln]; }
        E(32 * mt + (reg & 3) + 8 * (reg >> 2) + 4 * (ln >> 5), ln & 31, v0, v1); }
}
__device__ __forceinline__ void proj_store_sample(unsigned char* ws, float* out, int sr, int c, float v) {
    const int rng = c >> 10, cc = c & 1023; const size_t o = (size_t)(MP + sr) * DA + cc;
    if (rng == 1) { const float l = ((const float*)(ws + WS_LBV))[cc]; ((float*)(ws + WS_LF))[o] = __builtin_amdgcn_logf(l + (1.f - l) * sigmoid_f(v)); return; }
    if (rng == 5) out[OFF_KS + (size_t)sr * DA + cc] = v;
    if (rng == 6) out[OFF_VS + (size_t)sr * DA + cc] = v;
    if (rng == 0) v *= QSCALE; if (rng == 4) v *= QSCALE * LOG2E; if (rng == 3) v = silu_f(v);
    bf16* B = (bf16*)(ws + WS_QA + (size_t)(rng == 0 ? 0 : rng - 1) * (WS_IA - WS_QA));
    B[o] = (bf16)f2bf(v);
}
struct SEpiSwiGLU { bf16* H; int col0; __device__ __forceinline__ void operator()(int row, int col, float g, float u) const { H[(size_t)(MP + row) * DFF + col0 + col] = (bf16)f2bf(silu_f(g) * u); } };
struct SEpiResid { const float* xs  ; bf16* X; const float* gate; float scale; int col0;
    __device__ __forceinline__ void operator()(int row, int col, float v, float) const { const int c = col0 + col; const size_t o = (size_t)(MP + row) * DM + c;
        const float b = xs ? xs[(size_t)row * DM + c] : bf2f(X[o]);
        X[o] = (bf16)f2bf(b + scale * gate[(size_t)(4 + (row >> 3)) * NMODC + c] * v); } };
struct SEpiProj { unsigned char* ws; float* out; int col0; __device__ __forceinline__ void operator()(int row, int col, float v, float) const { proj_store_sample(ws, out, row, col0 + col, v); } };

template <int WHICH, bool PROBE = false> __device__ __forceinline__ void phase_gemm(ArgsRef a, LAS unsigned char* lds, int bid, int nblk) {
    bf16* const Xo = PROBE ? (bf16*)(a.ws + WS_PART + 200 * MiB) : WS_B(WS_X);
    using namespace pg8;
    if constexpr (WHICH == 1 || WHICH == 5) {
        const bf16* W = WS_B(WHICH == 1 ? WS_WGU1 : WS_WGU2);
        Gemm g{WS_B(WS_XN), W, MP, 2 * DFF, DM}; StaticOrder S; S.init(MP, 2 * DFF, nblk, bid);
        EpiSwiGLU E{WS_B(WS_H), DFF};
        gemm_phase<EpiSwiGLU, StaticOrder, true, true>(lds, g, S, E);
        for (int j = bid - nblk / 2; j >= 0 && j < DFF / 32; j += nblk / 2) { const int n0 = 32 * j, wrow = (n0 >> 7) * 256 + (n0 & 127);
            SEpiSwiGLU SE{WS_B(WS_H), n0};
            sgemm64_unit<true>(WS_B(WS_XN) + (size_t)MP * DM, DM, W + (size_t)wrow * DM, W + (size_t)(wrow + 128) * DM, lds, SE); }
        if constexpr (WHICH == 1) { if (bid >= nblk / 2) { __syncthreads(); phase_cvt<1>(a, lds, bid - nblk / 2, nblk - nblk / 2); } }
    } else if constexpr (WHICH == 2 || WHICH == 6) {
        const bf16* W = WS_B(WHICH == 2 ? WS_WD1 : WS_WD2);
        Gemm g{WS_B(WS_H), W, MP, DM, DFF}; StaticOrder S; S.init(MP, DM, nblk, bid);
        EpiResid<WHICH == 2> E{WHICH == 2 ? (const void*)IN_F(I_XP) : (const void*)WS_B(WS_X), Xo, WS_F(WS_MOD) + (WHICH == 2 ? 2 : 8) * DM, 0.5f};
        gemm_phase<EpiResid<WHICH == 2>, StaticOrder, true, true>(lds, g, S, E);
        if (!PROBE) for (int j = bid; j < DM / 32; j += nblk) {
            SEpiResid SE{WHICH == 2 ? IN_F(I_XS) : nullptr, WS_B(WS_X), WS_F(WS_MOD) + (WHICH == 2 ? 2 : 8) * DM, 0.5f, 32 * j};
            sgemm64_unit<false>(WS_B(WS_H) + (size_t)MP * DFF, DFF, W + (size_t)(32 * j) * DFF, W, lds, SE); }
    } else if constexpr (WHICH == 3) {
        Gemm g{WS_B(WS_XN), WS_B(WS_WIN), MP, DIN, DM}; StaticOrder S; S.init(MP, DIN, nblk, bid);
        EpiProj E{a.ws, WS_F(WS_LF), a.out, WS_F(WS_LBV)};
        gemm_phase<EpiProj, StaticOrder, true, true>(lds, g, S, E);
        for (int j = bid - nblk / 2; j >= 0 && j < DIN / 32; j += nblk / 2) {
            SEpiProj SE{a.ws, a.out, 32 * j};
            sgemm64_unit<false>(WS_B(WS_XN) + (size_t)MP * DM, DM, WS_B(WS_WIN) + (size_t)(32 * j) * DM, WS_B(WS_WIN), lds, SE); }
        if (bid >= nblk / 2) { __syncthreads(); phase_cvt<2>(a, lds, bid - nblk / 2, nblk - nblk / 2); }
    } else {
        Gemm g{WS_B(WS_OM), WS_B(WS_WOUT), MP, DM, DM}; StaticOrder S; S.init(MP, DM, nblk, bid);
        EpiResid<false> E{(const void*)WS_B(WS_X), Xo, WS_F(WS_MOD) + 5 * DM, 1.0f};
        gemm_phase<EpiResid<false>, StaticOrder, true, true>(lds, g, S, E);
        if (!PROBE) for (int j = bid; j < DM / 32; j += nblk) {
            SEpiResid SE{nullptr, WS_B(WS_X), WS_F(WS_MOD) + 5 * DM, 1.0f, 32 * j};
            sgemm64_unit<false>(WS_B(WS_OM) + (size_t)MP * DM, DM, WS_B(WS_WOUT) + (size_t)(32 * j) * DM, WS_B(WS_WOUT), lds, SE); }
    }
}

constexpr size_t WS_QD = WS_PART + 48 * MiB, WS_KI = WS_QD + 17 * MiB, WS_DEC = WS_KI + 17 * MiB;
static_assert(WS_DEC + 2 * MiB <= 700 * MiB, "workspace map");
__device__ __forceinline__ void phase_hprep(ArgsRef a, int bid, int nblk) {
    const int tid = tid_opaque(), lane = tid & 63, w = tid >> 6;
    const float* LF = WS_F(WS_LF); const bf16* QA = WS_B(WS_QA);
    for (int item = bid * NWAVES + w; item < NB * NHEAD * (SEQ / 32); item += nblk * NWAVES) {
        const int u = item >> 6, c = item & 63, b = u >> 3, h = u & 7;
        const size_t g0 = (size_t)(b * SEQ + 32 * c) * DA + h * HD + 2 * lane;
        f32x2 bc = (f32x2){0.f, 0.f};
#pragma unroll 8
        for (int t = 0; t < 32; ++t) {
            const size_t o = g0 + (size_t)t * DA;
            const f32x2 l = *(const f32x2*)(LF + o); const unsigned q = *(const unsigned*)(QA + o);
            bc += l;
            const float k0 = 1.f - __builtin_amdgcn_exp2f(l.x), k1 = 1.f - __builtin_amdgcn_exp2f(l.y);
            const float e0 = __builtin_amdgcn_exp2f(bc.x), e1 = __builtin_amdgcn_exp2f(bc.y);
            const float n0 = __builtin_amdgcn_exp2f(-bc.x), n1 = __builtin_amdgcn_exp2f(-bc.y);
            *(unsigned*)(WS_B(WS_QD) + o) = cvtpk(bflo(q) * e0, bfhi(q) * e1);
            *(unsigned*)(WS_B(WS_KI) + o) = cvtpk(k0 * n0, k1 * n1);
        }
        const f32x2 tot = bc;
        *(f32x2*)(WS_F(WS_DEC) + ((size_t)u * 64 + c) * HD + 2 * lane) = (f32x2){__builtin_amdgcn_exp2f(tot.x), __builtin_amdgcn_exp2f(tot.y)};
    }
}

constexpr int HG_BUF = 25600, HG_QD = 0, HG_KI = 8192, HG_VV = 16384, HG_DEC = 24576, HG_SSX = 2 * HG_BUF;

__device__ __forceinline__ void hgrn_chain_prompt(ArgsRef a, LAS unsigned char* lds, int u) {
    const int tid = tid_opaque(), lane = tid & 63, w = __builtin_amdgcn_readfirstlane(tid >> 6);
    const int b = u >> 3, h = u & 7, row00 = b * SEQ;
    const bf16* IA = WS_B(WS_IA); const bf16* GA = WS_B(WS_GA);
    constexpr int NCH = SEQ / 32;
    if (w >= 4) {
        const int pt = tid - 256;
        const bf16* QD = WS_B(WS_QD); const bf16* KI = WS_B(WS_KI); const float* DEC = WS_F(WS_DEC) + (size_t)u * 64 * HD;
        const int row0 = pt >> 4, ch = pt & 15;
        const size_t gsrc = (size_t)(row00 + row0) * DA + h * HD + 8 * ch;
        const unsigned ld0 = off_a(row0, ch), ld1 = off_a(row0 + 16, ch);
        v4u rA[6], rB[6]; float dA = 0.f, dB = 0.f;
#define HG_LOAD(R, D, cc) do { const size_t o_ = gsrc + (size_t)(cc) * 32 * DA; R[0] = *(const v4u*)(QD + o_); R[1] = *(const v4u*)(QD + o_ + 16 * DA); R[2] = *(const v4u*)(KI + o_); R[3] = *(const v4u*)(KI + o_ + 16 * DA); \
            R[4] = *(const v4u*)(IA + o_); R[5] = *(const v4u*)(IA + o_ + 16 * DA); if (pt < 128) D = DEC[(size_t)(cc) * HD + pt]; } while (0)
#define HG_WRITE(R, D, cc) do { LAS unsigned char* b_ = lds + ((cc) & 1) * HG_BUF; *(LAS v4u*)(b_ + HG_QD + ld0) = R[0]; *(LAS v4u*)(b_ + HG_QD + ld1) = R[1]; *(LAS v4u*)(b_ + HG_KI + ld0) = R[2]; *(LAS v4u*)(b_ + HG_KI + ld1) = R[3]; \
            *(LAS v4u*)(b_ + HG_VV + ld0) = R[4]; *(LAS v4u*)(b_ + HG_VV + ld1) = R[5]; if (pt < 128) *(LAS float*)(b_ + HG_DEC + 4 * pt) = D; } while (0)
        HG_LOAD(rA, dA, 0); HG_LOAD(rB, dB, 1);
        for (int c = 0; c < NCH; c += 2) {
            HG_WRITE(rA, dA, c); if (c + 2 < NCH) HG_LOAD(rA, dA, c + 2);
            __syncthreads();
            HG_WRITE(rB, dB, c + 1); if (c + 3 < NCH) HG_LOAD(rB, dB, c + 3);
            __syncthreads();
        }
#undef HG_LOAD
#undef HG_WRITE
        __syncthreads();
    } else {
        const int r = lane & 31, hh = lane >> 5, q4 = (lane & 15) >> 2, p4 = lane & 3, blk = (lane >> 4) & 1;
        int pb[4];
#pragma unroll
        for (int x = 0; x < 4; ++x) pb[x] = (int)(2048u * (r >> 3) + 64u * (r & 7) + 16u * ((unsigned)x ^ ((r >> 2) & 3)) + 8u * hh);
        const int vp0 = (int)(64u * (4 * hh + q4) + 16u * ((2 * blk + (p4 >> 1)) ^ ((0u + hh) & 3)) + 8u * (p4 & 1));
        const int vp1 = (int)(2048u + 64u * (4 * hh + q4) + 16u * ((2 * blk + (p4 >> 1)) ^ ((2u + hh) & 3)) + 8u * (p4 & 1));
        const int nb0 = (int)(2048u * hh + 64u * q4 + 16u * ((2 * blk + (p4 >> 1)) ^ ((2u * hh) & 3)) + 8u * (p4 & 1));
        const int nb1 = (int)(2048u * hh + 64u * (4 + q4) + 16u * ((2 * blk + (p4 >> 1)) ^ ((2u * hh + 1) & 3)) + 8u * (p4 & 1));
        const int tm = r - 4 * hh;
        f32x16 S[4];
#pragma unroll
        for (int kt = 0; kt < 4; ++kt)
#pragma unroll
            for (int i = 0; i < 16; ++i) S[kt][i] = 0.f;
        f32x16 oprev;
#pragma unroll
        for (int i = 0; i < 16; ++i) oprev[i] = 0.f;
        const float* gwv = IN_F(I_GOA) + h * HD + 32 * w;
        __syncthreads();
        for (int c = 0; c < NCH; ++c) {
            const LAS unsigned char* buf = lds + (c & 1) * HG_BUF;
            if (c > 0) {
                const LAS float* sx = (const LAS float*)(lds + HG_SSX) + ((c - 1) & 1) * 128 + r;
                const float ss = (sx[0] + sx[32]) + (sx[64] + sx[96]);
                const float rstd = 1.0f / sqrtf(ss * (1.f / HD) + EPS);
                const size_t row = (size_t)(row00 + 32 * (c - 1) + r);
#pragma unroll
                for (int g = 0; g < 4; ++g) { const int dv = 32 * w + 8 * g + 4 * hh; const f32x4 gv = *(const f32x4*)(gwv + 8 * g + 4 * hh);
                    const v2u gt = *(const v2u*)(GA + row * DA + h * HD + dv);
                    v2u o2; o2.x = cvtpk(oprev[4 * g] * rstd * gv.x * bflo(gt.x), oprev[4 * g + 1] * rstd * gv.y * bfhi(gt.x));
                    o2.y = cvtpk(oprev[4 * g + 2] * rstd * gv.z * bflo(gt.y), oprev[4 * g + 3] * rstd * gv.w * bfhi(gt.y));
                    *(v2u*)(WS_B(WS_OM) + row * DM + h * HD + dv) = o2; }
            }
            bf16x8 qd[8];
#pragma unroll
            for (int ks = 0; ks < 8; ++ks) { const v2u lo = *(const LAS v2u*)(buf + HG_QD + pb[2 * (ks & 1)] + 512 * (ks >> 1)), hi = *(const LAS v2u*)(buf + HG_QD + pb[2 * (ks & 1) + 1] + 512 * (ks >> 1));
                qd[ks] = __builtin_bit_cast(bf16x8, (v4u){lo.x, lo.y, hi.x, hi.y}); }
            f32x16 at;
#pragma unroll
            for (int i = 0; i < 16; ++i) at[i] = 0.f;
#pragma unroll
            for (int ks = 0; ks < 8; ++ks) { const v2u lo = *(const LAS v2u*)(buf + HG_KI + pb[2 * (ks & 1)] + 512 * (ks >> 1)), hi = *(const LAS v2u*)(buf + HG_KI + pb[2 * (ks & 1) + 1] + 512 * (ks >> 1));
                at = MFMA32(__builtin_bit_cast(bf16x8, (v4u){lo.x, lo.y, hi.x, hi.y}), qd[ks], at); }
            f32x16 o;
#pragma unroll
            for (int i = 0; i < 16; ++i) o[i] = 0.f;
#pragma unroll
            for (int kt = 0; kt < 4; ++kt) { o = MFMA32(pack8<0>(S[kt]), qd[2 * kt], o); o = MFMA32(pack8<1>(S[kt]), qd[2 * kt + 1], o); }
#pragma unroll
            for (int i = 0; i < 16; ++i) at[i] = ((i & 3) + 8 * (i >> 2) <= tm) ? at[i] : 0.f;
            { const bf16x8 p0 = pack8<0>(at), p1 = pack8<1>(at);
              const LAS unsigned char* vv = buf + HG_VV + 512 * w;
              { const s16x4 lo = vtr(vv + vp0), hi = vtr(vv + vp1); o = MFMA32(__builtin_shufflevector(lo, hi, 0, 1, 2, 3, 4, 5, 6, 7), p0, o); }
              { const s16x4 lo = vtr(vv + vp0 + 4096), hi = vtr(vv + vp1 + 4096); o = MFMA32(__builtin_shufflevector(lo, hi, 0, 1, 2, 3, 4, 5, 6, 7), p1, o); } }
            { const LAS unsigned char* vv = buf + HG_VV + 512 * w;
              const s16x4 a0 = vtr(vv + nb0), a1 = vtr(vv + nb1), a2 = vtr(vv + nb0 + 4096), a3 = vtr(vv + nb1 + 4096);
              const bf16x8 vf0 = __builtin_shufflevector(a0, a1, 0, 1, 2, 3, 4, 5, 6, 7), vf1 = __builtin_shufflevector(a2, a3, 0, 1, 2, 3, 4, 5, 6, 7);
#pragma unroll
              for (int kt = 0; kt < 4; ++kt) {
                  const LAS unsigned char* ki = buf + HG_KI + 512 * kt;
                  const s16x4 k0 = vtr(ki + nb0), k1 = vtr(ki + nb1), k2 = vtr(ki + nb0 + 4096), k3 = vtr(ki + nb1 + 4096);
                  S[kt] = MFMA32(__builtin_shufflevector(k0, k1, 0, 1, 2, 3, 4, 5, 6, 7), vf0, S[kt]);
                  S[kt] = MFMA32(__builtin_shufflevector(k2, k3, 0, 1, 2, 3, 4, 5, 6, 7), vf1, S[kt]);
#pragma unroll
                  for (int g = 0; g < 4; ++g) { const f32x4 dc = *(const LAS f32x4*)(buf + HG_DEC + 4 * (32 * kt + 8 * g + 4 * hh));
                      S[kt][4 * g] *= dc.x; S[kt][4 * g + 1] *= dc.y; S[kt][4 * g + 2] *= dc.z; S[kt][4 * g + 3] *= dc.w; }
              } }
            { float ss = 0.f;
#pragma unroll
              for (int i = 0; i < 16; ++i) ss += o[i] * o[i];
              ss += __shfl_xor(ss, 32);
              if (hh == 0) ((LAS float*)(lds + HG_SSX))[(c & 1) * 128 + w * 32 + r] = ss; }
            oprev = o;
            __syncthreads();
        }
        {
            const LAS float* sx = (const LAS float*)(lds + HG_SSX) + ((NCH - 1) & 1) * 128 + r;
            const float ss = (sx[0] + sx[32]) + (sx[64] + sx[96]);
            const float rstd = 1.0f / sqrtf(ss * (1.f / HD) + EPS);
            const size_t row = (size_t)(row00 + 32 * (NCH - 1) + r);
#pragma unroll
            for (int g = 0; g < 4; ++g) { const int dv = 32 * w + 8 * g + 4 * hh; const f32x4 gv = *(const f32x4*)(gwv + 8 * g + 4 * hh);
                const v2u gt = *(const v2u*)(GA + row * DA + h * HD + dv);
                v2u o2; o2.x = cvtpk(oprev[4 * g] * rstd * gv.x * bflo(gt.x), oprev[4 * g + 1] * rstd * gv.y * bfhi(gt.x));
                o2.y = cvtpk(oprev[4 * g + 2] * rstd * gv.z * bflo(gt.y), oprev[4 * g + 3] * rstd * gv.w * bfhi(gt.y));
                *(v2u*)(WS_B(WS_OM) + row * DM + h * HD + dv) = o2; }
        }
        float* sout = a.out + OFF_SP + (size_t)u * HD * HD;
#pragma unroll
        for (int kt = 0; kt < 4; ++kt)
#pragma unroll
            for (int i = 0; i < 16; ++i) sout[(size_t)(32 * kt + (i & 3) + 8 * (i >> 2) + 4 * hh) * HD + 32 * w + r] = S[kt][i];
    }
}
struct SbLane {
    int kb0, kb1;
    int vb0, vb1;
    bf16x8 nu0, nu1;
};
__device__ __forceinline__ SbLane sb_lane_init(int lane) {
    SbLane L; const unsigned r = lane & 31, h = lane >> 5, q = (lane & 15) >> 2, p = lane & 3, blk = (lane >> 4) & 1;
    L.kb0 = (int)(2048u * (r >> 3) + 64u * (r & 7) + 16u * ((0u + h) ^ ((r >> 2) & 3)));
    L.kb1 = (int)(2048u * (r >> 3) + 64u * (r & 7) + 16u * ((2u + h) ^ ((r >> 2) & 3)));
    L.vb0 = (int)(64u * (4 * h + q) + 16u * ((2 * blk + (p >> 1)) ^ ((0u + h) & 3)) + 8u * (p & 1));
    L.vb1 = (int)(2048u + 64u * (4 * h + q) + 16u * ((2 * blk + (p >> 1)) ^ ((2u + h) & 3)) + 8u * (p & 1));
#pragma unroll
    for (int j = 0; j < 8; ++j) { const unsigned k0 = 8 * (j >> 2) + 4 * h + (j & 3), k1 = 16 + k0;
        L.nu0[j] = (k0 >= r) ? (short)0xBF80 : (short)0; L.nu1[j] = (k1 >= r) ? (short)0xBF80 : (short)0; }
    return L;
}
__device__ __forceinline__ void sbm_step(const LAS unsigned char* kt, const LAS unsigned char* vt, const LAS unsigned char* qfl  , int qstride, float bias2, const SbLane& L, f32x16 (&o)[4], float& R, int lane, int tq) {
    f32x16 zt;
#pragma unroll
    for (int r = 0; r < 16; ++r) zt[r] = bias2;
#pragma unroll
    for (int s = 0; s < 8; ++s) { const bf16x8 kf = *(const LAS bf16x8*)(kt + ((s & 1) ? L.kb1 : L.kb0) + 512 * (s >> 1)); const bf16x8 qf = *(const LAS bf16x8*)(qfl + qstride * s); zt = MFMA32(kf, qf, zt); }
    f32x16 sp, cin;
#pragma unroll
    for (int r = 0; r < 16; ++r) {
        const float e = __builtin_amdgcn_exp2f(zt[r]); float l = __builtin_amdgcn_logf(1.f + e); l = zt[r] > 30.f ? zt[r] : l;
        l = ((r & 3) + 8 * (r >> 2) < tq) ? l : 0.f;
        sp[r] = l; cin[r] = zt[r] + R;
    }
    f32x16 out = MFMA32(L.nu0, pack8<0>(sp), cin);
    out = MFMA32(L.nu1, pack8<1>(sp), out);
    const float rn = out[0] - zt[0];
    R = __shfl(rn, lane & 31);
    f32x16 p;
#pragma unroll
    for (int r = 0; r < 16; ++r) { float v = __builtin_amdgcn_exp2f(out[r]); v = ((r & 3) + 8 * (r >> 2) < tq) ? v : 0.f; p[r] = v; }
    const bf16x8 p0 = pack8<0>(p), p1 = pack8<1>(p);
#pragma unroll
    for (int c = 0; c < 4; ++c) {
        { const s16x4 lo = vtr(vt + L.vb0 + 512 * c), hi = vtr(vt + L.vb1 + 512 * c); const bf16x8 vf = __builtin_shufflevector(lo, hi, 0, 1, 2, 3, 4, 5, 6, 7); o[c] = MFMA32(vf, p0, o[c]); }
        { const s16x4 lo = vtr(vt + L.vb0 + 4096 + 512 * c), hi = vtr(vt + L.vb1 + 4096 + 512 * c); const bf16x8 vf = __builtin_shufflevector(lo, hi, 0, 1, 2, 3, 4, 5, 6, 7); o[c] = MFMA32(vf, p1, o[c]); }
    }
}
__device__ __forceinline__ void sbm_finish(ArgsRef a, const f32x16 (&o)[4], int row, int h, int lane) {
    float ss = 0.f;
#pragma unroll
    for (int c = 0; c < 4; ++c)
#pragma unroll
        for (int r = 0; r < 16; ++r) ss += o[c][r] * o[c][r];
    ss += __shfl_xor(ss, 32);
    const float rstd = 1.0f / sqrtf(ss * (1.f / HD) + EPS);
    const int hh = lane >> 5; const float* gw = IN_F(I_GOB) + h * HD; bf16* dst = WS_B(WS_OM) + (size_t)row * DM + DA + h * HD;
#pragma unroll
    for (int c = 0; c < 4; ++c)
#pragma unroll
        for (int g = 0; g < 4; ++g) { const int d = 32 * c + 8 * g + 4 * hh; const f32x4 gv = *(const f32x4*)(gw + d);
            v2u w; w.x = cvtpk(o[c][4 * g + 0] * rstd * gv.x, o[c][4 * g + 1] * rstd * gv.y); w.y = cvtpk(o[c][4 * g + 2] * rstd * gv.z, o[c][4 * g + 3] * rstd * gv.w);
            *(v2u*)(dst + d) = w; }
}
__device__ __forceinline__ void sbm_unit_prompt(ArgsRef a, LAS unsigned char* lds, int bh, int qb) {
    const int tid = tid_opaque(), lane = tid & 63, w = __builtin_amdgcn_readfirstlane(tid >> 6);
    const int b = bh >> 3, h = bh & 7, q0 = 256 * qb + 32 * w, idiag = 8 * qb + w;
    const SbLane L = sb_lane_init(lane);
    const bf16* QB = WS_B(WS_QB); const bf16* KB = WS_B(WS_KB); const bf16* VB = WS_B(WS_VB);
    LAS unsigned char* qfl = lds + 65536 + w * 8192 + lane * 16;
    { const bf16* qp = QB + (size_t)(b * SEQ + q0 + (lane & 31)) * DA + h * HD + 8 * (lane >> 5);
#pragma unroll
      for (int s = 0; s < 8; ++s) *(LAS bf16x8*)(qfl + 1024 * s) = *(const bf16x8*)(qp + 16 * s); }
    const float bias2 = IN_F(I_BSB)[h] * LOG2E;
    f32x16 o[4];
#pragma unroll
    for (int c = 0; c < 4; ++c)
#pragma unroll
        for (int r = 0; r < 16; ++r) o[c][r] = 0.f;
    float R = 0.f; const int tq = (lane & 31) - 4 * (lane >> 5);
    const int key0 = tid >> 4, ch = tid & 15;
    const size_t gsrc = (size_t)(b * SEQ + key0) * DA + h * HD + 8 * ch;
    const unsigned ldst = off_a(key0 & 31, ch);
    v4u kr[2], vr[2];
    int j = 4 * qb + 3;
#define SBM_LOAD(jj) do { const size_t o_ = gsrc + (size_t)(jj) * 64 * DA; kr[0] = *(const v4u*)(KB + o_); vr[0] = *(const v4u*)(VB + o_); kr[1] = *(const v4u*)(KB + o_ + 32 * DA); vr[1] = *(const v4u*)(VB + o_ + 32 * DA); } while (0)
#define SBM_WRITE(buf) do { LAS unsigned char* b_ = lds + (buf) * 32768; *(LAS v4u*)(b_ + ldst) = kr[0]; *(LAS v4u*)(b_ + 8192 + ldst) = kr[1]; *(LAS v4u*)(b_ + 16384 + ldst) = vr[0]; *(LAS v4u*)(b_ + 16384 + 8192 + ldst) = vr[1]; } while (0)
    SBM_LOAD(j); SBM_WRITE(0);
    __syncthreads();
    int cur = 0;
    for (; j >= 0; --j) {
        if (j > 0) SBM_LOAD(j - 1);
        const LAS unsigned char* kb_ = lds + cur * 32768; const LAS unsigned char* vb_ = kb_ + 16384;
#pragma unroll 1
        for (int tt = 1; tt >= 0; --tt) { const int ti = 2 * j + tt;
            if (ti <= idiag) sbm_step(kb_ + tt * 8192, vb_ + tt * 8192, qfl, 1024, bias2, L, o, R, lane, ti == idiag ? tq : 64); }
        if (j > 0) SBM_WRITE(cur ^ 1);
        __syncthreads();
        cur ^= 1;
    }
#undef SBM_LOAD
#undef SBM_WRITE
    sbm_finish(a, o, b * SEQ + q0 + (lane & 31), h, lane);
}


constexpr int SEGK = 256, NSEG = PAST / SEGK, PART_STRIDE = 132;
__device__ __forceinline__ void sbm_unit_sample(ArgsRef a, LAS unsigned char* lds, int b, int seg) {
    const int tid = tid_opaque(), lane = tid & 63, w = __builtin_amdgcn_readfirstlane(tid >> 6);
    const SbLane L = sb_lane_init(lane);
    LAS unsigned char* kimg = lds + w * 16384; LAS unsigned char* vimg = kimg + 8192;
    LAS unsigned char* qreg = lds + 131072 + w * 2048;
    LAS unsigned char* zchunk = lds + 131072 + 16384 + w * 16;
    const int r = lane & 31, hh = lane >> 5;
    if (r < 8) { const bf16* qp = WS_B(WS_QB) + (size_t)(MP + b * DECT + r) * DA + w * HD + 8 * hh;
#pragma unroll
        for (int s = 0; s < 8; ++s) *(LAS bf16x8*)(qreg + (s * 16 + hh * 8 + r) * 16) = *(const bf16x8*)(qp + 16 * s); }
    if (lane == 0) { unsigned z_ = 0u; asm volatile("" : "+v"(z_)); *(LAS v4u*)zchunk = (v4u){z_, z_, z_, z_}; }
    const LAS unsigned char* qfl = r < 8 ? qreg + (hh * 8 + r) * 16 : zchunk; const int qstride = r < 8 ? 256 : 0;
    const float bias2 = IN_F(I_BSB)[w] * LOG2E;
    f32x16 o[4];
#pragma unroll
    for (int c = 0; c < 4; ++c)
#pragma unroll
        for (int q = 0; q < 16; ++q) o[c][q] = 0.f;
    float R = 0.f;
    LDS_WAIT();
    if (seg == NSEG - 1) {
        { const int j = lane >> 3, c2 = (lane & 7) * 2; const size_t src = (size_t)(MP + b * DECT + j) * DA + w * HD + 8 * c2;
          const v4u k0 = *(const v4u*)(WS_B(WS_KB) + src), k1 = *(const v4u*)(WS_B(WS_KB) + src + 8), v0 = *(const v4u*)(WS_B(WS_VB) + src), v1 = *(const v4u*)(WS_B(WS_VB) + src + 8);
          *(LAS v4u*)(kimg + off_a(j, c2)) = k0; *(LAS v4u*)(kimg + off_a(j, c2 + 1)) = k1; *(LAS v4u*)(vimg + off_a(j, c2)) = v0; *(LAS v4u*)(vimg + off_a(j, c2 + 1)) = v1; }
        { unsigned z_ = 0u; asm volatile("" : "+v"(z_)); const v4u zz = (v4u){z_, z_, z_, z_};
#pragma unroll
        for (int i = 0; i < 6; ++i) { const int n = lane + 64 * i, row = 8 + (n >> 4), c1 = n & 15; *(LAS v4u*)(kimg + off_a(row, c1)) = zz; *(LAS v4u*)(vimg + off_a(row, c1)) = zz; } }
        LDS_WAIT();
        sbm_step(kimg, vimg, qfl, qstride, bias2, L, o, R, lane, r - 4 * hh);
        LDS_WAIT();
    }
    const int* pt = (const int*)a.in[I_PT] + b * NPAGES;
    const float* ck = IN_F(I_CK); const float* cv = IN_F(I_CV);
    const int ch = r >> 1; const unsigned wconst = 512u * (ch >> 2) + 64u * hh + 8u * (lane & 1);
    f32x4 kr[8], vr[8];
#define SBS_LOAD(ti, hf) do { const int p_ = seg * SEGK + 32 * (ti); const size_t base_ = ((size_t)pt[p_ >> 7] * PAGE + (p_ & 127) + 16 * (hf) + hh) * (NHEAD * HD) + w * HD + 4 * r; \
        _Pragma("unroll") for (int i_ = 0; i_ < 8; ++i_) { kr[i_] = *(const f32x4*)(ck + base_ + (size_t)(2 * i_) * (NHEAD * HD)); vr[i_] = *(const f32x4*)(cv + base_ + (size_t)(2 * i_) * (NHEAD * HD)); } } while (0)
#define SBS_WRITE(hf) do { _Pragma("unroll") for (int i_ = 0; i_ < 8; ++i_) { \
        const unsigned off_ = 2048u * (2 * (hf) + (i_ >> 2)) + 64u * (2 * (i_ & 3)) + 16u * ((unsigned)(ch & 3) ^ (unsigned)((i_ >> 1) & 3)) + wconst; \
        v2u kk_, vv_; kk_.x = cvtpk(kr[i_].x, kr[i_].y); kk_.y = cvtpk(kr[i_].z, kr[i_].w); vv_.x = cvtpk(vr[i_].x, vr[i_].y); vv_.y = cvtpk(vr[i_].z, vr[i_].w); \
        *(LAS v2u*)(kimg + off_) = kk_; *(LAS v2u*)(vimg + off_) = vv_; } } while (0)
    SBS_LOAD(SEGK / 32 - 1, 1);
#pragma unroll 1
    for (int ti = SEGK / 32 - 1; ti >= 0; --ti) {
        SBS_WRITE(1);
        SBS_LOAD(ti, 0);
        SBS_WRITE(0);
        if (ti > 0) SBS_LOAD(ti - 1, 1);
        LDS_WAIT();
        sbm_step(kimg, vimg, qfl, qstride, bias2, L, o, R, lane, 64);
        LDS_WAIT();
    }
#undef SBS_LOAD
#undef SBS_WRITE
    if (r < 8) { float* dst = WS_F(WS_PART) + ((((size_t)b * NSEG + seg) * NHEAD + w) * 8 + r) * PART_STRIDE;
#pragma unroll
        for (int c = 0; c < 4; ++c)
#pragma unroll
            for (int g = 0; g < 4; ++g) *(f32x4*)(dst + 32 * c + 8 * g + 4 * hh) = (f32x4){o[c][4 * g], o[c][4 * g + 1], o[c][4 * g + 2], o[c][4 * g + 3]};
        if (hh == 0) dst[128] = R; }
}
__device__ __forceinline__ void phase_sbcombine(ArgsRef a, int bid, int nblk) {
    const int tid = tid_opaque(), lane = tid & 63, w = tid >> 6;
    static_assert(NSEG == 64, "one lane per segment");
    for (int item = bid * NWAVES + w; item < DECB * NHEAD * 8; item += nblk * NWAVES) {
        const int b = item >> 6, h = (item >> 3) & 7, i = item & 7;
        const float* p0 = WS_F(WS_PART) + (((size_t)b * NSEG * NHEAD + h) * 8 + i) * PART_STRIDE;
        const size_t sstride = (size_t)NHEAD * 8 * PART_STRIDE;
        const float rseg = p0[(size_t)lane * sstride + 128];
        float suf = rseg;
#pragma unroll
        for (int off = 1; off < 64; off <<= 1) { const float t = __shfl_down(suf, off); if (lane + off < 64) suf += t; }
        const float fac = __builtin_amdgcn_exp2f(suf - rseg);
        float o0 = 0.f, o1 = 0.f;
#pragma unroll 8
        for (int s = 0; s < NSEG; ++s) { const float f = __builtin_bit_cast(float, __builtin_amdgcn_readlane(__builtin_bit_cast(int, fac), s));
            o0 += f * p0[(size_t)s * sstride + lane]; o1 += f * p0[(size_t)s * sstride + 64 + lane]; }
        const float ss = wave_sum(o0 * o0 + o1 * o1);
        const float rstd = 1.0f / sqrtf(ss * (1.f / HD) + EPS);
        const float* gw = IN_F(I_GOB) + h * HD; bf16* dst = WS_B(WS_OM) + (size_t)(MP + b * DECT + i) * DM + DA + h * HD;
        dst[lane] = (bf16)f2bf(o0 * rstd * gw[lane]); dst[64 + lane] = (bf16)f2bf(o1 * rstd * gw[64 + lane]);
    }
}

constexpr int CTL_MIXQ = 4096;
__device__ __forceinline__ int queue_next(ArgsRef a, LAS unsigned char* lds, int tid, int qword) {
    LAS int* slot = (LAS int*)(lds + LDS_BYTES - 64);
    __syncthreads();
    if (tid == 0) *slot = (int)__hip_atomic_fetch_add((unsigned*)(a.ws + WS_CTL) + qword, 1u, __ATOMIC_RELAXED, __HIP_MEMORY_SCOPE_AGENT);
    __syncthreads();
    return *slot;
}
__device__ __forceinline__ void phase_mixer(ArgsRef a, LAS unsigned char* lds, int bid, int nblk, int qword = CTL_MIXQ, int ulo = 0, int uhi = 1 << 30) {
    const int tid = tid_opaque();
    constexpr int U0 = 32, U2 = U0 + 256 + DECB * NSEG, U3 = U2 + 64;
    static_assert(DECB * NSEG == 512, "two streaming units per prompt block");
    for (;;) {
        const int u = queue_next(a, lds, tid, qword) + ulo;
        if (u >= U3 || u >= uhi) break;
        if (u < U0) hgrn_chain_prompt(a, lds, u);
        else if (u < U2) { const int k = u - U0, g = k / 3, r3 = k - 3 * g;
            if (r3 == 0) sbm_unit_prompt(a, lds, g & 31, 7 - (g >> 5));
            else { const int v = 2 * g + r3 - 1; sbm_unit_sample(a, lds, v & 7, NSEG - 1 - (v >> 3)); } }
        else hgrn_unit(a, lds, 32 + (u - U2));
    }
}

enum { PH_MOD = 0, PH_CVT, PH_NORM1, PH_G1, PH_G2, PH_NORM2, PH_G3, PH_MIX, PH_G4, PH_NORM3, PH_G5, PH_G6, PH_FINAL, N_PHASES };

template <int PH> __device__ __forceinline__ void run_phase(ArgsRef a, LAS unsigned char* lds, int bid, int nblk) {
    if constexpr (PH == PH_MOD) phase_mod(a, lds, bid, nblk);
    else if constexpr (PH == PH_CVT) phase_cvt<0>(a, lds, bid, nblk);
    else if constexpr (PH == PH_NORM1) phase_norm<false, true>(a, bid, nblk, IN_F(I_N1), WS_F(WS_MOD), NMODC, 0 * DM, 1 * DM);
    else if constexpr (PH == PH_G1) phase_gemm<1>(a, lds, bid, nblk);
    else if constexpr (PH == PH_G2) phase_gemm<2>(a, lds, bid, nblk);
    else if constexpr (PH == PH_NORM2) phase_norm<false, false>(a, bid, nblk, IN_F(I_NM), WS_F(WS_MOD), NMODC, 3 * DM, 4 * DM);
    else if constexpr (PH == PH_G3) phase_gemm<3>(a, lds, bid, nblk);
    else if constexpr (PH == PH_MIX) phase_mixer(a, lds, bid, nblk);
    else if constexpr (PH == PH_G4) phase_gemm<4>(a, lds, bid, nblk);
    else if constexpr (PH == PH_NORM3) phase_norm<false, false>(a, bid, nblk, IN_F(I_N2), WS_F(WS_MOD), NMODC, 6 * DM, 7 * DM);
    else if constexpr (PH == PH_G5) phase_gemm<5>(a, lds, bid, nblk);
    else if constexpr (PH == PH_G6) phase_gemm<6>(a, lds, bid, nblk);
    else phase_norm<true, false>(a, bid, nblk, IN_F(I_NF), WS_F(WS_FMOD), NFMODC, 0, DM);
}

#define XB_TMO      128
#define XB_XCNT(j)  (256  + 64 * (j))
#define XB_XSUB(j)  (1280 + 64 * (j))
#define XB_XGEN(j)  (2304 + 64 * (j))
#define XB_TOP      3328
#define XB_TOPGEN   3392
#define XCD_BAR_WORDS 3456
#define XB_SPIN_CAP (1u << 18)

__device__ __forceinline__ unsigned xb_ld(unsigned* p)              { return __hip_atomic_load(p, __ATOMIC_RELAXED, __HIP_MEMORY_SCOPE_AGENT); }
__device__ __forceinline__ unsigned xb_add(unsigned* p, unsigned v) { return __hip_atomic_fetch_add(p, v, __ATOMIC_RELAXED, __HIP_MEMORY_SCOPE_AGENT); }
__device__ __forceinline__ unsigned xb_xcc_id() { return (unsigned)__builtin_amdgcn_s_getreg((3 << 11) | 20) & 0xFu; }
#define XB_SPIN(cond, bar) do { unsigned _sp = 0; while (cond) { __builtin_amdgcn_s_sleep(1); \
    if ((++_sp & 255u) == 0u) { if (xb_ld(&(bar)[XB_TMO])) break; if (_sp > XB_SPIN_CAP) { atomicAdd(&(bar)[XB_TMO], 1u); break; } } } } while (0)

struct XcdBarrier {
    unsigned* bar; unsigned x;
    volatile LAS unsigned* st;
};

__device__ __forceinline__ XcdBarrier xcd_barrier_post(unsigned* bar, volatile LAS unsigned* st) {
    XcdBarrier b; b.bar = bar; b.x = xb_xcc_id(); b.st = st;
    if (threadIdx.x == 0) (void)xb_add(&bar[XB_XCNT(b.x)], 1u);
    return b;
}
__device__ __forceinline__ void xcd_barrier_complete(unsigned* bar, unsigned x, unsigned& nloc, unsigned& nx) {
    const unsigned G = gridDim.x * gridDim.y * gridDim.z;
    unsigned sum, cnt, mine, sp = 0u;
    for (;;) {
        sum = 0u; cnt = 0u; mine = 0u;
#pragma unroll
        for (unsigned j = 0; j < 16; ++j) { const unsigned c = xb_ld(&bar[XB_XCNT(j)]); sum += c; cnt += (c > 0u) ? 1u : 0u; mine = (j == x) ? c : mine; }
        if (sum == G) break;
        __builtin_amdgcn_s_sleep(1);
        if ((++sp & 255u) == 0u) { if (xb_ld(&bar[XB_TMO])) break; if (sp > XB_SPIN_CAP) { atomicAdd(&bar[XB_TMO], 1u); break; } }
    }
    nloc = mine > 0u ? mine : 1u; nx = cnt > 0u ? cnt : 1u;
}

__device__ __forceinline__ void xcd_barrier(const XcdBarrier& b) {
    asm volatile("s_waitcnt vmcnt(0)" ::: "memory");
    __syncthreads();
    if (threadIdx.x == 0) {
        unsigned* bar = b.bar;
        __builtin_amdgcn_s_waitcnt(0);
        unsigned nloc = b.st[0], nx = b.st[1];
        if (nloc == 0u) { xcd_barrier_complete(bar, b.x, nloc, nx); b.st[0] = nloc; b.st[1] = nx; }
        const unsigned old = xb_add(&bar[XB_XSUB(b.x)], 1u);
        const unsigned gen = old / nloc;
        if (old + 1u == (gen + 1u) * nloc) {
            __builtin_amdgcn_fence(__ATOMIC_RELEASE, "agent");
            asm volatile("s_waitcnt vmcnt(0)" ::: "memory");
            const unsigned og = xb_add(&bar[XB_TOP], 1u);
            const unsigned tg = og / nx;
            if (og + 1u == (tg + 1u) * nx) xb_add(&bar[XB_TOPGEN], 1u);
            else XB_SPIN(xb_ld(&bar[XB_TOPGEN]) == tg, bar);
            __builtin_amdgcn_fence(__ATOMIC_ACQUIRE, "agent");
            xb_add(&bar[XB_XGEN(b.x)], 1u);
            asm volatile("s_waitcnt vmcnt(0)" ::: "memory");
        } else {
            XB_SPIN(xb_ld(&bar[XB_XGEN(b.x)]) == gen, bar);
            __builtin_amdgcn_fence(__ATOMIC_ACQUIRE, "agent");
            asm volatile("s_waitcnt vmcnt(0)" ::: "memory");
        }
    }
    __syncthreads();
}


constexpr int LDS_BAR_OFF = LDS_BYTES;
constexpr int LDS_TOTAL = LDS_BYTES + 64;

__device__ __forceinline__ ArgsPtr args_opaque(ArgsPtr p) { asm volatile("" : "+s"(p)); return p; }
__global__ void __launch_bounds__(NTHR, 2) mega_fwd(Args a_) {
    extern __shared__ __attribute__((aligned(16))) unsigned char lds_raw[];
    LAS unsigned char* lds = (LAS unsigned char*)lds_raw;
    const int bid = (int)blockIdx.x, nblk = (int)gridDim.x;
    ArgsPtr kp = (ArgsPtr)__builtin_amdgcn_kernarg_segment_ptr();
#define a (*args_opaque(kp))
    if (threadIdx.x < 16) ((LAS unsigned*)(lds + LDS_BAR_OFF))[threadIdx.x] = 0u;
    __syncthreads();
    XcdBarrier bar = xcd_barrier_post((unsigned*)(a.ws + WS_CTL), (volatile LAS unsigned*)(lds + LDS_BAR_OFF));
    run_phase<PH_MOD>(a, lds, bid, nblk);
    __syncthreads();
    run_phase<PH_CVT>(a, lds, bid, nblk);
    xcd_barrier(bar);
#ifdef PROBE_DUP_P0
    run_phase<PH_MOD>(a, lds, bid, nblk);
    __syncthreads();
    run_phase<PH_CVT>(a, lds, bid, nblk);
    xcd_barrier(bar);
#endif
    run_phase<PH_NORM1>(a, lds, bid, nblk);
    xcd_barrier(bar);
#ifdef PROBE_DUP_N1
    run_phase<PH_NORM1>(a, lds, bid, nblk);
    xcd_barrier(bar);
#endif
    run_phase<PH_G1>(a, lds, bid, nblk);
    xcd_barrier(bar);
#ifdef PROBE_DUP_G1
    run_phase<PH_G1>(a, lds, bid, nblk);
    xcd_barrier(bar);
#endif
    run_phase<PH_G2>(a, lds, bid, nblk);
    xcd_barrier(bar);
#ifdef PROBE_DUP_G2
    run_phase<PH_G2>(a, lds, bid, nblk);
    xcd_barrier(bar);
#endif
    run_phase<PH_NORM2>(a, lds, bid, nblk);
    xcd_barrier(bar);
#ifdef PROBE_DUP_N2
    run_phase<PH_NORM2>(a, lds, bid, nblk);
    xcd_barrier(bar);
#endif
    run_phase<PH_G3>(a, lds, bid, nblk);
    xcd_barrier(bar);
#ifdef PROBE_DUP_G3
    run_phase<PH_G3>(a, lds, bid, nblk);
    xcd_barrier(bar);
#endif
    phase_hprep(a, bid, nblk);
    xcd_barrier(bar);
#ifdef PROBE_DUP_HP
    phase_hprep(a, bid, nblk);
    xcd_barrier(bar);
#endif
    run_phase<PH_MIX>(a, lds, bid, nblk);
    xcd_barrier(bar);
#ifdef PROBE_DUP_MIX
    phase_mixer(a, lds, bid, nblk, CTL_MIXQ + 64, PROBE_MIX_LO, PROBE_MIX_HI);
    xcd_barrier(bar);
#endif
    phase_sbcombine(a, bid, nblk);
    xcd_barrier(bar);
#ifdef PROBE_DUP_CB
    phase_sbcombine(a, bid, nblk);
    xcd_barrier(bar);
#endif
    run_phase<PH_G4>(a, lds, bid, nblk);
    xcd_barrier(bar);
#ifdef PROBE_DUP_G4
    phase_gemm<4, true>(a, lds, bid, nblk);
    xcd_barrier(bar);
#endif
    run_phase<PH_NORM3>(a, lds, bid, nblk);
    xcd_barrier(bar);
    run_phase<PH_G5>(a, lds, bid, nblk);
    xcd_barrier(bar);
    run_phase<PH_G6>(a, lds, bid, nblk);
    xcd_barrier(bar);
#ifdef PROBE_DUP_G6
    phase_gemm<6, true>(a, lds, bid, nblk);
    xcd_barrier(bar);
#endif
    run_phase<PH_FINAL>(a, lds, bid, nblk);
#ifdef PROBE_DUP_FIN
    xcd_barrier(bar);
    run_phase<PH_FINAL>(a, lds, bid, nblk);
#endif
#undef a
}

extern "C" void kernel_launch(void* const* d_in, const int* in_sizes, int n_in, void* d_out, int out_size, void* d_ws, size_t ws_size, hipStream_t stream) {
    static int grid = 0;
    if (grid == 0) {
        if (n_in != N_IN || (size_t)out_size != OUT_TOTAL || ws_size < WS_END) { fprintf(stderr, "kernel_launch: unexpected shapes (n_in %d, out %d, ws %zu)\n", n_in, out_size, ws_size); grid = -1; return; }
        int dev = 0, cus = 0, per_cu = 0;
        if (hipGetDevice(&dev) != hipSuccess || hipDeviceGetAttribute(&cus, hipDeviceAttributeMultiprocessorCount, dev) != hipSuccess) { grid = -1; return; }
        if (hipFuncSetAttribute((const void*)mega_fwd, hipFuncAttributeMaxDynamicSharedMemorySize, LDS_TOTAL) != hipSuccess) { fprintf(stderr, "kernel_launch: hipFuncSetAttribute failed\n"); grid = -1; return; }
        if (hipOccupancyMaxActiveBlocksPerMultiprocessor(&per_cu, (const void*)mega_fwd, NTHR, LDS_TOTAL) != hipSuccess || per_cu < 1) { fprintf(stderr, "kernel_launch: occupancy query says %d blocks per CU\n", per_cu); grid = -1; (void)hipGetLastError(); return; }
        grid = cus;
    }
    if (grid < 0) return;
    (void)hipMemsetAsync((char*)d_ws + WS_CTL, 0, 65536, stream);
    Args a{};
    for (int i = 0; i < N_IN; ++i) a.in[i] = d_in[i];
    a.out = (float*)d_out; a.ws = (unsigned char*)d_ws;
    hipLaunchKernelGGL(mega_fwd, dim3(grid), dim3(NTHR), LDS_TOTAL, stream, a);
}
```

```cpp
#include <hip/hip_runtime.h>
#include <cstdio>
#include <cstdint>

constexpr int DM = 2048, SEQ = 2048, NB = 4, MP = NB * SEQ  , DECB = 8, DECT = 8, MS = DECB * DECT  ;
constexpr int MREAL = MP + MS  , MPAD = 8448  ;
constexpr int DFF = 5632, DIN = 7168, NMODC = 9 * DM  , NFMODC = 2 * DM;
constexpr int DA = 1024, NHEAD = 8, HD = 128, PAST = 16384, PAGE = 128, NPAGES = PAST / PAGE  ;
constexpr float EPS = 1e-6f, QSCALE = 0.08838834764831845f  ;
constexpr float LOG2E = 1.4426950408889634f, LN2 = 0.6931471805599453f;
constexpr size_t OFF_YP = 0, OFF_YS = OFF_YP + (size_t)MP * DM, OFF_KP = OFF_YS + (size_t)MS * DM, OFF_VP = OFF_KP + (size_t)MP * DA,
                 OFF_KS = OFF_VP + (size_t)MP * DA, OFF_VS = OFF_KS + (size_t)MS * DA, OFF_SP = OFF_VS + (size_t)MS * DA,
                 OFF_SS = OFF_SP + (size_t)NB * NHEAD * HD * HD, OUT_TOTAL = OFF_SS + (size_t)DECB * NHEAD * HD * HD;
enum { I_XP = 0, I_XS, I_CK, I_CV, I_ST, I_PT, I_CP, I_CS, I_LB, I_N1, I_NM, I_N2, I_WMOD, I_BMOD, I_WG1, I_WU1, I_WD1, I_WIN, I_GOA, I_GOB, I_BSB, I_WOUT,
       I_WG2, I_WU2, I_WD2, I_NF, I_WFM, I_BFM, N_IN };
constexpr size_t MiB = 1u << 20;
constexpr size_t WS_CTL = 0, CTL_BYTES = 1 * MiB;
constexpr size_t WS_MOD = 1 * MiB;
constexpr size_t WS_FMOD = 2 * MiB;
constexpr size_t WS_LBV = 3 * MiB;
constexpr size_t WS_WGU1 = 4 * MiB, WS_WD1 = 48 * MiB, WS_WIN = 70 * MiB, WS_WOUT = 98 * MiB, WS_WGU2 = 106 * MiB, WS_WD2 = 150 * MiB;
constexpr size_t WS_XN = 172 * MiB;
constexpr size_t WS_H = 206 * MiB;
constexpr size_t WS_X = 298 * MiB;
constexpr size_t WS_QA = 364 * MiB, WS_IA = 381 * MiB, WS_GA = 398 * MiB, WS_QB = 415 * MiB, WS_KB = 432 * MiB, WS_VB = 449 * MiB;
constexpr size_t WS_LF = 466 * MiB;
constexpr size_t WS_OM = 500 * MiB;
constexpr size_t WS_PART = 534 * MiB;
constexpr size_t WS_END = 900 * MiB;

#define GAS __attribute__((address_space(1)))
#define LAS __attribute__((address_space(3)))
typedef unsigned short bf16;
typedef unsigned v4u __attribute__((ext_vector_type(4)));
typedef unsigned v2u __attribute__((ext_vector_type(2)));
typedef float f32x4 __attribute__((ext_vector_type(4)));
typedef float f32x2 __attribute__((ext_vector_type(2)));
typedef short bf16x8 __attribute__((ext_vector_type(8)));

struct Args { const void* in[N_IN]; float* out; unsigned char* ws; };
typedef const __attribute__((address_space(4))) Args& ArgsRef;
typedef const __attribute__((address_space(4))) Args* ArgsPtr;

__device__ __forceinline__ unsigned f2bf(float f) { unsigned u = __builtin_bit_cast(unsigned, f); return (u + 0x7fffu + ((u >> 16) & 1u)) >> 16; }
__device__ __forceinline__ unsigned pk2(float lo, float hi) { return f2bf(lo) | (f2bf(hi) << 16); }
__device__ __forceinline__ float bf2f(unsigned short b) { return __builtin_bit_cast(float, (unsigned)b << 16); }
__device__ __forceinline__ float bflo(unsigned w) { return __builtin_bit_cast(float, w << 16); }
__device__ __forceinline__ float bfhi(unsigned w) { return __builtin_bit_cast(float, w & 0xffff0000u); }
__device__ __forceinline__ float sigmoid_f(float x) { return __builtin_amdgcn_rcpf(1.f + __expf(-x)); }
__device__ __forceinline__ float silu_f(float x) { return x * sigmoid_f(x); }
__device__ __forceinline__ int mod_row(int r) { const int s = 4 + ((r - MP) >> 3); return r < MP ? (r >> 11) : (s > 11 ? 11 : s); }
__device__ __forceinline__ float wave_sum(float v) {
#pragma unroll
    for (int o = 1; o < 64; o <<= 1) v += __shfl_xor(v, o);
    return v;
}
__device__ __forceinline__ int tid_opaque() { int t = (int)threadIdx.x; asm volatile("" : "+v"(t)); return t; }
#define LDS_WAIT() asm volatile("s_waitcnt lgkmcnt(0)" ::: "memory")
#define VM_WAIT() asm volatile("s_waitcnt vmcnt(0)" ::: "memory")

namespace pg8 {
#define PG8_LAS __attribute__((address_space(3)))
typedef unsigned short bf16_t;
typedef short bf16x8 __attribute__((ext_vector_type(8)));
typedef float f32x4 __attribute__((ext_vector_type(4)));
typedef unsigned u32x4 __attribute__((ext_vector_type(4)));
constexpr int BM = 256, BK = 64, HALF = 128, HTB = HALF * BK * 2  , STAGE_BYTES = 8 * HTB, NXCD = 8, WGM = 8;

__host__ __device__ __forceinline__ int lds_byte(int r, int c) { const int st = (r >> 4) * 2 + (c >> 5), rr = r & 15, cc = c & 31, ob = rr * 64 + cc * 2; return st * 1024 + (ob ^ (((ob >> 9) & 1) << 5)); }
__host__ __device__ __forceinline__ void stage_rc(int b, int& R, int& C) { const int st = b / 1024, sb = b % 1024, swz = sb ^ (((sb >> 9) & 1) << 5); R = (st >> 1) * 16 + swz / 64; C = (st & 1) * 32 + (swz % 64) / 2; }
__host__ __device__ __forceinline__ int perm32(int rho) { const int n = rho >> 4, i = rho & 15; return 8 * (i >> 2) + 4 * n + (i & 3); }

struct Unit { int pm, pn; };
struct Gemm { const bf16_t* A; const bf16_t* Bt; int M, N, K; };

struct StaticOrder {
    int nM, nN, nwg, G, c;
    __host__ __device__ void init(int M, int N, int G_, int c_) { nM = M / BM; nN = N / BM; nwg = nM * nN; G = G_; c = c_; }
    __host__ __device__ bool next(int i, Unit& u) const {
        const long L = (long)i * G + c; if (L >= nwg) return false;
        int wgid = (int)L; { const int q = nwg / NXCD, r = nwg % NXCD, xcd = wgid % NXCD, off = wgid / NXCD; wgid = (xcd < r ? xcd * (q + 1) : r * (q + 1) + (xcd - r) * q) + off; }
        const int nig = WGM * nN, gid = wgid / nig, fm = gid * WGM, gsz = (nM - fm) < WGM ? (nM - fm) : WGM;
        u.pm = fm + ((wgid % nig) % gsz); u.pn = (wgid % nig) / gsz; return true;
    }
    __device__ __forceinline__ void a_ready(const Unit&) const {}
    __device__ __forceinline__ void done(const Unit&) const {}
};


__device__ __forceinline__ unsigned cvt_pk_bf16(float lo, float hi) { unsigned r; asm volatile("v_cvt_pk_bf16_f32 %0, %1, %2" : "=v"(r) : "v"(lo), "v"(hi)); return r; }

struct EpiSwiGLU {
    static constexpr bool PERM = true, AFTER_DRAIN = false;
    bf16_t* H; int ldh;
    __device__ __forceinline__ void operator()(const f32x4 (&acc)[2][2][4][2], const Unit& u, int wr, int wc, int fr, int fq) const {
        const int row0 = u.pm * BM + wr * 64 + fr, col0 = u.pn * HALF + wc * 32 + 8 * fq;
#pragma unroll
        for (int ai = 0; ai < 2; ++ai)
#pragma unroll
            for (int m = 0; m < 4; ++m) {
                const f32x4 g0 = acc[ai][0][m][0], g1 = acc[ai][0][m][1], u0 = acc[ai][1][m][0], u1 = acc[ai][1][m][1];
                float v[8];
#pragma unroll
                for (int j = 0; j < 4; ++j) { v[j] = silu_f(g0[j]) * u0[j]; v[4 + j] = silu_f(g1[j]) * u1[j]; }
                u32x4 w; w.x = cvt_pk_bf16(v[0], v[1]); w.y = cvt_pk_bf16(v[2], v[3]); w.z = cvt_pk_bf16(v[4], v[5]); w.w = cvt_pk_bf16(v[6], v[7]);
                *(u32x4*)(H + (size_t)(row0 + ai * HALF + m * 16) * ldh + col0) = w;
            }
    }
};
template <bool BASE_F32> struct EpiResid {
    static constexpr bool PERM = true, AFTER_DRAIN = false;
    const void* base; bf16_t* Xo; const float* gate; float scale;
    __device__ __forceinline__ void operator()(const f32x4 (&acc)[2][2][4][2], const Unit& u, int wr, int wc, int fr, int fq) const {
        const int col0 = u.pn * BM + wc * 32 + 8 * fq;
        const float* gr = gate + (size_t)(u.pm >> 3) * NMODC;
        f32x4 gv[2][2];
#pragma unroll
        for (int bj = 0; bj < 2; ++bj)
#pragma unroll
            for (int n = 0; n < 2; ++n) gv[bj][n] = *(const f32x4*)(gr + col0 + bj * HALF + 4 * n) * scale;
#pragma unroll
        for (int ai = 0; ai < 2; ++ai)
#pragma unroll
            for (int m = 0; m < 4; ++m) { const size_t ro = (size_t)(u.pm * BM + ai * HALF + wr * 64 + m * 16 + fr) * DM + col0;
#pragma unroll
                for (int bj = 0; bj < 2; ++bj) { const size_t o = ro + bj * HALF;
                    f32x4 b0, b1;
                    if constexpr (BASE_F32) { b0 = *(const f32x4*)((const float*)base + o); b1 = *(const f32x4*)((const float*)base + o + 4); }
                    else { const u32x4 h = *(const u32x4*)((const bf16_t*)base + o); b0 = (f32x4){bflo(h.x), bfhi(h.x), bflo(h.y), bfhi(h.y)}; b1 = (f32x4){bflo(h.z), bfhi(h.z), bflo(h.w), bfhi(h.w)}; }
                    const f32x4 y0 = b0 + gv[bj][0] * acc[ai][bj][m][0], y1 = b1 + gv[bj][1] * acc[ai][bj][m][1];
                    u32x4 w; w.x = cvt_pk_bf16(y0[0], y0[1]); w.y = cvt_pk_bf16(y0[2], y0[3]); w.z = cvt_pk_bf16(y1[0], y1[1]); w.w = cvt_pk_bf16(y1[2], y1[3]);
                    *(u32x4*)(Xo + o) = w; } }
    }
};
struct EpiProj {
    static constexpr bool PERM = true, AFTER_DRAIN = false;
    unsigned char* ws; float* LF; float* out; const float* lbv;
    template <int MODE> __device__ __forceinline__ void run(const f32x4 (&acc)[2][2][4][2], const Unit& u, int wr, int wc, int fr, int fq, bf16_t* B, float s, size_t offp, size_t offs) const {
        const int cb = (u.pn & 3) * BM + wc * 32 + 8 * fq;
#pragma unroll
        for (int ai = 0; ai < 2; ++ai)
#pragma unroll
            for (int m = 0; m < 4; ++m) {
                const int row = u.pm * BM + ai * HALF + wr * 64 + m * 16 + fr;
#pragma unroll
                for (int bj = 0; bj < 2; ++bj) {
                    const int c = cb + bj * HALF; const size_t o = (size_t)row * DA + c;
                    f32x4 v0 = acc[ai][bj][m][0], v1 = acc[ai][bj][m][1];
                    if constexpr (MODE == 1) {
                        const f32x4 l0 = *(const f32x4*)(lbv + c), l1 = *(const f32x4*)(lbv + c + 4);
#pragma unroll
                        for (int j = 0; j < 4; ++j) { v0[j] = __builtin_amdgcn_logf(l0[j] + (1.f - l0[j]) * sigmoid_f(v0[j])); v1[j] = __builtin_amdgcn_logf(l1[j] + (1.f - l1[j]) * sigmoid_f(v1[j])); }
                        *(f32x4*)(LF + o) = v0; *(f32x4*)(LF + o + 4) = v1;
                    } else {
                        if constexpr (MODE == 3) {
                            if (row < MREAL) { float* dst = row < MP ? out + offp + o : out + offs + (o - (size_t)MP * DA); *(f32x4*)dst = v0; *(f32x4*)(dst + 4) = v1; }
                        }
                        if constexpr (MODE == 0) { v0 = v0 * s; v1 = v1 * s; }
                        if constexpr (MODE == 2) {
#pragma unroll
                            for (int j = 0; j < 4; ++j) { v0[j] = silu_f(v0[j]); v1[j] = silu_f(v1[j]); }
                        }
                        u32x4 w; w.x = cvt_pk_bf16(v0[0], v0[1]); w.y = cvt_pk_bf16(v0[2], v0[3]); w.z = cvt_pk_bf16(v1[0], v1[1]); w.w = cvt_pk_bf16(v1[2], v1[3]);
                        *(u32x4*)(B + o) = w;
                    }
                }
            }
    }
    __device__ __forceinline__ void operator()(const f32x4 (&acc)[2][2][4][2], const Unit& u, int wr, int wc, int fr, int fq) const {
        const int rng = u.pn >> 2;
        bf16_t* B = (bf16_t*)(ws + WS_QA + (size_t)(rng == 0 ? 0 : rng - 1) * (WS_IA - WS_QA));
        if (rng == 1) run<1>(acc, u, wr, wc, fr, fq, nullptr, 1.f, 0, 0);
        else if (rng == 3) run<2>(acc, u, wr, wc, fr, fq, B, 1.f, 0, 0);
        else if (rng >= 5) run<3>(acc, u, wr, wc, fr, fq, B, 1.f, rng == 5 ? OFF_KP : OFF_VP, rng == 5 ? OFF_KS : OFF_VS);
        else run<0>(acc, u, wr, wc, fr, fq, B, rng == 2 ? 1.f : (rng == 4 ? QSCALE * LOG2E : QSCALE), 0, 0);
    }
};
template <class Epi, class Sched, bool ALIGN_EPI = false, bool SP2 = false>
__device__ __forceinline__ void gemm_phase(PG8_LAS unsigned char* lds, const Gemm g, const Sched& S, const Epi& E) {
    const int tid = tid_opaque(), wid = __builtin_amdgcn_readfirstlane(tid >> 6), lane = tid & 63, wr = wid >> 2, wc = wid & 3, fr = lane & 15, fq = lane >> 4;
    const int K = g.K, nt = K / BK;
    unsigned voffA[2], voffB[2];
#pragma unroll
    for (int i = 0; i < 2; ++i) { int R, C; stage_rc(tid * 16 + i * 8192, R, C); const int Rb = Epi::PERM ? ((R & ~31) + perm32(R & 31)) : R;
        voffA[i] = (unsigned)(R * K + C) * 2u; voffB[i] = (unsigned)(Rb * K + C) * 2u; }
    const size_t kstep = (size_t)(BK * 2);
    const size_t hstep = (size_t)HALF * K * 2;
    const size_t tstep = 2 * hstep;
    const unsigned ldsw = (unsigned)wid * 1024u;
    const int aoff = lds_byte(wr * 64 + fr, fq * 8), boff = lds_byte(wc * 32 + fr, fq * 8);
#define PG8_SA(b, h) (((b) * 2 + (h)) * HTB)
#define PG8_SB(b, h) ((4 + (b) * 2 + (h)) * HTB)
#define PG8_STAGE(bufoff, gbase, voff) do { _Pragma("unroll") for (int _i = 0; _i < 2; ++_i) \
        __builtin_amdgcn_global_load_lds((const unsigned*)((const char*)(gbase) + (voff)[_i]), (PG8_LAS unsigned*)(lds + (bufoff) + ldsw + _i * 8192), 16, 0, 0); } while (0)
#define PG8_LDA(dst, b, h) do { _Pragma("unroll") for (int m = 0; m < 4; ++m) _Pragma("unroll") for (int k = 0; k < 2; ++k) dst[m][k] = *(const PG8_LAS bf16x8*)(lds + PG8_SA(b, h) + aoff + m * 2048 + k * 1024); } while (0)
#define PG8_LDB(dst, b, h) do { _Pragma("unroll") for (int n = 0; n < 2; ++n) _Pragma("unroll") for (int k = 0; k < 2; ++k) dst[n][k] = *(const PG8_LAS bf16x8*)(lds + PG8_SB(b, h) + boff + n * 2048 + k * 1024); } while (0)
#define PG8_MMA(ai, bj, At, Bt) do { __builtin_amdgcn_s_setprio(1); _Pragma("unroll") for (int m = 0; m < 4; ++m) _Pragma("unroll") for (int n = 0; n < 2; ++n) _Pragma("unroll") for (int k = 0; k < 2; ++k) \
        acc[ai][bj][m][n] = __builtin_amdgcn_mfma_f32_16x16x32_bf16(Bt[n][k], At[m][k], acc[ai][bj][m][n], 0, 0, 0); __builtin_amdgcn_s_setprio(0); } while (0)
#define PG8_WAIT_V(n) asm volatile("s_waitcnt vmcnt(" #n ")" ::: "memory")
#define PG8_WAIT_L(n) asm volatile("s_waitcnt lgkmcnt(" #n ")" ::: "memory")
#define PG8_BAR __builtin_amdgcn_s_barrier()
#define PG8_SCHED __builtin_amdgcn_sched_barrier(0)
    Unit cur, nxt; int ui = 0;
    if (!S.next(0, cur)) return;
    f32x4 acc[2][2][4][2];
#pragma unroll
    for (int a = 0; a < 2; ++a)
#pragma unroll
        for (int b = 0; b < 2; ++b)
#pragma unroll
            for (int m = 0; m < 4; ++m)
#pragma unroll
                for (int n = 0; n < 2; ++n) acc[a][b][m][n] = (f32x4){0.f, 0.f, 0.f, 0.f};
    bf16x8 At[4][2], B0[2][2], B1[2][2];
    const char* cA = (const char*)g.A + (size_t)cur.pm * tstep; const char* cB = (const char*)g.Bt + (size_t)cur.pn * tstep;
    S.a_ready(cur);
    if constexpr (SP2) {
        PG8_STAGE(PG8_SB(0, 0), cB, voffB); PG8_STAGE(PG8_SB(0, 1), cB + hstep, voffB); PG8_STAGE(PG8_SA(0, 0), cA, voffA); PG8_STAGE(PG8_SA(0, 1), cA + hstep, voffA);
        if (wr == 1) PG8_BAR;
        PG8_WAIT_V(2); PG8_BAR;
        PG8_STAGE(PG8_SB(1, 0), cB + kstep, voffB); PG8_STAGE(PG8_SA(1, 0), cA + kstep, voffA); PG8_STAGE(PG8_SB(1, 1), cB + hstep + kstep, voffB);
        PG8_WAIT_V(6); PG8_BAR;
    } else {
        PG8_STAGE(PG8_SB(0, 0), cB, voffB); PG8_STAGE(PG8_SA(0, 0), cA, voffA); PG8_STAGE(PG8_SB(0, 1), cB + hstep, voffB); PG8_STAGE(PG8_SA(0, 1), cA + hstep, voffA);
        if (wr == 1) PG8_BAR;
        PG8_WAIT_V(4); PG8_BAR;
        PG8_STAGE(PG8_SB(1, 0), cB + kstep, voffB); PG8_STAGE(PG8_SA(1, 0), cA + kstep, voffA); PG8_STAGE(PG8_SB(1, 1), cB + hstep + kstep, voffB);
        PG8_WAIT_V(6); PG8_BAR;
    }
    for (;;) {
        const bool has_next = S.next(ui + 1, nxt);
        const char* nA = has_next ? (const char*)g.A + (size_t)nxt.pm * tstep : cA; const char* nB = has_next ? (const char*)g.Bt + (size_t)nxt.pn * tstep : cB;
        for (int t = 0; t < nt; t += 2) {
            const bool last = (t == nt - 2);
            const char* a1 = cA + (size_t)(t + 1) * kstep;
            const char* a2 = last ? nA : cA + (size_t)(t + 2) * kstep; const char* b2 = last ? nB : cB + (size_t)(t + 2) * kstep;
            const char* a3 = a2 + kstep; const char* b3 = b2 + kstep;
            if (last && has_next) S.a_ready(nxt);
            if constexpr (SP2) {
            PG8_LDB(B0, 0, 0); PG8_LDB(B1, 0, 1); PG8_SCHED; PG8_LDA(At, 0, 0); PG8_STAGE(PG8_SA(1, 1), a1 + hstep, voffA);
            PG8_WAIT_V(8); PG8_WAIT_L(0); PG8_BAR; PG8_MMA(0, 0, At, B0); PG8_MMA(0, 1, At, B1); PG8_BAR; PG8_SCHED;
            PG8_LDA(At, 0, 1); PG8_STAGE(PG8_SB(0, 0), b2, voffB); PG8_STAGE(PG8_SB(0, 1), b2 + hstep, voffB); PG8_STAGE(PG8_SA(0, 0), a2, voffA);
            PG8_WAIT_V(8); PG8_WAIT_L(0); PG8_BAR; PG8_MMA(1, 0, At, B0); PG8_MMA(1, 1, At, B1); PG8_BAR; PG8_SCHED;
            PG8_LDB(B0, 1, 0); PG8_LDB(B1, 1, 1); PG8_SCHED; PG8_LDA(At, 1, 0); PG8_STAGE(PG8_SA(0, 1), a2 + hstep, voffA);
            PG8_WAIT_V(8); PG8_WAIT_L(0); PG8_BAR; PG8_MMA(0, 0, At, B0); PG8_MMA(0, 1, At, B1); PG8_BAR; PG8_SCHED;
            PG8_LDA(At, 1, 1); PG8_STAGE(PG8_SB(1, 0), b3, voffB); PG8_STAGE(PG8_SB(1, 1), b3 + hstep, voffB); PG8_STAGE(PG8_SA(1, 0), a3, voffA);
            PG8_WAIT_V(8); PG8_WAIT_L(0); PG8_BAR; PG8_MMA(1, 0, At, B0); PG8_MMA(1, 1, At, B1); PG8_BAR; PG8_SCHED;
            } else {
            PG8_LDB(B0, 0, 0); PG8_SCHED; PG8_LDA(At, 0, 0); PG8_STAGE(PG8_SA(1, 1), a1 + hstep, voffA);
            PG8_WAIT_L(8); PG8_BAR; PG8_WAIT_L(0); PG8_MMA(0, 0, At, B0); PG8_BAR; PG8_SCHED;
            PG8_LDB(B1, 0, 1); PG8_STAGE(PG8_SB(0, 0), b2, voffB);
            PG8_BAR; PG8_WAIT_L(0); PG8_MMA(0, 1, At, B1); PG8_BAR;
            PG8_LDA(At, 0, 1); PG8_STAGE(PG8_SA(0, 0), a2, voffA);
            PG8_BAR; PG8_WAIT_L(0); PG8_MMA(1, 0, At, B0); PG8_BAR; PG8_SCHED;
            PG8_STAGE(PG8_SB(0, 1), b2 + hstep, voffB);
            PG8_WAIT_V(6); PG8_BAR; PG8_MMA(1, 1, At, B1); PG8_BAR;
            PG8_LDB(B0, 1, 0); PG8_SCHED; PG8_LDA(At, 1, 0); PG8_STAGE(PG8_SA(0, 1), a2 + hstep, voffA);
            PG8_WAIT_L(8); PG8_BAR; PG8_WAIT_L(0); PG8_MMA(0, 0, At, B0); PG8_BAR; PG8_SCHED;
            PG8_LDB(B1, 1, 1); PG8_STAGE(PG8_SB(1, 0), b3, voffB);
            PG8_BAR; PG8_WAIT_L(0); PG8_MMA(0, 1, At, B1); PG8_BAR;
            PG8_LDA(At, 1, 1); PG8_STAGE(PG8_SA(1, 0), a3, voffA);
            PG8_BAR; PG8_WAIT_L(0); PG8_MMA(1, 0, At, B0); PG8_BAR; PG8_SCHED;
            PG8_STAGE(PG8_SB(1, 1), b3 + hstep, voffB);
            PG8_WAIT_V(6); PG8_BAR; PG8_MMA(1, 1, At, B1); PG8_BAR;
            }
        }
        if constexpr (ALIGN_EPI) { if (wr == 0) PG8_BAR; }
        if constexpr (!Epi::AFTER_DRAIN) { E(acc, cur, wr, wc, fr, fq); S.done(cur); }
        if (!has_next) break;
#pragma unroll
        for (int a = 0; a < 2; ++a)
#pragma unroll
            for (int b = 0; b < 2; ++b)
#pragma unroll
                for (int m = 0; m < 4; ++m)
#pragma unroll
                    for (int n = 0; n < 2; ++n) acc[a][b][m][n] = (f32x4){0.f, 0.f, 0.f, 0.f};
        cur = nxt; cA = nA; cB = nB; ++ui;
        if constexpr (ALIGN_EPI) { if (wr == 1) PG8_BAR; }
    }
    PG8_WAIT_V(0);
    if constexpr (!ALIGN_EPI) { if (wr == 0) PG8_BAR; }
    PG8_BAR;
    if constexpr (Epi::AFTER_DRAIN) { E.fused(acc, cur, wr, wc, fr, fq, lds, wid, lane); S.done(cur); }
#undef PG8_SA
#undef PG8_SB
#undef PG8_STAGE
#undef PG8_LDA
#undef PG8_LDB
#undef PG8_MMA
#undef PG8_WAIT_V
#undef PG8_WAIT_L
#undef PG8_BAR
#undef PG8_SCHED
}
}

constexpr int NTHR = 512, NWAVES = 8;
constexpr int LDS_BYTES = 155648;

#define IN_F(i) ((const float*)a.in[i])
#define WS_F(off) ((float*)(a.ws + (off)))
#define WS_B(off) ((bf16*)(a.ws + (off)))

__device__ __forceinline__ void phase_mod(ArgsRef a, LAS unsigned char* lds, int bid, int nblk) {
    LAS float* sc = (LAS float*)lds;
    LAS float* red = (LAS float*)(lds + 98304);
    { const unsigned tid = (unsigned)tid_opaque();
      for (unsigned i = tid; i < 12u * DM; i += NTHR) { const unsigned b = i >> 11, k = i & 2047u; const float c = b < 4u ? IN_F(I_CP)[b * DM + k] : IN_F(I_CS)[(b - 4u) * DM + k]; sc[i] = silu_f(c); }
      if (bid == 0) for (unsigned i = tid; i < (unsigned)DA; i += NTHR) WS_F(WS_LBV)[i] = sigmoid_f(IN_F(I_LB)[i]); }
    __syncthreads();
    for (int u = bid; u < 176; u += nblk) {
        const bool fm = u >= 144; const int n0 = (fm ? u - 144 : u) * 128, ld = fm ? NFMODC : NMODC;
        const float* W = fm ? IN_F(I_WFM) : IN_F(I_WMOD); const float* bias = fm ? IN_F(I_BFM) : IN_F(I_BMOD); float* outp = fm ? WS_F(WS_FMOD) : WS_F(WS_MOD);
        {
            const int tid = tid_opaque(), lane = tid & 63, wu = __builtin_amdgcn_readfirstlane(tid >> 6);
            f32x2 acc[12];
#pragma unroll
            for (int b = 0; b < 12; ++b) acc[b] = (f32x2){0.f, 0.f};
            const float* wbase = W + (size_t)(wu * 256) * ld + n0;
            const LAS float* scw = sc + wu * 256;
#pragma unroll 1
            for (int k = 0; k < 256; k += 16) {
                f32x2 wv[16];
#pragma unroll
                for (int i = 0; i < 16; ++i) wv[i] = *(const f32x2*)(wbase + (size_t)(k + i) * ld + 2 * lane);
#pragma unroll
                for (int q = 0; q < 4; ++q)
#pragma unroll
                    for (int b = 0; b < 12; ++b) { const f32x4 s = *(const LAS f32x4*)(scw + b * DM + k + 4 * q); acc[b] += wv[4 * q] * s.x + wv[4 * q + 1] * s.y + wv[4 * q + 2] * s.z + wv[4 * q + 3] * s.w; }
            }
#pragma unroll
            for (int b = 0; b < 12; ++b) *(LAS f32x2*)(red + (wu * 12 + b) * 128 + 2 * lane) = acc[b];
        }
        __syncthreads();
        { const int tid = tid_opaque();
          for (int i = tid; i < 12 * 128; i += NTHR) { const int b = i >> 7, c = i & 127; float s = 0.f;
#pragma unroll
            for (int ww = 0; ww < 8; ++ww) s += red[(ww * 12 + b) * 128 + c];
            outp[(size_t)b * ld + n0 + c] = s + bias[n0 + c]; } }
        __syncthreads();
    }
}

__device__ __forceinline__ void cvt_load(float (&v)[32], const float* W, int N, int k0, int n0, int lane) {
#pragma unroll
    for (int i = 0; i < 32; ++i) v[i] = W[(size_t)(k0 + 2 * i + (lane >> 5)) * N + n0 + (lane & 31)];
}
__device__ __forceinline__ void cvt_store(const float (&v)[32], int K, bf16* WT, int k0, int drow0, LAS float* scr, int lane) {
#pragma unroll
    for (int i = 0; i < 32; ++i) scr[(2 * i + (lane >> 5)) * 33 + (lane & 31)] = v[i];
    LDS_WAIT(); asm volatile("" ::: "memory");
    const int c = lane & 7;
#pragma unroll
    for (int j = 0; j < 4; ++j) { const int n = (lane >> 3) + 8 * j; const LAS float* s = scr + (8 * c) * 33 + n;
        v4u o; o.x = pk2(s[0 * 33], s[1 * 33]); o.y = pk2(s[2 * 33], s[3 * 33]); o.z = pk2(s[4 * 33], s[5 * 33]); o.w = pk2(s[6 * 33], s[7 * 33]);
        *(GAS v4u*)(WT + (size_t)(drow0 + n) * K + k0 + 8 * c) = o; }
    LDS_WAIT(); asm volatile("" ::: "memory");
}
__device__ __forceinline__ void cvt_matrix(const float* W, int K, int N, bf16* WT, int mode, LAS float* scr, int gw, int ngw, int lane) {
    const int nblk = N / 32, nitems = (K / 64) * nblk;
    for (int it = gw; it < nitems; it += 2 * ngw) {
        const int it2 = it + ngw; const bool two = it2 < nitems;
        const int kb = it / nblk, n0 = 32 * (it % nblk), kb2 = it2 / nblk, n02 = 32 * (it2 % nblk);
        float va[32], vb[32];
        cvt_load(va, W, N, 64 * kb, n0, lane);
        if (two) cvt_load(vb, W, N, 64 * kb2, n02, lane);
        cvt_store(va, K, WT, 64 * kb, mode == 0 ? n0 : ((n0 >> 7) * 256 + (mode == 2 ? 128 : 0) + (n0 & 127)), scr, lane);
        if (two) cvt_store(vb, K, WT, 64 * kb2, mode == 0 ? n02 : ((n02 >> 7) * 256 + (mode == 2 ? 128 : 0) + (n02 & 127)), scr, lane);
    }
}
template <int SEL> __device__ __forceinline__ void phase_cvt(ArgsRef a, LAS unsigned char* lds, int bid, int nblk) {
    const int tid = tid_opaque(), lane = tid & 63, w = tid >> 6;
    LAS float* scr = (LAS float*)(lds + w * 16384);
    const int gw = bid * NWAVES + w, ngw = nblk * NWAVES;
    if constexpr (SEL == 0) { cvt_matrix(IN_F(I_WG1), DM, DFF, WS_B(WS_WGU1), 1, scr, gw, ngw, lane); cvt_matrix(IN_F(I_WU1), DM, DFF, WS_B(WS_WGU1), 2, scr, gw, ngw, lane); }
    if constexpr (SEL == 1) { cvt_matrix(IN_F(I_WD1), DFF, DM, WS_B(WS_WD1), 0, scr, gw, ngw, lane); cvt_matrix(IN_F(I_WIN), DM, DIN, WS_B(WS_WIN), 0, scr, gw, ngw, lane); }
    if constexpr (SEL == 2) { cvt_matrix(IN_F(I_WG2), DM, DFF, WS_B(WS_WGU2), 1, scr, gw, ngw, lane); cvt_matrix(IN_F(I_WU2), DM, DFF, WS_B(WS_WGU2), 2, scr, gw, ngw, lane);
                              cvt_matrix(IN_F(I_WOUT), DM, DM, WS_B(WS_WOUT), 0, scr, gw, ngw, lane); }
    if constexpr (SEL == 3) { cvt_matrix(IN_F(I_WD2), DFF, DM, WS_B(WS_WD2), 0, scr, gw, ngw, lane); }
}

template <bool SRC_F32> struct NormRaw { f32x4 f[SRC_F32 ? 8 : 1]; v4u h[SRC_F32 ? 1 : 4]; };
template <bool SRC_F32> __device__ __forceinline__ void norm_issue(NormRaw<SRC_F32>& R, ArgsRef a, int r, int lane) {
    if constexpr (SRC_F32) { const float* xrow = r < MP ? IN_F(I_XP) + (size_t)r * DM : IN_F(I_XS) + (size_t)(r - MP) * DM; const GAS f32x4* p = (const GAS f32x4*)xrow + 2 * lane;
#pragma unroll
        for (int j = 0; j < 4; ++j) { R.f[2 * j] = p[128 * j]; R.f[2 * j + 1] = p[128 * j + 1]; } }
    else { const GAS v4u* p = (const GAS v4u*)(WS_B(WS_X) + (size_t)r * DM) + lane;
#pragma unroll
        for (int j = 0; j < 4; ++j) R.h[j] = p[64 * j]; }
}
template <bool FINAL, bool SRC_F32> __device__ __forceinline__ void norm_finish(const NormRaw<SRC_F32>& R, ArgsRef a, int r, int lane, const float* gvec, const float* shp, const float* scp) {
    f32x4 v[8];
#pragma unroll
    for (int j = 0; j < 4; ++j) {
        if constexpr (SRC_F32) { v[2 * j] = R.f[2 * j]; v[2 * j + 1] = R.f[2 * j + 1]; }
        else { const v4u h = R.h[j]; v[2 * j] = (f32x4){bflo(h.x), bfhi(h.x), bflo(h.y), bfhi(h.y)}; v[2 * j + 1] = (f32x4){bflo(h.z), bfhi(h.z), bflo(h.w), bfhi(h.w)}; } }
    float s = 0.f;
#pragma unroll
    for (int j = 0; j < 8; ++j) s += (v[j].x * v[j].x + v[j].y * v[j].y) + (v[j].z * v[j].z + v[j].w * v[j].w);
    const float rstd = 1.0f / sqrtf(wave_sum(s) * (1.f / DM) + EPS);
#pragma unroll
    for (int j = 0; j < 4; ++j) {
        const int c = 8 * lane + 512 * j;
        const f32x4 g0 = *(const f32x4*)(gvec + c), g1 = *(const f32x4*)(gvec + c + 4), c0 = *(const f32x4*)(scp + c), c1 = *(const f32x4*)(scp + c + 4), h0 = *(const f32x4*)(shp + c), h1 = *(const f32x4*)(shp + c + 4);
        const f32x4 y0 = (v[2 * j] * rstd * g0) * (1.f + c0) + h0, y1 = (v[2 * j + 1] * rstd * g1) * (1.f + c1) + h1;
        if constexpr (FINAL) { float* dst = (r < MP ? a.out + OFF_YP + (size_t)r * DM : a.out + OFF_YS + (size_t)(r - MP) * DM) + c; *(f32x4*)dst = y0; *(f32x4*)(dst + 4) = y1; }
        else { v4u o; o.x = pk2(y0.x, y0.y); o.y = pk2(y0.z, y0.w); o.z = pk2(y1.x, y1.y); o.w = pk2(y1.z, y1.w); *(GAS v4u*)(WS_B(WS_XN) + (size_t)r * DM + c) = o; }
        asm volatile("" ::: "memory");
    }
}
template <bool FINAL, bool SRC_F32>
__device__ __forceinline__ void phase_norm(ArgsRef a, int bid, int nblk, const float* gvec, const float* modp, int ldmod, int sh_off, int sc_off) {
    const int tid = tid_opaque(), lane = tid & 63, w = tid >> 6;
    const int gw = bid * NWAVES + w, ngw = nblk * NWAVES;
    for (int r0 = 4 * gw; r0 < MREAL; r0 += 4 * ngw) {
        NormRaw<SRC_F32> A, B;
        norm_issue<SRC_F32>(A, a, r0, lane); norm_issue<SRC_F32>(B, a, r0 + 1, lane);
        const float* mr = modp + (size_t)mod_row(r0) * ldmod; const float* shp = mr + sh_off; const float* scp = mr + sc_off;
        norm_finish<FINAL, SRC_F32>(A, a, r0, lane, gvec, shp, scp); norm_issue<SRC_F32>(A, a, r0 + 2, lane);
        norm_finish<FINAL, SRC_F32>(B, a, r0 + 1, lane, gvec, shp, scp); norm_issue<SRC_F32>(B, a, r0 + 3, lane);
        norm_finish<FINAL, SRC_F32>(A, a, r0 + 2, lane, gvec, shp, scp);
        norm_finish<FINAL, SRC_F32>(B, a, r0 + 3, lane, gvec, shp, scp);
    }
}

__device__ __forceinline__ void hgrn_unit(ArgsRef a, LAS unsigned char* lds, int unit) {
    const int tid = tid_opaque(), dv = tid & 127, g = tid >> 7;
    const bool smp = unit >= 32; const int u = smp ? unit - 32 : unit, b = u >> 3, h = u & 7;
    const int T = smp ? DECT : SEQ, row0 = smp ? MP + b * DECT : b * SEQ;
    float* sout = a.out + (smp ? OFF_SS : OFF_SP) + (size_t)u * HD * HD;
    LAS float* fL = (LAS float*)lds; LAS float* kL = fL + 2048; LAS float* qL = kL + 2048; LAS float* vL = qL + 2048; LAS float* red = vL + 2048;
    const bf16* QA = WS_B(WS_QA); const bf16* IA = WS_B(WS_IA); const bf16* GA = WS_B(WS_GA); const float* LF = WS_F(WS_LF);
    float S[32];
#pragma unroll
    for (int i = 0; i < 32; ++i) S[i] = smp ? IN_F(I_ST)[(size_t)u * HD * HD + (size_t)(32 * g + i) * HD + dv] : 0.f;
    for (int t0 = 0; t0 < T; t0 += 16) {
        const int nt = (T - t0) < 16 ? (T - t0) : 16;
        for (int i = tid; i < nt * 128; i += NTHR) { const int tt = i >> 7, ch = i & 127; const size_t o = (size_t)(row0 + t0 + tt) * DA + h * HD + ch;
            const float f = __builtin_amdgcn_exp2f(LF[o]);   fL[i] = f; kL[i] = 1.f - f; qL[i] = bf2f(QA[o]); vL[i] = bf2f(IA[o]); }
        __syncthreads();
        for (int tt = 0; tt < nt; ++tt) {
            const float v = vL[tt * 128 + dv]; float op = 0.f;
#pragma unroll
            for (int i4 = 0; i4 < 8; ++i4) {
                const f32x4 f4 = *(const LAS f32x4*)(fL + tt * 128 + g * 32 + 4 * i4), k4 = *(const LAS f32x4*)(kL + tt * 128 + g * 32 + 4 * i4), q4 = *(const LAS f32x4*)(qL + tt * 128 + g * 32 + 4 * i4);
#pragma unroll
                for (int j = 0; j < 4; ++j) { S[4 * i4 + j] = f4[j] * S[4 * i4 + j] + k4[j] * v; op += S[4 * i4 + j] * q4[j]; }
            }
            red[(g * 16 + tt) * 128 + dv] = op;
        }
        __syncthreads();
        { const int tt = tid >> 5, l32 = tid & 31;
          if (tt < nt) {
            f32x4 o = (f32x4){0.f, 0.f, 0.f, 0.f};
#pragma unroll
            for (int gg = 0; gg < 4; ++gg) o += *(const LAS f32x4*)(red + (gg * 16 + tt) * 128 + 4 * l32);
            float ss = (o.x * o.x + o.y * o.y) + (o.z * o.z + o.w * o.w);
#pragma unroll
            for (int m = 1; m < 32; m <<= 1) ss += __shfl_xor(ss, m);
            const float rstd = 1.0f / sqrtf(ss * (1.f / HD) + EPS);
            const int row = row0 + t0 + tt, col = h * HD + 4 * l32;
            const f32x4 gw = *(const f32x4*)(IN_F(I_GOA) + col); const v2u gt = *(const v2u*)(GA + (size_t)row * DA + col);
            v2u w; w.x = pk2(o.x * rstd * gw.x * bflo(gt.x), o.y * rstd * gw.y * bfhi(gt.x)); w.y = pk2(o.z * rstd * gw.z * bflo(gt.y), o.w * rstd * gw.w * bfhi(gt.y));
            *(v2u*)(WS_B(WS_OM) + (size_t)row * DM + col) = w;
          } }
        __syncthreads();
    }
#pragma unroll
    for (int i = 0; i < 32; ++i) sout[(size_t)(32 * g + i) * HD + dv] = S[i];
}

__device__ __forceinline__ void sb_tile(const LAS float* Kt, const LAS float* Vt, const LAS float* q, float bias, int lane, int nvis  , float& R, float& o0, float& o1) {
    float z = bias;
#pragma unroll 8
    for (int d = 0; d < HD; d += 4) { const f32x4 qv = *(const LAS f32x4*)(q + d);
        z += qv.x * Kt[lane * 129 + d] + qv.y * Kt[lane * 129 + d + 1] + qv.z * Kt[lane * 129 + d + 2] + qv.w * Kt[lane * 129 + d + 3]; }
    const bool vis = lane < nvis;
    const float L = vis ? -(z > 20.f ? z : log1pf(__expf(z))) : 0.f;
    float c = L;
#pragma unroll
    for (int off = 1; off < 64; off <<= 1) { const float t = __shfl_down(c, off); if (lane + off < 64) c += t; }
    const float P = vis ? __expf(z + c + R) : 0.f;
    R += __shfl(c, 0);
#pragma unroll 8
    for (int s = 0; s < 64; ++s) { const float p = __builtin_bit_cast(float, __builtin_amdgcn_readlane(__builtin_bit_cast(int, P), s));
        o0 += p * Vt[s * 128 + lane]; o1 += p * Vt[s * 128 + 64 + lane]; }
}
__device__ __forceinline__ void sb_finish(ArgsRef a, int row, int h, int lane, float o0, float o1) {
    const float ss = wave_sum(o0 * o0 + o1 * o1);
    const float rstd = 1.0f / sqrtf(ss * (1.f / HD) + EPS);
    const float* gw = IN_F(I_GOB) + h * HD; bf16* dst = WS_B(WS_OM) + (size_t)row * DM + DA + h * HD;
    dst[lane] = (bf16)f2bf(o0 * rstd * gw[lane]); dst[64 + lane] = (bf16)f2bf(o1 * rstd * gw[64 + lane]);
}
__device__ __forceinline__ void sb_stage_bf16(ArgsRef a, LAS float* Kt, LAS float* Vt, int krow0, int nvalid, int h, int tid) {
    const bf16* KB = WS_B(WS_KB); const bf16* VB = WS_B(WS_VB);
#pragma unroll
    for (int i = 0; i < 2; ++i) { const int ch = tid + i * NTHR, r = ch >> 4, d0 = (ch & 15) * 8;
        v4u kv = (v4u){0u, 0u, 0u, 0u}, vv = (v4u){0u, 0u, 0u, 0u};
        if (r < nvalid) { const size_t o = (size_t)(krow0 + r) * DA + h * HD + d0; kv = *(const v4u*)(KB + o); vv = *(const v4u*)(VB + o); }
        LAS float* kd = Kt + r * 129 + d0; LAS float* vd = Vt + r * 128 + d0;
        kd[0] = bflo(kv.x); kd[1] = bfhi(kv.x); kd[2] = bflo(kv.y); kd[3] = bfhi(kv.y); kd[4] = bflo(kv.z); kd[5] = bfhi(kv.z); kd[6] = bflo(kv.w); kd[7] = bfhi(kv.w);
        vd[0] = bflo(vv.x); vd[1] = bfhi(vv.x); vd[2] = bflo(vv.y); vd[3] = bfhi(vv.y); vd[4] = bflo(vv.z); vd[5] = bfhi(vv.z); vd[6] = bflo(vv.w); vd[7] = bfhi(vv.w); }
}
__device__ __forceinline__ void sb_unit_prompt(ArgsRef a, LAS unsigned char* lds, int unit) {
    const int tid = tid_opaque(), lane = tid & 63, w = tid >> 6;
    const int bh = unit >> 8, qb = unit & 255, b = bh >> 3, h = bh & 7, t = qb * 8 + w, row = b * SEQ + t;
    LAS float* Kt = (LAS float*)lds; LAS float* Vt = Kt + 64 * 129; LAS float* qs = Vt + 64 * 128;
    if (lane < 32) { const v2u qv = *(const v2u*)(WS_B(WS_QB) + (size_t)row * DA + h * HD + 4 * lane); LAS float* q = qs + w * HD + 4 * lane; q[0] = bflo(qv.x) * LN2; q[1] = bfhi(qv.x) * LN2; q[2] = bflo(qv.y) * LN2; q[3] = bfhi(qv.y) * LN2; }
    const float bias = IN_F(I_BSB)[h];
    float R = 0.f, o0 = 0.f, o1 = 0.f;
    for (int j = (qb * 8 + 6) >> 6; j >= 0; --j) {
        __syncthreads();
        sb_stage_bf16(a, Kt, Vt, b * SEQ + 64 * j, 64, h, tid);
        __syncthreads();
        int nvis = t - 64 * j; nvis = nvis < 0 ? 0 : (nvis > 64 ? 64 : nvis);
        sb_tile(Kt, Vt, qs + w * HD, bias, lane, nvis, R, o0, o1);
    }
    sb_finish(a, row, h, lane, o0, o1);
    __syncthreads();
}
__device__ __forceinline__ void sb_unit_sample(ArgsRef a, LAS unsigned char* lds, int unit) {
    const int tid = tid_opaque(), lane = tid & 63, w = tid >> 6;
    const int b = unit >> 3, h = unit & 7, row = MP + b * DECT + w;
    LAS float* Kt = (LAS float*)lds; LAS float* Vt = Kt + 64 * 129; LAS float* qs = Vt + 64 * 128;
    if (lane < 32) { const v2u qv = *(const v2u*)(WS_B(WS_QB) + (size_t)row * DA + h * HD + 4 * lane); LAS float* q = qs + w * HD + 4 * lane; q[0] = bflo(qv.x) * LN2; q[1] = bfhi(qv.x) * LN2; q[2] = bflo(qv.y) * LN2; q[3] = bfhi(qv.y) * LN2; }
    const float bias = IN_F(I_BSB)[h];
    float R = 0.f, o0 = 0.f, o1 = 0.f;
    __syncthreads();
    sb_stage_bf16(a, Kt, Vt, MP + b * DECT, DECT, h, tid);
    __syncthreads();
    sb_tile(Kt, Vt, qs + w * HD, bias, lane, w, R, o0, o1);
    const int* pt = (const int*)a.in[I_PT] + b * NPAGES;
    for (int j = PAST / 64 - 1; j >= 0; --j) {
        __syncthreads();
        { const int page = pt[j >> 1]; const size_t base = ((size_t)page * PAGE + (j & 1) * 64) * (NHEAD * HD) + h * HD;
          const float* ck = IN_F(I_CK) + base; const float* cv = IN_F(I_CV) + base;
#pragma unroll
          for (int i = 0; i < 4; ++i) { const int ch = tid + i * NTHR, r = ch >> 5, d0 = (ch & 31) * 4;
              const f32x4 kv = *(const f32x4*)(ck + (size_t)r * (NHEAD * HD) + d0), vv = *(const f32x4*)(cv + (size_t)r * (NHEAD * HD) + d0);
              LAS float* kd = Kt + r * 129 + d0; kd[0] = kv.x; kd[1] = kv.y; kd[2] = kv.z; kd[3] = kv.w;
              *(LAS f32x4*)(Vt + r * 128 + d0) = vv; } }
        __syncthreads();
        sb_tile(Kt, Vt, qs + w * HD, bias, lane, 64, R, o0, o1);
    }
    sb_finish(a, row, h, lane, o0, o1);
    __syncthreads();
}

typedef float f32x16 __attribute__((ext_vector_type(16)));
typedef short s16x4 __attribute__((ext_vector_type(4)));
typedef short v4i16_t __attribute__((ext_vector_type(4)));
typedef __bf16 bf16x2_t __attribute__((ext_vector_type(2)));
#define MFMA32(a, b, c) __builtin_amdgcn_mfma_f32_32x32x16_bf16((a), (b), (c), 0, 0, 0)

__device__ __forceinline__ unsigned cvtpk(float lo, float hi) { f32x2 v = {lo, hi}; bf16x2_t b = __builtin_convertvector(v, bf16x2_t); return __builtin_bit_cast(unsigned, b); }
template <int S> __device__ __forceinline__ bf16x8 pack8(const f32x16& x) {
    v4u p; p.x = cvtpk(x[8 * S + 0], x[8 * S + 1]); p.y = cvtpk(x[8 * S + 2], x[8 * S + 3]); p.z = cvtpk(x[8 * S + 4], x[8 * S + 5]); p.w = cvtpk(x[8 * S + 6], x[8 * S + 7]);
    return __builtin_bit_cast(bf16x8, p);
}
__device__ __forceinline__ unsigned off_a(unsigned row, unsigned ch) { return 2048u * (row >> 3) + 512u * (ch >> 2) + 64u * (row & 7) + 16u * ((ch & 3) ^ ((row >> 2) & 3)); }
__device__ __forceinline__ s16x4 vtr(const LAS unsigned char* p) { return __builtin_bit_cast(s16x4, __builtin_amdgcn_ds_read_tr16_b64_v4i16((LAS v4i16_t*)p)); }


template <bool DUAL, class Epi>
__device__ __forceinline__ void sgemm64_unit(const bf16* A, int K, const bf16* B0, const bf16* B1, LAS unsigned char* lds, const Epi& E) {
    const int tid = tid_opaque(), lane = tid & 63, w = tid >> 6, r = lane & 31, hh = lane >> 5;
    const int kw = K >> 3, k0 = w * kw, steps = kw >> 4;
    const bf16* pa0 = A + (size_t)r * K + k0 + 8 * hh; const bf16* pa1 = pa0 + (size_t)32 * K;
    const bf16* pb0 = B0 + (size_t)r * K + k0 + 8 * hh; const bf16* pb1 = B1 + (size_t)r * K + k0 + 8 * hh;
    f32x16 c00, c10, c01, c11;
#pragma unroll
    for (int i = 0; i < 16; ++i) { c00[i] = 0.f; c10[i] = 0.f; c01[i] = 0.f; c11[i] = 0.f; }
#pragma unroll 4
    for (int s = 0; s < steps; ++s) {
        const bf16x8 a0 = *(const bf16x8*)(pa0 + 16 * s), a1 = *(const bf16x8*)(pa1 + 16 * s), b0 = *(const bf16x8*)(pb0 + 16 * s);
        c00 = MFMA32(a0, b0, c00); c10 = MFMA32(a1, b0, c10);
        if constexpr (DUAL) { const bf16x8 b1 = *(const bf16x8*)(pb1 + 16 * s); c01 = MFMA32(a0, b1, c01); c11 = MFMA32(a1, b1, c11); }
    }
    constexpr int NT = DUAL ? 4 : 2;
    LAS float* red = (LAS float*)lds;
    __syncthreads();
#pragma unroll
    for (int i = 0; i < 16; ++i) { red[((w * NT + 0) * 16 + i) * 64 + lane] = c00[i]; red[((w * NT + 1) * 16 + i) * 64 + lane] = c10[i];
        if constexpr (DUAL) { red[((w * NT + 2) * 16 + i) * 64 + lane] = c01[i]; red[((w * NT + 3) * 16 + i) * 64 + lane] = c11[i]; } }
    __syncthreads();
#pragma unroll
    for (int j = 0; j < 4; ++j) { const int idx = tid + NTHR * j, mt = idx >> 10, reg = (idx >> 6) & 15, ln = idx & 63;
        float v0 = 0.f, v1 = 0.f;
#pragma unroll
        for (int ww = 0; ww < 8; ++ww) { v0 += red[((ww * NT + mt) * 16 + reg) * 64 + ln]; if constexpr (DUAL) v1 += red[((ww * NT + 2 + mt) * 16 + reg) * 64 + ln]; }
        E(32 * mt + (reg & 3) + 8 * (reg >> 2) + 4 * (ln >> 5), ln & 31, v0, v1); }
}
__device__ __forceinline__ void proj_store_sample(unsigned char* ws, float* out, int sr, int c, float v) {
    const int rng = c >> 10, cc = c & 1023; const size_t o = (size_t)(MP + sr) * DA + cc;
    if (rng == 1) { const float l = ((const float*)(ws + WS_LBV))[cc]; ((float*)(ws + WS_LF))[o] = __builtin_amdgcn_logf(l + (1.f - l) * sigmoid_f(v)); return; }
    if (rng == 5) out[OFF_KS + (size_t)sr * DA + cc] = v;
    if (rng == 6) out[OFF_VS + (size_t)sr * DA + cc] = v;
    if (rng == 0) v *= QSCALE; if (rng == 4) v *= QSCALE * LOG2E; if (rng == 3) v = silu_f(v);
    bf16* B = (bf16*)(ws + WS_QA + (size_t)(rng == 0 ? 0 : rng - 1) * (WS_IA - WS_QA));
    B[o] = (bf16)f2bf(v);
}
struct SEpiSwiGLU { bf16* H; int col0; __device__ __forceinline__ void operator()(int row, int col, float g, float u) const { H[(size_t)(MP + row) * DFF + col0 + col] = (bf16)f2bf(silu_f(g) * u); } };
struct SEpiResid { const float* xs  ; bf16* X; const float* gate; float scale; int col0;
    __device__ __forceinline__ void operator()(int row, int col, float v, float) const { const int c = col0 + col; const size_t o = (size_t)(MP + row) * DM + c;
        const float b = xs ? xs[(size_t)row * DM + c] : bf2f(X[o]);
        X[o] = (bf16)f2bf(b + scale * gate[(size_t)(4 + (row >> 3)) * NMODC + c] * v); } };
struct SEpiProj { unsigned char* ws; float* out; int col0; __device__ __forceinline__ void operator()(int row, int col, float v, float) const { proj_store_sample(ws, out, row, col0 + col, v); } };

template <int WHICH, bool PROBE = false> __device__ __forceinline__ void phase_gemm(ArgsRef a, LAS unsigned char* lds, int bid, int nblk) {
    bf16* const Xo = PROBE ? (bf16*)(a.ws + WS_PART + 200 * MiB) : WS_B(WS_X);
    using namespace pg8;
    if constexpr (WHICH == 1 || WHICH == 5) {
        const bf16* W = WS_B(WHICH == 1 ? WS_WGU1 : WS_WGU2);
        Gemm g{WS_B(WS_XN), W, MP, 2 * DFF, DM}; StaticOrder S; S.init(MP, 2 * DFF, nblk, bid);
        EpiSwiGLU E{WS_B(WS_H), DFF};
        gemm_phase<EpiSwiGLU, StaticOrder, true, true>(lds, g, S, E);
        for (int j = bid - nblk / 2; j >= 0 && j < DFF / 32; j += nblk / 2) { const int n0 = 32 * j, wrow = (n0 >> 7) * 256 + (n0 & 127);
            SEpiSwiGLU SE{WS_B(WS_H), n0};
            sgemm64_unit<true>(WS_B(WS_XN) + (size_t)MP * DM, DM, W + (size_t)wrow * DM, W + (size_t)(wrow + 128) * DM, lds, SE); }
        if (bid >= nblk / 2) { __syncthreads(); phase_cvt<WHICH == 1 ? 1 : 3>(a, lds, bid - nblk / 2, nblk - nblk / 2); }
    } else if constexpr (WHICH == 2 || WHICH == 6) {
        const bf16* W = WS_B(WHICH == 2 ? WS_WD1 : WS_WD2);
        Gemm g{WS_B(WS_H), W, MP, DM, DFF}; StaticOrder S; S.init(MP, DM, nblk, bid);
        EpiResid<WHICH == 2> E{WHICH == 2 ? (const void*)IN_F(I_XP) : (const void*)WS_B(WS_X), Xo, WS_F(WS_MOD) + (WHICH == 2 ? 2 : 8) * DM, 0.5f};
        gemm_phase<EpiResid<WHICH == 2>, StaticOrder, true, true>(lds, g, S, E);
        if (!PROBE) for (int j = bid; j < DM / 32; j += nblk) {
            SEpiResid SE{WHICH == 2 ? IN_F(I_XS) : nullptr, WS_B(WS_X), WS_F(WS_MOD) + (WHICH == 2 ? 2 : 8) * DM, 0.5f, 32 * j};
            sgemm64_unit<false>(WS_B(WS_H) + (size_t)MP * DFF, DFF, W + (size_t)(32 * j) * DFF, W, lds, SE); }
    } else if constexpr (WHICH == 3) {
        Gemm g{WS_B(WS_XN), WS_B(WS_WIN), MP, DIN, DM}; StaticOrder S; S.init(MP, DIN, nblk, bid);
        EpiProj E{a.ws, WS_F(WS_LF), a.out, WS_F(WS_LBV)};
        gemm_phase<EpiProj, StaticOrder, true, true>(lds, g, S, E);
        for (int j = bid - nblk / 2; j >= 0 && j < DIN / 32; j += nblk / 2) {
            SEpiProj SE{a.ws, a.out, 32 * j};
            sgemm64_unit<false>(WS_B(WS_XN) + (size_t)MP * DM, DM, WS_B(WS_WIN) + (size_t)(32 * j) * DM, WS_B(WS_WIN), lds, SE); }
        if (bid >= nblk / 2) { __syncthreads(); phase_cvt<2>(a, lds, bid - nblk / 2, nblk - nblk / 2); }
    } else {
        Gemm g{WS_B(WS_OM), WS_B(WS_WOUT), MP, DM, DM}; StaticOrder S; S.init(MP, DM, nblk, bid);
        EpiResid<false> E{(const void*)WS_B(WS_X), Xo, WS_F(WS_MOD) + 5 * DM, 1.0f};
        gemm_phase<EpiResid<false>, StaticOrder, true, true>(lds, g, S, E);
        if (!PROBE) for (int j = bid; j < DM / 32; j += nblk) {
            SEpiResid SE{nullptr, WS_B(WS_X), WS_F(WS_MOD) + 5 * DM, 1.0f, 32 * j};
            sgemm64_unit<false>(WS_B(WS_OM) + (size_t)MP * DM, DM, WS_B(WS_WOUT) + (size_t)(32 * j) * DM, WS_B(WS_WOUT), lds, SE); }
    }
}

constexpr size_t WS_QD = WS_PART + 48 * MiB, WS_KI = WS_QD + 17 * MiB, WS_DEC = WS_KI + 17 * MiB;
static_assert(WS_DEC + 2 * MiB <= 700 * MiB, "workspace map");
__device__ __forceinline__ void phase_hprep(ArgsRef a, int bid, int nblk) {
    const int tid = tid_opaque(), lane = tid & 63, w = tid >> 6;
    const float* LF = WS_F(WS_LF); const bf16* QA = WS_B(WS_QA);
    for (int item = bid * NWAVES + w; item < NB * NHEAD * (SEQ / 32); item += nblk * NWAVES) {
        const int u = item >> 6, c = item & 63, b = u >> 3, h = u & 7;
        const size_t g0 = (size_t)(b * SEQ + 32 * c) * DA + h * HD + 2 * lane;
        f32x2 bc = (f32x2){0.f, 0.f};
#pragma unroll 8
        for (int t = 0; t < 32; ++t) {
            const size_t o = g0 + (size_t)t * DA;
            const f32x2 l = *(const f32x2*)(LF + o); const unsigned q = *(const unsigned*)(QA + o);
            bc += l;
            const float k0 = 1.f - __builtin_amdgcn_exp2f(l.x), k1 = 1.f - __builtin_amdgcn_exp2f(l.y);
            const float e0 = __builtin_amdgcn_exp2f(bc.x), e1 = __builtin_amdgcn_exp2f(bc.y);
            const float n0 = __builtin_amdgcn_exp2f(-bc.x), n1 = __builtin_amdgcn_exp2f(-bc.y);
            *(unsigned*)(WS_B(WS_QD) + o) = cvtpk(bflo(q) * e0, bfhi(q) * e1);
            *(unsigned*)(WS_B(WS_KI) + o) = cvtpk(k0 * n0, k1 * n1);
        }
        const f32x2 tot = bc;
        *(f32x2*)(WS_F(WS_DEC) + ((size_t)u * 64 + c) * HD + 2 * lane) = (f32x2){__builtin_amdgcn_exp2f(tot.x), __builtin_amdgcn_exp2f(tot.y)};
    }
}

constexpr int HG_BUF = 25600, HG_QD = 0, HG_KI = 8192, HG_VV = 16384, HG_DEC = 24576, HG_SSX = 2 * HG_BUF;

__device__ __forceinline__ void hgrn_chain_prompt(ArgsRef a, LAS unsigned char* lds, int u) {
    const int tid = tid_opaque(), lane = tid & 63, w = __builtin_amdgcn_readfirstlane(tid >> 6);
    const int b = u >> 3, h = u & 7, row00 = b * SEQ;
    const bf16* IA = WS_B(WS_IA); const bf16* GA = WS_B(WS_GA);
    constexpr int NCH = SEQ / 32;
    if (w >= 4) {
        const int pt = tid - 256;
        const bf16* QD = WS_B(WS_QD); const bf16* KI = WS_B(WS_KI); const float* DEC = WS_F(WS_DEC) + (size_t)u * 64 * HD;
        const int row0 = pt >> 4, ch = pt & 15;
        const size_t gsrc = (size_t)(row00 + row0) * DA + h * HD + 8 * ch;
        const unsigned ld0 = off_a(row0, ch), ld1 = off_a(row0 + 16, ch);
        v4u rA[6], rB[6], rC[6], rD[6]; float dA = 0.f, dB = 0.f, dC = 0.f, dD = 0.f;
#define HG_LOAD(R, D, cc) do { const size_t o_ = gsrc + (size_t)(cc) * 32 * DA; R[0] = *(const v4u*)(QD + o_); R[1] = *(const v4u*)(QD + o_ + 16 * DA); R[2] = *(const v4u*)(KI + o_); R[3] = *(const v4u*)(KI + o_ + 16 * DA); \
            R[4] = *(const v4u*)(IA + o_); R[5] = *(const v4u*)(IA + o_ + 16 * DA); if (pt < 128) D = DEC[(size_t)(cc) * HD + pt]; } while (0)
#define HG_WRITE(R, D, cc) do { LAS unsigned char* b_ = lds + ((cc) & 1) * HG_BUF; *(LAS v4u*)(b_ + HG_QD + ld0) = R[0]; *(LAS v4u*)(b_ + HG_QD + ld1) = R[1]; *(LAS v4u*)(b_ + HG_KI + ld0) = R[2]; *(LAS v4u*)(b_ + HG_KI + ld1) = R[3]; \
            *(LAS v4u*)(b_ + HG_VV + ld0) = R[4]; *(LAS v4u*)(b_ + HG_VV + ld1) = R[5]; if (pt < 128) *(LAS float*)(b_ + HG_DEC + 4 * pt) = D; } while (0)
        HG_LOAD(rA, dA, 0); HG_LOAD(rB, dB, 1); HG_LOAD(rC, dC, 2); HG_LOAD(rD, dD, 3);
        for (int c = 0; c < NCH; c += 4) {
            HG_WRITE(rA, dA, c); if (c + 4 < NCH) HG_LOAD(rA, dA, c + 4);
            __syncthreads();
            HG_WRITE(rB, dB, c + 1); if (c + 5 < NCH) HG_LOAD(rB, dB, c + 5);
            __syncthreads();
            HG_WRITE(rC, dC, c + 2); if (c + 6 < NCH) HG_LOAD(rC, dC, c + 6);
            __syncthreads();
            HG_WRITE(rD, dD, c + 3); if (c + 7 < NCH) HG_LOAD(rD, dD, c + 7);
            __syncthreads();
        }
#undef HG_LOAD
#undef HG_WRITE
        __syncthreads();
    } else {
        const int r = lane & 31, hh = lane >> 5, q4 = (lane & 15) >> 2, p4 = lane & 3, blk = (lane >> 4) & 1;
        int pb[4];
#pragma unroll
        for (int x = 0; x < 4; ++x) pb[x] = (int)(2048u * (r >> 3) + 64u * (r & 7) + 16u * ((unsigned)x ^ ((r >> 2) & 3)) + 8u * hh);
        const int vp0 = (int)(64u * (4 * hh + q4) + 16u * ((2 * blk + (p4 >> 1)) ^ ((0u + hh) & 3)) + 8u * (p4 & 1));
        const int vp1 = (int)(2048u + 64u * (4 * hh + q4) + 16u * ((2 * blk + (p4 >> 1)) ^ ((2u + hh) & 3)) + 8u * (p4 & 1));
        const int nb0 = (int)(2048u * hh + 64u * q4 + 16u * ((2 * blk + (p4 >> 1)) ^ ((2u * hh) & 3)) + 8u * (p4 & 1));
        const int nb1 = (int)(2048u * hh + 64u * (4 + q4) + 16u * ((2 * blk + (p4 >> 1)) ^ ((2u * hh + 1) & 3)) + 8u * (p4 & 1));
        const int tm = r - 4 * hh;
        f32x16 S[4];
#pragma unroll
        for (int kt = 0; kt < 4; ++kt)
#pragma unroll
            for (int i = 0; i < 16; ++i) S[kt][i] = 0.f;
        f32x16 oprev;
#pragma unroll
        for (int i = 0; i < 16; ++i) oprev[i] = 0.f;
        const float* gwv = IN_F(I_GOA) + h * HD + 32 * w;
        f32x4 gvv[4]; v2u gprev[4];
#pragma unroll
        for (int g = 0; g < 4; ++g) { gvv[g] = *(const f32x4*)(gwv + 8 * g + 4 * hh); gprev[g] = (v2u){0u, 0u}; }
        __syncthreads();
        for (int c = 0; c < NCH; ++c) {
            const LAS unsigned char* buf = lds + (c & 1) * HG_BUF;
            v2u gcur[4];
            { const bf16* gp = GA + (size_t)(row00 + 32 * c + r) * DA + h * HD + 32 * w + 4 * hh;
#pragma unroll
              for (int g = 0; g < 4; ++g) gcur[g] = *(const v2u*)(gp + 8 * g); }
            if (c > 0) {
                const LAS float* sx = (const LAS float*)(lds + HG_SSX) + ((c - 1) & 1) * 128 + r;
                const float ss = (sx[0] + sx[32]) + (sx[64] + sx[96]);
                const float rstd = 1.0f / sqrtf(ss * (1.f / HD) + EPS);
                bf16* op = WS_B(WS_OM) + (size_t)(row00 + 32 * (c - 1) + r) * DM + h * HD + 32 * w + 4 * hh;
#pragma unroll
                for (int g = 0; g < 4; ++g) { const v2u gt = gprev[g];
                    v2u o2; o2.x = cvtpk(oprev[4 * g] * rstd * gvv[g].x * bflo(gt.x), oprev[4 * g + 1] * rstd * gvv[g].y * bfhi(gt.x));
                    o2.y = cvtpk(oprev[4 * g + 2] * rstd * gvv[g].z * bflo(gt.y), oprev[4 * g + 3] * rstd * gvv[g].w * bfhi(gt.y));
                    *(v2u*)(op + 8 * g) = o2; }
            }
            bf16x8 qd[8];
#pragma unroll
            for (int ks = 0; ks < 8; ++ks) { const v2u lo = *(const LAS v2u*)(buf + HG_QD + pb[2 * (ks & 1)] + 512 * (ks >> 1)), hi = *(const LAS v2u*)(buf + HG_QD + pb[2 * (ks & 1) + 1] + 512 * (ks >> 1));
                qd[ks] = __builtin_bit_cast(bf16x8, (v4u){lo.x, lo.y, hi.x, hi.y}); }
            f32x16 at;
#pragma unroll
            for (int i = 0; i < 16; ++i) at[i] = 0.f;
#pragma unroll
            for (int ks = 0; ks < 8; ++ks) { const v2u lo = *(const LAS v2u*)(buf + HG_KI + pb[2 * (ks & 1)] + 512 * (ks >> 1)), hi = *(const LAS v2u*)(buf + HG_KI + pb[2 * (ks & 1) + 1] + 512 * (ks >> 1));
                at = MFMA32(__builtin_bit_cast(bf16x8, (v4u){lo.x, lo.y, hi.x, hi.y}), qd[ks], at); }
            f32x16 o;
#pragma unroll
            for (int i = 0; i < 16; ++i) o[i] = 0.f;
#pragma unroll
            for (int kt = 0; kt < 4; ++kt) { o = MFMA32(pack8<0>(S[kt]), qd[2 * kt], o); o = MFMA32(pack8<1>(S[kt]), qd[2 * kt + 1], o); }
#pragma unroll
            for (int i = 0; i < 16; ++i) at[i] = ((i & 3) + 8 * (i >> 2) <= tm) ? at[i] : 0.f;
            { const bf16x8 p0 = pack8<0>(at), p1 = pack8<1>(at);
              const LAS unsigned char* vv = buf + HG_VV + 512 * w;
              { const s16x4 lo = vtr(vv + vp0), hi = vtr(vv + vp1); o = MFMA32(__builtin_shufflevector(lo, hi, 0, 1, 2, 3, 4, 5, 6, 7), p0, o); }
              { const s16x4 lo = vtr(vv + vp0 + 4096), hi = vtr(vv + vp1 + 4096); o = MFMA32(__builtin_shufflevector(lo, hi, 0, 1, 2, 3, 4, 5, 6, 7), p1, o); } }
            { const LAS unsigned char* vv = buf + HG_VV + 512 * w;
              const s16x4 a0 = vtr(vv + nb0), a1 = vtr(vv + nb1), a2 = vtr(vv + nb0 + 4096), a3 = vtr(vv + nb1 + 4096);
              const bf16x8 vf0 = __builtin_shufflevector(a0, a1, 0, 1, 2, 3, 4, 5, 6, 7), vf1 = __builtin_shufflevector(a2, a3, 0, 1, 2, 3, 4, 5, 6, 7);
#pragma unroll
              for (int kt = 0; kt < 4; ++kt) {
                  const LAS unsigned char* ki = buf + HG_KI + 512 * kt;
                  const s16x4 k0 = vtr(ki + nb0), k1 = vtr(ki + nb1), k2 = vtr(ki + nb0 + 4096), k3 = vtr(ki + nb1 + 4096);
                  S[kt] = MFMA32(__builtin_shufflevector(k0, k1, 0, 1, 2, 3, 4, 5, 6, 7), vf0, S[kt]);
                  S[kt] = MFMA32(__builtin_shufflevector(k2, k3, 0, 1, 2, 3, 4, 5, 6, 7), vf1, S[kt]);
#pragma unroll
                  for (int g = 0; g < 4; ++g) { const f32x4 dc = *(const LAS f32x4*)(buf + HG_DEC + 4 * (32 * kt + 8 * g + 4 * hh));
                      S[kt][4 * g] *= dc.x; S[kt][4 * g + 1] *= dc.y; S[kt][4 * g + 2] *= dc.z; S[kt][4 * g + 3] *= dc.w; }
              } }
            { float ss = 0.f;
#pragma unroll
              for (int i = 0; i < 16; ++i) ss += o[i] * o[i];
              ss += __shfl_xor(ss, 32);
              if (hh == 0) ((LAS float*)(lds + HG_SSX))[(c & 1) * 128 + w * 32 + r] = ss; }
            oprev = o;
#pragma unroll
            for (int g = 0; g < 4; ++g) gprev[g] = gcur[g];
            __syncthreads();
        }
        {
            const LAS float* sx = (const LAS float*)(lds + HG_SSX) + ((NCH - 1) & 1) * 128 + r;
            const float ss = (sx[0] + sx[32]) + (sx[64] + sx[96]);
            const float rstd = 1.0f / sqrtf(ss * (1.f / HD) + EPS);
            bf16* op = WS_B(WS_OM) + (size_t)(row00 + 32 * (NCH - 1) + r) * DM + h * HD + 32 * w + 4 * hh;
#pragma unroll
            for (int g = 0; g < 4; ++g) { const v2u gt = gprev[g];
                v2u o2; o2.x = cvtpk(oprev[4 * g] * rstd * gvv[g].x * bflo(gt.x), oprev[4 * g + 1] * rstd * gvv[g].y * bfhi(gt.x));
                o2.y = cvtpk(oprev[4 * g + 2] * rstd * gvv[g].z * bflo(gt.y), oprev[4 * g + 3] * rstd * gvv[g].w * bfhi(gt.y));
                *(v2u*)(op + 8 * g) = o2; }
        }
        float* sout = a.out + OFF_SP + (size_t)u * HD * HD;
#pragma unroll
        for (int kt = 0; kt < 4; ++kt)
#pragma unroll
            for (int i = 0; i < 16; ++i) sout[(size_t)(32 * kt + (i & 3) + 8 * (i >> 2) + 4 * hh) * HD + 32 * w + r] = S[kt][i];
    }
}
struct SbLane {
    int kb0, kb1;
    int vb0, vb1;
    bf16x8 nu0, nu1;
};
__device__ __forceinline__ SbLane sb_lane_init(int lane) {
    SbLane L; const unsigned r = lane & 31, h = lane >> 5, q = (lane & 15) >> 2, p = lane & 3, blk = (lane >> 4) & 1;
    L.kb0 = (int)(2048u * (r >> 3) + 64u * (r & 7) + 16u * ((0u + h) ^ ((r >> 2) & 3)));
    L.kb1 = (int)(2048u * (r >> 3) + 64u * (r & 7) + 16u * ((2u + h) ^ ((r >> 2) & 3)));
    L.vb0 = (int)(64u * (4 * h + q) + 16u * ((2 * blk + (p >> 1)) ^ ((0u + h) & 3)) + 8u * (p & 1));
    L.vb1 = (int)(2048u + 64u * (4 * h + q) + 16u * ((2 * blk + (p >> 1)) ^ ((2u + h) & 3)) + 8u * (p & 1));
#pragma unroll
    for (int j = 0; j < 8; ++j) { const unsigned k0 = 8 * (j >> 2) + 4 * h + (j & 3), k1 = 16 + k0;
        L.nu0[j] = (k0 >= r) ? (short)0xBF80 : (short)0; L.nu1[j] = (k1 >= r) ? (short)0xBF80 : (short)0; }
    return L;
}
__device__ __forceinline__ void sbm_step(const LAS unsigned char* kt, const LAS unsigned char* vt, const LAS unsigned char* qfl  , int qstride, float bias2, const SbLane& L, f32x16 (&o)[4], float& R, int lane, int tq) {
    f32x16 zt;
#pragma unroll
    for (int r = 0; r < 16; ++r) zt[r] = bias2;
#pragma unroll
    for (int s = 0; s < 8; ++s) { const bf16x8 kf = *(const LAS bf16x8*)(kt + ((s & 1) ? L.kb1 : L.kb0) + 512 * (s >> 1)); const bf16x8 qf = *(const LAS bf16x8*)(qfl + qstride * s); zt = MFMA32(kf, qf, zt); }
    f32x16 sp, cin;
#pragma unroll
    for (int r = 0; r < 16; ++r) {
        const float e = __builtin_amdgcn_exp2f(zt[r]); float l = __builtin_amdgcn_logf(1.f + e); l = zt[r] > 30.f ? zt[r] : l;
        l = ((r & 3) + 8 * (r >> 2) < tq) ? l : 0.f;
        sp[r] = l; cin[r] = zt[r] + R;
    }
    f32x16 out = MFMA32(L.nu0, pack8<0>(sp), cin);
    out = MFMA32(L.nu1, pack8<1>(sp), out);
    const float rn = out[0] - zt[0];
    R = __shfl(rn, lane & 31);
    f32x16 p;
#pragma unroll
    for (int r = 0; r < 16; ++r) { float v = __builtin_amdgcn_exp2f(out[r]); v = ((r & 3) + 8 * (r >> 2) < tq) ? v : 0.f; p[r] = v; }
    const bf16x8 p0 = pack8<0>(p), p1 = pack8<1>(p);
#pragma unroll
    for (int c = 0; c < 4; ++c) {
        { const s16x4 lo = vtr(vt + L.vb0 + 512 * c), hi = vtr(vt + L.vb1 + 512 * c); const bf16x8 vf = __builtin_shufflevector(lo, hi, 0, 1, 2, 3, 4, 5, 6, 7); o[c] = MFMA32(vf, p0, o[c]); }
        { const s16x4 lo = vtr(vt + L.vb0 + 4096 + 512 * c), hi = vtr(vt + L.vb1 + 4096 + 512 * c); const bf16x8 vf = __builtin_shufflevector(lo, hi, 0, 1, 2, 3, 4, 5, 6, 7); o[c] = MFMA32(vf, p1, o[c]); }
    }
}
__device__ __forceinline__ void sbm_finish(ArgsRef a, const f32x16 (&o)[4], int row, int h, int lane) {
    float ss = 0.f;
#pragma unroll
    for (int c = 0; c < 4; ++c)
#pragma unroll
        for (int r = 0; r < 16; ++r) ss += o[c][r] * o[c][r];
    ss += __shfl_xor(ss, 32);
    const float rstd = 1.0f / sqrtf(ss * (1.f / HD) + EPS);
    const int hh = lane >> 5; const float* gw = IN_F(I_GOB) + h * HD; bf16* dst = WS_B(WS_OM) + (size_t)row * DM + DA + h * HD;
#pragma unroll
    for (int c = 0; c < 4; ++c)
#pragma unroll
        for (int g = 0; g < 4; ++g) { const int d = 32 * c + 8 * g + 4 * hh; const f32x4 gv = *(const f32x4*)(gw + d);
            v2u w; w.x = cvtpk(o[c][4 * g + 0] * rstd * gv.x, o[c][4 * g + 1] * rstd * gv.y); w.y = cvtpk(o[c][4 * g + 2] * rstd * gv.z, o[c][4 * g + 3] * rstd * gv.w);
            *(v2u*)(dst + d) = w; }
}
__device__ __forceinline__ void sbm_unit_prompt(ArgsRef a, LAS unsigned char* lds, int bh, int qb) {
    const int tid = tid_opaque(), lane = tid & 63, w = __builtin_amdgcn_readfirstlane(tid >> 6);
    const int b = bh >> 3, h = bh & 7, q0 = 256 * qb + 32 * w, idiag = 8 * qb + w;
    const SbLane L = sb_lane_init(lane);
    const bf16* QB = WS_B(WS_QB); const bf16* KB = WS_B(WS_KB); const bf16* VB = WS_B(WS_VB);
    LAS unsigned char* qfl = lds + 65536 + w * 8192 + lane * 16;
    { const bf16* qp = QB + (size_t)(b * SEQ + q0 + (lane & 31)) * DA + h * HD + 8 * (lane >> 5);
#pragma unroll
      for (int s = 0; s < 8; ++s) *(LAS bf16x8*)(qfl + 1024 * s) = *(const bf16x8*)(qp + 16 * s); }
    const float bias2 = IN_F(I_BSB)[h] * LOG2E;
    f32x16 o[4];
#pragma unroll
    for (int c = 0; c < 4; ++c)
#pragma unroll
        for (int r = 0; r < 16; ++r) o[c][r] = 0.f;
    float R = 0.f; const int tq = (lane & 31) - 4 * (lane >> 5);
    const int key0 = tid >> 4, ch = tid & 15;
    const size_t gsrc = (size_t)(b * SEQ + key0) * DA + h * HD + 8 * ch;
    const unsigned ldst = off_a(key0 & 31, ch);
    v4u kr[2], vr[2], kr2[2], vr2[2];
    int j = 4 * qb + 3;
#define SBM_LOAD(KR, VR, jj) do { const size_t o_ = gsrc + (size_t)(jj) * 64 * DA; KR[0] = *(const v4u*)(KB + o_); VR[0] = *(const v4u*)(VB + o_); KR[1] = *(const v4u*)(KB + o_ + 32 * DA); VR[1] = *(const v4u*)(VB + o_ + 32 * DA); } while (0)
#define SBM_WRITE(KR, VR, buf) do { LAS unsigned char* b_ = lds + (buf) * 32768; *(LAS v4u*)(b_ + ldst) = KR[0]; *(LAS v4u*)(b_ + 8192 + ldst) = KR[1]; *(LAS v4u*)(b_ + 16384 + ldst) = VR[0]; *(LAS v4u*)(b_ + 16384 + 8192 + ldst) = VR[1]; } while (0)
#define SBM_STAGE(jj, cc) do { const LAS unsigned char* kb_ = lds + (cc) * 32768; const LAS unsigned char* vb_ = kb_ + 16384; \
        _Pragma("unroll 1") for (int tt = 1; tt >= 0; --tt) { const int ti = 2 * (jj) + tt; \
            if (ti <= idiag) sbm_step(kb_ + tt * 8192, vb_ + tt * 8192, qfl, 1024, bias2, L, o, R, lane, ti == idiag ? tq : 64); } } while (0)
    SBM_LOAD(kr, vr, j); SBM_WRITE(kr, vr, 0);
    if (j > 0) SBM_LOAD(kr, vr, j - 1);
    __syncthreads();
    for (; j >= 0; j -= 2) {
        if (j > 1) SBM_LOAD(kr2, vr2, j - 2);
        SBM_STAGE(j, 0);
        SBM_WRITE(kr, vr, 1);
        __syncthreads();
        if (j > 2) SBM_LOAD(kr, vr, j - 3);
        SBM_STAGE(j - 1, 1);
        if (j > 1) SBM_WRITE(kr2, vr2, 0);
        __syncthreads();
    }
#undef SBM_STAGE
#undef SBM_LOAD
#undef SBM_WRITE
    sbm_finish(a, o, b * SEQ + q0 + (lane & 31), h, lane);
}


constexpr int SEGK = 256, NSEG = PAST / SEGK, PART_STRIDE = 132;
__device__ __forceinline__ void sbm_unit_sample(ArgsRef a, LAS unsigned char* lds, int b, int seg) {
    const int tid = tid_opaque(), lane = tid & 63, w = __builtin_amdgcn_readfirstlane(tid >> 6);
    const SbLane L = sb_lane_init(lane);
    LAS unsigned char* kimg = lds + w * 16384; LAS unsigned char* vimg = kimg + 8192;
    LAS unsigned char* qreg = lds + 131072 + w * 2048;
    LAS unsigned char* zchunk = lds + 131072 + 16384 + w * 16;
    const int r = lane & 31, hh = lane >> 5;
    if (r < 8) { const bf16* qp = WS_B(WS_QB) + (size_t)(MP + b * DECT + r) * DA + w * HD + 8 * hh;
#pragma unroll
        for (int s = 0; s < 8; ++s) *(LAS bf16x8*)(qreg + (s * 16 + hh * 8 + r) * 16) = *(const bf16x8*)(qp + 16 * s); }
    if (lane == 0) { unsigned z_ = 0u; asm volatile("" : "+v"(z_)); *(LAS v4u*)zchunk = (v4u){z_, z_, z_, z_}; }
    const LAS unsigned char* qfl = r < 8 ? qreg + (hh * 8 + r) * 16 : zchunk; const int qstride = r < 8 ? 256 : 0;
    const float bias2 = IN_F(I_BSB)[w] * LOG2E;
    f32x16 o[4];
#pragma unroll
    for (int c = 0; c < 4; ++c)
#pragma unroll
        for (int q = 0; q < 16; ++q) o[c][q] = 0.f;
    float R = 0.f;
    LDS_WAIT();
    if (seg == NSEG - 1) {
        { const int j = lane >> 3, c2 = (lane & 7) * 2; const size_t src = (size_t)(MP + b * DECT + j) * DA + w * HD + 8 * c2;
          const v4u k0 = *(const v4u*)(WS_B(WS_KB) + src), k1 = *(const v4u*)(WS_B(WS_KB) + src + 8), v0 = *(const v4u*)(WS_B(WS_VB) + src), v1 = *(const v4u*)(WS_B(WS_VB) + src + 8);
          *(LAS v4u*)(kimg + off_a(j, c2)) = k0; *(LAS v4u*)(kimg + off_a(j, c2 + 1)) = k1; *(LAS v4u*)(vimg + off_a(j, c2)) = v0; *(LAS v4u*)(vimg + off_a(j, c2 + 1)) = v1; }
        { unsigned z_ = 0u; asm volatile("" : "+v"(z_)); const v4u zz = (v4u){z_, z_, z_, z_};
#pragma unroll
        for (int i = 0; i < 6; ++i) { const int n = lane + 64 * i, row = 8 + (n >> 4), c1 = n & 15; *(LAS v4u*)(kimg + off_a(row, c1)) = zz; *(LAS v4u*)(vimg + off_a(row, c1)) = zz; } }
        LDS_WAIT();
        sbm_step(kimg, vimg, qfl, qstride, bias2, L, o, R, lane, r - 4 * hh);
        LDS_WAIT();
    }
    const int* pt = (const int*)a.in[I_PT] + b * NPAGES;
    const float* ck = IN_F(I_CK); const float* cv = IN_F(I_CV);
    const int ch = r >> 1; const unsigned wconst = 512u * (ch >> 2) + 64u * hh + 8u * (lane & 1);
    f32x4 kr[8], vr[8];
#define SBS_LOAD(ti, hf) do { const int p_ = seg * SEGK + 32 * (ti); const size_t base_ = ((size_t)pt[p_ >> 7] * PAGE + (p_ & 127) + 16 * (hf) + hh) * (NHEAD * HD) + w * HD + 4 * r; \
        _Pragma("unroll") for (int i_ = 0; i_ < 8; ++i_) { kr[i_] = *(const f32x4*)(ck + base_ + (size_t)(2 * i_) * (NHEAD * HD)); vr[i_] = *(const f32x4*)(cv + base_ + (size_t)(2 * i_) * (NHEAD * HD)); } } while (0)
#define SBS_WRITE(hf) do { _Pragma("unroll") for (int i_ = 0; i_ < 8; ++i_) { \
        const unsigned off_ = 2048u * (2 * (hf) + (i_ >> 2)) + 64u * (2 * (i_ & 3)) + 16u * ((unsigned)(ch & 3) ^ (unsigned)((i_ >> 1) & 3)) + wconst; \
        v2u kk_, vv_; kk_.x = cvtpk(kr[i_].x, kr[i_].y); kk_.y = cvtpk(kr[i_].z, kr[i_].w); vv_.x = cvtpk(vr[i_].x, vr[i_].y); vv_.y = cvtpk(vr[i_].z, vr[i_].w); \
        *(LAS v2u*)(kimg + off_) = kk_; *(LAS v2u*)(vimg + off_) = vv_; } } while (0)
    SBS_LOAD(SEGK / 32 - 1, 1);
#pragma unroll 1
    for (int ti = SEGK / 32 - 1; ti >= 0; --ti) {
        SBS_WRITE(1);
        SBS_LOAD(ti, 0);
        SBS_WRITE(0);
        if (ti > 0) SBS_LOAD(ti - 1, 1);
        LDS_WAIT();
        sbm_step(kimg, vimg, qfl, qstride, bias2, L, o, R, lane, 64);
        LDS_WAIT();
    }
#undef SBS_LOAD
#undef SBS_WRITE
    if (r < 8) { float* dst = WS_F(WS_PART) + ((((size_t)b * NSEG + seg) * NHEAD + w) * 8 + r) * PART_STRIDE;
#pragma unroll
        for (int c = 0; c < 4; ++c)
#pragma unroll
            for (int g = 0; g < 4; ++g) *(f32x4*)(dst + 32 * c + 8 * g + 4 * hh) = (f32x4){o[c][4 * g], o[c][4 * g + 1], o[c][4 * g + 2], o[c][4 * g + 3]};
        if (hh == 0) dst[128] = R; }
}
__device__ __forceinline__ void phase_sbcombine(ArgsRef a, int bid, int nblk) {
    const int tid = tid_opaque(), lane = tid & 63, w = tid >> 6;
    static_assert(NSEG == 64, "one lane per segment");
    for (int item = bid * NWAVES + w; item < DECB * NHEAD * 8; item += nblk * NWAVES) {
        const int b = item >> 6, h = (item >> 3) & 7, i = item & 7;
        const float* p0 = WS_F(WS_PART) + (((size_t)b * NSEG * NHEAD + h) * 8 + i) * PART_STRIDE;
        const size_t sstride = (size_t)NHEAD * 8 * PART_STRIDE;
        const float rseg = p0[(size_t)lane * sstride + 128];
        float suf = rseg;
#pragma unroll
        for (int off = 1; off < 64; off <<= 1) { const float t = __shfl_down(suf, off); if (lane + off < 64) suf += t; }
        const float fac = __builtin_amdgcn_exp2f(suf - rseg);
        float o0 = 0.f, o1 = 0.f;
#pragma unroll 8
        for (int s = 0; s < NSEG; ++s) { const float f = __builtin_bit_cast(float, __builtin_amdgcn_readlane(__builtin_bit_cast(int, fac), s));
            o0 += f * p0[(size_t)s * sstride + lane]; o1 += f * p0[(size_t)s * sstride + 64 + lane]; }
        const float ss = wave_sum(o0 * o0 + o1 * o1);
        const float rstd = 1.0f / sqrtf(ss * (1.f / HD) + EPS);
        const float* gw = IN_F(I_GOB) + h * HD; bf16* dst = WS_B(WS_OM) + (size_t)(MP + b * DECT + i) * DM + DA + h * HD;
        dst[lane] = (bf16)f2bf(o0 * rstd * gw[lane]); dst[64 + lane] = (bf16)f2bf(o1 * rstd * gw[64 + lane]);
    }
}

constexpr int CTL_MIXQ = 4096;
__device__ __forceinline__ int queue_next(ArgsRef a, LAS unsigned char* lds, int tid, int qword) {
    LAS int* slot = (LAS int*)(lds + LDS_BYTES - 64);
    __syncthreads();
    if (tid == 0) *slot = (int)__hip_atomic_fetch_add((unsigned*)(a.ws + WS_CTL) + qword, 1u, __ATOMIC_RELAXED, __HIP_MEMORY_SCOPE_AGENT);
    __syncthreads();
    return *slot;
}
__device__ __forceinline__ void phase_mixer(ArgsRef a, LAS unsigned char* lds, int bid, int nblk, int qword = CTL_MIXQ, int ulo = 0, int uhi = 1 << 30, int skip = 0  ) {
    const int tid = tid_opaque();
    constexpr int U0 = 32, U2 = U0 + 256 + DECB * NSEG, U3 = U2 + 64;
    static_assert(DECB * NSEG == 512, "two streaming units per prompt block");
    for (;;) {
        const int u = queue_next(a, lds, tid, qword) + ulo;
        if (u >= U3 || u >= uhi) break;
        if (u < U0) hgrn_chain_prompt(a, lds, u);
        else if (u < U2) { const int k = u - U0, g = k / 3, r3 = k - 3 * g;
            if (r3 == 0) { if (skip != 2) sbm_unit_prompt(a, lds, g & 31, 7 - (g >> 5)); }
            else if (skip != 1) { const int v = 2 * g + r3 - 1; sbm_unit_sample(a, lds, v & 7, NSEG - 1 - (v >> 3)); } }
        else hgrn_unit(a, lds, 32 + (u - U2));
    }
}

enum { PH_MOD = 0, PH_CVT, PH_NORM1, PH_G1, PH_G2, PH_NORM2, PH_G3, PH_MIX, PH_G4, PH_NORM3, PH_G5, PH_G6, PH_FINAL, N_PHASES };

template <int PH> __device__ __forceinline__ void run_phase(ArgsRef a, LAS unsigned char* lds, int bid, int nblk) {
    if constexpr (PH == PH_MOD) phase_mod(a, lds, bid, nblk);
    else if constexpr (PH == PH_CVT) phase_cvt<0>(a, lds, bid, nblk);
    else if constexpr (PH == PH_NORM1) phase_norm<false, true>(a, bid, nblk, IN_F(I_N1), WS_F(WS_MOD), NMODC, 0 * DM, 1 * DM);
    else if constexpr (PH == PH_G1) phase_gemm<1>(a, lds, bid, nblk);
    else if constexpr (PH == PH_G2) phase_gemm<2>(a, lds, bid, nblk);
    else if constexpr (PH == PH_NORM2) phase_norm<false, false>(a, bid, nblk, IN_F(I_NM), WS_F(WS_MOD), NMODC, 3 * DM, 4 * DM);
    else if constexpr (PH == PH_G3) phase_gemm<3>(a, lds, bid, nblk);
    else if constexpr (PH == PH_MIX) phase_mixer(a, lds, bid, nblk);
    else if constexpr (PH == PH_G4) phase_gemm<4>(a, lds, bid, nblk);
    else if constexpr (PH == PH_NORM3) phase_norm<false, false>(a, bid, nblk, IN_F(I_N2), WS_F(WS_MOD), NMODC, 6 * DM, 7 * DM);
    else if constexpr (PH == PH_G5) phase_gemm<5>(a, lds, bid, nblk);
    else if constexpr (PH == PH_G6) phase_gemm<6>(a, lds, bid, nblk);
    else phase_norm<true, false>(a, bid, nblk, IN_F(I_NF), WS_F(WS_FMOD), NFMODC, 0, DM);
}

#define XB_TMO      128
#define XB_XCNT(j)  (256  + 64 * (j))
#define XB_XSUB(j)  (1280 + 64 * (j))
#define XB_XGEN(j)  (2304 + 64 * (j))
#define XB_TOP      3328
#define XB_TOPGEN   3392
#define XCD_BAR_WORDS 3456
#define XB_SPIN_CAP (1u << 18)

__device__ __forceinline__ unsigned xb_ld(unsigned* p)              { return __hip_atomic_load(p, __ATOMIC_RELAXED, __HIP_MEMORY_SCOPE_AGENT); }
__device__ __forceinline__ unsigned xb_add(unsigned* p, unsigned v) { return __hip_atomic_fetch_add(p, v, __ATOMIC_RELAXED, __HIP_MEMORY_SCOPE_AGENT); }
__device__ __forceinline__ unsigned xb_xcc_id() { return (unsigned)__builtin_amdgcn_s_getreg((3 << 11) | 20) & 0xFu; }
#define XB_SPIN(cond, bar) do { unsigned _sp = 0; while (cond) { __builtin_amdgcn_s_sleep(1); \
    if ((++_sp & 255u) == 0u) { if (xb_ld(&(bar)[XB_TMO])) break; if (_sp > XB_SPIN_CAP) { atomicAdd(&(bar)[XB_TMO], 1u); break; } } } } while (0)

struct XcdBarrier {
    unsigned* bar; unsigned x;
    volatile LAS unsigned* st;
};

__device__ __forceinline__ XcdBarrier xcd_barrier_post(unsigned* bar, volatile LAS unsigned* st) {
    XcdBarrier b; b.bar = bar; b.x = xb_xcc_id(); b.st = st;
    if (threadIdx.x == 0) (void)xb_add(&bar[XB_XCNT(b.x)], 1u);
    return b;
}
__device__ __forceinline__ void xcd_barrier_complete(unsigned* bar, unsigned x, unsigned& nloc, unsigned& nx) {
    const unsigned G = gridDim.x * gridDim.y * gridDim.z;
    unsigned sum, cnt, mine, sp = 0u;
    for (;;) {
        sum = 0u; cnt = 0u; mine = 0u;
#pragma unroll
        for (unsigned j = 0; j < 16; ++j) { const unsigned c = xb_ld(&bar[XB_XCNT(j)]); sum += c; cnt += (c > 0u) ? 1u : 0u; mine = (j == x) ? c : mine; }
        if (sum == G) break;
        __builtin_amdgcn_s_sleep(1);
        if ((++sp & 255u) == 0u) { if (xb_ld(&bar[XB_TMO])) break; if (sp > XB_SPIN_CAP) { atomicAdd(&bar[XB_TMO], 1u); break; } }
    }
    nloc = mine > 0u ? mine : 1u; nx = cnt > 0u ? cnt : 1u;
}

__device__ __forceinline__ void xcd_barrier(const XcdBarrier& b) {
    asm volatile("s_waitcnt vmcnt(0)" ::: "memory");
    __syncthreads();
    if (threadIdx.x == 0) {
        unsigned* bar = b.bar;
        __builtin_amdgcn_s_waitcnt(0);
        unsigned nloc = b.st[0], nx = b.st[1];
        if (nloc == 0u) { xcd_barrier_complete(bar, b.x, nloc, nx); b.st[0] = nloc; b.st[1] = nx; }
        const unsigned old = xb_add(&bar[XB_XSUB(b.x)], 1u);
        const unsigned gen = old / nloc;
        if (old + 1u == (gen + 1u) * nloc) {
            __builtin_amdgcn_fence(__ATOMIC_RELEASE, "agent");
            asm volatile("s_waitcnt vmcnt(0)" ::: "memory");
            const unsigned og = xb_add(&bar[XB_TOP], 1u);
            const unsigned tg = og / nx;
            if (og + 1u == (tg + 1u) * nx) xb_add(&bar[XB_TOPGEN], 1u);
            else XB_SPIN(xb_ld(&bar[XB_TOPGEN]) == tg, bar);
            __builtin_amdgcn_fence(__ATOMIC_ACQUIRE, "agent");
            xb_add(&bar[XB_XGEN(b.x)], 1u);
            asm volatile("s_waitcnt vmcnt(0)" ::: "memory");
        } else {
            XB_SPIN(xb_ld(&bar[XB_XGEN(b.x)]) == gen, bar);
            __builtin_amdgcn_fence(__ATOMIC_ACQUIRE, "agent");
            asm volatile("s_waitcnt vmcnt(0)" ::: "memory");
        }
    }
    __syncthreads();
}


constexpr int LDS_BAR_OFF = LDS_BYTES;
constexpr int LDS_TOTAL = LDS_BYTES + 64;

__device__ __forceinline__ ArgsPtr args_opaque(ArgsPtr p) { asm volatile("" : "+s"(p)); return p; }
__global__ void __launch_bounds__(NTHR, 2) mega_fwd(Args a_) {
    extern __shared__ __attribute__((aligned(16))) unsigned char lds_raw[];
    LAS unsigned char* lds = (LAS unsigned char*)lds_raw;
    const int bid = (int)blockIdx.x, nblk = (int)gridDim.x;
    ArgsPtr kp = (ArgsPtr)__builtin_amdgcn_kernarg_segment_ptr();
#define a (*args_opaque(kp))
    if (threadIdx.x < 16) ((LAS unsigned*)(lds + LDS_BAR_OFF))[threadIdx.x] = 0u;
    __syncthreads();
    XcdBarrier bar = xcd_barrier_post((unsigned*)(a.ws + WS_CTL), (volatile LAS unsigned*)(lds + LDS_BAR_OFF));
    run_phase<PH_MOD>(a, lds, bid, nblk);
    __syncthreads();
    run_phase<PH_CVT>(a, lds, bid, nblk);
    xcd_barrier(bar);
#ifdef PROBE_DUP_MOD
    run_phase<PH_MOD>(a, lds, bid, nblk);
    xcd_barrier(bar);
#endif
#ifdef PROBE_DUP_CVT
    run_phase<PH_CVT>(a, lds, bid, nblk);
    xcd_barrier(bar);
#endif
#ifdef PROBE_DUP_P0
    run_phase<PH_MOD>(a, lds, bid, nblk);
    __syncthreads();
    run_phase<PH_CVT>(a, lds, bid, nblk);
    xcd_barrier(bar);
#endif
    run_phase<PH_NORM1>(a, lds, bid, nblk);
    xcd_barrier(bar);
#ifdef PROBE_DUP_N1
    run_phase<PH_NORM1>(a, lds, bid, nblk);
    xcd_barrier(bar);
#endif
    run_phase<PH_G1>(a, lds, bid, nblk);
    xcd_barrier(bar);
#ifdef PROBE_DUP_G1
    run_phase<PH_G1>(a, lds, bid, nblk);
    xcd_barrier(bar);
#endif
    run_phase<PH_G2>(a, lds, bid, nblk);
    xcd_barrier(bar);
#ifdef PROBE_DUP_G2
    run_phase<PH_G2>(a, lds, bid, nblk);
    xcd_barrier(bar);
#endif
    run_phase<PH_NORM2>(a, lds, bid, nblk);
    xcd_barrier(bar);
#ifdef PROBE_DUP_N2
    run_phase<PH_NORM2>(a, lds, bid, nblk);
    xcd_barrier(bar);
#endif
    run_phase<PH_G3>(a, lds, bid, nblk);
    xcd_barrier(bar);
#ifdef PROBE_DUP_G3
    run_phase<PH_G3>(a, lds, bid, nblk);
    xcd_barrier(bar);
#endif
    phase_hprep(a, bid, nblk);
    xcd_barrier(bar);
#ifdef PROBE_DUP_HP
    phase_hprep(a, bid, nblk);
    xcd_barrier(bar);
#endif
    run_phase<PH_MIX>(a, lds, bid, nblk);
    xcd_barrier(bar);
#ifdef PROBE_DUP_MIX
    phase_mixer(a, lds, bid, nblk, CTL_MIXQ + 64, PROBE_MIX_LO, PROBE_MIX_HI, PROBE_MIX_SKIP);
    xcd_barrier(bar);
#endif
    phase_sbcombine(a, bid, nblk);
    xcd_barrier(bar);
#ifdef PROBE_DUP_CB
    phase_sbcombine(a, bid, nblk);
    xcd_barrier(bar);
#endif
    run_phase<PH_G4>(a, lds, bid, nblk);
    xcd_barrier(bar);
#ifdef PROBE_DUP_G4
    phase_gemm<4, true>(a, lds, bid, nblk);
    xcd_barrier(bar);
#endif
    run_phase<PH_NORM3>(a, lds, bid, nblk);
    xcd_barrier(bar);
    run_phase<PH_G5>(a, lds, bid, nblk);
    xcd_barrier(bar);
    run_phase<PH_G6>(a, lds, bid, nblk);
    xcd_barrier(bar);
#ifdef PROBE_DUP_G6
    phase_gemm<6, true>(a, lds, bid, nblk);
    xcd_barrier(bar);
#endif
    run_phase<PH_FINAL>(a, lds, bid, nblk);
#ifdef PROBE_DUP_FIN
    xcd_barrier(bar);
    run_phase<PH_FINAL>(a, lds, bid, nblk);
#endif
#undef a
}

extern "C" void kernel_launch(void* const* d_in, const int* in_sizes, int n_in, void* d_out, int out_size, void* d_ws, size_t ws_size, hipStream_t stream) {
    static int grid = 0;
    if (grid == 0) {
        if (n_in != N_IN || (size_t)out_size != OUT_TOTAL || ws_size < WS_END) { fprintf(stderr, "kernel_launch: unexpected shapes (n_in %d, out %d, ws %zu)\n", n_in, out_size, ws_size); grid = -1; return; }
        int dev = 0, cus = 0, per_cu = 0;
        if (hipGetDevice(&dev) != hipSuccess || hipDeviceGetAttribute(&cus, hipDeviceAttributeMultiprocessorCount, dev) != hipSuccess) { grid = -1; return; }
        if (hipFuncSetAttribute((const void*)mega_fwd, hipFuncAttributeMaxDynamicSharedMemorySize, LDS_TOTAL) != hipSuccess) { fprintf(stderr, "kernel_launch: hipFuncSetAttribute failed\n"); grid = -1; return; }
        if (hipOccupancyMaxActiveBlocksPerMultiprocessor(&per_cu, (const void*)mega_fwd, NTHR, LDS_TOTAL) != hipSuccess || per_cu < 1) { fprintf(stderr, "kernel_launch: occupancy query says %d blocks per CU\n", per_cu); grid = -1; (void)hipGetLastError(); return; }
        grid = cus;
    }
    if (grid < 0) return;
    (void)hipMemsetAsync((char*)d_ws + WS_CTL, 0, 65536, stream);
    Args a{};
    for (int i = 0; i < N_IN; ++i) a.in[i] = d_in[i];
    a.out = (float*)d_out; a.ws = (unsigned char*)d_ws;
    hipLaunchKernelGGL(mega_fwd, dim3(grid), dim3(NTHR), LDS_TOTAL, stream, a);
}
```
